# Optimizing an MI355X kernel written in HIP

```python
import math
import jax
import jax.numpy as jnp
from jax import lax
import numpy as np

D_MODEL = 2048
BATCH = 4
SEQ = 2048
DEPTH = 2

MIX_WIDTH = D_MODEL
N_MIXERS = 4
GROUP_WIDTH = MIX_WIDTH // N_MIXERS
FN_HEADS = 4
FN_HEAD_DIM = GROUP_WIDTH // FN_HEADS
S5_GROUP_CH = 16
S5_GROUPS = GROUP_WIDTH // S5_GROUP_CH
S5_STATE = 64
HEAD_DIM = 128
ATT_HEADS = GROUP_WIDTH // HEAD_DIM
KV_HEADS = ATT_HEADS // 2
Q_BLOCK = 128
GRID_W = 64
ROPE_THETA = 10000.0
AXIS_ROT_DIM = HEAD_DIM // 2
RW_HEAD_DIM = 64
RW_HEADS = GROUP_WIDTH // RW_HEAD_DIM
RW_DECAY_LORA = 32
RW_AICL_LORA = 32
RW_GATE_LORA = 96
RW_GN_EPS = 64e-5
PEER_HEADS = 8
PEER_KEY_DIM = 128
PEER_HALF = PEER_KEY_DIM // 2
PEER_N_KEYS = 128
PEER_EXPERTS = PEER_N_KEYS * PEER_N_KEYS
PEER_TOPK = 16
PEER_CHUNK = 128
NORM_EPS = 1e-6

COL_SIZES = (GROUP_WIDTH, GROUP_WIDTH, ATT_HEADS * HEAD_DIM, KV_HEADS * HEAD_DIM,
             KV_HEADS * HEAD_DIM, GROUP_WIDTH, GROUP_WIDTH, GROUP_WIDTH, GROUP_WIDTH)
PROJ_WIDTH = sum(COL_SIZES)
SPLIT_POINTS = tuple(sum(COL_SIZES[:i + 1]) for i in range(len(COL_SIZES) - 1))

kernel_name = 'hymba_style_hybrid_encoder_peer'


def rms_norm(x, gain):
    xf = x.astype(jnp.float32)
    y = xf * lax.rsqrt(jnp.mean(xf * xf, axis=-1, keepdims=True) + NORM_EPS)
    return (y * gain.astype(jnp.float32)).astype(x.dtype)


def fourier_mix(u, w_f):
    bn, s, _ = u.shape
    uh = u.astype(jnp.float32).reshape(bn, s, FN_HEADS, FN_HEAD_DIM)
    f = jnp.fft.fft2(uh, axes=(1, 3), norm='ortho').real
    return f.reshape(bn, s, GROUP_WIDTH).astype(u.dtype) @ w_f


def _ssm_combine(e1, e2):
    a1, b1 = e1
    a2, b2 = e2
    return a1 * a2, a2 * b1 + b2


def s5_mix(u, lam_re, lam_im, log_step, b_re, b_im, c_re, c_im, d_skip, w_glu):
    f32 = jnp.float32
    bn, s, _ = u.shape
    uf = u.astype(f32).reshape(bn, s, S5_GROUPS, S5_GROUP_CH)
    uc = uf.astype(jnp.complex64)
    ys = []
    for d in range(2):
        lam = lax.complex(lam_re[d].astype(f32), lam_im[d].astype(f32))
        step = jnp.exp(log_step[d].astype(f32))[:, None]
        lam_bar = jnp.exp(lam * step)
        bmat = lax.complex(b_re[d].astype(f32), b_im[d].astype(f32))
        b_bar = ((lam_bar - 1.0) / lam)[..., None] * bmat
        bu = jnp.einsum('gph,bsgh->bsgp', b_bar, uc)
        a = jnp.broadcast_to(lam_bar, bu.shape)
        _, states = lax.associative_scan(_ssm_combine, (a, bu), reverse=(d == 1), axis=1)
        cmat = lax.complex(c_re[d].astype(f32), c_im[d].astype(f32))
        ys.append(jnp.einsum('ghp,bsgp->bsgh', cmat, states).real)
    y = ys[0] + ys[1] + d_skip.astype(f32) * uf
    y = jax.nn.gelu(y.reshape(bn, s, GROUP_WIDTH)).astype(u.dtype)
    return y * jax.nn.sigmoid(y @ w_glu)


def axial_rope_tables(seq_len):
    rows = seq_len // GRID_W
    row_id = jnp.repeat(jnp.arange(rows), GRID_W).astype(jnp.float32)
    col_id = jnp.tile(jnp.arange(GRID_W), rows).astype(jnp.float32)
    inv = ROPE_THETA ** (-jnp.arange(0, AXIS_ROT_DIM, 2, dtype=jnp.float32) / AXIS_ROT_DIM)
    ang = jnp.concatenate([row_id[:, None] * inv, col_id[:, None] * inv], axis=-1)
    return jnp.cos(ang), jnp.sin(ang)


def apply_rope(x, cos, sin):
    xf = x.astype(jnp.float32)
    half = HEAD_DIM // 2
    x1, x2 = xf[..., :half], xf[..., half:]
    c = cos[None, :, None, :]
    s = sin[None, :, None, :]
    return jnp.concatenate([x1 * c - x2 * s, x1 * s + x2 * c], axis=-1).astype(x.dtype)


def block_attention(q, k, v):
    bn, s, _, _ = q.shape
    rep = ATT_HEADS // KV_HEADS
    nb = s // Q_BLOCK
    qb = q.reshape(bn, nb, Q_BLOCK, KV_HEADS, rep, HEAD_DIM).transpose(1, 0, 2, 3, 4, 5)
    scale = HEAD_DIM ** -0.5

    def one_block(qblk):
        sc = jnp.einsum('bqgrd,bkgd->bgrqk', qblk, k, preferred_element_type=jnp.float32) * scale
        p = jax.nn.softmax(sc, axis=-1).astype(v.dtype)
        return jnp.einsum('bgrqk,bkgd->bqgrd', p, v)

    o = lax.map(one_block, qb)
    return o.transpose(1, 0, 2, 3, 4, 5).reshape(bn, s, ATT_HEADS * HEAD_DIM)


def attention_mix(q, k, v, q_gain, k_gain, cos, sin):
    bn, s, _ = q.shape
    q = q.reshape(bn, s, ATT_HEADS, HEAD_DIM)
    k = k.reshape(bn, s, KV_HEADS, HEAD_DIM)
    v = v.reshape(bn, s, KV_HEADS, HEAD_DIM)
    q = apply_rope(rms_norm(q, q_gain), cos, sin)
    k = apply_rope(rms_norm(k, k_gain), cos, sin)
    return block_attention(q, k, v)


def centred_shift(x, mu):
    prev = jnp.pad(x[:, :-1], ((0, 0), (1, 0), (0, 0)))
    nxt = jnp.pad(x[:, 1:], ((0, 0), (0, 1), (0, 0)))
    return x + (prev - x) * mu[0] + (nxt - x) * mu[1]


def rwkv_scan(r, w, k, v, kk, b, reverse):
    bn, _, h, n = r.shape

    def step(state, inp):
        r_t, w_t, k_t, v_t, kk_t, b_t = inp
        sa = jnp.einsum('bhvk,bhk->bhv', state, -kk_t)
        state = (state * w_t[:, :, None, :] + sa[..., None] * b_t[:, :, None, :]
                 + v_t[..., None] * k_t[:, :, None, :])
        return state, jnp.einsum('bhvk,bhk->bhv', state, r_t)

    s0 = jnp.zeros((bn, h, n, n), jnp.float32)
    xs = tuple(jnp.moveaxis(t, 1, 0) for t in (r, w, k, v, kk, b))
    _, ys = lax.scan(step, s0, xs, reverse=reverse)
    return jnp.moveaxis(ys, 0, 1)


def rwkv7_mix(r, k, v, z, mu, w0, w1, w2, a0, a1, a2, g1, g2, k_k, k_a, r_k, ln_w, ln_b):
    f32 = jnp.float32
    bn, s, c = r.shape
    r = centred_shift(r, mu[0])
    k = centred_shift(k, mu[1])
    v = centred_shift(v, mu[2])
    z = centred_shift(z, mu[3])

    def heads(t):
        return t.astype(f32).reshape(bn, s, RW_HEADS, RW_HEAD_DIM)

    g = jax.nn.sigmoid(z @ g1) @ g2
    kk = heads(k * k_k)
    kk = kk * lax.rsqrt(jnp.sum(kk * kk, axis=-1, keepdims=True) + 1e-12)
    rh = heads(r)
    vh = heads(v)
    ys = []
    bonuses = []
    for d in range(2):
        w_log = -jax.nn.softplus(-(w0[d] + jnp.tanh(z @ w1[d]) @ w2[d])) - 0.5
        decay = heads(jnp.exp(-jnp.exp(w_log.astype(f32))))
        a = jax.nn.sigmoid(a0[d] + (z @ a1[d]) @ a2[d])
        kd = heads(k * (1.0 + (a - 1.0) * k_a))
        ys.append(rwkv_scan(rh, decay, kd, vh, kk, kk * heads(a), reverse=(d == 1)))
        bonuses.append(jnp.sum(rh * kd * r_k.astype(f32), axis=-1, keepdims=True) * vh)
    y = ys[0] + ys[1]
    mean = jnp.mean(y, axis=-1, keepdims=True)
    var = jnp.mean(jnp.square(y - mean), axis=-1, keepdims=True)
    yn = ((y - mean) * lax.rsqrt(var + RW_GN_EPS)).reshape(bn, s, c)
    yn = yn * ln_w.astype(f32) + ln_b.astype(f32)
    out = (yn + (bonuses[0] + bonuses[1]).reshape(bn, s, c)) * g.astype(f32)
    return out.astype(r.dtype)


def peer_ffn(h, w_query, sub_keys, expert_u, expert_v):
    bn, s, d = h.shape
    xt = h.reshape(bn * s // PEER_CHUNK, PEER_CHUNK, d)
    kk2 = PEER_TOPK * PEER_TOPK

    def chunk(xc):
        q = (xc @ w_query).reshape(PEER_CHUNK, PEER_HEADS, 2, PEER_HALF)
        sc = jnp.einsum('chpd,hpkd->chpk', q, sub_keys, preferred_element_type=jnp.float32)
        s1, i1 = lax.top_k(sc[:, :, 0], PEER_TOPK)
        s2, i2 = lax.top_k(sc[:, :, 1], PEER_TOPK)
        cand_s = (s1[..., :, None] + s2[..., None, :]).reshape(PEER_CHUNK, PEER_HEADS, kk2)
        cand_i = (i1[..., :, None] * PEER_N_KEYS + i2[..., None, :]).reshape(PEER_CHUNK, PEER_HEADS, kk2)
        top_s, pos = lax.top_k(cand_s, PEER_TOPK)
        idx = jnp.take_along_axis(cand_i, pos, axis=-1)
        gate = jax.nn.softmax(top_s, axis=-1)
        u = jnp.take(expert_u, idx, axis=0)
        act = jax.nn.gelu(jnp.einsum('chkd,cd->chk', u, xc, preferred_element_type=jnp.float32),
                          approximate=False)
        vsel = jnp.take(expert_v, idx, axis=0)
        return jnp.einsum('chk,chkd->cd', (gate * act).astype(xc.dtype), vsel)

    return lax.map(chunk, xt).reshape(bn, s, d)


def setup_inputs(seed: int = 0) -> dict:
    key = jax.random.key(seed)
    keys = list(jax.random.split(key, 48))
    f32 = jnp.float32
    L = DEPTH
    G, P, GW = S5_GROUPS, S5_STATE, GROUP_WIDTH

    def nrm(shape, scale):
        return scale * jax.random.normal(keys.pop(), shape, f32)

    def gain(shape):
        return 1.0 + nrm(shape, 0.02)

    w0_base = -6.5 + 5.0 * jnp.linspace(0.0, 1.0, GW, dtype=f32) ** 0.9
    return {
        'x': nrm((BATCH, SEQ, D_MODEL), 1.0),
        'norm_mix': gain((L, D_MODEL)),
        'w_in': nrm((L, D_MODEL, PROJ_WIDTH), D_MODEL ** -0.5),
        'fourier_w': nrm((L, GW, GW), GW ** -0.5),
        's5_lam_re': -0.5 + nrm((L, 2, G, P), 0.01),
        's5_lam_im': jnp.pi * jnp.arange(P, dtype=f32) + nrm((L, 2, G, P), 0.01),
        's5_log_step': jax.random.uniform(keys.pop(), (L, 2, G), f32,
                                          minval=math.log(1e-3), maxval=math.log(1e-1)),
        's5_b_re': nrm((L, 2, G, P, S5_GROUP_CH), (2 * S5_GROUP_CH) ** -0.5),
        's5_b_im': nrm((L, 2, G, P, S5_GROUP_CH), (2 * S5_GROUP_CH) ** -0.5),
        's5_c_re': nrm((L, 2, G, S5_GROUP_CH, P), P ** -0.5),
        's5_c_im': nrm((L, 2, G, S5_GROUP_CH, P), P ** -0.5),
        's5_d': nrm((L, G, S5_GROUP_CH), 1.0),
        's5_w_glu': nrm((L, GW, GW), GW ** -0.5),
        'attn_q_norm': gain((L, HEAD_DIM)),
        'attn_k_norm': gain((L, HEAD_DIM)),
        'rwkv_mu': jax.random.uniform(keys.pop(), (L, 4, 2, GW), f32, minval=0.0, maxval=0.5),
        'rwkv_w0': w0_base + nrm((L, 2, GW), 0.1),
        'rwkv_w1': nrm((L, 2, GW, RW_DECAY_LORA), GW ** -0.5),
        'rwkv_w2': nrm((L, 2, RW_DECAY_LORA, GW), 0.1 * RW_DECAY_LORA ** -0.5),
        'rwkv_a0': nrm((L, 2, GW), 0.1),
        'rwkv_a1': nrm((L, 2, GW, RW_AICL_LORA), GW ** -0.5),
        'rwkv_a2': nrm((L, 2, RW_AICL_LORA, GW), RW_AICL_LORA ** -0.5),
        'rwkv_g1': nrm((L, GW, RW_GATE_LORA), GW ** -0.5),
        'rwkv_g2': nrm((L, RW_GATE_LORA, GW), RW_GATE_LORA ** -0.5),
        'rwkv_k_k': 0.85 + nrm((L, GW), 0.02),
        'rwkv_k_a': gain((L, GW)),
        'rwkv_r_k': nrm((L, RW_HEADS, RW_HEAD_DIM), 0.1),
        'rwkv_ln_w': gain((L, GW)),
        'rwkv_ln_b': nrm((L, GW), 0.02),
        'branch_norm': gain((L, MIX_WIDTH)),
        'w_out': nrm((L, MIX_WIDTH, D_MODEL), MIX_WIDTH ** -0.5),
        'norm_ffn': gain((L, D_MODEL)),
        'peer_w_query': nrm((L, D_MODEL, PEER_HEADS * PEER_KEY_DIM), D_MODEL ** -0.5),
        'peer_sub_keys': nrm((L, PEER_HEADS, 2, PEER_N_KEYS, PEER_HALF), PEER_HALF ** -0.5),
        'peer_u': nrm((L, PEER_EXPERTS, D_MODEL), D_MODEL ** -0.5),
        'peer_v': nrm((L, PEER_EXPERTS, D_MODEL), PEER_HEADS ** -0.5),
    }


def reference(x, norm_mix, w_in, fourier_w, s5_lam_re, s5_lam_im, s5_log_step, s5_b_re, s5_b_im,
              s5_c_re, s5_c_im, s5_d, s5_w_glu, attn_q_norm, attn_k_norm, rwkv_mu, rwkv_w0,
              rwkv_w1, rwkv_w2, rwkv_a0, rwkv_a1, rwkv_a2, rwkv_g1, rwkv_g2, rwkv_k_k, rwkv_k_a,
              rwkv_r_k, rwkv_ln_w, rwkv_ln_b, branch_norm, w_out, norm_ffn, peer_w_query,
              peer_sub_keys, peer_u, peer_v):
    bn, s, _ = x.shape
    cos, sin = axial_rope_tables(s)
    for l in range(DEPTH):
        h = rms_norm(x, norm_mix[l])
        proj = h @ w_in[l]
        pa, pb, pq, pk, pv, rr, rk, rv, rz = jnp.split(proj, SPLIT_POINTS, axis=-1)
        ya = fourier_mix(pa, fourier_w[l])
        yb = s5_mix(pb, s5_lam_re[l], s5_lam_im[l], s5_log_step[l], s5_b_re[l], s5_b_im[l],
                    s5_c_re[l], s5_c_im[l], s5_d[l], s5_w_glu[l])
        yc = attention_mix(pq, pk, pv, attn_q_norm[l], attn_k_norm[l], cos, sin)
        yd = rwkv7_mix(rr, rk, rv, rz, rwkv_mu[l], rwkv_w0[l], rwkv_w1[l], rwkv_w2[l],
                       rwkv_a0[l], rwkv_a1[l], rwkv_a2[l], rwkv_g1[l], rwkv_g2[l],
                       rwkv_k_k[l], rwkv_k_a[l], rwkv_r_k[l], rwkv_ln_w[l], rwkv_ln_b[l])
        ycat = jnp.stack([ya, yb, yc.astype(ya.dtype), yd.astype(ya.dtype)], axis=2)
        ycat = rms_norm(ycat, branch_norm[l].reshape(N_MIXERS, GROUP_WIDTH))
        x = x + ycat.reshape(bn, s, MIX_WIDTH) @ w_out[l]
        x = x + peer_ffn(rms_norm(x, norm_ffn[l]), peer_w_query[l], peer_sub_keys[l],
                         peer_u[l], peer_v[l])
    return x
```

```cpp
#include <hip/hip_runtime.h>
#include <hip/hip_cooperative_groups.h>
#include <cstdio>
#include <cstdint>
#include <cstddef>
namespace cg = cooperative_groups;

#ifndef MK_ONE_LAUNCH
#define MK_ONE_LAUNCH 1
#endif
#ifndef PHM
#define PHM 0x3ffff
#endif
#define PON(i) (((PHM) >> (i)) & 1)
#ifndef PROBE_REP_MASK
#define PROBE_REP_MASK 0u
#endif

namespace pg8 {
#define PG8_LAS __attribute__((address_space(3)))
typedef unsigned short bf16_t;
typedef short bf16x8 __attribute__((ext_vector_type(8)));
typedef float f32x4 __attribute__((ext_vector_type(4)));
typedef unsigned u32x4 __attribute__((ext_vector_type(4)));
typedef unsigned u32x2 __attribute__((ext_vector_type(2)));
constexpr int BM = 256, BK = 64, HALF = 128, HTB = HALF * BK * 2, STAGE_BYTES = 8 * HTB, NXCD = 8, WGM = 8;

__host__ __device__ __forceinline__ int lds_byte(int r, int c) { const int st = (r >> 4) * 2 + (c >> 5), rr = r & 15, cc = c & 31, ob = rr * 64 + cc * 2; return st * 1024 + (ob ^ (((ob >> 9) & 1) << 5)); }
__host__ __device__ __forceinline__ void stage_rc(int b, int& R, int& C) { const int st = b / 1024, sb = b % 1024, swz = sb ^ (((sb >> 9) & 1) << 5); R = (st >> 1) * 16 + swz / 64; C = (st & 1) * 32 + (swz % 64) / 2; }

struct Unit { int pm, pn, pa, pb; };
struct Gemm { const bf16_t* A; const bf16_t* Bt; int K; };

struct Order {
    int nM, nN, nb, nwg, G, c, aM, bN, oM;
    __device__ __forceinline__ void init(int nM_, int nN_, int nb_, int aM_, int bN_, int oM_, int G_, int c_) { nM = nM_; nN = nN_; nb = nb_; aM = aM_; bN = bN_; oM = oM_; nwg = nM * nN * nb; G = G_; c = c_; }
    __device__ __forceinline__ bool next(int i, Unit& u) const {
        const int L = i * G + c; if (L >= nwg || c < 0) return false;
        const int per = nM * nN, b = L / per; int wgid = L - b * per;
        { const int q = per / NXCD, r = per % NXCD, xcd = wgid % NXCD, off = wgid / NXCD; wgid = (xcd < r ? xcd * (q + 1) : r * (q + 1) + (xcd - r) * q) + off; }
        const int nig = WGM * nN, gid = wgid / nig, fm = gid * WGM, gsz = (nM - fm) < WGM ? (nM - fm) : WGM;
        const int pm = fm + ((wgid % nig) % gsz), pn = (wgid % nig) / gsz;
        u.pm = pm + b * oM; u.pn = pn; u.pa = pm + b * aM; u.pb = pn + b * bN; return true;
    }
};

__device__ __forceinline__ unsigned cvt_pk_bf16(float lo, float hi) { unsigned r; asm volatile("v_cvt_pk_bf16_f32 %0, %1, %2" : "=v"(r) : "v"(lo), "v"(hi)); return r; }

#define PG8_EPI_LOOP(...) \
    _Pragma("unroll") for (int ai = 0; ai < 2; ++ai) _Pragma("unroll") for (int m = 0; m < 4; ++m) { const int row = u.pm * BM + ai * HALF + wr * 64 + m * 16 + fr; \
        _Pragma("unroll") for (int bj = 0; bj < 2; ++bj) _Pragma("unroll") for (int n = 0; n < 2; ++n) { const int col = u.pn * BM + bj * HALF + wc * 32 + n * 16 + 4 * fq; const f32x4 v = acc[ai][bj][m][n]; __VA_ARGS__ } }

struct EpiF32 {
    float* out; int ldc;
    __device__ __forceinline__ void operator()(const f32x4 (&acc)[2][2][4][2], const Unit& u, int wr, int wc, int fr, int fq) const {
        PG8_EPI_LOOP( *(f32x4*)(out + (size_t)row * ldc + col) = v; )
    }
};
struct EpiResid {
    const float* base; float* out; int ldc;
    __device__ __forceinline__ void operator()(const f32x4 (&acc)[2][2][4][2], const Unit& u, int wr, int wc, int fr, int fq) const {
        PG8_EPI_LOOP( const f32x4 b = *(const f32x4*)(base + (size_t)row * ldc + col); *(f32x4*)(out + (size_t)row * ldc + col) = b + v; )
    }
};
struct EpiInProj {
    bf16_t* pa; float* proj;
    __device__ __forceinline__ void operator()(const f32x4 (&acc)[2][2][4][2], const Unit& u, int wr, int wc, int fr, int fq) const {
        if (u.pn < 2) { PG8_EPI_LOOP( u32x2 w; w.x = cvt_pk_bf16(v[0], v[1]); w.y = cvt_pk_bf16(v[2], v[3]); *(u32x2*)(pa + (size_t)row * 512 + col) = w; ) }
        else { PG8_EPI_LOOP( *(f32x4*)(proj + (size_t)row * 4096 + col) = v; ) }
    }
};
struct EpiC1 {
    bf16_t* c1;
    __device__ __forceinline__ void operator()(const f32x4 (&acc)[2][2][4][2], const Unit& u, int wr, int wc, int fr, int fq) const {
        PG8_EPI_LOOP( const int b = col >> 11, s = col & 2047; u32x2 w; w.x = cvt_pk_bf16(v[0], v[1]); w.y = cvt_pk_bf16(v[2], v[3]);
                      *(u32x2*)(c1 + ((size_t)b * 1024 + row) * 2048 + s) = w; )
    }
};
struct EpiGlu {
    const bf16_t* y; float* out;
    __device__ __forceinline__ void operator()(const f32x4 (&acc)[2][2][4][2], const Unit& u, int wr, int wc, int fr, int fq) const {
        PG8_EPI_LOOP( const u32x2 yw = *(const u32x2*)(y + (size_t)row * 512 + col);
                      f32x4 yv; yv[0] = __uint_as_float(yw.x << 16); yv[1] = __uint_as_float(yw.x & 0xffff0000u); yv[2] = __uint_as_float(yw.y << 16); yv[3] = __uint_as_float(yw.y & 0xffff0000u);
                      f32x4 o; _Pragma("unroll") for (int e = 0; e < 4; ++e) o[e] = yv[e] / (1.f + __expf(-v[e]));
                      *(f32x4*)(out + (size_t)row * 512 + col) = o; )
    }
};

template <class Epi, class Sched>
__device__ __forceinline__ void gemm_phase(PG8_LAS unsigned char* lds, const Gemm g, const Sched& S, const Epi& E, const int tid) {
    const int wid = __builtin_amdgcn_readfirstlane(tid >> 6), lane = tid & 63, wr = wid >> 2, wc = wid & 3, fr = lane & 15, fq = lane >> 4;
    const int K = g.K, nt = K / BK;
    unsigned voffA[2];
#pragma unroll
    for (int i = 0; i < 2; ++i) { int R, C; stage_rc(tid * 16 + i * 8192, R, C); voffA[i] = (unsigned)(R * K + C) * 2u; }
    const size_t kstep = (size_t)(BK * 2);
    const size_t hstep = (size_t)HALF * K * 2;
    const size_t tstep = 2 * hstep;
    const unsigned ldsw = (unsigned)wid * 1024u;
    const int aoff = lds_byte(wr * 64 + fr, fq * 8), boff = lds_byte(wc * 32 + fr, fq * 8);
#define PG8_SA(b, h) (((b) * 2 + (h)) * HTB)
#define PG8_SB(b, h) ((4 + (b) * 2 + (h)) * HTB)
#define PG8_STAGE(bufoff, gbase, voff) do { _Pragma("unroll") for (int _i = 0; _i < 2; ++_i) \
        __builtin_amdgcn_global_load_lds((const unsigned*)((const char*)(gbase) + (voff)[_i]), (PG8_LAS unsigned*)(lds + (bufoff) + ldsw + _i * 8192), 16, 0, 0); } while (0)
#define PG8_LDA(dst, b, h) do { _Pragma("unroll") for (int m = 0; m < 4; ++m) _Pragma("unroll") for (int k = 0; k < 2; ++k) dst[m][k] = *(const PG8_LAS bf16x8*)(lds + PG8_SA(b, h) + aoff + m * 2048 + k * 1024); } while (0)
#define PG8_LDB(dst, b, h) do { _Pragma("unroll") for (int n = 0; n < 2; ++n) _Pragma("unroll") for (int k = 0; k < 2; ++k) dst[n][k] = *(const PG8_LAS bf16x8*)(lds + PG8_SB(b, h) + boff + n * 2048 + k * 1024); } while (0)
#define PG8_MMA(ai, bj, At, Bt) do { __builtin_amdgcn_s_setprio(1); _Pragma("unroll") for (int m = 0; m < 4; ++m) _Pragma("unroll") for (int n = 0; n < 2; ++n) _Pragma("unroll") for (int k = 0; k < 2; ++k) \
        acc[ai][bj][m][n] = __builtin_amdgcn_mfma_f32_16x16x32_bf16(Bt[n][k], At[m][k], acc[ai][bj][m][n], 0, 0, 0); __builtin_amdgcn_s_setprio(0); } while (0)
#define PG8_WAIT_V(n) asm volatile("s_waitcnt vmcnt(" #n ")" ::: "memory")
#define PG8_WAIT_L(n) asm volatile("s_waitcnt lgkmcnt(" #n ")" ::: "memory")
#define PG8_BAR __builtin_amdgcn_s_barrier()
#define PG8_SCHED __builtin_amdgcn_sched_barrier(0)
    Unit cur, nxt; int ui = 0;
    if (!S.next(0, cur)) return;
    f32x4 acc[2][2][4][2];
#pragma unroll
    for (int a = 0; a < 2; ++a)
#pragma unroll
        for (int b = 0; b < 2; ++b)
#pragma unroll
            for (int m = 0; m < 4; ++m)
#pragma unroll
                for (int n = 0; n < 2; ++n) acc[a][b][m][n] = (f32x4){0.f, 0.f, 0.f, 0.f};
    bf16x8 At[4][2], B0[2][2], B1[2][2];
    const char* cA = (const char*)g.A + (size_t)cur.pa * tstep; const char* cB = (const char*)g.Bt + (size_t)cur.pb * tstep;
    PG8_STAGE(PG8_SB(0, 0), cB, voffA); PG8_STAGE(PG8_SB(0, 1), cB + hstep, voffA); PG8_STAGE(PG8_SA(0, 0), cA, voffA); PG8_STAGE(PG8_SA(0, 1), cA + hstep, voffA);
    if (wr == 1) PG8_BAR;
    PG8_WAIT_V(2); PG8_BAR;
    PG8_STAGE(PG8_SB(1, 0), cB + kstep, voffA); PG8_STAGE(PG8_SA(1, 0), cA + kstep, voffA); PG8_STAGE(PG8_SB(1, 1), cB + hstep + kstep, voffA);
    PG8_WAIT_V(6); PG8_BAR;
    for (;;) {
        const bool has_next = S.next(ui + 1, nxt);
        const char* nA = has_next ? (const char*)g.A + (size_t)nxt.pa * tstep : cA; const char* nB = has_next ? (const char*)g.Bt + (size_t)nxt.pb * tstep : cB;
        for (int t = 0; t < nt; t += 2) {
            const bool last = (t == nt - 2);
            const char* a1 = cA + (size_t)(t + 1) * kstep;
            const char* a2 = last ? nA : cA + (size_t)(t + 2) * kstep; const char* b2 = last ? nB : cB + (size_t)(t + 2) * kstep;
            const char* a3 = a2 + kstep; const char* b3 = b2 + kstep;
            PG8_LDB(B0, 0, 0); PG8_LDB(B1, 0, 1); PG8_SCHED; PG8_LDA(At, 0, 0); PG8_STAGE(PG8_SA(1, 1), a1 + hstep, voffA);
            PG8_WAIT_V(8); PG8_WAIT_L(0); PG8_BAR; PG8_MMA(0, 0, At, B0); PG8_MMA(0, 1, At, B1); PG8_BAR; PG8_SCHED;
            PG8_LDA(At, 0, 1); PG8_STAGE(PG8_SB(0, 0), b2, voffA); PG8_STAGE(PG8_SB(0, 1), b2 + hstep, voffA); PG8_STAGE(PG8_SA(0, 0), a2, voffA);
            PG8_WAIT_V(8); PG8_WAIT_L(0); PG8_BAR; PG8_MMA(1, 0, At, B0); PG8_MMA(1, 1, At, B1); PG8_BAR; PG8_SCHED;
            PG8_LDB(B0, 1, 0); PG8_LDB(B1, 1, 1); PG8_SCHED; PG8_LDA(At, 1, 0); PG8_STAGE(PG8_SA(0, 1), a2 + hstep, voffA);
            PG8_WAIT_V(8); PG8_WAIT_L(0); PG8_BAR; PG8_MMA(0, 0, At, B0); PG8_MMA(0, 1, At, B1); PG8_BAR; PG8_SCHED;
            PG8_LDA(At, 1, 1); PG8_STAGE(PG8_SB(1, 0), b3, voffA); PG8_STAGE(PG8_SB(1, 1), b3 + hstep, voffA); PG8_STAGE(PG8_SA(1, 0), a3, voffA);
            PG8_WAIT_V(8); PG8_WAIT_L(0); PG8_BAR; PG8_MMA(1, 0, At, B0); PG8_MMA(1, 1, At, B1); PG8_BAR; PG8_SCHED;
        }
        if (wr == 0) PG8_BAR;
        E(acc, cur, wr, wc, fr, fq);
        if (!has_next) break;
#pragma unroll
        for (int a = 0; a < 2; ++a)
#pragma unroll
            for (int b = 0; b < 2; ++b)
#pragma unroll
                for (int m = 0; m < 4; ++m)
#pragma unroll
                    for (int n = 0; n < 2; ++n) acc[a][b][m][n] = (f32x4){0.f, 0.f, 0.f, 0.f};
        cur = nxt; cA = nA; cB = nB; ++ui;
        if (wr == 1) PG8_BAR;
    }
    PG8_WAIT_V(0);
    PG8_BAR;
#undef PG8_SA
#undef PG8_SB
#undef PG8_STAGE
#undef PG8_LDA
#undef PG8_LDB
#undef PG8_MMA
#undef PG8_WAIT_V
#undef PG8_WAIT_L
#undef PG8_BAR
#undef PG8_SCHED
}
}

namespace att {
using bf16 = unsigned short;
constexpr int   D = 128, NW = 8, QBLK = 32, KVBLK = 64;
constexpr float SCALE = 0.088388347648318440f;
constexpr float THR = 8.f;
constexpr int SDEPTH = 1;
constexpr int LDQ = 512, LDK = 256, LDO = 512;
constexpr size_t SHM_V = KVBLK * D * 2, SHM_K = KVBLK * D * 2, SHM_ATTN = 2 * SHM_V + 2 * SHM_K + NW * 64 * 4;

using bf16x8 = __attribute__((ext_vector_type(8))) short;
using s16x4  = __attribute__((ext_vector_type(4))) short;
using f32x16 = __attribute__((ext_vector_type(16))) float;
using f32x8  = __attribute__((ext_vector_type(8))) float;
using u32x4  = __attribute__((ext_vector_type(4))) unsigned;
#define KSWZ(row, colB) ((row) * 256 + ((colB) ^ (((row) & 7) << 4)))
#define SBAR() __builtin_amdgcn_sched_barrier(0)
__device__ __forceinline__ int crow(int r, int hi) { return (r & 3) + 8 * (r >> 2) + 4 * hi; }
__device__ __forceinline__ unsigned cvtpk(float lo, float hi) {
  unsigned r; asm volatile("v_cvt_pk_bf16_f32 %0, %1, %2" : "=v"(r) : "v"(lo), "v"(hi)); return r;
}
template <typename TIn> struct Stage;
template <> struct Stage<bf16>  { using T = bf16x8;
  __device__ static __forceinline__ T ld8(const bf16* p) { return *reinterpret_cast<const bf16x8*>(p); }
  __device__ static __forceinline__ bf16x8 tobf(T x) { return x; } };

__device__ __forceinline__ void partialSM(f32x16& p0, f32x16& p1, float& m_reg, float& mn, float& alpha) {
  constexpr float C = SCALE * 1.4426950408889634f;
  float pmax = p0[0]; for (int r = 1; r < 16; ++r) pmax = fmaxf(pmax, p0[r]); for (int r = 0; r < 16; ++r) pmax = fmaxf(pmax, p1[r]);
  { auto rr = __builtin_amdgcn_permlane32_swap(__float_as_uint(pmax), __float_as_uint(pmax), false, false);
    pmax = fmaxf(__uint_as_float(rr[0]), __uint_as_float(rr[1])); }
  if (__builtin_expect(__all(pmax - m_reg <= THR / SCALE), 1)) { mn = m_reg; alpha = 1.f; }
  else { mn = fmaxf(m_reg, pmax); alpha = __builtin_amdgcn_exp2f((m_reg - mn) * C); m_reg = mn; }
  float mnC = -mn * C;
  for (int r = 0; r < 16; ++r) p0[r] = fmaf(p0[r], C, mnC); for (int r = 0; r < 16; ++r) p1[r] = fmaf(p1[r], C, mnC);
  for (int r = 0; r < 16; ++r) p0[r] = __builtin_amdgcn_exp2f(p0[r]);
}
__device__ __forceinline__ void finishSM(f32x16& p0, f32x16& p1, float alpha, float& l_reg, bf16x8& pa0, bf16x8& pa1, bf16x8& pa2, bf16x8& pa3) {
  for (int r = 0; r < 16; ++r) p1[r] = __builtin_amdgcn_exp2f(p1[r]);
  float ps = 0; for (int r = 0; r < 16; ++r) ps += p0[r]; for (int r = 0; r < 16; ++r) ps += p1[r];
  { auto rr = __builtin_amdgcn_permlane32_swap(__float_as_uint(ps), __float_as_uint(ps), false, false);
    ps = __uint_as_float(rr[0]) + __uint_as_float(rr[1]); }
  l_reg = l_reg * alpha + ps;
#define PK4(P, BASE, OUT) do { unsigned a0 = cvtpk(P[BASE + 0], P[BASE + 1]), a1 = cvtpk(P[BASE + 2], P[BASE + 3]);   \
    unsigned b0 = cvtpk(P[BASE + 4], P[BASE + 5]), b1 = cvtpk(P[BASE + 6], P[BASE + 7]);                              \
    auto r0 = __builtin_amdgcn_permlane32_swap(a0, b0, false, false); auto r1 = __builtin_amdgcn_permlane32_swap(a1, b1, false, false); \
    u32x4 w = {r0[0], r1[0], r0[1], r1[1]}; OUT = *reinterpret_cast<bf16x8*>(&w); } while (0)
  PK4(p0, 0, pa0); PK4(p0, 8, pa1); PK4(p1, 0, pa2); PK4(p1, 8, pa3);
#undef PK4
}
__device__ __forceinline__ void qkt(f32x16& p0, f32x16& p1, const bf16* Ks, const bf16x8* qr, int r32, int hi) {
  p0 = f32x16{}; p1 = f32x16{};
  for (int d0 = 0; d0 < 8; ++d0) { int cb = (d0 * 16 + hi * 8) * 2;
    bf16x8 b0 = *reinterpret_cast<const bf16x8*>((const char*)Ks + KSWZ(r32, cb));
    bf16x8 b1 = *reinterpret_cast<const bf16x8*>((const char*)Ks + KSWZ(32 + r32, cb));
    p0 = __builtin_amdgcn_mfma_f32_32x32x16_bf16(b0, qr[d0], p0, 0, 0, 0);
    p1 = __builtin_amdgcn_mfma_f32_32x32x16_bf16(b1, qr[d0], p1, 0, 0, 0); }
}
__device__ __forceinline__ int v_st(int k, int c) { const int kk = (k & ~0xC) | ((k & 4) << 1) | ((k & 8) >> 1); return ((kk >> 3) * 4 + (c >> 5)) * 512 + ((kk & 7) * 32 + (c & 31)) * 2; }
__device__ __forceinline__ int v_rd_base(int lane) { return ((lane & 3) << 3) | (((lane >> 2) & 3) << 6) | (((lane >> 4) & 1) << 5) | (((lane >> 5) & 1) << 8); }
constexpr int v_rd_off(int d0, int ks, int half) { return d0 * 512 + ks * 4096 + half * 2048; }
template <int OFF> __device__ __forceinline__ s16x4 tr_read(int vb) {
  s16x4 r; asm volatile("ds_read_b64_tr_b16 %0, %1 offset:%2" : "=&v"(r) : "v"(vb), "i"(OFF) : "memory"); return r;
}
template <int D0> __device__ __forceinline__ void pv_one(f32x16& od, int vb, bf16x8 pa0, bf16x8 pa1, bf16x8 pa2, bf16x8 pa3) {
  const s16x4 l0 = tr_read<v_rd_off(D0, 0, 0)>(vb), h0 = tr_read<v_rd_off(D0, 0, 1)>(vb), l1 = tr_read<v_rd_off(D0, 1, 0)>(vb), h1 = tr_read<v_rd_off(D0, 1, 1)>(vb);
  const s16x4 l2 = tr_read<v_rd_off(D0, 2, 0)>(vb), h2 = tr_read<v_rd_off(D0, 2, 1)>(vb), l3 = tr_read<v_rd_off(D0, 3, 0)>(vb), h3 = tr_read<v_rd_off(D0, 3, 1)>(vb);
  asm volatile("s_waitcnt lgkmcnt(0)" ::: "memory"); SBAR();
#define PK(L, H) (bf16x8){L[0], L[1], L[2], L[3], H[0], H[1], H[2], H[3]}
  od = __builtin_amdgcn_mfma_f32_32x32x16_bf16(pa0, PK(l0, h0), od, 0, 0, 0);
  od = __builtin_amdgcn_mfma_f32_32x32x16_bf16(pa1, PK(l1, h1), od, 0, 0, 0);
  od = __builtin_amdgcn_mfma_f32_32x32x16_bf16(pa2, PK(l2, h2), od, 0, 0, 0);
  od = __builtin_amdgcn_mfma_f32_32x32x16_bf16(pa3, PK(l3, h3), od, 0, 0, 0);
#undef PK
}
__device__ __forceinline__ void pv_d0(f32x16* o, int vb, bf16x8 pa0, bf16x8 pa1, bf16x8 pa2, bf16x8 pa3) {
  pv_one<0>(o[0], vb, pa0, pa1, pa2, pa3); pv_one<1>(o[1], vb, pa0, pa1, pa2, pa3); pv_one<2>(o[2], vb, pa0, pa1, pa2, pa3); pv_one<3>(o[3], vb, pa0, pa1, pa2, pa3);
}
template <typename TQ>
__device__ __forceinline__ void attn_dense_body(const TQ* __restrict__ Qb, const bf16* __restrict__ Kh, const bf16* __restrict__ Vh,
                                                float* __restrict__ Ob, int seq, char* lds, const int tid_) {
  using St = Stage<bf16>; using SQ = Stage<TQ>;
  int tid = tid_; asm volatile("" : "+v"(tid));
  const int wid = tid >> 6, lane = tid & 63, r32 = lane & 31, hi = lane >> 5;
  bf16* V_lds = (bf16*)lds; bf16* K_lds = (bf16*)(lds + 2 * SHM_V);
  float* ws = (float*)(lds + 2 * SHM_V + 2 * SHM_K) + wid * 64; float* li_l = ws; float* al_l = ws + 32;
  float m_reg = -1e30f, l_reg = 0; f32x16 o[4] = {}; bf16x8 qr[8];
  const TQ* Qw = Qb + (long)(wid * QBLK + r32) * LDQ + hi * 8;
#pragma unroll
  for (int d0 = 0; d0 < 8; ++d0) qr[d0] = SQ::tobf(SQ::ld8(Qw + d0 * 16));
  const int sr = tid >> 4, sc = (tid & 15) * 8, vst0 = v_st(sr, sc), vst1 = v_st(32 + sr, sc);
  const int vb0 = (int)(uintptr_t)V_lds + v_rd_base(lane);
  struct { typename St::T vs0, vs1, ks0, ks1; } sr_[SDEPTH];
  const unsigned loff = (unsigned)(sr * LDK + sc);
#define SLOAD(i, k0) do { const bf16* Vt_ = Vh + (size_t)(k0) * LDK; const bf16* Kt_ = Kh + (size_t)(k0) * LDK; \
    sr_[i].vs0 = St::ld8(Vt_ + loff); sr_[i].vs1 = St::ld8(Vt_ + 32 * LDK + loff); \
    sr_[i].ks0 = St::ld8(Kt_ + loff); sr_[i].ks1 = St::ld8(Kt_ + 32 * LDK + loff); } while (0)
#define SWRITE(b, i) do { *(bf16x8*)((char*)V_lds + (b) * SHM_V + vst0) = St::tobf(sr_[i].vs0);          \
    *(bf16x8*)((char*)V_lds + (b) * SHM_V + vst1) = St::tobf(sr_[i].vs1); int kc = sc * 2;               \
    *(bf16x8*)((char*)K_lds + (b) * SHM_K + KSWZ(sr, kc)) = St::tobf(sr_[i].ks0);                       \
    *(bf16x8*)((char*)K_lds + (b) * SHM_K + KSWZ(32 + sr, kc)) = St::tobf(sr_[i].ks1); } while (0)
#define SWAIT() do { if constexpr (SDEPTH == 2) asm volatile("s_waitcnt vmcnt(4)" ::: "memory"); else asm volatile("s_waitcnt vmcnt(0)" ::: "memory"); } while (0)
#define RESC(a) do { if (__any((a) < 1.f)) { if (hi == 0) al_l[r32] = (a); asm volatile("s_waitcnt lgkmcnt(0)" ::: "memory"); \
    for (int d = 0; d < 4; ++d) for (int r = 0; r < 16; ++r) o[d][r] *= al_l[crow(r, hi)]; } } while (0)
  f32x16 pA0, pA1, pB0, pB1; float mnA, mnB, alA, alB; bf16x8 pa0, pa1, pa2, pa3; const int NT = seq / KVBLK;
  constexpr int SE = 0, SO = SDEPTH - 1;
  SLOAD(SE, 0); asm volatile("s_waitcnt vmcnt(0)" ::: "memory"); SWRITE(0, SE); __syncthreads();
  qkt(pA0, pA1, K_lds, qr, r32, hi); partialSM(pA0, pA1, m_reg, mnA, alA);
  SLOAD(SO, KVBLK); if constexpr (SDEPTH == 2) { if (2 < NT) SLOAD(SE, 2 * KVBLK); }
  SWAIT(); SWRITE(1, SO); __syncthreads();
  for (int j = 1; j + 1 < NT; j += 2) {
    SBAR(); qkt(pB0, pB1, (bf16*)((char*)K_lds + SHM_K), qr, r32, hi);
    finishSM(pA0, pA1, alA, l_reg, pa0, pa1, pa2, pa3); SBAR();
    SLOAD(SO, (j + SDEPTH) * KVBLK); SBAR();
    pv_d0(o, vb0, pa0, pa1, pa2, pa3); partialSM(pB0, pB1, m_reg, mnB, alB);
    __syncthreads(); SWAIT(); SWRITE(0, SE);
    RESC(alB); __syncthreads();
    SBAR(); qkt(pA0, pA1, K_lds, qr, r32, hi);
    finishSM(pB0, pB1, alB, l_reg, pa0, pa1, pa2, pa3); SBAR();
    if (SDEPTH == 1 || j + 3 < NT) SLOAD(SE, (j + 1 + SDEPTH) * KVBLK); SBAR();
    pv_d0(o, vb0 + (int)SHM_V, pa0, pa1, pa2, pa3); partialSM(pA0, pA1, m_reg, mnA, alA);
    __syncthreads(); SWAIT(); SWRITE(1, SO);
    RESC(alA); __syncthreads();
  }
  SBAR(); qkt(pB0, pB1, (bf16*)((char*)K_lds + SHM_K), qr, r32, hi);
  finishSM(pA0, pA1, alA, l_reg, pa0, pa1, pa2, pa3); SBAR();
  pv_d0(o, vb0, pa0, pa1, pa2, pa3); partialSM(pB0, pB1, m_reg, mnB, alB);
  __syncthreads(); RESC(alB);
  finishSM(pB0, pB1, alB, l_reg, pa0, pa1, pa2, pa3); SBAR();
  pv_d0(o, vb0 + (int)SHM_V, pa0, pa1, pa2, pa3);
  if (hi == 0) li_l[r32] = l_reg; asm volatile("s_waitcnt lgkmcnt(0)" ::: "memory");
  float rli[16];
#pragma unroll
  for (int r = 0; r < 16; ++r) rli[r] = __builtin_amdgcn_rcpf(li_l[crow(r, hi)]);
  int le = lane; asm volatile("" : "+v"(le));
  float* Ow = Ob + (size_t)(wid * QBLK) * LDO; const unsigned eo = (unsigned)((le >> 5) * 4 * LDO + (le & 31));
#pragma unroll
  for (int r = 0; r < 16; ++r) { const unsigned ro = eo + (unsigned)(((r & 3) + 8 * (r >> 2)) * LDO);
#pragma unroll
    for (int d0 = 0; d0 < 4; ++d0) Ow[ro + d0 * 32] = o[d0][r] * rli[r]; }
#undef SLOAD
#undef SWRITE
#undef SWAIT
#undef RESC
}
}
#define LAS __attribute__((address_space(3)))
typedef unsigned short bf16_t;
typedef float f32x4 __attribute__((ext_vector_type(4)));
typedef float f32x2 __attribute__((ext_vector_type(2)));
typedef unsigned u32x4 __attribute__((ext_vector_type(4)));
typedef unsigned u32x2 __attribute__((ext_vector_type(2)));

typedef short bf16x8_t __attribute__((ext_vector_type(8)));
__device__ __forceinline__ bf16x8_t mk8(unsigned d0, unsigned d1, unsigned d2, unsigned d3) { const u32x4 w = {d0, d1, d2, d3}; return __builtin_bit_cast(bf16x8_t, w); }
constexpr int NTHR = 512, NWAVES = 8;
constexpr int MTOK = 8192, DM = 2048, SEQ = 2048, NBATCH = 4, PROJ = 4096, GW = 512;
constexpr int LDS_BYTES = 147456;

constexpr size_t MiB = 1u << 20;
constexpr size_t WS_CTL = 0;
constexpr size_t WS_WINT = 1 * MiB;
constexpr size_t WS_WOUTT = WS_WINT + 32 * MiB;
constexpr size_t WS_WQT = WS_WOUTT + 16 * MiB;
constexpr size_t WS_WGLUT = WS_WQT + 8 * MiB;
constexpr size_t WS_WCST = WS_WGLUT + 1 * MiB;
constexpr size_t WS_DFT = WS_WCST + 2 * MiB;
constexpr size_t WS_UB = WS_DFT + 16 * MiB;
constexpr size_t WS_VB = WS_UB + 128 * MiB;
constexpr size_t WS_KEYST = WS_VB + 128 * MiB;
constexpr size_t WS_ROPE = WS_KEYST + 1 * MiB;
constexpr size_t WS_HB = WS_ROPE + 1 * MiB;
constexpr size_t WS_PROJ = WS_HB + 32 * MiB;
constexpr size_t WS_PA = WS_PROJ + 128 * MiB;
constexpr size_t WS_C1 = WS_PA + 8 * MiB;
constexpr size_t WS_YA = WS_C1 + 16 * MiB;
constexpr size_t WS_QB = WS_YA + 64 * MiB;
constexpr size_t WS_S5E = WS_QB + 16 * MiB;
constexpr size_t WS_YGELU = WS_S5E + 4 * MiB;
constexpr size_t WS_RW = WS_YGELU + 8 * MiB;
constexpr size_t WS_YRW = WS_RW + 176 * MiB;
constexpr size_t WS_X1 = WS_YRW + 32 * MiB;
constexpr size_t WS_X2 = WS_X1 + 64 * MiB;
constexpr size_t WS_KS = WS_X2 + 64 * MiB;
constexpr size_t WS_S5T = WS_VB + 122 * MiB;
constexpr size_t WS_END = WS_KS + 16 * MiB;
static_assert(WS_END <= 1024 * MiB, "workspace map must fit 1 GiB");
constexpr size_t WS_LORA = WS_VB + 1 * MiB;
constexpr size_t WS_RWC = WS_VB + 2 * MiB;
constexpr int RWC_REC = 15360;
constexpr size_t RWSZ = (size_t)MTOK * GW;
enum { RW_R = 0, RW_V, RW_KK, RW_W0, RW_W1, RW_KD0, RW_KD1, RW_B0, RW_B1, RW_G, RW_BONUS };

struct Args { const float* in[36]; float* out; unsigned char* ws; int ph_lo, ph_hi; };

__device__ __forceinline__ unsigned f2bf(float f) { const unsigned u = __float_as_uint(f); return (u + 0x7fffu + ((u >> 16) & 1u)) >> 16; }
__device__ __forceinline__ unsigned pk2(float lo, float hi) { return f2bf(lo) | (f2bf(hi) << 16); }
__device__ __forceinline__ float bflo(unsigned w) { return __uint_as_float(w << 16); }
__device__ __forceinline__ float bfhi(unsigned w) { return __uint_as_float(w & 0xffff0000u); }
#define DPPF(x, ctrl) __builtin_bit_cast(float, __builtin_amdgcn_update_dpp(0, __builtin_bit_cast(int, (x)), (ctrl), 0xF, 0xF, true))
#define RDL(x, l) __builtin_bit_cast(float, __builtin_amdgcn_readlane(__builtin_bit_cast(int, (x)), (l)))
__device__ __forceinline__ float wave_sum(float v) {
    v += DPPF(v, 0xB1); v += DPPF(v, 0x4E); v += DPPF(v, 0x124); v += DPPF(v, 0x128);
    return (RDL(v, 0) + RDL(v, 16)) + (RDL(v, 32) + RDL(v, 48));
}
__device__ __forceinline__ float wave_max(float v) {
    v = fmaxf(v, DPPF(v, 0xB1)); v = fmaxf(v, DPPF(v, 0x4E)); v = fmaxf(v, DPPF(v, 0x124)); v = fmaxf(v, DPPF(v, 0x128));
    return fmaxf(fmaxf(RDL(v, 0), RDL(v, 16)), fmaxf(RDL(v, 32), RDL(v, 48)));
}
__device__ __forceinline__ float sigmoidf_(float x) { return 1.f / (1.f + __expf(-x)); }
__device__ __forceinline__ float gelu_tanh(float x) { const float u = 0.7978845608028654f * (x + 0.044715f * x * x * x); return 0.5f * x * (1.f + tanhf(u)); }
__device__ __forceinline__ float gelu_erf(float x) { return 0.5f * x * (1.f + erff(x * 0.7071067811865476f)); }
#define LDS_WAIT() asm volatile("s_waitcnt lgkmcnt(0)" ::: "memory")

struct Ctx {
    LAS unsigned char* lds; int tid, lane, wave, G, gw, ngw, bx;
};
__device__ __forceinline__ Ctx fresh_ctx_w(unsigned char* lds_raw, int wave0) {
    Ctx C; int ln = __builtin_amdgcn_mbcnt_hi(~0u, __builtin_amdgcn_mbcnt_lo(~0u, 0u)); asm volatile("" : "+v"(ln));
    int wv = wave0; asm volatile("" : "+s"(wv));
    int t = wv * 64 + ln;
    int bx = blockIdx.x, G = gridDim.x; asm volatile("" : "+s"(bx), "+s"(G));
    unsigned lo_ = 0u; asm volatile("" : "+s"(lo_));
    C.lds = (LAS unsigned char*)lds_raw + lo_; C.tid = t; C.lane = ln; C.wave = wv;
    C.G = G; C.bx = bx; C.gw = bx * NWAVES + C.wave; C.ngw = G * NWAVES; return C;
}
#define AS4 __attribute__((address_space(4)))
typedef const float* const AS4* InTab;
struct AP { InTab in; float* out; unsigned char* ws; };
static_assert(offsetof(Args, out) == 288 && offsetof(Args, ws) == 296, "Args layout");
__device__ __forceinline__ AP fresh_args() {
    unsigned long long p = (unsigned long long)__builtin_amdgcn_kernarg_segment_ptr(); asm volatile("" : "+s"(p));
    AP r; r.in = (InTab)p; r.out = *(float* const AS4*)(p + 288); r.ws = *(unsigned char* const AS4*)(p + 296); return r;
}

typedef __attribute__((address_space(1))) unsigned gu32;
#define RLX_AGENT __ATOMIC_RELAXED, __HIP_MEMORY_SCOPE_AGENT
#define XB_TMO      128
#define XB_XCNT(j)  (256  + 64 * (j))
#define XB_XSUB(j)  (1280 + 64 * (j))
#define XB_XGEN(j)  (2304 + 64 * (j))
#define XB_TOP      3328
#define XB_TOPGEN   3392
#define XCD_BAR_WORDS 3456
#define XB_SPIN_CAP (1u << 18)

__device__ __forceinline__ unsigned xb_ld(unsigned* p)              { return __hip_atomic_load(p, __ATOMIC_RELAXED, __HIP_MEMORY_SCOPE_AGENT); }
__device__ __forceinline__ unsigned xb_add(unsigned* p, unsigned v) { return __hip_atomic_fetch_add(p, v, __ATOMIC_RELAXED, __HIP_MEMORY_SCOPE_AGENT); }
__device__ __forceinline__ unsigned xb_xcc_id() { return (unsigned)__builtin_amdgcn_s_getreg((3 << 11) | 20) & 0xFu; }
#define XB_SPIN(cond, bar) do { unsigned _sp = 0; while (cond) { __builtin_amdgcn_s_sleep(1); \
    if ((++_sp & 255u) == 0u) { if (xb_ld(&(bar)[XB_TMO])) break; if (_sp > XB_SPIN_CAP) { atomicAdd(&(bar)[XB_TMO], 1u); break; } } } } while (0)

struct XcdBarrier {
    unsigned* bar; unsigned x;
    volatile LAS unsigned* st;
};

__device__ __forceinline__ XcdBarrier xcd_barrier_post(unsigned* bar, volatile LAS unsigned* st) {
    XcdBarrier b; b.bar = bar; b.x = xb_xcc_id(); b.st = st;
    if (threadIdx.x == 0) (void)xb_add(&bar[XB_XCNT(b.x)], 1u);
    return b;
}
__device__ __forceinline__ void xcd_barrier_complete(unsigned* bar, unsigned x, unsigned& nloc, unsigned& nx) {
    const unsigned G = gridDim.x * gridDim.y * gridDim.z;
    unsigned sum, cnt, mine, sp = 0u;
    for (;;) {
        sum = 0u; cnt = 0u; mine = 0u;
#pragma unroll
        for (unsigned j = 0; j < 16; ++j) { const unsigned c = xb_ld(&bar[XB_XCNT(j)]); sum += c; cnt += (c > 0u) ? 1u : 0u; mine = (j == x) ? c : mine; }
        if (sum == G) break;
        __builtin_amdgcn_s_sleep(1);
        if ((++sp & 255u) == 0u) { if (xb_ld(&bar[XB_TMO])) break; if (sp > XB_SPIN_CAP) { atomicAdd(&bar[XB_TMO], 1u); break; } }
    }
    nloc = mine > 0u ? mine : 1u; nx = cnt > 0u ? cnt : 1u;
}

__device__ __forceinline__ void xcd_barrier(const XcdBarrier& b) {
    asm volatile("s_waitcnt vmcnt(0)" ::: "memory");
    __syncthreads();
    if (threadIdx.x == 0) {
        unsigned* bar = b.bar;
        __builtin_amdgcn_s_waitcnt(0);
        unsigned nloc = b.st[0], nx = b.st[1];
        if (nloc == 0u) { xcd_barrier_complete(bar, b.x, nloc, nx); b.st[0] = nloc; b.st[1] = nx; }
        const unsigned old = xb_add(&bar[XB_XSUB(b.x)], 1u);
        const unsigned gen = old / nloc;
        if (old + 1u == (gen + 1u) * nloc) {
            __builtin_amdgcn_fence(__ATOMIC_RELEASE, "agent");
            asm volatile("s_waitcnt vmcnt(0)" ::: "memory");
            const unsigned og = xb_add(&bar[XB_TOP], 1u);
            const unsigned tg = og / nx;
            if (og + 1u == (tg + 1u) * nx) xb_add(&bar[XB_TOPGEN], 1u);
            else XB_SPIN(xb_ld(&bar[XB_TOPGEN]) == tg, bar);
            __builtin_amdgcn_fence(__ATOMIC_ACQUIRE, "agent");
            xb_add(&bar[XB_XGEN(b.x)], 1u);
            asm volatile("s_waitcnt vmcnt(0)" ::: "memory");
        } else {
            XB_SPIN(xb_ld(&bar[XB_XGEN(b.x)]) == gen, bar);
            __builtin_amdgcn_fence(__ATOMIC_ACQUIRE, "agent");
            asm volatile("s_waitcnt vmcnt(0)" ::: "memory");
        }
    }
    __syncthreads();
}

__device__ __forceinline__ void transpose_item(const float* W, const float* gain, int K, int N, bf16_t* WT, LAS float* scr, int item, int lane) {
    const int nblk = N / 64, kb = item / nblk, nb = item % nblk, k0 = 64 * kb, n0 = 64 * nb;
    const int lr = lane >> 4, lc = (lane & 15) * 4;
    f32x4 v[16];
#pragma unroll
    for (int i = 0; i < 16; ++i) v[i] = *(const f32x4*)(W + (size_t)(k0 + 4 * i + lr) * N + n0 + lc);
#pragma unroll
    for (int i = 0; i < 16; ++i) { const int kk = 4 * i + lr; const float g = gain ? gain[k0 + kk] : 1.f; LAS float* d = scr + kk * 65 + lc;
        d[0] = v[i].x * g; d[1] = v[i].y * g; d[2] = v[i].z * g; d[3] = v[i].w * g; }
    LDS_WAIT(); asm volatile("" ::: "memory");
#pragma unroll
    for (int c = 0; c < 8; ++c) { const LAS float* sp = scr + (8 * c) * 65 + lane;
        u32x4 o; o.x = pk2(sp[0 * 65], sp[1 * 65]); o.y = pk2(sp[2 * 65], sp[3 * 65]); o.z = pk2(sp[4 * 65], sp[5 * 65]); o.w = pk2(sp[6 * 65], sp[7 * 65]);
        *(u32x4*)(WT + (size_t)(n0 + lane) * K + k0 + 8 * c) = o; }
    LDS_WAIT(); asm volatile("" ::: "memory");
}
__device__ __forceinline__ void rms_row_to_bf16(const float* xrow, bf16_t* orow, int lane) {
    const f32x4* xr = (const f32x4*)xrow + lane;
    f32x4 v[8]; float s = 0.f;
#pragma unroll
    for (int j = 0; j < 8; ++j) { v[j] = xr[64 * j]; s += (v[j].x * v[j].x + v[j].y * v[j].y) + (v[j].z * v[j].z + v[j].w * v[j].w); }
    const float rs = rsqrtf(wave_sum(s) * (1.f / DM) + 1e-6f);
    u32x2* o8 = (u32x2*)orow + lane;
#pragma unroll
    for (int j = 0; j < 8; ++j) { u32x2 w; w.x = pk2(v[j].x * rs, v[j].y * rs); w.y = pk2(v[j].z * rs, v[j].w * rs); o8[64 * j] = w; }
}
__device__ __forceinline__ void s5_tables(const Ctx& C, const AP& a);
typedef float v16f_t __attribute__((ext_vector_type(16)));
typedef float v32f_t __attribute__((ext_vector_type(32)));
typedef unsigned v6u_t __attribute__((ext_vector_type(6)));
constexpr int EROW = 1536; constexpr size_t ETAB = (size_t)16384 * EROW;
__device__ __forceinline__ void expert_row_pack(const AP& a, int which, int l, int e, int lane, const f32x4 (&v)[8], float mx) {
    unsigned char* ws = a.ws;
    if (which) {
        const float sc4 = mx > 0.f ? 6.f / mx : 1.f;
        unsigned wv[4];
#pragma unroll
        for (int d4 = 0; d4 < 4; ++d4) { unsigned w_ = 0u;
            w_ = __builtin_amdgcn_cvt_scalef32_pk_fp4_f32(w_, v[2 * d4].x * sc4, v[2 * d4].y * sc4, 1.0f, 0); w_ = __builtin_amdgcn_cvt_scalef32_pk_fp4_f32(w_, v[2 * d4].z * sc4, v[2 * d4].w * sc4, 1.0f, 1);
            w_ = __builtin_amdgcn_cvt_scalef32_pk_fp4_f32(w_, v[2 * d4 + 1].x * sc4, v[2 * d4 + 1].y * sc4, 1.0f, 2); w_ = __builtin_amdgcn_cvt_scalef32_pk_fp4_f32(w_, v[2 * d4 + 1].z * sc4, v[2 * d4 + 1].w * sc4, 1.0f, 3);
            wv[d4] = w_; }
        ((u32x4*)(ws + WS_UB + 64 * MiB + (size_t)l * 16 * MiB + (size_t)e * 1024))[lane] = (u32x4){wv[0], wv[1], wv[2], wv[3]};
        if (lane == 0) ((float*)(ws + WS_VB))[(2 + l) * 16384 + e] = mx > 0.f ? mx * (1.f / 6.f) : 1.f;
        return;
    }
    if (true) {
        const float sc4 = mx > 0.f ? 6.f / mx : 1.f;
        unsigned wv[4];
#pragma unroll
        for (int d4 = 0; d4 < 4; ++d4) { unsigned w_ = 0u;
            w_ = __builtin_amdgcn_cvt_scalef32_pk_fp4_f32(w_, v[2 * d4].x * sc4, v[2 * d4].y * sc4, 1.0f, 0); w_ = __builtin_amdgcn_cvt_scalef32_pk_fp4_f32(w_, v[2 * d4].z * sc4, v[2 * d4].w * sc4, 1.0f, 1);
            w_ = __builtin_amdgcn_cvt_scalef32_pk_fp4_f32(w_, v[2 * d4 + 1].x * sc4, v[2 * d4 + 1].y * sc4, 1.0f, 2); w_ = __builtin_amdgcn_cvt_scalef32_pk_fp4_f32(w_, v[2 * d4 + 1].z * sc4, v[2 * d4 + 1].w * sc4, 1.0f, 3);
            wv[d4] = w_; }
        ((u32x4*)(ws + WS_UB + (size_t)l * ETAB + (size_t)e * 1024))[lane] = (u32x4){wv[0], wv[1], wv[2], wv[3]};
        if (lane == 0) ((float*)(ws + WS_VB))[(0 * 2 + l) * 16384 + e] = mx > 0.f ? mx * (1.f / 6.f) : 1.f;
        return;
    }
    const float sc = mx > 0.f ? 7.f / mx : 1.f;
    typedef unsigned v16u_t __attribute__((ext_vector_type(16))); typedef __bf16 v32bf_t __attribute__((ext_vector_type(32)));
    v16u_t pw;
#pragma unroll
    for (int j = 0; j < 8; ++j) { pw[j * 2] = pk2(v[j].x * sc, v[j].y * sc); pw[j * 2 + 1] = pk2(v[j].z * sc, v[j].w * sc); }
    const v6u_t w = __builtin_amdgcn_cvt_scalef32_pk32_fp6_bf16(__builtin_bit_cast(v32bf_t, pw), 1.0f);
    unsigned char* row = ws + WS_UB + (size_t)l * ETAB + (size_t)e * EROW;
    ((u32x4*)row)[lane] = (u32x4){w[0], w[1], w[2], w[3]}; ((u32x2*)(row + 1024))[lane] = (u32x2){w[4], w[5]};
    if (lane == 0) ((float*)(ws + WS_VB))[(0 * 2 + l) * 16384 + e] = mx > 0.f ? mx * (1.f / 7.f) : 1.f;
}
__device__ __forceinline__ void expert_row_item2(const AP& a, int which, int l, int e, int lane) {
    const f32x4* src = (const f32x4*)(a.in[which ? 35 : 34] + ((size_t)l * 16384 + e) * DM) + lane;
    const f32x4* gp = (const f32x4*)(a.in[31] + l * DM) + lane;
    f32x4 v0[8], v1[8]; float m0 = 0.f, m1 = 0.f;
#pragma unroll
    for (int j = 0; j < 8; ++j) { v0[j] = src[64 * j]; v1[j] = src[512 + 64 * j]; }
#pragma unroll
    for (int j = 0; j < 8; ++j) { if (!which) { const f32x4 g = gp[64 * j]; v0[j] = v0[j] * g; v1[j] = v1[j] * g; }
        m0 = fmaxf(m0, fmaxf(fmaxf(fabsf(v0[j].x), fabsf(v0[j].y)), fmaxf(fabsf(v0[j].z), fabsf(v0[j].w))));
        m1 = fmaxf(m1, fmaxf(fmaxf(fabsf(v1[j].x), fabsf(v1[j].y)), fmaxf(fabsf(v1[j].z), fabsf(v1[j].w)))); }
    m0 = wave_max(m0); m1 = wave_max(m1);
    expert_row_pack(a, which, l, e, lane, v0, m0); expert_row_pack(a, which, l, e + 1, lane, v1, m1);
}
__device__ __forceinline__ void phase_prep(const Ctx& C, const AP& a) {
    unsigned char* ws = a.ws;
    LAS float* scr = (LAS float*)(C.lds + C.wave * 16640);
    constexpr int I_IN = 32 * 64, I_OUT = 32 * 32, I_Q = 32 * 16, I_GLU = 8 * 8, I_L = I_IN + I_OUT + I_Q + I_GLU;
    for (int it = C.gw; it < 2 * I_L; it += C.ngw) {
        const int l = it / I_L; int r = it % I_L;
        if (r < I_IN) { transpose_item(a.in[2] + (size_t)l * DM * PROJ, a.in[1] + l * DM, DM, PROJ, (bf16_t*)(ws + WS_WINT) + (size_t)l * PROJ * DM, scr, r, C.lane); continue; } r -= I_IN;
        if (r < I_OUT) { transpose_item(a.in[30] + (size_t)l * DM * DM, a.in[29] + l * DM, DM, DM, (bf16_t*)(ws + WS_WOUTT) + (size_t)l * DM * DM, scr, r, C.lane); continue; } r -= I_OUT;
        if (r < I_Q) { transpose_item(a.in[32] + (size_t)l * DM * 1024, a.in[31] + l * DM, DM, 1024, (bf16_t*)(ws + WS_WQT) + (size_t)l * 1024 * DM, scr, r, C.lane); continue; } r -= I_Q;
        transpose_item(a.in[12] + (size_t)l * 512 * 512, nullptr, 512, 512, (bf16_t*)(ws + WS_WGLUT) + (size_t)l * 512 * 512, scr, r, C.lane);
    }
    {
        LAS float* tc = (LAS float*)(C.lds + 8 * 16640); LAS float* ts = tc + 128;
        if (C.tid < 128) { tc[C.tid] = cospif((float)C.tid / 64.f); ts[C.tid] = sinpif((float)C.tid / 64.f); }
        __syncthreads();
        for (int it = C.bx * NTHR + C.tid; it < 2 * 4 * 32 * 512; it += C.G * NTHR) {
            const int cp = it & 511, ccg = (it >> 9) & 31, blk = (it >> 14) & 3, l = it >> 16;
            const float* fw = a.in[3] + (size_t)l * 512 * 512 + (size_t)blk * 128 * 512 + cp;
            float sc[4] = {0.f, 0.f, 0.f, 0.f}, ss[4] = {0.f, 0.f, 0.f, 0.f};
#pragma unroll 8
            for (int m = 0; m < 128; ++m) { const float f = fw[(size_t)m * 512];
#pragma unroll
                for (int r = 0; r < 4; ++r) { const int ix = (m * (ccg * 4 + r)) & 127; sc[r] += tc[ix] * f; ss[r] += ts[ix] * f; } }
            bf16_t* o = (bf16_t*)(ws + WS_WCST) + (size_t)l * 1024 * 512; const int c0 = blk * 128 + ccg * 4;
            u32x2 w; w.x = pk2(sc[0] * (1.f / 512.f), sc[1] * (1.f / 512.f)); w.y = pk2(sc[2] * (1.f / 512.f), sc[3] * (1.f / 512.f)); *(u32x2*)(o + (size_t)(2 * cp) * 512 + c0) = w;
            w.x = pk2(ss[0] * (1.f / 512.f), ss[1] * (1.f / 512.f)); w.y = pk2(ss[2] * (1.f / 512.f), ss[3] * (1.f / 512.f)); *(u32x2*)(o + (size_t)(2 * cp + 1) * 512 + c0) = w;
        }
    }
    for (int it = C.bx * NTHR + C.tid; it < 2048 * 512; it += C.G * NTHR) {
        const int k = it >> 9, j0 = (it & 511) * 8; float v[8];
#pragma unroll
        for (int e = 0; e < 8; ++e) { const int j = j0 + e, s = j & 2047; const float x = (float)((k * s) & 2047) * (1.f / 1024.f); v[e] = (j < 2048) ? cospif(x) : -sinpif(x); }
        u32x4 w; w.x = pk2(v[0], v[1]); w.y = pk2(v[2], v[3]); w.z = pk2(v[4], v[5]); w.w = pk2(v[6], v[7]);
        *(u32x4*)((bf16_t*)(ws + WS_DFT) + (size_t)k * 4096 + j0) = w;
    }
    for (int it = C.bx * NTHR + C.tid; it < 2 * 8 * 2 * 64 * 128; it += C.G * NTHR) {
        const int key = it & 127, d = (it >> 7) & 63, lhp = it >> 13;
        ((float*)(ws + WS_KEYST))[it] = a.in[33][((size_t)lhp * 128 + key) * 64 + d];
    }
    for (int it = C.bx * NTHR + C.tid; it < 2048 * 64; it += C.G * NTHR) {
        const int pos = it >> 6, j = it & 63; const float inv = powf(10000.f, -(float)(2 * (j & 31)) / 64.f);
        const float ang = (float)(j < 32 ? (pos >> 6) : (pos & 63)) * inv;
        ((float*)(ws + WS_ROPE))[it] = cosf(ang); ((float*)(ws + WS_ROPE))[2048 * 64 + it] = sinf(ang);
    }
    {
        bf16_t* W1T = (bf16_t*)(ws + WS_LORA); bf16_t* g2T = W1T + 2 * 224 * 512; bf16_t* w2T = g2T + 2 * 512 * 96; bf16_t* a2T = w2T + 2 * 2 * 512 * 32;
        for (int it = C.bx * NTHR + C.tid; it < 2 * 224 * 512; it += C.G * NTHR) {
            const int k = it & 511, j = (it >> 9) % 224, l = it / (224 * 512); float v;
            if (j < 96) v = a.in[22][((size_t)l * 512 + k) * 96 + j];
            else if (j < 160) v = a.in[17][((size_t)(l * 2 + ((j - 96) >> 5)) * 512 + k) * 32 + ((j - 96) & 31)];
            else v = a.in[20][((size_t)(l * 2 + ((j - 160) >> 5)) * 512 + k) * 32 + ((j - 160) & 31)];
            W1T[it] = (bf16_t)f2bf(v);
        }
        for (int it = C.bx * NTHR + C.tid; it < 2 * 512 * 96; it += C.G * NTHR) {
            const int j = it % 96, ch = (it / 96) & 511, l = it / (96 * 512);
            g2T[it] = (bf16_t)f2bf(a.in[23][((size_t)l * 96 + j) * 512 + ch]);
        }
        for (int it = C.bx * NTHR + C.tid; it < 2 * 2 * 512 * 32; it += C.G * NTHR) {
            const int j = it & 31, ch = (it >> 5) & 511, ld = it >> 14;
            w2T[it] = (bf16_t)f2bf(a.in[18][((size_t)ld * 32 + j) * 512 + ch]); a2T[it] = (bf16_t)f2bf(a.in[21][((size_t)ld * 32 + j) * 512 + ch]);
        }
    }
    for (int m = C.gw; m < MTOK; m += C.ngw) rms_row_to_bf16(a.in[0] + (size_t)m * DM, (bf16_t*)(ws + WS_HB) + (size_t)m * DM, C.lane);
}

__device__ __forceinline__ void qk_prep_token(const AP& a, int l, int m, int lane) {
    unsigned char* ws = a.ws;
    const float* pr = (const float*)(ws + WS_PROJ) + (size_t)m * PROJ;
    const int pos = m & (SEQ - 1);
    const float cs = ((const float*)(ws + WS_ROPE))[pos * 64 + lane], sn = ((const float*)(ws + WS_ROPE))[2048 * 64 + pos * 64 + lane];
    bf16_t* qo = (bf16_t*)(ws + WS_QB) + (size_t)m * 512; bf16_t* ko = (bf16_t*)(ws + WS_QB) + (size_t)MTOK * 512 + (size_t)m * 256; bf16_t* vo = ko + (size_t)MTOK * 256;
#pragma unroll
    for (int hh = 0; hh < 6; ++hh) {
        const float* src = pr + 1024 + hh * 128;
        const float* gn = a.in[hh < 4 ? 13 : 14] + l * 128;
        const float x1 = src[lane], x2 = src[lane + 64];
        const float rs = rsqrtf(wave_sum(x1 * x1 + x2 * x2) * (1.f / 128.f) + 1e-6f);
        const float y1 = x1 * rs * gn[lane], y2 = x2 * rs * gn[lane + 64];
        bf16_t* dst = hh < 4 ? qo + hh * 128 : ko + (hh - 4) * 128;
        dst[lane] = (bf16_t)f2bf(y1 * cs - y2 * sn); dst[lane + 64] = (bf16_t)f2bf(y1 * sn + y2 * cs);
    }
    const f32x4 vv = *((const f32x4*)(pr + 1792) + lane);
    u32x2 w; w.x = pk2(vv.x, vv.y); w.y = pk2(vv.z, vv.w); *((u32x2*)vo + lane) = w;
}

struct S5P { float lr, li, cr, ci; };
__device__ __forceinline__ S5P s5_params(const AP& a, int l, int d, int g, int p, float mult) {
    const int ix = ((l * 2 + d) * 32 + g) * 64 + p;
    const float lre = a.in[4][ix], lim = a.in[5][ix], step = __expf(a.in[6][(l * 2 + d) * 32 + g]) * mult;
    const float er = __expf(lre * step); float sn, cs; sincosf(lim * step, &sn, &cs);
    S5P r; r.lr = er * cs; r.li = er * sn;
    const float nr = r.lr - 1.f, ni = r.li, den = 1.f / (lre * lre + lim * lim);
    r.cr = (nr * lre + ni * lim) * den; r.ci = (ni * lre - nr * lim) * den;
    return r;
}
__device__ __forceinline__ void s5_ends_item(const AP& a, int l, int item, int lane, LAS float* us) {
    unsigned char* ws = a.ws;
    const int c = item & 31, g = (item >> 5) & 31, b = item >> 10, p = lane;
    const float* ur = (const float*)(ws + WS_PROJ) + ((size_t)(b * SEQ + c * 64 + lane)) * PROJ + 512 + g * 16;
#pragma unroll
    for (int q = 0; q < 4; ++q) *((LAS f32x4*)(us + lane * 16) + q) = *((const f32x4*)ur + q);
    LDS_WAIT(); asm volatile("" ::: "memory");
#pragma unroll 1
    for (int d = 0; d < 2; ++d) {
        const S5P P = s5_params(a, l, d, g, p, 1.f);
        f32x2 bb2[16];
        const float* bre = a.in[7] + ((size_t)((l * 2 + d) * 32 + g) * 64 + p) * 16; const float* bim = a.in[8] + ((size_t)((l * 2 + d) * 32 + g) * 64 + p) * 16;
#pragma unroll
        for (int h = 0; h < 16; ++h) { const float x = bre[h], y = bim[h]; bb2[h].x = P.cr * x - P.ci * y; bb2[h].y = P.cr * y + P.ci * x; }
        const f32x2 lam2 = {P.lr, P.lr}, lami = {-P.li, P.li};
        float xr = 0.f, xi = 0.f;
#pragma unroll 4
        for (int tt = 0; tt < 64; ++tt) {
            const int t = d ? 63 - tt : tt;
            f32x2 acc2 = {0.f, 0.f};
#pragma unroll
            for (int q = 0; q < 4; ++q) { const f32x4 u4 = *((const LAS f32x4*)(us + t * 16) + q);
#pragma unroll
                for (int e = 0; e < 4; ++e) acc2 += bb2[q * 4 + e] * u4[e]; }
            const f32x2 x2 = {xr, xi}, xs = {xi, xr}; const f32x2 n2 = lam2 * x2 + lami * xs + acc2; xr = n2.x; xi = n2.y;
        }
        f32x2 o; o.x = xr; o.y = xi;
        ((f32x2*)(ws + WS_S5E))[((size_t)((b * 32 + g) * 2 + d) * 32 + c) * 64 + p] = o;
    }
    LDS_WAIT(); asm volatile("" ::: "memory");
}
__device__ __forceinline__ void s5_final_item(const AP& a, int l, int item, int lane, LAS float* us  , LAS float* yb  , LAS float* X  ) {
    unsigned char* ws = a.ws;
    const int c = item & 31, g = (item >> 5) & 31, b = item >> 10, p = lane;
    const float* ur = (const float*)(ws + WS_PROJ) + ((size_t)(b * SEQ + c * 64 + lane)) * PROJ + 512 + g * 16;
#pragma unroll
    for (int q = 0; q < 4; ++q) { *((LAS f32x4*)(us + lane * 16) + q) = *((const f32x4*)ur + q); *((LAS f32x4*)(yb + lane * 16) + q) = (f32x4){0.f, 0.f, 0.f, 0.f}; }
    LDS_WAIT(); asm volatile("" ::: "memory");
    const int oh = lane & 15, otq = lane >> 4;
#pragma unroll 1
    for (int d = 0; d < 2; ++d) {
        const S5P P = s5_params(a, l, d, g, p, 1.f);
        const S5P P64 = s5_params(a, l, d, g, p, 64.f);
        float br[16], bi[16];
        const float* bre = a.in[7] + ((size_t)((l * 2 + d) * 32 + g) * 64 + p) * 16; const float* bim = a.in[8] + ((size_t)((l * 2 + d) * 32 + g) * 64 + p) * 16;
#pragma unroll
        for (int h = 0; h < 16; ++h) { const float x = bre[h], y = bim[h]; br[h] = P.cr * x - P.ci * y; bi[h] = P.cr * y + P.ci * x; }
        const f32x2* E = (const f32x2*)(ws + WS_S5E) + ((size_t)((b * 32 + g) * 2 + d) * 32) * 64 + p;
        float xr = 0.f, xi = 0.f;
        { f32x2 nx[4];
#pragma unroll
          for (int i = 0; i < 4; ++i) nx[i] = E[(d ? 31 - i : i) * 64];
#pragma unroll 1
          for (int grp = 0; grp < 8; ++grp) {
              if (d ? (31 - grp * 4 <= c) : (grp * 4 >= c)) break;
              f32x2 cu[4];
#pragma unroll
              for (int i = 0; i < 4; ++i) cu[i] = nx[i];
              if (grp < 7) {
#pragma unroll
                  for (int i = 0; i < 4; ++i) nx[i] = E[(d ? 27 - grp * 4 - i : grp * 4 + 4 + i) * 64];
              }
#pragma unroll
              for (int i = 0; i < 4; ++i) { const int cc = d ? 31 - grp * 4 - i : grp * 4 + i;
                  if (d ? (cc > c) : (cc < c)) { const float nr = P64.lr * xr - P64.li * xi + cu[i].x, ni = P64.lr * xi + P64.li * xr + cu[i].y; xr = nr; xi = ni; } }
          } }
        const float* cre = a.in[9] + ((size_t)((l * 2 + d) * 32 + g) * 16 + oh) * 64; const float* cim = a.in[10] + ((size_t)((l * 2 + d) * 32 + g) * 16 + oh) * 64;
#pragma unroll 1
        for (int sb = 0; sb < 4; ++sb) {
            for (int tt = 0; tt < 16; ++tt) {
                const int ts = sb * 16 + tt, t = d ? 63 - ts : ts;
                float ar = 0.f, ai = 0.f;
#pragma unroll
                for (int q = 0; q < 4; ++q) { const f32x4 u4 = *((const LAS f32x4*)(us + t * 16) + q);
#pragma unroll
                    for (int e = 0; e < 4; ++e) { ar += br[q * 4 + e] * u4[e]; ai += bi[q * 4 + e] * u4[e]; } }
                const float nr = P.lr * xr - P.li * xi + ar, ni = P.lr * xi + P.li * xr + ai; xr = nr; xi = ni;
                f32x2 o; o.x = xr; o.y = xi; *((LAS f32x2*)X + tt * 64 + p) = o;
            }
            LDS_WAIT(); asm volatile("" ::: "memory");
            float acc[4] = {0.f, 0.f, 0.f, 0.f};
            for (int pq = 0; pq < 16; ++pq) {
                const f32x4 c4r = *((const f32x4*)cre + pq), c4i = *((const f32x4*)cim + pq);
#pragma unroll
                for (int i = 0; i < 4; ++i) {
                    const LAS f32x4* xp = (const LAS f32x4*)(X + ((otq * 4 + i) * 64 + pq * 4) * 2);
                    const f32x4 xa = xp[0], xb = xp[1];
                    acc[i] += c4r[0] * xa[0] - c4i[0] * xa[1] + c4r[1] * xa[2] - c4i[1] * xa[3] + c4r[2] * xb[0] - c4i[2] * xb[1] + c4r[3] * xb[2] - c4i[3] * xb[3];
                }
            }
#pragma unroll
            for (int i = 0; i < 4; ++i) { const int ts = sb * 16 + otq * 4 + i, t = d ? 63 - ts : ts; yb[t * 16 + oh] += acc[i]; }
            LDS_WAIT(); asm volatile("" ::: "memory");
        }
    }
    const float* dsk = a.in[11] + (l * 32 + g) * 16;
    unsigned w[8];
#pragma unroll
    for (int h = 0; h < 16; h += 2) {
        const float y0 = gelu_tanh(yb[lane * 16 + h] + dsk[h] * us[lane * 16 + h]), y1 = gelu_tanh(yb[lane * 16 + h + 1] + dsk[h + 1] * us[lane * 16 + h + 1]);
        w[h >> 1] = pk2(y0, y1);
    }
    u32x4* dst = (u32x4*)((bf16_t*)(ws + WS_YGELU) + (size_t)(b * SEQ + c * 64 + lane) * 512 + g * 16);
    dst[0] = (u32x4){w[0], w[1], w[2], w[3]}; dst[1] = (u32x4){w[4], w[5], w[6], w[7]};
    LDS_WAIT(); asm volatile("" ::: "memory");
}

__device__ __forceinline__ void s5_tables(const Ctx& C, const AP& a) {
    unsigned char* ws = a.ws;
    f32x4* LAMT = (f32x4*)(ws + WS_S5T); bf16_t* BBop = (bf16_t*)(ws + WS_S5T + 131072); bf16_t* CBop = (bf16_t*)(ws + WS_S5T + 131072 + 1048576);
    for (int it = C.bx * NTHR + C.tid; it < 128 * 64; it += C.G * NTHR) {
        const int p = it & 63, ldg = it >> 6, g = ldg & 31, d = (ldg >> 5) & 1, l = ldg >> 6;
        const S5P P = s5_params(a, l, d, g, p, 1.f), P64 = s5_params(a, l, d, g, p, 64.f);
        LAMT[it] = (f32x4){P.lr, P.li, P64.lr, P64.li};
    }
    for (int it = C.bx * NTHR + C.tid; it < 128 * 8 * 64; it += C.G * NTHR) {
        const int lane = it & 63, nt = (it >> 6) & 7, ldg = it >> 9, g = ldg & 31, d = (ldg >> 5) & 1, l = ldg >> 6, fr = lane & 15, fq = lane >> 4;
        const int col = nt * 16 + fr, p = col >> 1, ri = col & 1;
        unsigned w[4] = {0u, 0u, 0u, 0u};
        if (fq < 2) {
            const S5P P = s5_params(a, l, d, g, p, 1.f);
            const float* bre = a.in[7] + ((size_t)ldg * 64 + p) * 16 + fq * 8; const float* bim = a.in[8] + ((size_t)ldg * 64 + p) * 16 + fq * 8;
            float v[8];
#pragma unroll
            for (int jj = 0; jj < 8; ++jj) v[jj] = ri ? (P.cr * bim[jj] + P.ci * bre[jj]) : (P.cr * bre[jj] - P.ci * bim[jj]);
            w[0] = pk2(v[0], v[1]); w[1] = pk2(v[2], v[3]); w[2] = pk2(v[4], v[5]); w[3] = pk2(v[6], v[7]);
        }
        *(u32x4*)(BBop + (size_t)it * 8) = (u32x4){w[0], w[1], w[2], w[3]};
    }
    for (int it = C.bx * NTHR + C.tid; it < 128 * 4 * 64; it += C.G * NTHR) {
        const int lane = it & 63, s2 = (it >> 6) & 3, ldg = it >> 8, fr = lane & 15, fq = lane >> 4;
        const float* cre = a.in[9] + ((size_t)ldg * 16 + fr) * 64 + 16 * s2 + fq * 4; const float* cim = a.in[10] + ((size_t)ldg * 16 + fr) * 64 + 16 * s2 + fq * 4;
        *(u32x4*)(CBop + (size_t)it * 8) = (u32x4){pk2(cre[0], -cim[0]), pk2(cre[1], -cim[1]), pk2(cre[2], -cim[2]), pk2(cre[3], -cim[3])};
    }
}
__device__ __forceinline__ void s5_load_u(const float* ur, LAS unsigned char* wl, int lane) {
    const f32x4 u0 = *((const f32x4*)ur + 0), u1 = *((const f32x4*)ur + 1), u2 = *((const f32x4*)ur + 2), u3 = *((const f32x4*)ur + 3);
    LAS u32x4* dst = (LAS u32x4*)(wl + lane * 32);
    dst[0] = (u32x4){pk2(u0.x, u0.y), pk2(u0.z, u0.w), pk2(u1.x, u1.y), pk2(u1.z, u1.w)}; dst[1] = (u32x4){pk2(u2.x, u2.y), pk2(u2.z, u2.w), pk2(u3.x, u3.y), pk2(u3.z, u3.w)};
}
__device__ __forceinline__ void s5_build_bb(const AP& a, int ldg, float cr, float ci, int lane, LAS unsigned char* wl, bf16x8_t (&bb)[8]) {
    const int fr = lane & 15, fq = lane >> 4;
    LAS f32x2* cf = (LAS f32x2*)(wl + 14848);
    f32x2 me; me.x = cr; me.y = ci; cf[lane] = me;
    LDS_WAIT(); asm volatile("" ::: "memory");
#pragma unroll
    for (int nt = 0; nt < 8; ++nt) {
        const int col = nt * 16 + fr, p = col >> 1, ri = col & 1;
        unsigned w_[4] = {0u, 0u, 0u, 0u};
        if (fq < 2) {
            const f32x2 c2 = cf[p];
            const f32x4* bre = (const f32x4*)(a.in[7] + ((size_t)ldg * 64 + p) * 16 + fq * 8); const f32x4* bim = (const f32x4*)(a.in[8] + ((size_t)ldg * 64 + p) * 16 + fq * 8);
            const f32x4 r0 = bre[0], r1 = bre[1], i0 = bim[0], i1 = bim[1];
            float v[8];
#pragma unroll
            for (int jj = 0; jj < 4; ++jj) { v[jj] = ri ? (c2.x * i0[jj] + c2.y * r0[jj]) : (c2.x * r0[jj] - c2.y * i0[jj]); v[4 + jj] = ri ? (c2.x * i1[jj] + c2.y * r1[jj]) : (c2.x * r1[jj] - c2.y * i1[jj]); }
            w_[0] = pk2(v[0], v[1]); w_[1] = pk2(v[2], v[3]); w_[2] = pk2(v[4], v[5]); w_[3] = pk2(v[6], v[7]);
        }
        bb[nt] = mk8(w_[0], w_[1], w_[2], w_[3]);
        asm volatile("" ::: "memory");
    }
}
template <bool FINAL>
__device__ __forceinline__ void s5_subblock(LAS unsigned char* wl, const bf16x8_t (&bb)[8], int d, int sb, int lane, float lr, float li, float& xr, float& xi) {
    const int fr = lane & 15, fq = lane >> 4;
    LAS float* BUs = (LAS float*)(wl + 2048); LAS bf16_t* Xb = (LAS bf16_t*)(wl + 10496);
    const int trow = d ? 63 - (sb * 16 + fr) : sb * 16 + fr;
    bf16x8_t aU = mk8(0u, 0u, 0u, 0u);
    if (fq < 2) aU = *(const LAS bf16x8_t*)(wl + trow * 32 + fq * 16);
    const f32x4 z4 = {0.f, 0.f, 0.f, 0.f};
#pragma unroll
    for (int nt = 0; nt < 8; ++nt) { const f32x4 bu = __builtin_amdgcn_mfma_f32_16x16x32_bf16(aU, bb[nt], z4, 0, 0, 0);
#pragma unroll
        for (int r = 0; r < 4; ++r) BUs[(fq * 4 + r) * 132 + nt * 16 + fr] = bu[r]; }
    LDS_WAIT(); asm volatile("" ::: "memory");
#pragma unroll
    for (int tt = 0; tt < 16; ++tt) {
        const f32x2 bq = *(const LAS f32x2*)(BUs + tt * 132 + 2 * lane);
        const float nr = lr * xr - li * xi + bq.x, ni = lr * xi + li * xr + bq.y; xr = nr; xi = ni;
        if (FINAL) *(LAS unsigned*)(Xb + (d ? 15 - tt : tt) * 136 + 2 * lane) = pk2(xr, xi);
    }
    LDS_WAIT(); asm volatile("" ::: "memory");
}
__device__ __forceinline__ void s5_ends_item_m(const AP& a, int l, int item, int lane, LAS unsigned char* wl) {
    unsigned char* ws = a.ws;
    const int c = item & 31, g = (item >> 5) & 31, b = item >> 10;
    s5_load_u((const float*)(ws + WS_PROJ) + ((size_t)(b * SEQ + c * 64 + lane)) * PROJ + 512 + g * 16, wl, lane);
    LDS_WAIT(); asm volatile("" ::: "memory");
#pragma unroll 1
    for (int d = 0; d < 2; ++d) {
        const int ldg = (l * 2 + d) * 32 + g;
        const S5P Pq = s5_params(a, l, d, g, lane, 1.f);
        const f32x4 lam = {Pq.lr, Pq.li, 0.f, 0.f};
        bf16x8_t bb[8]; s5_build_bb(a, ldg, Pq.cr, Pq.ci, lane, wl, bb);
        float xr = 0.f, xi = 0.f;
#pragma unroll 1
        for (int sb = 0; sb < 4; ++sb) s5_subblock<false>(wl, bb, d, sb, lane, lam[0], lam[1], xr, xi);
        f32x2 o; o.x = xr; o.y = xi;
        ((f32x2*)(ws + WS_S5E))[((size_t)((b * 32 + g) * 2 + d) * 32 + c) * 64 + lane] = o;
    }
}
__device__ __forceinline__ void s5_final_item_m(const AP& a, int l, int item, int lane, LAS unsigned char* wl) {
    unsigned char* ws = a.ws;
    const int c = item & 31, g = (item >> 5) & 31, b = item >> 10, fr = lane & 15, fq = lane >> 4;
    const float* ubase = (const float*)(ws + WS_PROJ) + ((size_t)(b * SEQ + c * 64)) * PROJ + 512 + g * 16;
    s5_load_u(ubase + (size_t)lane * PROJ, wl, lane);
    LDS_WAIT(); asm volatile("" ::: "memory");
    LAS bf16_t* Xb = (LAS bf16_t*)(wl + 10496);
    f32x4 yacc[4];
#pragma unroll
    for (int q = 0; q < 4; ++q) yacc[q] = (f32x4){0.f, 0.f, 0.f, 0.f};
#pragma unroll 1
    for (int d = 0; d < 2; ++d) {
        const int ldg = (l * 2 + d) * 32 + g;
        const S5P Pq = s5_params(a, l, d, g, lane, 1.f), P64 = s5_params(a, l, d, g, lane, 64.f);
        const f32x4 lam = {Pq.lr, Pq.li, P64.lr, P64.li};
        bf16x8_t bb[8], cb[4]; s5_build_bb(a, ldg, Pq.cr, Pq.ci, lane, wl, bb);
#pragma unroll
        for (int s2 = 0; s2 < 4; ++s2) {
            const f32x4 cr4 = *(const f32x4*)(a.in[9] + ((size_t)ldg * 16 + fr) * 64 + 16 * s2 + fq * 4), ci4 = *(const f32x4*)(a.in[10] + ((size_t)ldg * 16 + fr) * 64 + 16 * s2 + fq * 4);
            cb[s2] = mk8(pk2(cr4[0], -ci4[0]), pk2(cr4[1], -ci4[1]), pk2(cr4[2], -ci4[2]), pk2(cr4[3], -ci4[3])); }
        const f32x2* E = (const f32x2*)(ws + WS_S5E) + ((size_t)((b * 32 + g) * 2 + d) * 32) * 64 + lane;
        float xr = 0.f, xi = 0.f;
        { f32x2 nx[4];
#pragma unroll
          for (int i = 0; i < 4; ++i) nx[i] = E[(d ? 31 - i : i) * 64];
#pragma unroll 1
          for (int grp = 0; grp < 8; ++grp) {
              if (d ? (31 - grp * 4 <= c) : (grp * 4 >= c)) break;
              f32x2 cu[4];
#pragma unroll
              for (int i = 0; i < 4; ++i) cu[i] = nx[i];
              if (grp < 7) {
#pragma unroll
                  for (int i = 0; i < 4; ++i) nx[i] = E[(d ? 27 - grp * 4 - i : grp * 4 + 4 + i) * 64];
              }
#pragma unroll
              for (int i = 0; i < 4; ++i) { const int cc = d ? 31 - grp * 4 - i : grp * 4 + i;
                  if (d ? (cc > c) : (cc < c)) { const float nr = lam[2] * xr - lam[3] * xi + cu[i].x, ni = lam[2] * xi + lam[3] * xr + cu[i].y; xr = nr; xi = ni; } }
          } }
#pragma unroll
        for (int sb = 0; sb < 4; ++sb) {
            s5_subblock<true>(wl, bb, d, sb, lane, lam[0], lam[1], xr, xi);
            f32x4 acc = d ? yacc[3 - sb] : yacc[sb];
#pragma unroll
            for (int s2 = 0; s2 < 4; ++s2) acc = __builtin_amdgcn_mfma_f32_16x16x32_bf16(*(const LAS bf16x8_t*)(Xb + fr * 136 + s2 * 32 + fq * 8), cb[s2], acc, 0, 0, 0);
            if (d) yacc[3 - sb] = acc; else yacc[sb] = acc;
            LDS_WAIT(); asm volatile("" ::: "memory");
        }
    }
    const float dsk = a.in[11][(l * 32 + g) * 16 + fr];
#pragma unroll
    for (int q = 0; q < 4; ++q)
#pragma unroll
        for (int r = 0; r < 4; ++r) { const int t = q * 16 + fq * 4 + r;
            const float y = gelu_tanh(yacc[q][r] + dsk * ubase[(size_t)t * PROJ + fr]);
            ((bf16_t*)(ws + WS_YGELU))[(size_t)(b * SEQ + c * 64 + t) * 512 + g * 16 + fr] = (bf16_t)f2bf(y); }
}
__device__ __forceinline__ float gelu_tanh_fast(float x) { const float u2 = 1.5957691216057308f * (x + 0.044715f * x * x * x); return x / (1.f + __expf(-u2)); }
__device__ __forceinline__ void s5_final_item_h(const AP& a, int l, int item, int lane, LAS unsigned char* wl) {
    unsigned char* ws = a.ws;
    const int c = item & 31, g = (item >> 5) & 31, b = item >> 10, p = lane, fr = lane & 15, fq = lane >> 4;
    LAS float* us = (LAS float*)wl; LAS bf16_t* Xb = (LAS bf16_t*)(wl + 4096);
    const float* ur = (const float*)(ws + WS_PROJ) + ((size_t)(b * SEQ + c * 64 + lane)) * PROJ + 512 + g * 16;
#pragma unroll
    for (int q = 0; q < 4; ++q) *((LAS f32x4*)(us + lane * 16) + q) = *((const f32x4*)ur + q);
    LDS_WAIT(); asm volatile("" ::: "memory");
    f32x4 yacc[4];
#pragma unroll
    for (int q = 0; q < 4; ++q) yacc[q] = (f32x4){0.f, 0.f, 0.f, 0.f};
#pragma unroll 1
    for (int d = 0; d < 2; ++d) {
        const int ldg = (l * 2 + d) * 32 + g;
        const S5P P = s5_params(a, l, d, g, p, 1.f), P64 = s5_params(a, l, d, g, p, 64.f);
        f32x2 bb2[16];
        const float* bre = a.in[7] + ((size_t)ldg * 64 + p) * 16; const float* bim = a.in[8] + ((size_t)ldg * 64 + p) * 16;
#pragma unroll
        for (int h = 0; h < 16; ++h) { const float x = bre[h], y = bim[h]; bb2[h].x = P.cr * x - P.ci * y; bb2[h].y = P.cr * y + P.ci * x; }
        const f32x2 lam2 = {P.lr, P.lr}, lami = {-P.li, P.li};
        bf16x8_t cb[4];
#pragma unroll
        for (int s2 = 0; s2 < 4; ++s2) {
            const f32x4 cr4 = *(const f32x4*)(a.in[9] + ((size_t)ldg * 16 + fr) * 64 + 16 * s2 + fq * 4), ci4 = *(const f32x4*)(a.in[10] + ((size_t)ldg * 16 + fr) * 64 + 16 * s2 + fq * 4);
            cb[s2] = mk8(pk2(cr4[0], -ci4[0]), pk2(cr4[1], -ci4[1]), pk2(cr4[2], -ci4[2]), pk2(cr4[3], -ci4[3])); }
        const f32x2* E = (const f32x2*)(ws + WS_S5E) + ((size_t)((b * 32 + g) * 2 + d) * 32) * 64 + p;
        float xr = 0.f, xi = 0.f;
        { f32x2 nx[4];
#pragma unroll
          for (int i = 0; i < 4; ++i) nx[i] = E[(d ? 31 - i : i) * 64];
#pragma unroll 1
          for (int grp = 0; grp < 8; ++grp) {
              if (d ? (31 - grp * 4 <= c) : (grp * 4 >= c)) break;
              f32x2 cu[4];
#pragma unroll
              for (int i = 0; i < 4; ++i) cu[i] = nx[i];
              if (grp < 7) {
#pragma unroll
                  for (int i = 0; i < 4; ++i) nx[i] = E[(d ? 27 - grp * 4 - i : grp * 4 + 4 + i) * 64];
              }
#pragma unroll
              for (int i = 0; i < 4; ++i) { const int cc = d ? 31 - grp * 4 - i : grp * 4 + i;
                  if (d ? (cc > c) : (cc < c)) { const float nr = P64.lr * xr - P64.li * xi + cu[i].x, ni = P64.lr * xi + P64.li * xr + cu[i].y; xr = nr; xi = ni; } }
          } }
#pragma unroll
        for (int sb = 0; sb < 4; ++sb) {
#pragma unroll 4
            for (int tt = 0; tt < 16; ++tt) {
                const int ts = sb * 16 + tt, t = d ? 63 - ts : ts;
                f32x2 acc2 = {0.f, 0.f};
#pragma unroll
                for (int q = 0; q < 4; ++q) { const f32x4 u4 = *((const LAS f32x4*)(us + t * 16) + q);
#pragma unroll
                    for (int e = 0; e < 4; ++e) acc2 += bb2[q * 4 + e] * u4[e]; }
                { const f32x2 x2 = {xr, xi}, xs = {xi, xr}; const f32x2 n2 = lam2 * x2 + lami * xs + acc2; xr = n2.x; xi = n2.y; }
                *(LAS unsigned*)(Xb + (d ? 15 - tt : tt) * 136 + 2 * p) = pg8::cvt_pk_bf16(xr, xi);
            }
            LDS_WAIT(); asm volatile("" ::: "memory");
            f32x4 acc = d ? yacc[3 - sb] : yacc[sb];
#pragma unroll
            for (int s2 = 0; s2 < 4; ++s2) acc = __builtin_amdgcn_mfma_f32_16x16x32_bf16(*(const LAS bf16x8_t*)(Xb + fr * 136 + s2 * 32 + fq * 8), cb[s2], acc, 0, 0, 0);
            if (d) yacc[3 - sb] = acc; else yacc[sb] = acc;
            LDS_WAIT(); asm volatile("" ::: "memory");
        }
    }
    const float dsk = a.in[11][(l * 32 + g) * 16 + fr];
#pragma unroll
    for (int q = 0; q < 4; ++q)
#pragma unroll
        for (int r = 0; r < 4; ++r) { const int t = q * 16 + fq * 4 + r;
            const float y = gelu_tanh_fast(yacc[q][r] + dsk * us[t * 16 + fr]);
            ((bf16_t*)(ws + WS_YGELU))[(size_t)(b * SEQ + c * 64 + t) * 512 + g * 16 + fr] = (bf16_t)f2bf(y); }
    LDS_WAIT(); asm volatile("" ::: "memory");
}
__device__ __forceinline__ float shift3(float p, float c, float n, float m0, float m1) { return c + (p - c) * m0 + (n - c) * m1; }
__device__ __forceinline__ float dpp_ror4(float x) { return __builtin_bit_cast(float, __builtin_amdgcn_update_dpp(0, __builtin_bit_cast(int, x), 0x124, 0xF, 0xF, true)); }
__device__ __forceinline__ float dpp_ror8(float x) { return __builtin_bit_cast(float, __builtin_amdgcn_update_dpp(0, __builtin_bit_cast(int, x), 0x128, 0xF, 0xF, true)); }
__device__ __forceinline__ float dpp_q1(float x) { return __builtin_bit_cast(float, __builtin_amdgcn_update_dpp(0, __builtin_bit_cast(int, x), 0xB1, 0xF, 0xF, true)); }
__device__ __forceinline__ float dpp_q2(float x) { return __builtin_bit_cast(float, __builtin_amdgcn_update_dpp(0, __builtin_bit_cast(int, x), 0x4E, 0xF, 0xF, true)); }
__device__ __forceinline__ float row_sum16(float x) { x += dpp_q1(x); x += dpp_q2(x); x += dpp_ror4(x); x += dpp_ror8(x); return x; }
__device__ __forceinline__ void rwkv_prep_item(const Ctx& C, const AP& a, int l, int ti) {
    unsigned char* ws = a.ws;
    LAS bf16_t* zsb = (LAS bf16_t*)C.lds;
    LAS bf16_t* hidb = (LAS bf16_t*)(C.lds + 33280);
    const float* proj = (const float*)(ws + WS_PROJ);
    const int m0 = ti * 32, s0 = m0 & (SEQ - 1), tid = C.tid, lane = C.lane, w = C.wave;
    const float* mu = a.in[15] + (size_t)l * 4 * 2 * 512;
    float* RW = (float*)(ws + WS_RW); float* KS = (float*)(ws + WS_KS);
    {
        const int c = tid;
        const float mr0 = mu[0 * 512 + c], mr1 = mu[1 * 512 + c], mk0 = mu[2 * 512 + c], mk1 = mu[3 * 512 + c], mv0 = mu[4 * 512 + c], mv1 = mu[5 * 512 + c], mz0 = mu[6 * 512 + c], mz1 = mu[7 * 512 + c];
        const float kk_c = a.in[24][l * 512 + c];
#pragma unroll 1
        for (int hf = 0; hf < 2; ++hf) {
            const int tb0 = hf * 16;
            const float* rp = proj + (size_t)(m0 + tb0) * PROJ + 2048 + c;
            float rr[18], kr[18], vr[18], zr[18];
#pragma unroll
            for (int i = 0; i < 18; ++i) {
                const int sq = s0 + tb0 - 1 + i; const bool ok = (sq >= 0) && (sq < SEQ); const float* q = rp + (long)(i - 1) * PROJ;
                rr[i] = ok ? q[0] : 0.f; kr[i] = ok ? q[512] : 0.f; vr[i] = ok ? q[1024] : 0.f; zr[i] = ok ? q[1536] : 0.f;
            }
#pragma unroll
            for (int t = 0; t < 16; ++t) {
                const float rs = shift3(rr[t], rr[t + 1], rr[t + 2], mr0, mr1), ks = shift3(kr[t], kr[t + 1], kr[t + 2], mk0, mk1);
                const float vs = shift3(vr[t], vr[t + 1], vr[t + 2], mv0, mv1), zs = shift3(zr[t], zr[t + 1], zr[t + 2], mz0, mz1);
                const float kkr = ks * kk_c; const float kkn = kkr * rsqrtf(wave_sum(kkr * kkr) + 1e-12f);
                const size_t o = (size_t)(m0 + tb0 + t) * 512 + c;
                RW[(size_t)RW_R * RWSZ + o] = rs; RW[(size_t)RW_V * RWSZ + o] = vs; RW[(size_t)RW_KK * RWSZ + o] = kkn; KS[o] = ks;
                zsb[(tb0 + t) * 520 + c] = (bf16_t)f2bf(zs);
            }
        }
    }
    __syncthreads();
    const int fr = lane & 15, fq = lane >> 4;
    const bf16_t* W1T = (const bf16_t*)(ws + WS_LORA) + (size_t)l * 224 * 512; const bf16_t* g2T = (const bf16_t*)(ws + WS_LORA) + 2 * 224 * 512 + (size_t)l * 512 * 96;
    const bf16_t* w2T = (const bf16_t*)(ws + WS_LORA) + 2 * 224 * 512 + 2 * 512 * 96 + (size_t)l * 2 * 512 * 32; const bf16_t* a2T = w2T + 2 * 2 * 512 * 32;
    for (int tile = w; tile < 28; tile += 8) {
        const int mt = tile / 14, nt = tile % 14;
        f32x4 acc = {0.f, 0.f, 0.f, 0.f};
        const LAS bf16_t* ap = zsb + (mt * 16 + fr) * 520 + fq * 8; const bf16_t* bp = W1T + (size_t)(nt * 16 + fr) * 512 + fq * 8;
#pragma unroll
        for (int kk = 0; kk < 16; ++kk) acc = __builtin_amdgcn_mfma_f32_16x16x32_bf16(*(const LAS bf16x8_t*)(ap + kk * 32), *(const bf16x8_t*)(bp + kk * 32), acc, 0, 0, 0);
        const int hj = nt * 16 + fr;
#pragma unroll
        for (int j = 0; j < 4; ++j) { float v = acc[j]; if (hj < 96) v = sigmoidf_(v); else if (hj < 160) v = tanhf(v); hidb[(mt * 16 + fq * 4 + j) * 240 + hj] = (bf16_t)f2bf(v); }
    }
    __syncthreads();
#pragma unroll 1
    for (int mt = 0; mt < 2; ++mt) {
        bf16x8_t a7[7];
#pragma unroll
        for (int kk = 0; kk < 7; ++kk) a7[kk] = *(const LAS bf16x8_t*)(hidb + (mt * 16 + fr) * 240 + kk * 32 + fq * 8);
        float pb0[4] = {0.f, 0.f, 0.f, 0.f}, pb1[4] = {0.f, 0.f, 0.f, 0.f}, vsr[4][4];
        float cks[4], ckk[4], crs[4], nks[4], nkk[4], nrs[4];
#pragma unroll
        for (int j = 0; j < 4; ++j) { const size_t o = (size_t)(m0 + mt * 16 + fq * 4 + j) * 512 + w * 64 + fr;
            cks[j] = KS[o]; ckk[j] = RW[(size_t)RW_KK * RWSZ + o]; crs[j] = RW[(size_t)RW_R * RWSZ + o]; vsr[0][j] = RW[(size_t)RW_V * RWSZ + o]; }
#pragma unroll
        for (int nt = 0; nt < 4; ++nt) {
            if (nt < 3) {
#pragma unroll
                for (int j = 0; j < 4; ++j) { const size_t o = (size_t)(m0 + mt * 16 + fq * 4 + j) * 512 + w * 64 + (nt + 1) * 16 + fr;
                    nks[j] = KS[o]; nkk[j] = RW[(size_t)RW_KK * RWSZ + o]; nrs[j] = RW[(size_t)RW_R * RWSZ + o]; vsr[nt + 1][j] = RW[(size_t)RW_V * RWSZ + o]; }
            }
            const int ch = w * 64 + nt * 16 + fr;
            f32x4 ag = {0.f, 0.f, 0.f, 0.f}, aw0 = ag, aw1 = ag, aa0 = ag, aa1 = ag;
#pragma unroll
            for (int kk = 0; kk < 3; ++kk) ag = __builtin_amdgcn_mfma_f32_16x16x32_bf16(a7[kk], *(const bf16x8_t*)(g2T + (size_t)ch * 96 + kk * 32 + fq * 8), ag, 0, 0, 0);
            aw0 = __builtin_amdgcn_mfma_f32_16x16x32_bf16(a7[3], *(const bf16x8_t*)(w2T + (size_t)(0 * 512 + ch) * 32 + fq * 8), aw0, 0, 0, 0);
            aw1 = __builtin_amdgcn_mfma_f32_16x16x32_bf16(a7[4], *(const bf16x8_t*)(w2T + (size_t)(1 * 512 + ch) * 32 + fq * 8), aw1, 0, 0, 0);
            aa0 = __builtin_amdgcn_mfma_f32_16x16x32_bf16(a7[5], *(const bf16x8_t*)(a2T + (size_t)(0 * 512 + ch) * 32 + fq * 8), aa0, 0, 0, 0);
            aa1 = __builtin_amdgcn_mfma_f32_16x16x32_bf16(a7[6], *(const bf16x8_t*)(a2T + (size_t)(1 * 512 + ch) * 32 + fq * 8), aa1, 0, 0, 0);
            const float w00 = a.in[16][(l * 2 + 0) * 512 + ch], w01 = a.in[16][(l * 2 + 1) * 512 + ch], a00 = a.in[19][(l * 2 + 0) * 512 + ch], a01 = a.in[19][(l * 2 + 1) * 512 + ch];
            const float ka_c = a.in[25][l * 512 + ch], rk_c = a.in[26][l * 512 + ch];
#pragma unroll
            for (int j = 0; j < 4; ++j) {
                const size_t o = (size_t)(m0 + mt * 16 + fq * 4 + j) * 512 + ch;
                const float ks = cks[j], kkn = ckk[j], rs = crs[j];
#pragma unroll
                for (int d = 0; d < 2; ++d) {
                    const float wl = (d ? w01 : w00) + (d ? aw1[j] : aw0[j]);
                    const float nx = -wl, sp = fmaxf(nx, 0.f) + log1pf(__expf(-fabsf(nx)));
                    const float decay = __expf(-__expf(-sp - 0.5f));
                    const float av = sigmoidf_((d ? a01 : a00) + (d ? aa1[j] : aa0[j]));
                    const float kd = ks * (1.f + (av - 1.f) * ka_c), bb = kkn * av;
                    if (d) pb1[j] += rs * kd * rk_c; else pb0[j] += rs * kd * rk_c;
                    RW[(size_t)(RW_W0 + d) * RWSZ + o] = decay; RW[(size_t)(RW_KD0 + d) * RWSZ + o] = kd; RW[(size_t)(RW_B0 + d) * RWSZ + o] = bb;
                }
                RW[(size_t)RW_G * RWSZ + o] = ag[j];
            }
#pragma unroll
            for (int j = 0; j < 4; ++j) { cks[j] = nks[j]; ckk[j] = nkk[j]; crs[j] = nrs[j]; }
        }
#pragma unroll
        for (int j = 0; j < 4; ++j) { const float tb = row_sum16(pb0[j]) + row_sum16(pb1[j]);
#pragma unroll
            for (int nt = 0; nt < 4; ++nt) RW[(size_t)RW_BONUS * RWSZ + (size_t)(m0 + mt * 16 + fq * 4 + j) * 512 + w * 64 + nt * 16 + fr] = tb * vsr[nt][j]; }
    }
    __syncthreads();
}

__device__ __forceinline__ void rwkv_chunk_pre(const AP& a, int cid, int lane, LAS unsigned char* wl) {
    unsigned char* ws = a.ws;
    const int c = cid & 127, ci = cid >> 7, d = ci & 1, h = (ci >> 1) & 7, b = ci >> 4, fr = lane & 15, fq = lane >> 4;
    const float* RW = (const float*)(ws + WS_RW);
    unsigned char* rec = ws + WS_RWC + (size_t)cid * RWC_REC;
    LAS bf16_t* KH = (LAS bf16_t*)wl; LAS bf16_t* BC = KH + 1152; LAS bf16_t* KC = BC + 1152; LAS bf16_t* RH = KC + 1152;
    LAS bf16_t* KHT = RH + 1152;
    LAS float* Am = (LAS float*)(wl + 11264); LAS float* Bmm = Am + 256; LAS float* Abm = Bmm + 256; LAS float* Akm = Abm + 256; LAS float* Tm = Akm + 256;
    const size_t tok0 = (size_t)b * SEQ; const int colk = h * 64 + lane;
#define TOKI(i) (tok0 + (size_t)(d ? (SEQ - 1 - (c * 16 + (i))) : (c * 16 + (i))))
    {
        float W[16];
#pragma unroll
        for (int i = 0; i < 16; ++i) W[i] = RW[(size_t)(RW_W0 + d) * RWSZ + TOKI(i) * 512 + colk];
#pragma unroll
        for (int i = 1; i < 16; ++i) W[i] *= W[i - 1];
        const float W15 = W[15];
        unsigned zt[16];
#pragma unroll
        for (int i = 0; i < 16; ++i) {
            const size_t o = TOKI(i) * 512 + colk;
            const float kap = RW[(size_t)RW_KK * RWSZ + o], bv = RW[(size_t)(RW_B0 + d) * RWSZ + o], kdv = RW[(size_t)(RW_KD0 + d) * RWSZ + o], rv = RW[(size_t)RW_R * RWSZ + o];
            const float wm1 = i ? W[i - 1] : 1.f, iw = 1.f / W[i], wr = W15 * iw;
            const unsigned kh = f2bf(kap * wm1);
            KH[i * 72 + lane] = (bf16_t)kh; KHT[lane * 16 + i] = (bf16_t)kh;
            BC[i * 72 + lane] = (bf16_t)f2bf(bv * iw); KC[i * 72 + lane] = (bf16_t)f2bf(kdv * iw); RH[i * 72 + lane] = (bf16_t)f2bf(rv * W[i]);
            const unsigned bb = f2bf(bv * wr), kb = f2bf(kdv * wr);
            const int sb = (i >> 2) * 8 + (i & 3), sk = sb + 4;
            if (sb & 1) zt[sb >> 1] |= bb << 16; else zt[sb >> 1] = bb;
            if (sk & 1) zt[sk >> 1] |= kb << 16; else zt[sk >> 1] = kb;
        }
        u32x4* zp = (u32x4*)(rec + 4096 + lane * 64);
#pragma unroll
        for (int q = 0; q < 4; ++q) zp[q] = (u32x4){zt[q * 4], zt[q * 4 + 1], zt[q * 4 + 2], zt[q * 4 + 3]};
        ((float*)(rec + 8192))[lane] = W15;
    }
    float Vq[4][4];
#pragma unroll
    for (int nt = 0; nt < 4; ++nt) {
#pragma unroll
        for (int r = 0; r < 4; ++r) Vq[nt][r] = RW[(size_t)RW_V * RWSZ + TOKI(fq * 4 + r) * 512 + h * 64 + nt * 16 + fr];
        u32x2 pv; pv.x = pk2(Vq[nt][0], Vq[nt][1]); pv.y = pk2(Vq[nt][2], Vq[nt][3]);
        *(u32x2*)(rec + 12800 + (nt * 64 + lane) * 8) = pv;
    }
    LDS_WAIT(); asm volatile("" ::: "memory");
    {
        f32x4 cA = {0.f, 0.f, 0.f, 0.f}, cB = cA, cAb = cA, cAk = cA;
#pragma unroll
        for (int s2 = 0; s2 < 2; ++s2) {
            const int off = fr * 72 + s2 * 32 + fq * 8;
            const bf16x8_t fkh = *(const LAS bf16x8_t*)(KH + off), fbc = *(const LAS bf16x8_t*)(BC + off), fkc = *(const LAS bf16x8_t*)(KC + off), frh = *(const LAS bf16x8_t*)(RH + off);
            cA = __builtin_amdgcn_mfma_f32_16x16x32_bf16(fkh, fbc, cA, 0, 0, 0); cB = __builtin_amdgcn_mfma_f32_16x16x32_bf16(fkh, fkc, cB, 0, 0, 0);
            cAb = __builtin_amdgcn_mfma_f32_16x16x32_bf16(frh, fbc, cAb, 0, 0, 0); cAk = __builtin_amdgcn_mfma_f32_16x16x32_bf16(frh, fkc, cAk, 0, 0, 0);
        }
#pragma unroll
        for (int r = 0; r < 4; ++r) { const int i = fq * 4 + r, j = fr;
            Am[i * 16 + j] = j < i ? cA[r] : 0.f; Bmm[i * 16 + j] = j < i ? cB[r] : 0.f; Abm[i * 16 + j] = j <= i ? cAb[r] : 0.f; Akm[i * 16 + j] = j <= i ? cAk[r] : 0.f; }
    }
    LDS_WAIT(); asm volatile("" ::: "memory");
    {
        float x[16];
#pragma unroll
        for (int i = 0; i < 16; ++i) {
            float sacc = (i == fr) ? 1.f : 0.f;
#pragma unroll
            for (int jq = 0; jq < (i + 3) / 4; ++jq) { const f32x4 q = *(const LAS f32x4*)(Am + i * 16 + jq * 4);
#pragma unroll
                for (int e = 0; e < 4; ++e) if (jq * 4 + e < i) sacc -= q[e] * x[jq * 4 + e]; }
            x[i] = sacc;
        }
        if (fq == 0) {
#pragma unroll
            for (int i = 0; i < 16; ++i) Tm[i * 16 + fr] = x[i];
        }
    }
    LDS_WAIT(); asm volatile("" ::: "memory");
    {
        const f32x4 qT = *(const LAS f32x4*)(Tm + fr * 16 + fq * 4), qB = *(const LAS f32x4*)(Bmm + fr * 16 + fq * 4), qAb = *(const LAS f32x4*)(Abm + fr * 16 + fq * 4), qAk = *(const LAS f32x4*)(Akm + fr * 16 + fq * 4);
        const unsigned ab0 = pk2(qAb[0], qAb[1]), ab1 = pk2(qAb[2], qAb[3]);
        const bf16x8_t aT = mk8(pk2(qT[0], qT[1]), pk2(qT[2], qT[3]), 0u, 0u), aBm = mk8(pk2(qB[0], qB[1]), pk2(qB[2], qB[3]), 0u, 0u);
        const bf16x8_t aAb = mk8(ab0, ab1, 0u, 0u), aAbAk = mk8(ab0, ab1, pk2(qAk[0], qAk[1]), pk2(qAk[2], qAk[3]));
        const f32x4 z4 = {0.f, 0.f, 0.f, 0.f};
#pragma unroll
        for (int nt = 0; nt < 4; ++nt) {
            const u32x2 kq = *(const LAS u32x2*)(KHT + (nt * 16 + fr) * 16 + fq * 4);
            f32x4 ut = __builtin_amdgcn_mfma_f32_16x16x32_bf16(aT, mk8(kq.x, kq.y, 0u, 0u), z4, 0, 0, 0); ut = -ut;
            const unsigned v0 = pk2(Vq[nt][0], Vq[nt][1]), v1 = pk2(Vq[nt][2], Vq[nt][3]);
            const f32x4 bmv = __builtin_amdgcn_mfma_f32_16x16x32_bf16(aBm, mk8(v0, v1, 0u, 0u), z4, 0, 0, 0);
            f32x4 ul = __builtin_amdgcn_mfma_f32_16x16x32_bf16(aT, mk8(pk2(bmv[0], bmv[1]), pk2(bmv[2], bmv[3]), 0u, 0u), z4, 0, 0, 0); ul = -ul;
            const unsigned u0 = pk2(ut[0], ut[1]), u1 = pk2(ut[2], ut[3]);
            f32x4 yh = __builtin_amdgcn_mfma_f32_16x16x32_bf16(aAb, mk8(u0, u1, 0u, 0u), z4, 0, 0, 0);
#pragma unroll
            for (int r = 0; r < 4; ++r) yh[r] += bflo((unsigned)RH[(fq * 4 + r) * 72 + nt * 16 + fr]);
            const unsigned l0 = pk2(ul[0], ul[1]), l1 = pk2(ul[2], ul[3]);
            const f32x4 yl = __builtin_amdgcn_mfma_f32_16x16x32_bf16(aAbAk, mk8(l0, l1, v0, v1), z4, 0, 0, 0);
            const int s2 = nt >> 1, slot = (fr >> 2) * 8 + (fr & 3) + ((nt & 1) ? 4 : 0);
            bf16_t* m0p = (bf16_t*)rec + ((0 * 2 + s2) * 16) * 32 + slot; bf16_t* m1p = (bf16_t*)rec + ((1 * 2 + s2) * 16) * 32 + slot;
#pragma unroll
            for (int r = 0; r < 4; ++r) { m0p[(fq * 4 + r) * 32] = (bf16_t)((r & 1) ? (((r >> 1) ? u1 : u0) >> 16) : (((r >> 1) ? u1 : u0) & 0xffffu)); m1p[(fq * 4 + r) * 32] = (bf16_t)f2bf(yh[r]); }
            u32x2 pl; pl.x = l0; pl.y = l1; *(u32x2*)(rec + 8704 + (nt * 64 + lane) * 8) = pl;
            u32x2 py; py.x = pk2(yl[0], yl[1]); py.y = pk2(yl[2], yl[3]); *(u32x2*)(rec + 10752 + (nt * 64 + lane) * 8) = py;
        }
    }
    LDS_WAIT(); asm volatile("" ::: "memory");
#undef TOKI
}
__device__ __forceinline__ void vm_wait_chunks(int n) {
    switch (n) { case 0: asm volatile("s_waitcnt vmcnt(0)" ::: "memory"); break; case 1: asm volatile("s_waitcnt vmcnt(4)" ::: "memory"); break;
                 case 2: asm volatile("s_waitcnt vmcnt(8)" ::: "memory"); break; case 3: asm volatile("s_waitcnt vmcnt(12)" ::: "memory"); break;
                 case 4: asm volatile("s_waitcnt vmcnt(16)" ::: "memory"); break; case 5: asm volatile("s_waitcnt vmcnt(20)" ::: "memory"); break;
                 default: asm volatile("s_waitcnt vmcnt(24)" ::: "memory"); break; }
}
__device__ __forceinline__ void rwkv_seq_chain(const Ctx& C, const AP& a, int ci) {
    unsigned char* ws = a.ws;
    const int w = C.wave, lane = C.lane, fr = lane & 15, fq = lane >> 4, d = ci & 1, h = (ci >> 1) & 7, b = ci >> 4;
    const unsigned char* recs = ws + WS_RWC + (size_t)ci * 128 * RWC_REC;
    LAS unsigned char* ring = C.lds;
    const bool loader = w >= 4; const int lw = w - 4;
#define RWC_ISSUE(cc) do { _Pragma("unroll") for (int p_ = 0; p_ < 4; ++p_) { const int pc_ = (lw * 4 + p_) < 15 ? (lw * 4 + p_) : 14; \
        __builtin_amdgcn_global_load_lds((const unsigned*)(recs + (size_t)(cc) * RWC_REC + pc_ * 1024 + lane * 16), (LAS unsigned*)(ring + ((cc) & 7) * RWC_REC + pc_ * 1024), 16, 0, 0); } } while (0)
    if (loader) {
#pragma unroll 1
        for (int cc = 0; cc < 8; ++cc) RWC_ISSUE(cc);
        asm volatile("s_waitcnt vmcnt(28)" ::: "memory");
    }
    __builtin_amdgcn_s_barrier(); asm volatile("" ::: "memory");
    f32x4 ST[4];
#pragma unroll
    for (int kt = 0; kt < 4; ++kt) ST[kt] = (f32x4){0.f, 0.f, 0.f, 0.f};
    float* Y = (float*)(ws + WS_YRW) + (size_t)d * RWSZ + (size_t)b * SEQ * 512 + h * 64 + w * 16 + fr;
#pragma unroll 1
    for (int c = 0; c < 128; ++c) {
        if (!loader) {
            const LAS unsigned char* sl = ring + (c & 7) * RWC_REC;
            const bf16x8_t a00 = *(const LAS bf16x8_t*)(sl + (0 * 16 + fr) * 64 + fq * 16), a01 = *(const LAS bf16x8_t*)(sl + (1 * 16 + fr) * 64 + fq * 16);
            const bf16x8_t a10 = *(const LAS bf16x8_t*)(sl + (2 * 16 + fr) * 64 + fq * 16), a11 = *(const LAS bf16x8_t*)(sl + (3 * 16 + fr) * 64 + fq * 16);
            const u32x2 ulw = *(const LAS u32x2*)(sl + 8704 + (w * 64 + lane) * 8), ylw = *(const LAS u32x2*)(sl + 10752 + (w * 64 + lane) * 8), vpw = *(const LAS u32x2*)(sl + 12800 + (w * 64 + lane) * 8);
            const bf16x8_t bs0 = mk8(pk2(ST[0][0], ST[0][1]), pk2(ST[0][2], ST[0][3]), pk2(ST[1][0], ST[1][1]), pk2(ST[1][2], ST[1][3]));
            const bf16x8_t bs1 = mk8(pk2(ST[2][0], ST[2][1]), pk2(ST[2][2], ST[2][3]), pk2(ST[3][0], ST[3][1]), pk2(ST[3][2], ST[3][3]));
            const f32x4 z4 = {0.f, 0.f, 0.f, 0.f};
            f32x4 g0 = __builtin_amdgcn_mfma_f32_16x16x32_bf16(a00, bs0, z4, 0, 0, 0); g0 = __builtin_amdgcn_mfma_f32_16x16x32_bf16(a01, bs1, g0, 0, 0, 0);
            f32x4 g1 = __builtin_amdgcn_mfma_f32_16x16x32_bf16(a10, bs0, z4, 0, 0, 0); g1 = __builtin_amdgcn_mfma_f32_16x16x32_bf16(a11, bs1, g1, 0, 0, 0);
            const float uf0 = g0[0] + bflo(ulw.x), uf1 = g0[1] + bfhi(ulw.x), uf2 = g0[2] + bflo(ulw.y), uf3 = g0[3] + bfhi(ulw.y);
            const bf16x8_t xb = mk8(pk2(uf0, uf1), pk2(uf2, uf3), vpw.x, vpw.y);
#pragma unroll
            for (int kt = 0; kt < 4; ++kt) {
                const f32x4 dq = *(const LAS f32x4*)(sl + 8192 + (kt * 16 + fq * 4) * 4);
                const bf16x8_t az = *(const LAS bf16x8_t*)(sl + 4096 + (kt * 16 + fr) * 64 + fq * 16);
                ST[kt] = __builtin_amdgcn_mfma_f32_16x16x32_bf16(az, xb, ST[kt] * dq, 0, 0, 0);
            }
            const float y0 = g1[0] + bflo(ylw.x), y1 = g1[1] + bfhi(ylw.x), y2 = g1[2] + bflo(ylw.y), y3 = g1[3] + bfhi(ylw.y);
            const int sbase = c * 16 + fq * 4;
            Y[(size_t)(d ? SEQ - 1 - (sbase + 0) : sbase + 0) * 512] = y0; Y[(size_t)(d ? SEQ - 1 - (sbase + 1) : sbase + 1) * 512] = y1;
            Y[(size_t)(d ? SEQ - 1 - (sbase + 2) : sbase + 2) * 512] = y2; Y[(size_t)(d ? SEQ - 1 - (sbase + 3) : sbase + 3) * 512] = y3;
            asm volatile("s_waitcnt lgkmcnt(0)" ::: "memory");
        } else if (c + 1 < 128) {
            const int lastc = (c + 7 < 127) ? c + 7 : 127;
            vm_wait_chunks(lastc - (c + 1));
        }
        __builtin_amdgcn_s_barrier(); asm volatile("" ::: "memory");
        if (loader && c + 8 < 128) RWC_ISSUE(c + 8);
    }
    asm volatile("s_waitcnt vmcnt(0)" ::: "memory");
    __builtin_amdgcn_s_barrier(); asm volatile("" ::: "memory");
#undef RWC_ISSUE
}

__device__ __forceinline__ float dpp_sum8(float x) {
    x += __builtin_bit_cast(float, __builtin_amdgcn_update_dpp(0, __builtin_bit_cast(int, x), 0xB1, 0xF, 0xF, true));
    x += __builtin_bit_cast(float, __builtin_amdgcn_update_dpp(0, __builtin_bit_cast(int, x), 0x4E, 0xF, 0xF, true));
    x += __builtin_bit_cast(float, __builtin_amdgcn_update_dpp(0, __builtin_bit_cast(int, x), 0x141, 0xF, 0xF, true));
    return x;
}
__device__ __forceinline__ void rwkv_scan_item(const Ctx& C, const AP& a, int item) {
    unsigned char* ws = a.ws;
    const int d = item & 1, h = (item >> 1) & 7, b = item >> 4, tid = C.tid, v = tid >> 3, kq = tid & 7;
    const float* RW = (const float*)(ws + WS_RW);
    const float* arr[6] = { RW + (size_t)RW_KK * RWSZ, RW + (size_t)(RW_W0 + d) * RWSZ, RW + (size_t)(RW_B0 + d) * RWSZ, RW + (size_t)(RW_KD0 + d) * RWSZ, RW + (size_t)RW_R * RWSZ, RW + (size_t)RW_V * RWSZ };
    float* Y = (float*)(ws + WS_YRW) + (size_t)d * RWSZ;
    LAS float* buf = (LAS float*)C.lds;
    const int ls = tid >> 4, lq = tid & 15;
    f32x4 stg[6];
    const size_t colbase = (size_t)h * 64;
#define RW_LOAD(ch) do { const int s_ = (ch) * 32 + ls, t_ = d ? (SEQ - 1 - s_) : s_; const size_t o_ = ((size_t)(b * SEQ + t_)) * 512 + colbase + lq * 4; \
        _Pragma("unroll") for (int q_ = 0; q_ < 6; ++q_) stg[q_] = *(const f32x4*)(arr[q_] + o_); } while (0)
#define RW_WRITE(bi) do { _Pragma("unroll") for (int q_ = 0; q_ < 6; ++q_) *(LAS f32x4*)(buf + (((bi) * 6 + q_) * 32 + ls) * 64 + lq * 4) = stg[q_]; } while (0)
    float S[8];
#pragma unroll
    for (int j = 0; j < 8; ++j) S[j] = 0.f;
    RW_LOAD(0); RW_WRITE(0); __syncthreads();
    for (int ch = 0; ch < SEQ / 32; ++ch) {
        const int bi = ch & 1;
        if (ch + 1 < SEQ / 32) RW_LOAD(ch + 1);
        const LAS float* B0 = buf + (bi * 6) * 32 * 64;
        for (int st = 0; st < 32; ++st) {
            const LAS float* bp = B0 + st * 64 + kq * 8;
            const f32x4 k0 = *(const LAS f32x4*)(bp), k1 = *(const LAS f32x4*)(bp + 4);
            const f32x4 w0 = *(const LAS f32x4*)(bp + 2048), w1 = *(const LAS f32x4*)(bp + 2048 + 4);
            const f32x4 b0 = *(const LAS f32x4*)(bp + 4096), b1 = *(const LAS f32x4*)(bp + 4096 + 4);
            const f32x4 d0 = *(const LAS f32x4*)(bp + 6144), d1 = *(const LAS f32x4*)(bp + 6144 + 4);
            const f32x4 r0 = *(const LAS f32x4*)(bp + 8192), r1 = *(const LAS f32x4*)(bp + 8192 + 4);
            const float vv = B0[10240 + st * 64 + v];
            float sa = S[0] * k0[0] + S[1] * k0[1] + S[2] * k0[2] + S[3] * k0[3] + S[4] * k1[0] + S[5] * k1[1] + S[6] * k1[2] + S[7] * k1[3];
            sa = -dpp_sum8(sa);
            float y = 0.f;
#pragma unroll
            for (int j = 0; j < 4; ++j) { S[j] = S[j] * w0[j] + (sa * b0[j] + vv * d0[j]); y += S[j] * r0[j]; S[4 + j] = S[4 + j] * w1[j] + (sa * b1[j] + vv * d1[j]); y += S[4 + j] * r1[j]; }
            y = dpp_sum8(y);
            if (kq == 0) { const int s_ = ch * 32 + st, t_ = d ? (SEQ - 1 - s_) : s_; Y[((size_t)(b * SEQ + t_)) * 512 + colbase + v] = y; }
        }
        if (ch + 1 < SEQ / 32) RW_WRITE(bi ^ 1);
        __syncthreads();
    }
#undef RW_LOAD
#undef RW_WRITE
}
__device__ __forceinline__ void rwkv_post_item(const AP& a, int l, int item, int lane) {
    unsigned char* ws = a.ws;
    const int hh = item & 7, m = item >> 3, c = hh * 64 + lane; const size_t o = (size_t)m * 512 + c;
    const float* Y = (const float*)(ws + WS_YRW); const float* RW = (const float*)(ws + WS_RW);
    const float y = Y[o] + Y[RWSZ + o];
    const float mean = wave_sum(y) * (1.f / 64.f), dv = y - mean, var = wave_sum(dv * dv) * (1.f / 64.f);
    const float yn = dv * rsqrtf(var + 64e-5f) * a.in[27][l * 512 + c] + a.in[28][l * 512 + c];
    ((float*)(ws + WS_YA))[(size_t)3 * RWSZ + o] = (yn + RW[(size_t)RW_BONUS * RWSZ + o]) * RW[(size_t)RW_G * RWSZ + o];
}
__device__ __forceinline__ void branch_d_item(const AP& a, int l, int m, int lane) {
    unsigned char* ws = a.ws;
    const float* Y = (const float*)(ws + WS_YRW); const float* RW = (const float*)(ws + WS_RW);
    float o[8]; float ss = 0.f;
#pragma unroll
    for (int hh = 0; hh < 8; ++hh) {
        const int c = hh * 64 + lane; const size_t ix = (size_t)m * 512 + c;
        const float y = Y[ix] + Y[RWSZ + ix];
        const float mean = wave_sum(y) * (1.f / 64.f), dv = y - mean, var = wave_sum(dv * dv) * (1.f / 64.f);
        const float yn = dv * rsqrtf(var + 64e-5f) * a.in[27][l * 512 + c] + a.in[28][l * 512 + c];
        o[hh] = (yn + RW[(size_t)RW_BONUS * RWSZ + ix]) * RW[(size_t)RW_G * RWSZ + ix]; ss += o[hh] * o[hh];
    }
    const float rs = rsqrtf(wave_sum(ss) * (1.f / 512.f) + 1e-6f);
    bf16_t* dst = (bf16_t*)(ws + WS_HB) + (size_t)m * DM + 1536 + lane;
#pragma unroll
    for (int hh = 0; hh < 8; ++hh) dst[hh * 64] = (bf16_t)f2bf(o[hh] * rs);
}
__device__ __forceinline__ void branch_norm_item(const AP& a, int item, int lane) {
    unsigned char* ws = a.ws;
    const int br = item & 3, m = item >> 2;
    const f32x4* src = (const f32x4*)((const float*)(ws + WS_YA) + (size_t)br * RWSZ + (size_t)m * 512) + lane;
    const f32x4 v0 = src[0], v1 = src[64];
    const float ss = wave_sum(v0.x * v0.x + v0.y * v0.y + v0.z * v0.z + v0.w * v0.w + v1.x * v1.x + v1.y * v1.y + v1.z * v1.z + v1.w * v1.w);
    const float rs = rsqrtf(ss * (1.f / 512.f) + 1e-6f);
    u32x2* dst = (u32x2*)((bf16_t*)(ws + WS_HB) + (size_t)m * DM + br * 512) + lane;
    u32x2 w; w.x = pk2(v0.x * rs, v0.y * rs); w.y = pk2(v0.z * rs, v0.w * rs); dst[0] = w;
    w.x = pk2(v1.x * rs, v1.y * rs); w.y = pk2(v1.z * rs, v1.w * rs); dst[64] = w;
}

__device__ __forceinline__ unsigned fkey(float f) { const unsigned u = __float_as_uint(f); return (u & 0x80000000u) ? ~u : (u | 0x80000000u); }
__device__ __forceinline__ int lane_rank(unsigned long long m) { return __builtin_amdgcn_mbcnt_hi((unsigned)(m >> 32), __builtin_amdgcn_mbcnt_lo((unsigned)m, 0)); }
template <int N>
__device__ __forceinline__ void top16_select(const float (&val)[N], const int (&idx)[N], LAS float* lv, LAS int* li) {
    unsigned k[N];
#pragma unroll
    for (int e = 0; e < N; ++e) k[e] = fkey(val[e]);
    unsigned T = 0;
    for (int bit = 31; bit >= 0; --bit) {
        const unsigned cand = T | (1u << bit); int cnt = 0;
#pragma unroll
        for (int e = 0; e < N; ++e) cnt += __popcll(__ballot(k[e] >= cand));
        if (cnt >= 16) T = cand;
        if (cnt == 16) break;
    }
    int ngt = 0;
#pragma unroll
    for (int e = 0; e < N; ++e) ngt += __popcll(__ballot(k[e] > T));
    const int need = 16 - ngt; int eqbase = 0, posbase = 0;
#pragma unroll
    for (int e = 0; e < N; ++e) {
        const unsigned long long meq = __ballot(k[e] == T);
        const int eqrank = eqbase + lane_rank(meq);
        const bool sel = (k[e] > T) || (k[e] == T && eqrank < need);
        const unsigned long long msel = __ballot(sel);
        const int pos = posbase + lane_rank(msel);
        if (sel) { lv[pos] = val[e]; li[pos] = idx[e]; }
        eqbase += __popcll(meq); posbase += __popcll(msel);
    }
    LDS_WAIT(); asm volatile("" ::: "memory");
}
__device__ __forceinline__ float dpp_xor1(float x) { return __builtin_bit_cast(float, __builtin_amdgcn_update_dpp(0, __builtin_bit_cast(int, x), 0xB1, 0xF, 0xF, true)); }
__device__ __forceinline__ float dpp_xor2(float x) { return __builtin_bit_cast(float, __builtin_amdgcn_update_dpp(0, __builtin_bit_cast(int, x), 0x4E, 0xF, 0xF, true)); }
__device__ __forceinline__ float reduce8(const float (&v)[8], int lane) {
    const bool b0 = lane & 1, b1 = lane & 2, b2 = lane & 4;
    float w4[4], w2[2];
#pragma unroll
    for (int k = 0; k < 4; ++k) { const float keep = b0 ? v[4 + k] : v[k], send = b0 ? v[k] : v[4 + k]; w4[k] = keep + dpp_xor1(send); }
#pragma unroll
    for (int k = 0; k < 2; ++k) { const float keep = b1 ? w4[2 + k] : w4[k], send = b1 ? w4[k] : w4[2 + k]; w2[k] = keep + dpp_xor2(send); }
    const float keep = b2 ? w2[1] : w2[0], send = b2 ? w2[0] : w2[1];
    float r = keep + __shfl_xor(send, 4);
    r += __shfl_xor(r, 8); r += __shfl_xor(r, 16); r += __shfl_xor(r, 32);
    return r;
}
typedef float f32x2v __attribute__((ext_vector_type(2)));
__device__ __forceinline__ void split8(const f32x4 a0, const f32x4 a1, bf16x8_t& hi, bf16x8_t& lo) {
    unsigned h[4], l_[4];
#pragma unroll
    for (int i = 0; i < 4; ++i) { const float x0 = i < 2 ? a0[2 * i] : a1[2 * i - 4], x1 = i < 2 ? a0[2 * i + 1] : a1[2 * i - 3];
        const unsigned h0 = f2bf(x0), h1 = f2bf(x1); h[i] = h0 | (h1 << 16);
        l_[i] = pk2(x0 - __uint_as_float(h0 << 16), x1 - __uint_as_float(h1 << 16)); }
    hi = mk8(h[0], h[1], h[2], h[3]); lo = mk8(l_[0], l_[1], l_[2], l_[3]);
}
__device__ __forceinline__ void peer_select_head(const f32x2 s0, const f32x2 s1, int lane, LAS float* wl, LAS int* fe, LAS float* fg, int ci_i, int ci_j, bool cand_on) {
    { const float v0[2] = {s0.x, s0.y}; const int i0[2] = {2 * lane, 2 * lane + 1}; top16_select<2>(v0, i0, wl, (LAS int*)(wl + 16)); }
    { const float v1[2] = {s1.x, s1.y}; const int i1[2] = {2 * lane, 2 * lane + 1}; top16_select<2>(v1, i1, wl + 32, (LAS int*)(wl + 48)); }
    if (lane < 32) { const int lst = lane >> 4, ii = lane & 15; const LAS float* lv = wl + lst * 32;
      const float v = lv[ii]; const int ix = ((const LAS int*)lv)[16 + ii]; int rank = 0;
#pragma unroll
      for (int jq = 0; jq < 4; ++jq) { const f32x4 q = *(const LAS f32x4*)(lv + jq * 4);
#pragma unroll
          for (int e = 0; e < 4; ++e) rank += (q[e] > v || (q[e] == v && (jq * 4 + e) < ii)) ? 1 : 0; }
      wl[64 + lst * 32 + rank] = v; ((LAS int*)wl)[64 + lst * 32 + 16 + rank] = ix; }
    LDS_WAIT(); asm volatile("" ::: "memory");
    { const float cvv = cand_on ? wl[64 + ci_i] + wl[96 + ci_j] : -INFINITY;
      const float cv[1] = {cvv}; const int ci[1] = {ci_i * 16 + ci_j};
      top16_select<1>(cv, ci, wl + 128, (LAS int*)(wl + 144)); }
    { const bool act = lane < 16; const float sc = act ? wl[128 + lane] : -3.0e38f; const int fi = act ? ((LAS int*)wl)[144 + lane] : 0;
      const int e = ((LAS int*)wl)[80 + (fi >> 4)] * 128 + ((LAS int*)wl)[112 + (fi & 15)];
      const float mx = wave_max(sc), ex = act ? __expf(sc - mx) : 0.f, sm = wave_sum(ex);
      if (act) { fe[lane] = e; fg[lane] = ex / sm; } }
    LDS_WAIT(); asm volatile("" ::: "memory");
}
__device__ __forceinline__ void peer_tile(const Ctx& C, const AP& a, int l, int tile, const float* x1, float* xout, bool write_hb) {
    unsigned char* ws = a.ws;
    const int tid = C.tid, lane = C.lane, w = C.wave, tb = tile * 32;
    LAS float* keys = (LAS float*)C.lds;
    LAS int* rt_idx = (LAS int*)(C.lds + 65536);
    LAS float* rt_gate = (LAS float*)(C.lds + 81920);
    LAS float* wl = (LAS float*)(C.lds + 98304) + w * 256;
    LAS float* ssp = (LAS float*)(C.lds + 98304 + 8 * 1024);
    const float* qry = (const float*)(ws + WS_PROJ);
    int ci_i, ci_j; const bool cand_on = lane < 50;
    if (lane < 16) { ci_i = 0; ci_j = lane; } else if (lane < 24) { ci_i = 1; ci_j = lane - 16; } else if (lane < 29) { ci_i = 2; ci_j = lane - 24; }
    else if (lane < 33) { ci_i = 3; ci_j = lane - 29; } else if (lane < 36) { ci_i = 4; ci_j = lane - 33; } else if (lane < 38) { ci_i = 5; ci_j = lane - 36; }
    else if (lane < 40) { ci_i = 6; ci_j = lane - 38; } else if (lane < 42) { ci_i = 7; ci_j = lane - 40; } else if (lane < 50) { ci_i = lane - 34; ci_j = 0; } else { ci_i = 0; ci_j = 0; }
    float* Ssc = (float*)(ws + WS_RW) + (size_t)tile * 65536;
    { const int fr = lane & 15, fq = lane >> 4;
#pragma unroll 1
      for (int hp = 0; hp < 16; ++hp) {
        const int h = hp >> 1, pp = hp & 1;
        bf16x8_t ah[2][2], al[2][2], bh[2], bl[2];
#pragma unroll
        for (int ks = 0; ks < 2; ++ks) {
            const float* kp = a.in[33] + ((size_t)(((l * 8 + h) * 2 + pp) * 128 + 16 * w + fr)) * 64 + ks * 32 + fq * 8;
            split8(*(const f32x4*)kp, *(const f32x4*)(kp + 4), bh[ks], bl[ks]);
#pragma unroll
            for (int mt = 0; mt < 2; ++mt) { const float* qp = qry + (size_t)(tb + mt * 16 + fr) * 1024 + h * 128 + pp * 64 + ks * 32 + fq * 8;
                split8(*(const f32x4*)qp, *(const f32x4*)(qp + 4), ah[mt][ks], al[mt][ks]); }
        }
#pragma unroll
        for (int mt = 0; mt < 2; ++mt) { f32x4 acc = {0.f, 0.f, 0.f, 0.f};
#pragma unroll
            for (int ks = 0; ks < 2; ++ks) { acc = __builtin_amdgcn_mfma_f32_16x16x32_bf16(al[mt][ks], bh[ks], acc, 0, 0, 0); acc = __builtin_amdgcn_mfma_f32_16x16x32_bf16(ah[mt][ks], bl[ks], acc, 0, 0, 0);
                acc = __builtin_amdgcn_mfma_f32_16x16x32_bf16(ah[mt][ks], bh[ks], acc, 0, 0, 0); }
#pragma unroll
            for (int r = 0; r < 4; ++r) Ssc[(size_t)(hp * 32 + mt * 16 + fq * 4 + r) * 128 + 16 * w + fr] = acc[r]; }
      } }
    __syncthreads();
    const unsigned char* U6 = ws + WS_UB + (size_t)l * ETAB; const unsigned char* V4 = ws + WS_UB + 64 * MiB + (size_t)l * 16 * MiB;
    const float* Us = (const float*)(ws + WS_VB) + (0 * 2 + l) * 16384; const float* Vs = (const float*)(ws + WS_VB) + (1 * 2 + l) * 16384;
    bf16_t* hb = (bf16_t*)(ws + WS_HB);
    u32x4 ua[8]; u32x4 va[8]; float sul, svl, gl; float xf[32], acc[32];
#define PEER_IDS(mye_, ei_) _Pragma("unroll") for (int e = 0; e < 8; ++e) ei_[e] = __builtin_amdgcn_readlane(mye_, ((e >> 2) & 1) | (((e >> 1) & 1) << 1) | ((e & 1) << 2));
#define PEER_ISSUE_U(ei_, ln_) _Pragma("unroll") for (int e = 0; e < 8; ++e) ua[e] = ((const u32x4*)(U6 + (size_t)ei_[e] * 1024))[ln_];
#define PEER_ISSUE_V(ei_, ln_) _Pragma("unroll") for (int e = 0; e < 8; ++e) va[e] = ((const u32x4*)(V4 + (size_t)ei_[e] * 1024))[ln_];
#define PEER_DOTS(dot_) _Pragma("unroll") for (int e = 0; e < 8; ++e) { f32x2v s2 = {0.f, 0.f}; \
        _Pragma("unroll") for (int d4 = 0; d4 < 4; ++d4) { const unsigned wd = ua[e][d4]; \
            s2 = __builtin_elementwise_fma((f32x2v){xf[8 * d4 + 0], xf[8 * d4 + 1]}, __builtin_amdgcn_cvt_scalef32_pk_f32_fp4(wd, 1.0f, 0), s2); \
            s2 = __builtin_elementwise_fma((f32x2v){xf[8 * d4 + 2], xf[8 * d4 + 3]}, __builtin_amdgcn_cvt_scalef32_pk_f32_fp4(wd, 1.0f, 1), s2); \
            s2 = __builtin_elementwise_fma((f32x2v){xf[8 * d4 + 4], xf[8 * d4 + 5]}, __builtin_amdgcn_cvt_scalef32_pk_f32_fp4(wd, 1.0f, 2), s2); \
            s2 = __builtin_elementwise_fma((f32x2v){xf[8 * d4 + 6], xf[8 * d4 + 7]}, __builtin_amdgcn_cvt_scalef32_pk_f32_fp4(wd, 1.0f, 3), s2); } \
        dot_[e] = s2.x + s2.y; }
#define PEER_ACCUM(cfl_) _Pragma("unroll") for (int e = 0; e < 8; ++e) { \
        const int src = ((e >> 2) & 1) | (((e >> 1) & 1) << 1) | ((e & 1) << 2); \
        const float cf = __builtin_bit_cast(float, __builtin_amdgcn_readlane(__builtin_bit_cast(int, cfl_), src)); \
        _Pragma("unroll") for (int d4 = 0; d4 < 4; ++d4) { const unsigned wd = va[e][d4]; \
            const f32x2v p0 = __builtin_amdgcn_cvt_scalef32_pk_f32_fp4(wd, 1.0f, 0), p1 = __builtin_amdgcn_cvt_scalef32_pk_f32_fp4(wd, 1.0f, 1); \
            const f32x2v p2 = __builtin_amdgcn_cvt_scalef32_pk_f32_fp4(wd, 1.0f, 2), p3 = __builtin_amdgcn_cvt_scalef32_pk_f32_fp4(wd, 1.0f, 3); \
            acc[8 * d4 + 0] += cf * p0.x; acc[8 * d4 + 1] += cf * p0.y; acc[8 * d4 + 2] += cf * p1.x; acc[8 * d4 + 3] += cf * p1.y; \
            acc[8 * d4 + 4] += cf * p2.x; acc[8 * d4 + 5] += cf * p2.y; acc[8 * d4 + 6] += cf * p3.x; acc[8 * d4 + 7] += cf * p3.y; } \
        if (e < 7) {   \
            asm volatile("" : "+v"(va[e + 1][0]), "+v"(va[e + 1][1]) : "v"(acc[0]), "v"(acc[1]), "v"(acc[2]), "v"(acc[3]), "v"(acc[4]), "v"(acc[5]), "v"(acc[6]), "v"(acc[7]), \
                         "v"(acc[8]), "v"(acc[9]), "v"(acc[10]), "v"(acc[11]), "v"(acc[12]), "v"(acc[13]), "v"(acc[14]), "v"(acc[15])); \
            asm volatile("" : "+v"(va[e + 1][2]), "+v"(va[e + 1][3]) : "v"(acc[16]), "v"(acc[17]), "v"(acc[18]), "v"(acc[19]), "v"(acc[20]), "v"(acc[21]), "v"(acc[22]), "v"(acc[23]), \
                         "v"(acc[24]), "v"(acc[25]), "v"(acc[26]), "v"(acc[27]), "v"(acc[28]), "v"(acc[29]), "v"(acc[30]), "v"(acc[31])); } }
    {
        const int tokl = w * 4;
        peer_select_head(*(const f32x2*)(Ssc + (size_t)(0 * 32 + tokl) * 128 + 2 * lane), *(const f32x2*)(Ssc + (size_t)(1 * 32 + tokl) * 128 + 2 * lane), lane, wl, (LAS int*)(wl + 160), wl + 176, ci_i, ci_j, cand_on);
        int ln = lane; asm volatile("" : "+v"(ln)); const int el1 = ((ln >> 2) & 1) | (((ln >> 1) & 1) << 1) | ((ln & 1) << 2);
        const int mye = ((LAS int*)(wl + 160))[el1]; int ei[8]; PEER_IDS(mye, ei) PEER_ISSUE_U(ei, ln) PEER_ISSUE_V(ei, ln)
        sul = Us[mye]; svl = Vs[mye]; gl = (wl + 176)[el1];
    }
#pragma unroll 1
    for (int hh = 0; hh < 32; ++hh) {
        const int h = hh & 7, tokl = w * 4 + (hh >> 3), tok = tb + tokl;
        LAS int* fe = (LAS int*)(wl + 160 + (hh & 1) * 32); LAS float* fg = wl + 176 + (hh & 1) * 32;
        if (h == 0) {
            const u32x2* xp = (const u32x2*)(hb + (size_t)tok * DM) + lane;
#pragma unroll
            for (int j = 0; j < 8; ++j) { const u32x2 xw = xp[64 * j]; xf[j * 4 + 0] = bflo(xw.x); xf[j * 4 + 1] = bfhi(xw.x); xf[j * 4 + 2] = bflo(xw.y); xf[j * 4 + 3] = bfhi(xw.y); }
#pragma unroll
            for (int i = 0; i < 32; ++i) acc[i] = 0.f;
        }
        {
            float dot[8]; PEER_DOTS(dot)
            int ln = lane; asm volatile("" : "+v"(ln)); const int el1 = ((ln >> 2) & 1) | (((ln >> 1) & 1) << 1) | ((ln & 1) << 2);
            const int mye = fe[8 + el1]; int ei[8]; PEER_IDS(mye, ei) PEER_ISSUE_U(ei, ln)
            const float cfl = gl * gelu_erf(reduce8(dot, lane) * sul) * svl;
            PEER_ACCUM(cfl)
            f32x2 ns0 = {0.f, 0.f}, ns1 = {0.f, 0.f};
            if (hh < 31) { const int tk2 = w * 4 + ((hh + 1) >> 3), h2 = (hh + 1) & 7;
                ns0 = *(const f32x2*)(Ssc + (size_t)((h2 * 2 + 0) * 32 + tk2) * 128 + 2 * ln); ns1 = *(const f32x2*)(Ssc + (size_t)((h2 * 2 + 1) * 32 + tk2) * 128 + 2 * ln); }
            PEER_ISSUE_V(ei, ln)
            sul = Us[mye]; svl = Vs[mye]; gl = fg[8 + el1];
            if (hh < 31) peer_select_head(ns0, ns1, lane, wl, (LAS int*)(wl + 160 + ((hh + 1) & 1) * 32), wl + 176 + ((hh + 1) & 1) * 32, ci_i, ci_j, cand_on);
        }
        {
            float dot[8]; PEER_DOTS(dot)
            int ln = lane; asm volatile("" : "+v"(ln)); const int el1 = ((ln >> 2) & 1) | (((ln >> 1) & 1) << 1) | ((ln & 1) << 2);
            const int nofs = hh < 31 ? ((hh + 1) & 1) * 32 : (hh & 1) * 32 + 8;
            const int mye = ((LAS int*)(wl + 160 + nofs))[el1]; int ei[8]; PEER_IDS(mye, ei) PEER_ISSUE_U(ei, ln)
            const float cfl = gl * gelu_erf(reduce8(dot, lane) * sul) * svl;
            PEER_ACCUM(cfl)
            PEER_ISSUE_V(ei, ln)
            sul = Us[mye]; svl = Vs[mye]; gl = (wl + 176 + nofs)[el1];
        }
        if (h == 7) {
        f32x4 o[8]; float ssq = 0.f;
#pragma unroll
        for (int j = 0; j < 8; ++j) { o[j] = *((const f32x4*)(x1 + (size_t)tok * DM) + 64 * j + lane) + (f32x4){acc[j * 4 + 0], acc[j * 4 + 1], acc[j * 4 + 2], acc[j * 4 + 3]};
            *((f32x4*)(xout + (size_t)tok * DM) + 64 * j + lane) = o[j]; ssq += o[j].x * o[j].x + o[j].y * o[j].y + o[j].z * o[j].z + o[j].w * o[j].w; }
        if (write_hb) {
            const float rs = rsqrtf(wave_sum(ssq) * (1.f / DM) + 1e-6f);
#pragma unroll
            for (int j = 0; j < 8; ++j) { u32x2 pw; pw.x = pk2(o[j].x * rs, o[j].y * rs); pw.y = pk2(o[j].z * rs, o[j].w * rs); *((u32x2*)(hb + (size_t)tok * DM) + 64 * j + lane) = pw; }
        }
        }
    }
#undef PEER_IDS
#undef PEER_ISSUE_U
#undef PEER_ISSUE_V
#undef PEER_DOTS
#undef PEER_ACCUM
    __syncthreads();
}

constexpr int N_PHASES = 19;
template <int PH>
__device__ __forceinline__ void run_phase(unsigned char* lds_raw, const int wave0) {
    if constexpr (PH == 0) { if (PON(9)) { const Ctx C = fresh_ctx_w(lds_raw, wave0); const AP a = fresh_args(); phase_prep(C, a); } }
    else {
            constexpr int l = (PH - 1) / 9, k = (PH - 1) % 9;
            switch (k) {
            case 0: if (PON(0)) {
                const Ctx C = fresh_ctx_w(lds_raw, wave0); const AP a = fresh_args(); unsigned char* ws = a.ws;
                pg8::Gemm g{(const bf16_t*)(ws + WS_HB), (const bf16_t*)(ws + WS_WINT) + (size_t)l * PROJ * DM, DM};
                pg8::Order S; S.init(32, 16, 1, 0, 0, 0, C.G, C.bx);
                pg8::EpiInProj E{(bf16_t*)(ws + WS_PA), (float*)(ws + WS_PROJ)};
                pg8::gemm_phase(C.lds, g, S, E, C.tid);
            } break;
            case 1: if (PON(1)) {
                if (PON(10)) { const Ctx C = fresh_ctx_w(lds_raw, wave0); const AP a = fresh_args();
                  for (int ti = C.bx; ti < MTOK / 32; ti += C.G) rwkv_prep_item(C, a, l, ti); }
                if (PON(11)) { const Ctx C = fresh_ctx_w(lds_raw, wave0); const AP a = fresh_args(); unsigned char* ws = a.ws;
                  pg8::Gemm g{(const bf16_t*)(ws + WS_WCST) + (size_t)l * 1024 * 512, (const bf16_t*)(ws + WS_PA), 512};
                  pg8::Order S; S.init(4, 32, 1, 0, 0, 0, C.G, C.bx);
                  pg8::EpiC1 E{(bf16_t*)(ws + WS_C1)};
                  pg8::gemm_phase(C.lds, g, S, E, C.tid); }
                __syncthreads();
                if (PON(12)) { const Ctx C = fresh_ctx_w(lds_raw, wave0); const AP a = fresh_args();
                  const int m0 = C.bx < 128 ? C.gw : 2048 + C.gw, m1 = C.bx < 128 ? 3072 : MTOK;
                  for (int m = m0; m < m1; m += 1024) qk_prep_token(a, l, m, C.lane); }
                if (PON(13)) { const Ctx C = fresh_ctx_w(lds_raw, wave0); const AP a = fresh_args();
                  const int i0 = C.bx < 128 ? C.gw : C.gw, i1 = C.bx < 128 ? 1024 : 4096;
                  for (int it = i0; it < i1; it += 1024) s5_ends_item(a, l, it, C.lane, (LAS float*)(C.lds + C.wave * 4096)); }
            } break;
            case 2: if (PON(2)) {
                if (PON(17)) { const Ctx C = fresh_ctx_w(lds_raw, wave0); const AP a = fresh_args();
                  volatile LAS int* qs = (volatile LAS int*)(C.lds + LDS_BYTES - 128);
                  unsigned* qctr = (unsigned*)(a.ws + WS_CTL) + 64 + l * 64;
#pragma unroll 1
                  for (;;) {
                    __syncthreads();
                    if (C.tid == 0) *qs = (int)__hip_atomic_fetch_add(qctr, 8u, __ATOMIC_RELAXED, __HIP_MEMORY_SCOPE_AGENT);
                    __syncthreads();
                    const int base = *qs; if (base >= 12288) break;
                    const int it = base + C.wave;
                    if (it < 4096) s5_final_item_h(a, l, it, C.lane, C.lds + C.wave * 16384);
                    else rwkv_chunk_pre(a, it - 4096, C.lane, C.lds + C.wave * 16384);
                  } }
            } break;
            case 3: if (PON(3)) {
                int bx0 = blockIdx.x; asm volatile("" : "+s"(bx0));
                if (bx0 < 64) { const Ctx C = fresh_ctx_w(lds_raw, wave0); const AP a = fresh_args(); rwkv_seq_chain(C, a, C.bx); }
                else if (bx0 < 192) {
                    if (bx0 < 128) { const Ctx C = fresh_ctx_w(lds_raw, wave0); const AP a = fresh_args(); unsigned char* ws = a.ws;
                        pg8::Gemm g{(const bf16_t*)(ws + WS_YGELU), (const bf16_t*)(ws + WS_WGLUT) + (size_t)l * 512 * 512, 512};
                        pg8::Order S; S.init(32, 2, 1, 0, 0, 0, 64, C.bx - 64);
                        pg8::EpiGlu E{(const bf16_t*)(ws + WS_YGELU), (float*)(ws + WS_YA) + RWSZ};
                        pg8::gemm_phase(C.lds, g, S, E, C.tid);
                        __syncthreads(); }
                    if (PON(15)) { const Ctx C = fresh_ctx_w(lds_raw, wave0); const AP a = fresh_args(); unsigned char* ws = a.ws;
                      const int au = C.bx - 64;
                      { const int qblk = au & 7, hq = (au >> 3) & 3, b = au >> 5;
                        const bf16_t* Q = (const bf16_t*)(ws + WS_QB) + ((size_t)(b * SEQ + qblk * 256)) * 512 + hq * 128;
                        const bf16_t* Kp = (const bf16_t*)(ws + WS_QB) + (size_t)MTOK * 512 + ((size_t)b * SEQ) * 256 + (hq >> 1) * 128;
                        const bf16_t* Vp = Kp + (size_t)MTOK * 256;
                        float* O = (float*)(ws + WS_YA) + (size_t)2 * RWSZ + ((size_t)(b * SEQ + qblk * 256)) * 512 + hq * 128;
                        att::attn_dense_body<att::bf16>(Q, Kp, Vp, O, SEQ, (char*)C.lds, C.tid);
                      } }
                } else {
                    if (PON(16)) { const Ctx C = fresh_ctx_w(lds_raw, wave0); const AP a = fresh_args(); unsigned char* ws = a.ws;
                      pg8::Gemm g{(const bf16_t*)(ws + WS_DFT), (const bf16_t*)(ws + WS_C1), 4096};
                      pg8::Order S; S.init(8, 2, 4, 0, 2, 8, 64, C.bx - 192);
                      pg8::EpiF32 E{(float*)(ws + WS_YA), 512};
                      pg8::gemm_phase(C.lds, g, S, E, C.tid); }
                }
            } break;
            case 4: if (PON(4)) {
                const Ctx C = fresh_ctx_w(lds_raw, wave0); const AP a = fresh_args();
                for (int m = C.gw; m < MTOK; m += C.ngw) {
                    branch_norm_item(a, m * 4 + 0, C.lane); branch_norm_item(a, m * 4 + 1, C.lane); branch_norm_item(a, m * 4 + 2, C.lane); branch_d_item(a, l, m, C.lane); }
            } break;
            case 5: if (PON(5)) {
                const Ctx C = fresh_ctx_w(lds_raw, wave0); const AP a = fresh_args(); unsigned char* ws = a.ws;
                const float* xin = l == 0 ? a.in[0] : (const float*)(ws + WS_X2);
                pg8::Gemm g{(const bf16_t*)(ws + WS_HB), (const bf16_t*)(ws + WS_WOUTT) + (size_t)l * DM * DM, DM};
                pg8::Order S; S.init(32, 8, 1, 0, 0, 0, C.G, C.bx);
                pg8::EpiResid E{xin, (float*)(ws + WS_X1), DM};
                pg8::gemm_phase(C.lds, g, S, E, C.tid);
            } break;
            case 6: if (PON(6)) {
                const Ctx C = fresh_ctx_w(lds_raw, wave0); const AP a = fresh_args(); unsigned char* ws = a.ws;
                for (int m = C.gw; m < MTOK; m += C.ngw) rms_row_to_bf16((const float*)(ws + WS_X1) + (size_t)m * DM, (bf16_t*)(ws + WS_HB) + (size_t)m * DM, C.lane);
            } break;
            case 7: if (PON(7)) {
                int bx0 = blockIdx.x; asm volatile("" : "+s"(bx0));
                if (bx0 < 128) {
                    const Ctx C = fresh_ctx_w(lds_raw, wave0); const AP a = fresh_args(); unsigned char* ws = a.ws;
                    pg8::Gemm g{(const bf16_t*)(ws + WS_HB), (const bf16_t*)(ws + WS_WQT) + (size_t)l * 1024 * DM, DM};
                    pg8::Order S; S.init(32, 4, 1, 0, 0, 0, 128, C.bx);
                    pg8::EpiF32 E{(float*)(ws + WS_PROJ), 1024};
                    pg8::gemm_phase(C.lds, g, S, E, C.tid);
                } else {
                    const Ctx C = fresh_ctx_w(lds_raw, wave0); const AP a = fresh_args();
#pragma unroll 1
                    for (int it = (C.bx - 128) * 8 + C.wave; it < 16384; it += 1024) { const int r2 = it * 2; expert_row_item2(a, r2 >> 14, l, r2 & 16383, C.lane); }
                }
            } break;
            case 8: if (PON(8)) {
                const Ctx C = fresh_ctx_w(lds_raw, wave0); const AP a = fresh_args(); unsigned char* ws = a.ws;
                float* xo = l == 0 ? (float*)(ws + WS_X2) : a.out;
                for (int tile = C.bx; tile < MTOK / 32; tile += C.G) peer_tile(C, a, l, tile, (const float*)(ws + WS_X1), xo, l == 0);
            } break;
            default: break;
            }
    }
}
__global__ void __launch_bounds__(NTHR, 2) fwd_kernel(Args a0) {
    extern __shared__ __attribute__((aligned(16))) unsigned char lds_raw[];
    cg::grid_group grid = cg::this_grid();
    const int wave0 = __builtin_amdgcn_readfirstlane((int)threadIdx.x >> 6);
    volatile LAS unsigned* bst = (volatile LAS unsigned*)((LAS unsigned char*)lds_raw + LDS_BYTES - 64);
    if (threadIdx.x < 2) bst[threadIdx.x] = 0u;
    __syncthreads();
    const XcdBarrier xbar = xcd_barrier_post((unsigned*)(a0.ws + WS_CTL) + 4096, bst);
    const int lo = a0.ph_lo, hi = a0.ph_hi;
    if (lo < 0) grid.sync();
#define MK_STEP(PH) if (lo <= (PH) && (PH) < hi) { run_phase<PH>(lds_raw, wave0); \
        if ((((unsigned)PROBE_REP_MASK >> (PH)) & 1u) != 0u) { xcd_barrier(xbar); run_phase<PH>(lds_raw, wave0); } \
        if ((PH) + 1 < hi) xcd_barrier(xbar); }
    MK_STEP(0) MK_STEP(1) MK_STEP(2) MK_STEP(3) MK_STEP(4) MK_STEP(5) MK_STEP(6) MK_STEP(7) MK_STEP(8) MK_STEP(9)
    MK_STEP(10) MK_STEP(11) MK_STEP(12) MK_STEP(13) MK_STEP(14) MK_STEP(15) MK_STEP(16) MK_STEP(17) MK_STEP(18)
#undef MK_STEP
}

extern "C" void kernel_launch(void* const* d_in, const int* in_sizes, int n_in, void* d_out, int out_size, void* d_ws, size_t ws_size, hipStream_t stream) {
    static int grid = 0;
    if (grid == 0) {
        if (n_in != 36 || in_sizes[0] != MTOK * DM || out_size != MTOK * DM || ws_size < WS_END) {
            fprintf(stderr, "kernel_launch: shape mismatch: n_in %d in0 %d out %d ws %zu (need %zu)\n", n_in, n_in > 0 ? in_sizes[0] : -1, out_size, ws_size, (size_t)WS_END); grid = -1; return; }
        int dev = 0, cus = 0, per_cu = 0;
        if (hipGetDevice(&dev) != hipSuccess || hipDeviceGetAttribute(&cus, hipDeviceAttributeMultiprocessorCount, dev) != hipSuccess) { fprintf(stderr, "kernel_launch: device query failed\n"); grid = -1; return; }
        if (hipFuncSetAttribute((const void*)fwd_kernel, hipFuncAttributeMaxDynamicSharedMemorySize, LDS_BYTES) != hipSuccess) { fprintf(stderr, "kernel_launch: hipFuncSetAttribute failed\n"); grid = -1; return; }
        if (hipOccupancyMaxActiveBlocksPerMultiprocessor(&per_cu, (const void*)fwd_kernel, NTHR, LDS_BYTES) != hipSuccess || per_cu < 1) { fprintf(stderr, "kernel_launch: occupancy query gives %d\n", per_cu); grid = -1; return; }
        grid = cus * per_cu; if (grid > 256) grid = 256;
        if (grid < 128) { fprintf(stderr, "kernel_launch: grid %d too small\n", grid); grid = -1; return; }
    }
    if (grid < 0) return;
    if (hipMemsetAsync((char*)d_ws + WS_CTL, 0, 65536, stream) != hipSuccess) { fprintf(stderr, "kernel_launch: memset failed\n"); return; }
    Args a{};
    for (int i = 0; i < 36; ++i) a.in[i] = (const float*)d_in[i];
    a.out = (float*)d_out; a.ws = (unsigned char*)d_ws;
#if MK_ONE_LAUNCH
    a.ph_lo = 0; a.ph_hi = N_PHASES;
    void* args[] = {&a};
    hipError_t e = hipLaunchCooperativeKernel((const void*)fwd_kernel, dim3(grid), dim3(NTHR), args, LDS_BYTES, stream);
    if (e != hipSuccess) fprintf(stderr, "kernel_launch: cooperative launch failed: %s (grid %d)\n", hipGetErrorString(e), grid);
#else
    for (int ph = 0; ph < N_PHASES; ++ph) {
        a.ph_lo = ph; a.ph_hi = ph + 1;
        hipLaunchKernelGGL(fwd_kernel, dim3(grid), dim3(NTHR), LDS_BYTES, stream, a);
    }
    hipError_t e = hipPeekAtLastError();
    if (e != hipSuccess) fprintf(stderr, "kernel_launch: launch failed: %s\n", hipGetErrorString(e));
#endif
}
```

```cpp
#include <hip/hip_runtime.h>
#include <hip/hip_cooperative_groups.h>
#include <cstdio>
#include <cstdint>
#include <cstddef>
namespace cg = cooperative_groups;

#ifndef MK_ONE_LAUNCH
#define MK_ONE_LAUNCH 1
#endif
#ifndef PHM
#define PHM 0x3ffff
#endif
#define PON(i) (((PHM) >> (i)) & 1)
#ifndef PROBE_REP_MASK
#define PROBE_REP_MASK 0u
#endif

namespace pg8 {
#define PG8_LAS __attribute__((address_space(3)))
typedef unsigned short bf16_t;
typedef short bf16x8 __attribute__((ext_vector_type(8)));
typedef float f32x4 __attribute__((ext_vector_type(4)));
typedef unsigned u32x4 __attribute__((ext_vector_type(4)));
typedef unsigned u32x2 __attribute__((ext_vector_type(2)));
constexpr int BM = 256, BK = 64, HALF = 128, HTB = HALF * BK * 2, STAGE_BYTES = 8 * HTB, NXCD = 8, WGM = 8;

__host__ __device__ __forceinline__ int lds_byte(int r, int c) { const int st = (r >> 4) * 2 + (c >> 5), rr = r & 15, cc = c & 31, ob = rr * 64 + cc * 2; return st * 1024 + (ob ^ (((ob >> 9) & 1) << 5)); }
__host__ __device__ __forceinline__ void stage_rc(int b, int& R, int& C) { const int st = b / 1024, sb = b % 1024, swz = sb ^ (((sb >> 9) & 1) << 5); R = (st >> 1) * 16 + swz / 64; C = (st & 1) * 32 + (swz % 64) / 2; }

struct Unit { int pm, pn, pa, pb; };
struct Gemm { const bf16_t* A; const bf16_t* Bt; int K; };

struct Order {
    int nM, nN, nb, nwg, G, c, aM, bN, oM;
    __device__ __forceinline__ void init(int nM_, int nN_, int nb_, int aM_, int bN_, int oM_, int G_, int c_) { nM = nM_; nN = nN_; nb = nb_; aM = aM_; bN = bN_; oM = oM_; nwg = nM * nN * nb; G = G_; c = c_; }
    __device__ __forceinline__ bool next(int i, Unit& u) const {
        const int L = i * G + c; if (L >= nwg || c < 0) return false;
        const int per = nM * nN, b = L / per; int wgid = L - b * per;
        { const int q = per / NXCD, r = per % NXCD, xcd = wgid % NXCD, off = wgid / NXCD; wgid = (xcd < r ? xcd * (q + 1) : r * (q + 1) + (xcd - r) * q) + off; }
        const int nig = WGM * nN, gid = wgid / nig, fm = gid * WGM, gsz = (nM - fm) < WGM ? (nM - fm) : WGM;
        const int pm = fm + ((wgid % nig) % gsz), pn = (wgid % nig) / gsz;
        u.pm = pm + b * oM; u.pn = pn; u.pa = pm + b * aM; u.pb = pn + b * bN; return true;
    }
};

__device__ __forceinline__ unsigned cvt_pk_bf16(float lo, float hi) { unsigned r; asm volatile("v_cvt_pk_bf16_f32 %0, %1, %2" : "=v"(r) : "v"(lo), "v"(hi)); return r; }

#define PG8_EPI_LOOP(...) \
    _Pragma("unroll") for (int ai = 0; ai < 2; ++ai) _Pragma("unroll") for (int m = 0; m < 4; ++m) { const int row = u.pm * BM + ai * HALF + wr * 64 + m * 16 + fr; \
        _Pragma("unroll") for (int bj = 0; bj < 2; ++bj) _Pragma("unroll") for (int n = 0; n < 2; ++n) { const int col = u.pn * BM + bj * HALF + wc * 32 + n * 16 + 4 * fq; const f32x4 v = acc[ai][bj][m][n]; __VA_ARGS__ } }

struct EpiF32 {
    float* out; int ldc;
    __device__ __forceinline__ void operator()(const f32x4 (&acc)[2][2][4][2], const Unit& u, int wr, int wc, int fr, int fq) const {
        PG8_EPI_LOOP( *(f32x4*)(out + (size_t)row * ldc + col) = v; )
    }
};
struct EpiResid {
    const float* base; float* out; int ldc;
    __device__ __forceinline__ void operator()(const f32x4 (&acc)[2][2][4][2], const Unit& u, int wr, int wc, int fr, int fq) const {
        PG8_EPI_LOOP( const f32x4 b = *(const f32x4*)(base + (size_t)row * ldc + col); *(f32x4*)(out + (size_t)row * ldc + col) = b + v; )
    }
};
struct EpiInProj {
    bf16_t* pa; float* proj;
    __device__ __forceinline__ void operator()(const f32x4 (&acc)[2][2][4][2], const Unit& u, int wr, int wc, int fr, int fq) const {
        if (u.pn < 2) { PG8_EPI_LOOP( u32x2 w; w.x = cvt_pk_bf16(v[0], v[1]); w.y = cvt_pk_bf16(v[2], v[3]); *(u32x2*)(pa + (size_t)row * 512 + col) = w; ) }
        else { PG8_EPI_LOOP( *(f32x4*)(proj + (size_t)row * 4096 + col) = v; ) }
    }
};
struct EpiC1 {
    bf16_t* c1;
    __device__ __forceinline__ void operator()(const f32x4 (&acc)[2][2][4][2], const Unit& u, int wr, int wc, int fr, int fq) const {
        PG8_EPI_LOOP( const int b = col >> 11, s = col & 2047; u32x2 w; w.x = cvt_pk_bf16(v[0], v[1]); w.y = cvt_pk_bf16(v[2], v[3]);
                      *(u32x2*)(c1 + ((size_t)b * 1024 + row) * 2048 + s) = w; )
    }
};
struct EpiGlu {
    const bf16_t* y; float* out;
    __device__ __forceinline__ void operator()(const f32x4 (&acc)[2][2][4][2], const Unit& u, int wr, int wc, int fr, int fq) const {
        PG8_EPI_LOOP( const u32x2 yw = *(const u32x2*)(y + (size_t)row * 512 + col);
                      f32x4 yv; yv[0] = __uint_as_float(yw.x << 16); yv[1] = __uint_as_float(yw.x & 0xffff0000u); yv[2] = __uint_as_float(yw.y << 16); yv[3] = __uint_as_float(yw.y & 0xffff0000u);
                      f32x4 o; _Pragma("unroll") for (int e = 0; e < 4; ++e) o[e] = yv[e] / (1.f + __expf(-v[e]));
                      *(f32x4*)(out + (size_t)row * 512 + col) = o; )
    }
};

template <class Epi, class Sched>
__device__ __forceinline__ void gemm_phase(PG8_LAS unsigned char* lds, const Gemm g, const Sched& S, const Epi& E, const int tid) {
    const int wid = __builtin_amdgcn_readfirstlane(tid >> 6), lane = tid & 63, wr = wid >> 2, wc = wid & 3, fr = lane & 15, fq = lane >> 4;
    const int K = g.K, nt = K / BK;
    unsigned voffA[2];
#pragma unroll
    for (int i = 0; i < 2; ++i) { int R, C; stage_rc(tid * 16 + i * 8192, R, C); voffA[i] = (unsigned)(R * K + C) * 2u; }
    const size_t kstep = (size_t)(BK * 2);
    const size_t hstep = (size_t)HALF * K * 2;
    const size_t tstep = 2 * hstep;
    const unsigned ldsw = (unsigned)wid * 1024u;
    const int aoff = lds_byte(wr * 64 + fr, fq * 8), boff = lds_byte(wc * 32 + fr, fq * 8);
#define PG8_SA(b, h) (((b) * 2 + (h)) * HTB)
#define PG8_SB(b, h) ((4 + (b) * 2 + (h)) * HTB)
#define PG8_STAGE(bufoff, gbase, voff) do { _Pragma("unroll") for (int _i = 0; _i < 2; ++_i) \
        __builtin_amdgcn_global_load_lds((const unsigned*)((const char*)(gbase) + (voff)[_i]), (PG8_LAS unsigned*)(lds + (bufoff) + ldsw + _i * 8192), 16, 0, 0); } while (0)
#define PG8_LDA(dst, b, h) do { _Pragma("unroll") for (int m = 0; m < 4; ++m) _Pragma("unroll") for (int k = 0; k < 2; ++k) dst[m][k] = *(const PG8_LAS bf16x8*)(lds + PG8_SA(b, h) + aoff + m * 2048 + k * 1024); } while (0)
#define PG8_LDB(dst, b, h) do { _Pragma("unroll") for (int n = 0; n < 2; ++n) _Pragma("unroll") for (int k = 0; k < 2; ++k) dst[n][k] = *(const PG8_LAS bf16x8*)(lds + PG8_SB(b, h) + boff + n * 2048 + k * 1024); } while (0)
#define PG8_MMA(ai, bj, At, Bt) do { __builtin_amdgcn_s_setprio(1); _Pragma("unroll") for (int m = 0; m < 4; ++m) _Pragma("unroll") for (int n = 0; n < 2; ++n) _Pragma("unroll") for (int k = 0; k < 2; ++k) \
        acc[ai][bj][m][n] = __builtin_amdgcn_mfma_f32_16x16x32_bf16(Bt[n][k], At[m][k], acc[ai][bj][m][n], 0, 0, 0); __builtin_amdgcn_s_setprio(0); } while (0)
#define PG8_WAIT_V(n) asm volatile("s_waitcnt vmcnt(" #n ")" ::: "memory")
#define PG8_WAIT_L(n) asm volatile("s_waitcnt lgkmcnt(" #n ")" ::: "memory")
#define PG8_BAR __builtin_amdgcn_s_barrier()
#define PG8_SCHED __builtin_amdgcn_sched_barrier(0)
    Unit cur, nxt; int ui = 0;
    if (!S.next(0, cur)) return;
    f32x4 acc[2][2][4][2];
#pragma unroll
    for (int a = 0; a < 2; ++a)
#pragma unroll
        for (int b = 0; b < 2; ++b)
#pragma unroll
            for (int m = 0; m < 4; ++m)
#pragma unroll
                for (int n = 0; n < 2; ++n) acc[a][b][m][n] = (f32x4){0.f, 0.f, 0.f, 0.f};
    bf16x8 At[4][2], B0[2][2], B1[2][2];
    const char* cA = (const char*)g.A + (size_t)cur.pa * tstep; const char* cB = (const char*)g.Bt + (size_t)cur.pb * tstep;
    PG8_STAGE(PG8_SB(0, 0), cB, voffA); PG8_STAGE(PG8_SB(0, 1), cB + hstep, voffA); PG8_STAGE(PG8_SA(0, 0), cA, voffA); PG8_STAGE(PG8_SA(0, 1), cA + hstep, voffA);
    if (wr == 1) PG8_BAR;
    PG8_WAIT_V(2); PG8_BAR;
    PG8_STAGE(PG8_SB(1, 0), cB + kstep, voffA); PG8_STAGE(PG8_SA(1, 0), cA + kstep, voffA); PG8_STAGE(PG8_SB(1, 1), cB + hstep + kstep, voffA);
    PG8_WAIT_V(6); PG8_BAR;
    for (;;) {
        const bool has_next = S.next(ui + 1, nxt);
        const char* nA = has_next ? (const char*)g.A + (size_t)nxt.pa * tstep : cA; const char* nB = has_next ? (const char*)g.Bt + (size_t)nxt.pb * tstep : cB;
        for (int t = 0; t < nt; t += 2) {
            const bool last = (t == nt - 2);
            const char* a1 = cA + (size_t)(t + 1) * kstep;
            const char* a2 = last ? nA : cA + (size_t)(t + 2) * kstep; const char* b2 = last ? nB : cB + (size_t)(t + 2) * kstep;
            const char* a3 = a2 + kstep; const char* b3 = b2 + kstep;
            PG8_LDB(B0, 0, 0); PG8_LDB(B1, 0, 1); PG8_SCHED; PG8_LDA(At, 0, 0); PG8_STAGE(PG8_SA(1, 1), a1 + hstep, voffA);
            PG8_WAIT_V(8); PG8_WAIT_L(0); PG8_BAR; PG8_MMA(0, 0, At, B0); PG8_MMA(0, 1, At, B1); PG8_BAR; PG8_SCHED;
            PG8_LDA(At, 0, 1); PG8_STAGE(PG8_SB(0, 0), b2, voffA); PG8_STAGE(PG8_SB(0, 1), b2 + hstep, voffA); PG8_STAGE(PG8_SA(0, 0), a2, voffA);
            PG8_WAIT_V(8); PG8_WAIT_L(0); PG8_BAR; PG8_MMA(1, 0, At, B0); PG8_MMA(1, 1, At, B1); PG8_BAR; PG8_SCHED;
            PG8_LDB(B0, 1, 0); PG8_LDB(B1, 1, 1); PG8_SCHED; PG8_LDA(At, 1, 0); PG8_STAGE(PG8_SA(0, 1), a2 + hstep, voffA);
            PG8_WAIT_V(8); PG8_WAIT_L(0); PG8_BAR; PG8_MMA(0, 0, At, B0); PG8_MMA(0, 1, At, B1); PG8_BAR; PG8_SCHED;
            PG8_LDA(At, 1, 1); PG8_STAGE(PG8_SB(1, 0), b3, voffA); PG8_STAGE(PG8_SB(1, 1), b3 + hstep, voffA); PG8_STAGE(PG8_SA(1, 0), a3, voffA);
            PG8_WAIT_V(8); PG8_WAIT_L(0); PG8_BAR; PG8_MMA(1, 0, At, B0); PG8_MMA(1, 1, At, B1); PG8_BAR; PG8_SCHED;
        }
        if (wr == 0) PG8_BAR;
        E(acc, cur, wr, wc, fr, fq);
        if (!has_next) break;
#pragma unroll
        for (int a = 0; a < 2; ++a)
#pragma unroll
            for (int b = 0; b < 2; ++b)
#pragma unroll
                for (int m = 0; m < 4; ++m)
#pragma unroll
                    for (int n = 0; n < 2; ++n) acc[a][b][m][n] = (f32x4){0.f, 0.f, 0.f, 0.f};
        cur = nxt; cA = nA; cB = nB; ++ui;
        if (wr == 1) PG8_BAR;
    }
    PG8_WAIT_V(0);
    PG8_BAR;
#undef PG8_SA
#undef PG8_SB
#undef PG8_STAGE
#undef PG8_LDA
#undef PG8_LDB
#undef PG8_MMA
#undef PG8_WAIT_V
#undef PG8_WAIT_L
#undef PG8_BAR
#undef PG8_SCHED
}
}

namespace att {
using bf16 = unsigned short;
constexpr int   D = 128, NW = 8, QBLK = 32, KVBLK = 64;
constexpr float SCALE = 0.088388347648318440f;
constexpr float THR = 8.f;
constexpr int SDEPTH = 1;
constexpr int LDQ = 512, LDK = 256, LDO = 512;
constexpr size_t SHM_V = KVBLK * D * 2, SHM_K = KVBLK * D * 2, SHM_ATTN = 2 * SHM_V + 2 * SHM_K + NW * 64 * 4;

using bf16x8 = __attribute__((ext_vector_type(8))) short;
using s16x4  = __attribute__((ext_vector_type(4))) short;
using f32x16 = __attribute__((ext_vector_type(16))) float;
using f32x8  = __attribute__((ext_vector_type(8))) float;
using u32x4  = __attribute__((ext_vector_type(4))) unsigned;
#define KSWZ(row, colB) ((row) * 256 + ((colB) ^ (((row) & 7) << 4)))
#define SBAR() __builtin_amdgcn_sched_barrier(0)
__device__ __forceinline__ int crow(int r, int hi) { return (r & 3) + 8 * (r >> 2) + 4 * hi; }
__device__ __forceinline__ unsigned cvtpk(float lo, float hi) {
  unsigned r; asm volatile("v_cvt_pk_bf16_f32 %0, %1, %2" : "=v"(r) : "v"(lo), "v"(hi)); return r;
}
template <typename TIn> struct Stage;
template <> struct Stage<bf16>  { using T = bf16x8;
  __device__ static __forceinline__ T ld8(const bf16* p) { return *reinterpret_cast<const bf16x8*>(p); }
  __device__ static __forceinline__ bf16x8 tobf(T x) { return x; } };

__device__ __forceinline__ void partialSM(f32x16& p0, f32x16& p1, float& m_reg, float& mn, float& alpha) {
  constexpr float C = SCALE * 1.4426950408889634f;
  float pmax = p0[0]; for (int r = 1; r < 16; ++r) pmax = fmaxf(pmax, p0[r]); for (int r = 0; r < 16; ++r) pmax = fmaxf(pmax, p1[r]);
  { auto rr = __builtin_amdgcn_permlane32_swap(__float_as_uint(pmax), __float_as_uint(pmax), false, false);
    pmax = fmaxf(__uint_as_float(rr[0]), __uint_as_float(rr[1])); }
  if (__builtin_expect(__all(pmax - m_reg <= THR / SCALE), 1)) { mn = m_reg; alpha = 1.f; }
  else { mn = fmaxf(m_reg, pmax); alpha = __builtin_amdgcn_exp2f((m_reg - mn) * C); m_reg = mn; }
  float mnC = -mn * C;
  for (int r = 0; r < 16; ++r) p0[r] = fmaf(p0[r], C, mnC); for (int r = 0; r < 16; ++r) p1[r] = fmaf(p1[r], C, mnC);
  for (int r = 0; r < 16; ++r) p0[r] = __builtin_amdgcn_exp2f(p0[r]);
}
__device__ __forceinline__ void finishSM(f32x16& p0, f32x16& p1, float alpha, float& l_reg, bf16x8& pa0, bf16x8& pa1, bf16x8& pa2, bf16x8& pa3) {
  for (int r = 0; r < 16; ++r) p1[r] = __builtin_amdgcn_exp2f(p1[r]);
  float ps = 0; for (int r = 0; r < 16; ++r) ps += p0[r]; for (int r = 0; r < 16; ++r) ps += p1[r];
  { auto rr = __builtin_amdgcn_permlane32_swap(__float_as_uint(ps), __float_as_uint(ps), false, false);
    ps = __uint_as_float(rr[0]) + __uint_as_float(rr[1]); }
  l_reg = l_reg * alpha + ps;
#define PK4(P, BASE, OUT) do { unsigned a0 = cvtpk(P[BASE + 0], P[BASE + 1]), a1 = cvtpk(P[BASE + 2], P[BASE + 3]);   \
    unsigned b0 = cvtpk(P[BASE + 4], P[BASE + 5]), b1 = cvtpk(P[BASE + 6], P[BASE + 7]);                              \
    auto r0 = __builtin_amdgcn_permlane32_swap(a0, b0, false, false); auto r1 = __builtin_amdgcn_permlane32_swap(a1, b1, false, false); \
    u32x4 w = {r0[0], r1[0], r0[1], r1[1]}; OUT = *reinterpret_cast<bf16x8*>(&w); } while (0)
  PK4(p0, 0, pa0); PK4(p0, 8, pa1); PK4(p1, 0, pa2); PK4(p1, 8, pa3);
#undef PK4
}
__device__ __forceinline__ void qkt(f32x16& p0, f32x16& p1, const bf16* Ks, const bf16x8* qr, int r32, int hi) {
  p0 = f32x16{}; p1 = f32x16{};
  for (int d0 = 0; d0 < 8; ++d0) { int cb = (d0 * 16 + hi * 8) * 2;
    bf16x8 b0 = *reinterpret_cast<const bf16x8*>((const char*)Ks + KSWZ(r32, cb));
    bf16x8 b1 = *reinterpret_cast<const bf16x8*>((const char*)Ks + KSWZ(32 + r32, cb));
    p0 = __builtin_amdgcn_mfma_f32_32x32x16_bf16(b0, qr[d0], p0, 0, 0, 0);
    p1 = __builtin_amdgcn_mfma_f32_32x32x16_bf16(b1, qr[d0], p1, 0, 0, 0); }
}
__device__ __forceinline__ int v_st(int k, int c) { const int kk = (k & ~0xC) | ((k & 4) << 1) | ((k & 8) >> 1); return ((kk >> 3) * 4 + (c >> 5)) * 512 + ((kk & 7) * 32 + (c & 31)) * 2; }
__device__ __forceinline__ int v_rd_base(int lane) { return ((lane & 3) << 3) | (((lane >> 2) & 3) << 6) | (((lane >> 4) & 1) << 5) | (((lane >> 5) & 1) << 8); }
constexpr int v_rd_off(int d0, int ks, int half) { return d0 * 512 + ks * 4096 + half * 2048; }
template <int OFF> __device__ __forceinline__ s16x4 tr_read(int vb) {
  s16x4 r; asm volatile("ds_read_b64_tr_b16 %0, %1 offset:%2" : "=&v"(r) : "v"(vb), "i"(OFF) : "memory"); return r;
}
template <int D0> __device__ __forceinline__ void pv_one(f32x16& od, int vb, bf16x8 pa0, bf16x8 pa1, bf16x8 pa2, bf16x8 pa3) {
  const s16x4 l0 = tr_read<v_rd_off(D0, 0, 0)>(vb), h0 = tr_read<v_rd_off(D0, 0, 1)>(vb), l1 = tr_read<v_rd_off(D0, 1, 0)>(vb), h1 = tr_read<v_rd_off(D0, 1, 1)>(vb);
  const s16x4 l2 = tr_read<v_rd_off(D0, 2, 0)>(vb), h2 = tr_read<v_rd_off(D0, 2, 1)>(vb), l3 = tr_read<v_rd_off(D0, 3, 0)>(vb), h3 = tr_read<v_rd_off(D0, 3, 1)>(vb);
  asm volatile("s_waitcnt lgkmcnt(0)" ::: "memory"); SBAR();
#define PK(L, H) (bf16x8){L[0], L[1], L[2], L[3], H[0], H[1], H[2], H[3]}
  od = __builtin_amdgcn_mfma_f32_32x32x16_bf16(pa0, PK(l0, h0), od, 0, 0, 0);
  od = __builtin_amdgcn_mfma_f32_32x32x16_bf16(pa1, PK(l1, h1), od, 0, 0, 0);
  od = __builtin_amdgcn_mfma_f32_32x32x16_bf16(pa2, PK(l2, h2), od, 0, 0, 0);
  od = __builtin_amdgcn_mfma_f32_32x32x16_bf16(pa3, PK(l3, h3), od, 0, 0, 0);
#undef PK
}
__device__ __forceinline__ void pv_d0(f32x16* o, int vb, bf16x8 pa0, bf16x8 pa1, bf16x8 pa2, bf16x8 pa3) {
  pv_one<0>(o[0], vb, pa0, pa1, pa2, pa3); pv_one<1>(o[1], vb, pa0, pa1, pa2, pa3); pv_one<2>(o[2], vb, pa0, pa1, pa2, pa3); pv_one<3>(o[3], vb, pa0, pa1, pa2, pa3);
}
template <typename TQ>
__device__ __forceinline__ void attn_dense_body(const TQ* __restrict__ Qb, const bf16* __restrict__ Kh, const bf16* __restrict__ Vh,
                                                float* __restrict__ Ob, int seq, char* lds, const int tid_) {
  using St = Stage<bf16>; using SQ = Stage<TQ>;
  int tid = tid_; asm volatile("" : "+v"(tid));
  const int wid = tid >> 6, lane = tid & 63, r32 = lane & 31, hi = lane >> 5;
  bf16* V_lds = (bf16*)lds; bf16* K_lds = (bf16*)(lds + 2 * SHM_V);
  float* ws = (float*)(lds + 2 * SHM_V + 2 * SHM_K) + wid * 64; float* li_l = ws; float* al_l = ws + 32;
  float m_reg = -1e30f, l_reg = 0; f32x16 o[4] = {}; bf16x8 qr[8];
  const TQ* Qw = Qb + (long)(wid * QBLK + r32) * LDQ + hi * 8;
#pragma unroll
  for (int d0 = 0; d0 < 8; ++d0) qr[d0] = SQ::tobf(SQ::ld8(Qw + d0 * 16));
  const int sr = tid >> 4, sc = (tid & 15) * 8, vst0 = v_st(sr, sc), vst1 = v_st(32 + sr, sc);
  const int vb0 = (int)(uintptr_t)V_lds + v_rd_base(lane);
  struct { typename St::T vs0, vs1, ks0, ks1; } sr_[SDEPTH];
  const unsigned loff = (unsigned)(sr * LDK + sc);
#define SLOAD(i, k0) do { const bf16* Vt_ = Vh + (size_t)(k0) * LDK; const bf16* Kt_ = Kh + (size_t)(k0) * LDK; \
    sr_[i].vs0 = St::ld8(Vt_ + loff); sr_[i].vs1 = St::ld8(Vt_ + 32 * LDK + loff); \
    sr_[i].ks0 = St::ld8(Kt_ + loff); sr_[i].ks1 = St::ld8(Kt_ + 32 * LDK + loff); } while (0)
#define SWRITE(b, i) do { *(bf16x8*)((char*)V_lds + (b) * SHM_V + vst0) = St::tobf(sr_[i].vs0);          \
    *(bf16x8*)((char*)V_lds + (b) * SHM_V + vst1) = St::tobf(sr_[i].vs1); int kc = sc * 2;               \
    *(bf16x8*)((char*)K_lds + (b) * SHM_K + KSWZ(sr, kc)) = St::tobf(sr_[i].ks0);                       \
    *(bf16x8*)((char*)K_lds + (b) * SHM_K + KSWZ(32 + sr, kc)) = St::tobf(sr_[i].ks1); } while (0)
#define SWAIT() do { if constexpr (SDEPTH == 2) asm volatile("s_waitcnt vmcnt(4)" ::: "memory"); else asm volatile("s_waitcnt vmcnt(0)" ::: "memory"); } while (0)
#define RESC(a) do { if (__any((a) < 1.f)) { if (hi == 0) al_l[r32] = (a); asm volatile("s_waitcnt lgkmcnt(0)" ::: "memory"); \
    for (int d = 0; d < 4; ++d) for (int r = 0; r < 16; ++r) o[d][r] *= al_l[crow(r, hi)]; } } while (0)
  f32x16 pA0, pA1, pB0, pB1; float mnA, mnB, alA, alB; bf16x8 pa0, pa1, pa2, pa3; const int NT = seq / KVBLK;
  constexpr int SE = 0, SO = SDEPTH - 1;
  SLOAD(SE, 0); asm volatile("s_waitcnt vmcnt(0)" ::: "memory"); SWRITE(0, SE); __syncthreads();
  qkt(pA0, pA1, K_lds, qr, r32, hi); partialSM(pA0, pA1, m_reg, mnA, alA);
  SLOAD(SO, KVBLK); if constexpr (SDEPTH == 2) { if (2 < NT) SLOAD(SE, 2 * KVBLK); }
  SWAIT(); SWRITE(1, SO); __syncthreads();
  for (int j = 1; j + 1 < NT; j += 2) {
    SBAR(); qkt(pB0, pB1, (bf16*)((char*)K_lds + SHM_K), qr, r32, hi);
    finishSM(pA0, pA1, alA, l_reg, pa0, pa1, pa2, pa3); SBAR();
    SLOAD(SO, (j + SDEPTH) * KVBLK); SBAR();
    pv_d0(o, vb0, pa0, pa1, pa2, pa3); partialSM(pB0, pB1, m_reg, mnB, alB);
    __syncthreads(); SWAIT(); SWRITE(0, SE);
    RESC(alB); __syncthreads();
    SBAR(); qkt(pA0, pA1, K_lds, qr, r32, hi);
    finishSM(pB0, pB1, alB, l_reg, pa0, pa1, pa2, pa3); SBAR();
    if (SDEPTH == 1 || j + 3 < NT) SLOAD(SE, (j + 1 + SDEPTH) * KVBLK); SBAR();
    pv_d0(o, vb0 + (int)SHM_V, pa0, pa1, pa2, pa3); partialSM(pA0, pA1, m_reg, mnA, alA);
    __syncthreads(); SWAIT(); SWRITE(1, SO);
    RESC(alA); __syncthreads();
  }
  SBAR(); qkt(pB0, pB1, (bf16*)((char*)K_lds + SHM_K), qr, r32, hi);
  finishSM(pA0, pA1, alA, l_reg, pa0, pa1, pa2, pa3); SBAR();
  pv_d0(o, vb0, pa0, pa1, pa2, pa3); partialSM(pB0, pB1, m_reg, mnB, alB);
  __syncthreads(); RESC(alB);
  finishSM(pB0, pB1, alB, l_reg, pa0, pa1, pa2, pa3); SBAR();
  pv_d0(o, vb0 + (int)SHM_V, pa0, pa1, pa2, pa3);
  if (hi == 0) li_l[r32] = l_reg; asm volatile("s_waitcnt lgkmcnt(0)" ::: "memory");
  float rli[16];
#pragma unroll
  for (int r = 0; r < 16; ++r) rli[r] = __builtin_amdgcn_rcpf(li_l[crow(r, hi)]);
  int le = lane; asm volatile("" : "+v"(le));
  float* Ow = Ob + (size_t)(wid * QBLK) * LDO; const unsigned eo = (unsigned)((le >> 5) * 4 * LDO + (le & 31));
#pragma unroll
  for (int r = 0; r < 16; ++r) { const unsigned ro = eo + (unsigned)(((r & 3) + 8 * (r >> 2)) * LDO);
#pragma unroll
    for (int d0 = 0; d0 < 4; ++d0) Ow[ro + d0 * 32] = o[d0][r] * rli[r]; }
#undef SLOAD
#undef SWRITE
#undef SWAIT
#undef RESC
}
}
#define LAS __attribute__((address_space(3)))
typedef unsigned short bf16_t;
typedef float f32x4 __attribute__((ext_vector_type(4)));
typedef float f32x2 __attribute__((ext_vector_type(2)));
typedef unsigned u32x4 __attribute__((ext_vector_type(4)));
typedef unsigned u32x2 __attribute__((ext_vector_type(2)));

typedef short bf16x8_t __attribute__((ext_vector_type(8)));
__device__ __forceinline__ bf16x8_t mk8(unsigned d0, unsigned d1, unsigned d2, unsigned d3) { const u32x4 w = {d0, d1, d2, d3}; return __builtin_bit_cast(bf16x8_t, w); }
constexpr int NTHR = 512, NWAVES = 8;
constexpr int MTOK = 8192, DM = 2048, SEQ = 2048, NBATCH = 4, PROJ = 4096, GW = 512;
constexpr int LDS_BYTES = 147456;

constexpr size_t MiB = 1u << 20;
constexpr size_t WS_CTL = 0;
constexpr size_t WS_WINT = 1 * MiB;
constexpr size_t WS_WOUTT = WS_WINT + 32 * MiB;
constexpr size_t WS_WQT = WS_WOUTT + 16 * MiB;
constexpr size_t WS_WGLUT = WS_WQT + 8 * MiB;
constexpr size_t WS_WCST = WS_WGLUT + 1 * MiB;
constexpr size_t WS_DFT = WS_WCST + 2 * MiB;
constexpr size_t WS_C1F = WS_DFT + 8 * MiB;
constexpr size_t WS_UB = WS_DFT + 16 * MiB;
constexpr size_t WS_VB = WS_UB + 128 * MiB;
constexpr size_t WS_KEYST = WS_VB + 128 * MiB;
constexpr size_t WS_ROPE = WS_KEYST + 1 * MiB;
constexpr size_t WS_HB = WS_ROPE + 1 * MiB;
constexpr size_t WS_PROJ = WS_HB + 32 * MiB;
constexpr size_t WS_PA = WS_PROJ + 128 * MiB;
constexpr size_t WS_C1 = WS_PA + 8 * MiB;
constexpr size_t WS_YA = WS_C1 + 16 * MiB;
constexpr size_t WS_QB = WS_YA + 64 * MiB;
constexpr size_t WS_S5E = WS_QB + 16 * MiB;
constexpr size_t WS_YGELU = WS_S5E + 4 * MiB;
constexpr size_t WS_RW = WS_YGELU + 8 * MiB;
constexpr size_t WS_YRW = WS_RW + 176 * MiB;
constexpr size_t WS_X1 = WS_YRW + 32 * MiB;
constexpr size_t WS_X2 = WS_X1 + 64 * MiB;
constexpr size_t WS_KS = WS_X2 + 64 * MiB;
constexpr size_t WS_S5T = WS_VB + 122 * MiB;
constexpr size_t WS_END = WS_KS + 16 * MiB;
static_assert(WS_END <= 1024 * MiB, "workspace map must fit 1 GiB");
constexpr size_t WS_LORA = WS_VB + 1 * MiB;
constexpr size_t WS_RWC = WS_VB + 2 * MiB;
constexpr int RWC_REC = 15360;
constexpr size_t RWSZ = (size_t)MTOK * GW;
enum { RW_R = 0, RW_V, RW_KK, RW_W0, RW_W1, RW_KD0, RW_KD1, RW_B0, RW_B1, RW_G, RW_BONUS };

struct Args { const float* in[36]; float* out; unsigned char* ws; int ph_lo, ph_hi; };

__device__ __forceinline__ unsigned f2bf(float f) { const unsigned u = __float_as_uint(f); return (u + 0x7fffu + ((u >> 16) & 1u)) >> 16; }
__device__ __forceinline__ unsigned pk2(float lo, float hi) { return f2bf(lo) | (f2bf(hi) << 16); }
__device__ __forceinline__ float bflo(unsigned w) { return __uint_as_float(w << 16); }
__device__ __forceinline__ float bfhi(unsigned w) { return __uint_as_float(w & 0xffff0000u); }
#define DPPF(x, ctrl) __builtin_bit_cast(float, __builtin_amdgcn_update_dpp(0, __builtin_bit_cast(int, (x)), (ctrl), 0xF, 0xF, true))
#define RDL(x, l) __builtin_bit_cast(float, __builtin_amdgcn_readlane(__builtin_bit_cast(int, (x)), (l)))
__device__ __forceinline__ float wave_sum(float v) {
    v += DPPF(v, 0xB1); v += DPPF(v, 0x4E); v += DPPF(v, 0x124); v += DPPF(v, 0x128);
    return (RDL(v, 0) + RDL(v, 16)) + (RDL(v, 32) + RDL(v, 48));
}
__device__ __forceinline__ float wave_max(float v) {
    v = fmaxf(v, DPPF(v, 0xB1)); v = fmaxf(v, DPPF(v, 0x4E)); v = fmaxf(v, DPPF(v, 0x124)); v = fmaxf(v, DPPF(v, 0x128));
    return fmaxf(fmaxf(RDL(v, 0), RDL(v, 16)), fmaxf(RDL(v, 32), RDL(v, 48)));
}
__device__ __forceinline__ float sigmoidf_(float x) { return 1.f / (1.f + __expf(-x)); }
__device__ __forceinline__ float gelu_tanh(float x) { const float u = 0.7978845608028654f * (x + 0.044715f * x * x * x); return 0.5f * x * (1.f + tanhf(u)); }
__device__ __forceinline__ float gelu_erf(float x) { return 0.5f * x * (1.f + erff(x * 0.7071067811865476f)); }
#define LDS_WAIT() asm volatile("s_waitcnt lgkmcnt(0)" ::: "memory")

struct Ctx {
    LAS unsigned char* lds; int tid, lane, wave, G, gw, ngw, bx;
};
__device__ __forceinline__ Ctx fresh_ctx_w(unsigned char* lds_raw, int wave0) {
    Ctx C; int ln = __builtin_amdgcn_mbcnt_hi(~0u, __builtin_amdgcn_mbcnt_lo(~0u, 0u)); asm volatile("" : "+v"(ln));
    int wv = wave0; asm volatile("" : "+s"(wv));
    int t = wv * 64 + ln;
    int bx = blockIdx.x, G = gridDim.x; asm volatile("" : "+s"(bx), "+s"(G));
    unsigned lo_ = 0u; asm volatile("" : "+s"(lo_));
    C.lds = (LAS unsigned char*)lds_raw + lo_; C.tid = t; C.lane = ln; C.wave = wv;
    C.G = G; C.bx = bx; C.gw = bx * NWAVES + C.wave; C.ngw = G * NWAVES; return C;
}
#define AS4 __attribute__((address_space(4)))
typedef const float* const AS4* InTab;
struct AP { InTab in; float* out; unsigned char* ws; };
static_assert(offsetof(Args, out) == 288 && offsetof(Args, ws) == 296, "Args layout");
__device__ __forceinline__ AP fresh_args() {
    unsigned long long p = (unsigned long long)__builtin_amdgcn_kernarg_segment_ptr(); asm volatile("" : "+s"(p));
    AP r; r.in = (InTab)p; r.out = *(float* const AS4*)(p + 288); r.ws = *(unsigned char* const AS4*)(p + 296); return r;
}

typedef __attribute__((address_space(1))) unsigned gu32;
#define RLX_AGENT __ATOMIC_RELAXED, __HIP_MEMORY_SCOPE_AGENT
#define XB_TMO      128
#define XB_XCNT(j)  (256  + 64 * (j))
#define XB_XSUB(j)  (1280 + 64 * (j))
#define XB_XGEN(j)  (2304 + 64 * (j))
#define XB_TOP      3328
#define XB_TOPGEN   3392
#define XCD_BAR_WORDS 3456
#define XB_SPIN_CAP (1u << 18)

__device__ __forceinline__ unsigned xb_ld(unsigned* p)              { return __hip_atomic_load(p, __ATOMIC_RELAXED, __HIP_MEMORY_SCOPE_AGENT); }
__device__ __forceinline__ unsigned xb_add(unsigned* p, unsigned v) { return __hip_atomic_fetch_add(p, v, __ATOMIC_RELAXED, __HIP_MEMORY_SCOPE_AGENT); }
__device__ __forceinline__ unsigned xb_xcc_id() { return (unsigned)__builtin_amdgcn_s_getreg((3 << 11) | 20) & 0xFu; }
#define XB_SPIN(cond, bar) do { unsigned _sp = 0; while (cond) { __builtin_amdgcn_s_sleep(1); \
    if ((++_sp & 255u) == 0u) { if (xb_ld(&(bar)[XB_TMO])) break; if (_sp > XB_SPIN_CAP) { atomicAdd(&(bar)[XB_TMO], 1u); break; } } } } while (0)

struct XcdBarrier {
    unsigned* bar; unsigned x;
    volatile LAS unsigned* st;
};

__device__ __forceinline__ XcdBarrier xcd_barrier_post(unsigned* bar, volatile LAS unsigned* st) {
    XcdBarrier b; b.bar = bar; b.x = xb_xcc_id(); b.st = st;
    if (threadIdx.x == 0) (void)xb_add(&bar[XB_XCNT(b.x)], 1u);
    return b;
}
__device__ __forceinline__ void xcd_barrier_complete(unsigned* bar, unsigned x, unsigned& nloc, unsigned& nx) {
    const unsigned G = gridDim.x * gridDim.y * gridDim.z;
    unsigned sum, cnt, mine, sp = 0u;
    for (;;) {
        sum = 0u; cnt = 0u; mine = 0u;
#pragma unroll
        for (unsigned j = 0; j < 16; ++j) { const unsigned c = xb_ld(&bar[XB_XCNT(j)]); sum += c; cnt += (c > 0u) ? 1u : 0u; mine = (j == x) ? c : mine; }
        if (sum == G) break;
        __builtin_amdgcn_s_sleep(1);
        if ((++sp & 255u) == 0u) { if (xb_ld(&bar[XB_TMO])) break; if (sp > XB_SPIN_CAP) { atomicAdd(&bar[XB_TMO], 1u); break; } }
    }
    nloc = mine > 0u ? mine : 1u; nx = cnt > 0u ? cnt : 1u;
}

__device__ __forceinline__ void xcd_barrier(const XcdBarrier& b) {
    asm volatile("s_waitcnt vmcnt(0)" ::: "memory");
    __syncthreads();
    if (threadIdx.x == 0) {
        unsigned* bar = b.bar;
        __builtin_amdgcn_s_waitcnt(0);
        unsigned nloc = b.st[0], nx = b.st[1];
        if (nloc == 0u) { xcd_barrier_complete(bar, b.x, nloc, nx); b.st[0] = nloc; b.st[1] = nx; }
        const unsigned old = xb_add(&bar[XB_XSUB(b.x)], 1u);
        const unsigned gen = old / nloc;
        if (old + 1u == (gen + 1u) * nloc) {
            __builtin_amdgcn_fence(__ATOMIC_RELEASE, "agent");
            asm volatile("s_waitcnt vmcnt(0)" ::: "memory");
            const unsigned og = xb_add(&bar[XB_TOP], 1u);
            const unsigned tg = og / nx;
            if (og + 1u == (tg + 1u) * nx) xb_add(&bar[XB_TOPGEN], 1u);
            else XB_SPIN(xb_ld(&bar[XB_TOPGEN]) == tg, bar);
            __builtin_amdgcn_fence(__ATOMIC_ACQUIRE, "agent");
            xb_add(&bar[XB_XGEN(b.x)], 1u);
            asm volatile("s_waitcnt vmcnt(0)" ::: "memory");
        } else {
            XB_SPIN(xb_ld(&bar[XB_XGEN(b.x)]) == gen, bar);
            __builtin_amdgcn_fence(__ATOMIC_ACQUIRE, "agent");
            asm volatile("s_waitcnt vmcnt(0)" ::: "memory");
        }
    }
    __syncthreads();
}

__device__ __forceinline__ void transpose_item(const float* W, const float* gain, int K, int N, bf16_t* WT, LAS float* scr, int item, int lane) {
    const int nblk = N / 64, kb = item / nblk, nb = item % nblk, k0 = 64 * kb, n0 = 64 * nb;
    const int lr = lane >> 4, lc = (lane & 15) * 4;
    f32x4 v[16];
#pragma unroll
    for (int i = 0; i < 16; ++i) v[i] = *(const f32x4*)(W + (size_t)(k0 + 4 * i + lr) * N + n0 + lc);
#pragma unroll
    for (int i = 0; i < 16; ++i) { const int kk = 4 * i + lr; const float g = gain ? gain[k0 + kk] : 1.f; LAS float* d = scr + kk * 65 + lc;
        d[0] = v[i].x * g; d[1] = v[i].y * g; d[2] = v[i].z * g; d[3] = v[i].w * g; }
    LDS_WAIT(); asm volatile("" ::: "memory");
#pragma unroll
    for (int c = 0; c < 8; ++c) { const LAS float* sp = scr + (8 * c) * 65 + lane;
        u32x4 o; o.x = pk2(sp[0 * 65], sp[1 * 65]); o.y = pk2(sp[2 * 65], sp[3 * 65]); o.z = pk2(sp[4 * 65], sp[5 * 65]); o.w = pk2(sp[6 * 65], sp[7 * 65]);
        *(u32x4*)(WT + (size_t)(n0 + lane) * K + k0 + 8 * c) = o; }
    LDS_WAIT(); asm volatile("" ::: "memory");
}
__device__ __forceinline__ void rms_row_to_bf16(const float* xrow, bf16_t* orow, int lane) {
    const f32x4* xr = (const f32x4*)xrow + lane;
    f32x4 v[8]; float s = 0.f;
#pragma unroll
    for (int j = 0; j < 8; ++j) { v[j] = xr[64 * j]; s += (v[j].x * v[j].x + v[j].y * v[j].y) + (v[j].z * v[j].z + v[j].w * v[j].w); }
    const float rs = rsqrtf(wave_sum(s) * (1.f / DM) + 1e-6f);
    u32x2* o8 = (u32x2*)orow + lane;
#pragma unroll
    for (int j = 0; j < 8; ++j) { u32x2 w; w.x = pk2(v[j].x * rs, v[j].y * rs); w.y = pk2(v[j].z * rs, v[j].w * rs); o8[64 * j] = w; }
}
__device__ __forceinline__ void s5_tables(const Ctx& C, const AP& a);
typedef float v16f_t __attribute__((ext_vector_type(16)));
typedef float v32f_t __attribute__((ext_vector_type(32)));
typedef unsigned v6u_t __attribute__((ext_vector_type(6)));
constexpr int EROW = 1536; constexpr size_t ETAB = (size_t)16384 * EROW;
__device__ __forceinline__ void expert_row_pack(const AP& a, int which, int l, int e, int lane, const f32x4 (&v)[8], float mx) {
    unsigned char* ws = a.ws;
    if (which) {
        const float sc4 = mx > 0.f ? 6.f / mx : 1.f;
        unsigned wv[4];
#pragma unroll
        for (int d4 = 0; d4 < 4; ++d4) { unsigned w_ = 0u;
            w_ = __builtin_amdgcn_cvt_scalef32_pk_fp4_f32(w_, v[2 * d4].x * sc4, v[2 * d4].y * sc4, 1.0f, 0); w_ = __builtin_amdgcn_cvt_scalef32_pk_fp4_f32(w_, v[2 * d4].z * sc4, v[2 * d4].w * sc4, 1.0f, 1);
            w_ = __builtin_amdgcn_cvt_scalef32_pk_fp4_f32(w_, v[2 * d4 + 1].x * sc4, v[2 * d4 + 1].y * sc4, 1.0f, 2); w_ = __builtin_amdgcn_cvt_scalef32_pk_fp4_f32(w_, v[2 * d4 + 1].z * sc4, v[2 * d4 + 1].w * sc4, 1.0f, 3);
            wv[d4] = w_; }
        ((u32x4*)(ws + WS_UB + 64 * MiB + (size_t)l * 16 * MiB + (size_t)e * 1024))[lane] = (u32x4){wv[0], wv[1], wv[2], wv[3]};
        if (lane == 0) ((float*)(ws + WS_VB))[(2 + l) * 16384 + e] = mx > 0.f ? mx * (1.f / 6.f) : 1.f;
        return;
    }
    if (true) {
        const float sc4 = mx > 0.f ? 6.f / mx : 1.f;
        unsigned wv[4];
#pragma unroll
        for (int d4 = 0; d4 < 4; ++d4) { unsigned w_ = 0u;
            w_ = __builtin_amdgcn_cvt_scalef32_pk_fp4_f32(w_, v[2 * d4].x * sc4, v[2 * d4].y * sc4, 1.0f, 0); w_ = __builtin_amdgcn_cvt_scalef32_pk_fp4_f32(w_, v[2 * d4].z * sc4, v[2 * d4].w * sc4, 1.0f, 1);
            w_ = __builtin_amdgcn_cvt_scalef32_pk_fp4_f32(w_, v[2 * d4 + 1].x * sc4, v[2 * d4 + 1].y * sc4, 1.0f, 2); w_ = __builtin_amdgcn_cvt_scalef32_pk_fp4_f32(w_, v[2 * d4 + 1].z * sc4, v[2 * d4 + 1].w * sc4, 1.0f, 3);
            wv[d4] = w_; }
        ((u32x4*)(ws + WS_UB + (size_t)l * ETAB + (size_t)e * 1024))[lane] = (u32x4){wv[0], wv[1], wv[2], wv[3]};
        if (lane == 0) ((float*)(ws + WS_VB))[(0 * 2 + l) * 16384 + e] = mx > 0.f ? mx * (1.f / 6.f) : 1.f;
        return;
    }
    const float sc = mx > 0.f ? 7.f / mx : 1.f;
    typedef unsigned v16u_t __attribute__((ext_vector_type(16))); typedef __bf16 v32bf_t __attribute__((ext_vector_type(32)));
    v16u_t pw;
#pragma unroll
    for (int j = 0; j < 8; ++j) { pw[j * 2] = pk2(v[j].x * sc, v[j].y * sc); pw[j * 2 + 1] = pk2(v[j].z * sc, v[j].w * sc); }
    const v6u_t w = __builtin_amdgcn_cvt_scalef32_pk32_fp6_bf16(__builtin_bit_cast(v32bf_t, pw), 1.0f);
    unsigned char* row = ws + WS_UB + (size_t)l * ETAB + (size_t)e * EROW;
    ((u32x4*)row)[lane] = (u32x4){w[0], w[1], w[2], w[3]}; ((u32x2*)(row + 1024))[lane] = (u32x2){w[4], w[5]};
    if (lane == 0) ((float*)(ws + WS_VB))[(0 * 2 + l) * 16384 + e] = mx > 0.f ? mx * (1.f / 7.f) : 1.f;
}
__device__ __forceinline__ void expert_row_item2(const AP& a, int which, int l, int e, int lane) {
    const f32x4* src = (const f32x4*)(a.in[which ? 35 : 34] + ((size_t)l * 16384 + e) * DM) + lane;
    const f32x4* gp = (const f32x4*)(a.in[31] + l * DM) + lane;
    f32x4 v0[8], v1[8]; float m0 = 0.f, m1 = 0.f;
#pragma unroll
    for (int j = 0; j < 8; ++j) { v0[j] = src[64 * j]; v1[j] = src[512 + 64 * j]; }
#pragma unroll
    for (int j = 0; j < 8; ++j) { if (!which) { const f32x4 g = gp[64 * j]; v0[j] = v0[j] * g; v1[j] = v1[j] * g; }
        m0 = fmaxf(m0, fmaxf(fmaxf(fabsf(v0[j].x), fabsf(v0[j].y)), fmaxf(fabsf(v0[j].z), fabsf(v0[j].w))));
        m1 = fmaxf(m1, fmaxf(fmaxf(fabsf(v1[j].x), fabsf(v1[j].y)), fmaxf(fabsf(v1[j].z), fabsf(v1[j].w)))); }
    m0 = wave_max(m0); m1 = wave_max(m1);
    expert_row_pack(a, which, l, e, lane, v0, m0); expert_row_pack(a, which, l, e + 1, lane, v1, m1);
}
__device__ __forceinline__ void phase_prep(const Ctx& C, const AP& a) {
    unsigned char* ws = a.ws;
    LAS float* scr = (LAS float*)(C.lds + C.wave * 16640);
    constexpr int I_IN = 32 * 64, I_OUT = 32 * 32, I_Q = 32 * 16, I_GLU = 8 * 8, I_L = I_IN + I_OUT + I_Q + I_GLU;
    for (int it = C.gw; it < 2 * I_L; it += C.ngw) {
        const int l = it / I_L; int r = it % I_L;
        if (r < I_IN) { transpose_item(a.in[2] + (size_t)l * DM * PROJ, a.in[1] + l * DM, DM, PROJ, (bf16_t*)(ws + WS_WINT) + (size_t)l * PROJ * DM, scr, r, C.lane); continue; } r -= I_IN;
        if (r < I_OUT) { transpose_item(a.in[30] + (size_t)l * DM * DM, a.in[29] + l * DM, DM, DM, (bf16_t*)(ws + WS_WOUTT) + (size_t)l * DM * DM, scr, r, C.lane); continue; } r -= I_OUT;
        if (r < I_Q) { transpose_item(a.in[32] + (size_t)l * DM * 1024, a.in[31] + l * DM, DM, 1024, (bf16_t*)(ws + WS_WQT) + (size_t)l * 1024 * DM, scr, r, C.lane); continue; } r -= I_Q;
        transpose_item(a.in[12] + (size_t)l * 512 * 512, nullptr, 512, 512, (bf16_t*)(ws + WS_WGLUT) + (size_t)l * 512 * 512, scr, r, C.lane);
    }
    {
        LAS float* tc = (LAS float*)(C.lds + 8 * 16640); LAS float* ts = tc + 128;
        if (C.tid < 128) { tc[C.tid] = cospif((float)C.tid / 64.f); ts[C.tid] = sinpif((float)C.tid / 64.f); }
        __syncthreads();
        for (int it = C.bx * NTHR + C.tid; it < 2 * 4 * 32 * 512; it += C.G * NTHR) {
            const int cp = it & 511, ccg = (it >> 9) & 31, blk = (it >> 14) & 3, l = it >> 16;
            const float* fw = a.in[3] + (size_t)l * 512 * 512 + (size_t)blk * 128 * 512 + cp;
            float sc[4] = {0.f, 0.f, 0.f, 0.f}, ss[4] = {0.f, 0.f, 0.f, 0.f};
#pragma unroll 8
            for (int m = 0; m < 128; ++m) { const float f = fw[(size_t)m * 512];
#pragma unroll
                for (int r = 0; r < 4; ++r) { const int ix = (m * (ccg * 4 + r)) & 127; sc[r] += tc[ix] * f; ss[r] += ts[ix] * f; } }
            bf16_t* o = (bf16_t*)(ws + WS_WCST) + (size_t)l * 1024 * 512; const int c0 = blk * 128 + ccg * 4;
            u32x2 w; w.x = pk2(sc[0] * (1.f / 512.f), sc[1] * (1.f / 512.f)); w.y = pk2(sc[2] * (1.f / 512.f), sc[3] * (1.f / 512.f)); *(u32x2*)(o + (size_t)(2 * cp) * 512 + c0) = w;
            w.x = pk2(ss[0] * (1.f / 512.f), ss[1] * (1.f / 512.f)); w.y = pk2(ss[2] * (1.f / 512.f), ss[3] * (1.f / 512.f)); *(u32x2*)(o + (size_t)(2 * cp + 1) * 512 + c0) = w;
        }
    }
    for (int it = C.bx * NTHR + C.tid; it < 2048 * 256; it += C.G * NTHR) {
        const int k = it >> 8, j0 = (it & 255) * 8; float v[8];
#pragma unroll
        for (int e = 0; e < 8; ++e) { const int j = j0 + e, s = j <= 1024 ? j : j - 1024; const float x = (float)((k * s) & 2047) * (1.f / 1024.f); v[e] = (j <= 1024) ? cospif(x) : -sinpif(x); }
        u32x4 w; w.x = pk2(v[0], v[1]); w.y = pk2(v[2], v[3]); w.z = pk2(v[4], v[5]); w.w = pk2(v[6], v[7]);
        *(u32x4*)((bf16_t*)(ws + WS_DFT) + (size_t)k * 2048 + j0) = w;
    }
    for (int it = C.bx * NTHR + C.tid; it < 2 * 8 * 2 * 64 * 128; it += C.G * NTHR) {
        const int key = it & 127, d = (it >> 7) & 63, lhp = it >> 13;
        ((float*)(ws + WS_KEYST))[it] = a.in[33][((size_t)lhp * 128 + key) * 64 + d];
    }
    for (int it = C.bx * NTHR + C.tid; it < 2048 * 64; it += C.G * NTHR) {
        const int pos = it >> 6, j = it & 63; const float inv = powf(10000.f, -(float)(2 * (j & 31)) / 64.f);
        const float ang = (float)(j < 32 ? (pos >> 6) : (pos & 63)) * inv;
        ((float*)(ws + WS_ROPE))[it] = cosf(ang); ((float*)(ws + WS_ROPE))[2048 * 64 + it] = sinf(ang);
    }
    {
        bf16_t* W1T = (bf16_t*)(ws + WS_LORA); bf16_t* g2T = W1T + 2 * 224 * 512; bf16_t* w2T = g2T + 2 * 512 * 96; bf16_t* a2T = w2T + 2 * 2 * 512 * 32;
        for (int it = C.bx * NTHR + C.tid; it < 2 * 224 * 512; it += C.G * NTHR) {
            const int k = it & 511, j = (it >> 9) % 224, l = it / (224 * 512); float v;
            if (j < 96) v = a.in[22][((size_t)l * 512 + k) * 96 + j];
            else if (j < 160) v = a.in[17][((size_t)(l * 2 + ((j - 96) >> 5)) * 512 + k) * 32 + ((j - 96) & 31)];
            else v = a.in[20][((size_t)(l * 2 + ((j - 160) >> 5)) * 512 + k) * 32 + ((j - 160) & 31)];
            W1T[it] = (bf16_t)f2bf(v);
        }
        for (int it = C.bx * NTHR + C.tid; it < 2 * 512 * 96; it += C.G * NTHR) {
            const int j = it % 96, ch = (it / 96) & 511, l = it / (96 * 512);
            g2T[it] = (bf16_t)f2bf(a.in[23][((size_t)l * 96 + j) * 512 + ch]);
        }
        for (int it = C.bx * NTHR + C.tid; it < 2 * 2 * 512 * 32; it += C.G * NTHR) {
            const int j = it & 31, ch = (it >> 5) & 511, ld = it >> 14;
            w2T[it] = (bf16_t)f2bf(a.in[18][((size_t)ld * 32 + j) * 512 + ch]); a2T[it] = (bf16_t)f2bf(a.in[21][((size_t)ld * 32 + j) * 512 + ch]);
        }
    }
    for (int m = C.gw; m < MTOK; m += C.ngw) rms_row_to_bf16(a.in[0] + (size_t)m * DM, (bf16_t*)(ws + WS_HB) + (size_t)m * DM, C.lane);
}

__device__ __forceinline__ void qk_prep_token(const AP& a, int l, int m, int lane) {
    unsigned char* ws = a.ws;
    const float* pr = (const float*)(ws + WS_PROJ) + (size_t)m * PROJ;
    const int pos = m & (SEQ - 1);
    const float cs = ((const float*)(ws + WS_ROPE))[pos * 64 + lane], sn = ((const float*)(ws + WS_ROPE))[2048 * 64 + pos * 64 + lane];
    bf16_t* qo = (bf16_t*)(ws + WS_QB) + (size_t)m * 512; bf16_t* ko = (bf16_t*)(ws + WS_QB) + (size_t)MTOK * 512 + (size_t)m * 256; bf16_t* vo = ko + (size_t)MTOK * 256;
#pragma unroll
    for (int hh = 0; hh < 6; ++hh) {
        const float* src = pr + 1024 + hh * 128;
        const float* gn = a.in[hh < 4 ? 13 : 14] + l * 128;
        const float x1 = src[lane], x2 = src[lane + 64];
        const float rs = rsqrtf(wave_sum(x1 * x1 + x2 * x2) * (1.f / 128.f) + 1e-6f);
        const float y1 = x1 * rs * gn[lane], y2 = x2 * rs * gn[lane + 64];
        bf16_t* dst = hh < 4 ? qo + hh * 128 : ko + (hh - 4) * 128;
        dst[lane] = (bf16_t)f2bf(y1 * cs - y2 * sn); dst[lane + 64] = (bf16_t)f2bf(y1 * sn + y2 * cs);
    }
    const f32x4 vv = *((const f32x4*)(pr + 1792) + lane);
    u32x2 w; w.x = pk2(vv.x, vv.y); w.y = pk2(vv.z, vv.w); *((u32x2*)vo + lane) = w;
}

struct S5P { float lr, li, cr, ci; };
__device__ __forceinline__ S5P s5_params(const AP& a, int l, int d, int g, int p, float mult) {
    const int ix = ((l * 2 + d) * 32 + g) * 64 + p;
    const float lre = a.in[4][ix], lim = a.in[5][ix], step = __expf(a.in[6][(l * 2 + d) * 32 + g]) * mult;
    const float er = __expf(lre * step); float sn, cs; sincosf(lim * step, &sn, &cs);
    S5P r; r.lr = er * cs; r.li = er * sn;
    const float nr = r.lr - 1.f, ni = r.li, den = 1.f / (lre * lre + lim * lim);
    r.cr = (nr * lre + ni * lim) * den; r.ci = (ni * lre - nr * lim) * den;
    return r;
}
__device__ __forceinline__ void s5_ends_item(const AP& a, int l, int item, int lane, LAS float* us) {
    unsigned char* ws = a.ws;
    const int c = item & 31, g = (item >> 5) & 31, b = item >> 10, p = lane;
    const float* ur = (const float*)(ws + WS_PROJ) + ((size_t)(b * SEQ + c * 64 + lane)) * PROJ + 512 + g * 16;
#pragma unroll
    for (int q = 0; q < 4; ++q) *((LAS f32x4*)(us + lane * 16) + q) = *((const f32x4*)ur + q);
    LDS_WAIT(); asm volatile("" ::: "memory");
#pragma unroll 1
    for (int d = 0; d < 2; ++d) {
        const S5P P = s5_params(a, l, d, g, p, 1.f);
        f32x2 bb2[16];
        const float* bre = a.in[7] + ((size_t)((l * 2 + d) * 32 + g) * 64 + p) * 16; const float* bim = a.in[8] + ((size_t)((l * 2 + d) * 32 + g) * 64 + p) * 16;
#pragma unroll
        for (int h = 0; h < 16; ++h) { const float x = bre[h], y = bim[h]; bb2[h].x = P.cr * x - P.ci * y; bb2[h].y = P.cr * y + P.ci * x; }
        const f32x2 lam2 = {P.lr, P.lr}, lami = {-P.li, P.li};
        float xr = 0.f, xi = 0.f;
#pragma unroll 4
        for (int tt = 0; tt < 64; ++tt) {
            const int t = d ? 63 - tt : tt;
            f32x2 acc2 = {0.f, 0.f};
#pragma unroll
            for (int q = 0; q < 4; ++q) { const f32x4 u4 = *((const LAS f32x4*)(us + t * 16) + q);
#pragma unroll
                for (int e = 0; e < 4; ++e) acc2 += bb2[q * 4 + e] * u4[e]; }
            const f32x2 x2 = {xr, xi}, xs = {xi, xr}; const f32x2 n2 = lam2 * x2 + lami * xs + acc2; xr = n2.x; xi = n2.y;
        }
        f32x2 o; o.x = xr; o.y = xi;
        ((f32x2*)(ws + WS_S5E))[((size_t)((b * 32 + g) * 2 + d) * 32 + c) * 64 + p] = o;
    }
    LDS_WAIT(); asm volatile("" ::: "memory");
}
__device__ __forceinline__ void s5_final_item(const AP& a, int l, int item, int lane, LAS float* us  , LAS float* yb  , LAS float* X  ) {
    unsigned char* ws = a.ws;
    const int c = item & 31, g = (item >> 5) & 31, b = item >> 10, p = lane;
    const float* ur = (const float*)(ws + WS_PROJ) + ((size_t)(b * SEQ + c * 64 + lane)) * PROJ + 512 + g * 16;
#pragma unroll
    for (int q = 0; q < 4; ++q) { *((LAS f32x4*)(us + lane * 16) + q) = *((const f32x4*)ur + q); *((LAS f32x4*)(yb + lane * 16) + q) = (f32x4){0.f, 0.f, 0.f, 0.f}; }
    LDS_WAIT(); asm volatile("" ::: "memory");
    const int oh = lane & 15, otq = lane >> 4;
#pragma unroll 1
    for (int d = 0; d < 2; ++d) {
        const S5P P = s5_params(a, l, d, g, p, 1.f);
        const S5P P64 = s5_params(a, l, d, g, p, 64.f);
        float br[16], bi[16];
        const float* bre = a.in[7] + ((size_t)((l * 2 + d) * 32 + g) * 64 + p) * 16; const float* bim = a.in[8] + ((size_t)((l * 2 + d) * 32 + g) * 64 + p) * 16;
#pragma unroll
        for (int h = 0; h < 16; ++h) { const float x = bre[h], y = bim[h]; br[h] = P.cr * x - P.ci * y; bi[h] = P.cr * y + P.ci * x; }
        const f32x2* E = (const f32x2*)(ws + WS_S5E) + ((size_t)((b * 32 + g) * 2 + d) * 32) * 64 + p;
        float xr = 0.f, xi = 0.f;
        { f32x2 nx[4];
#pragma unroll
          for (int i = 0; i < 4; ++i) nx[i] = E[(d ? 31 - i : i) * 64];
#pragma unroll 1
          for (int grp = 0; grp < 8; ++grp) {
              if (d ? (31 - grp * 4 <= c) : (grp * 4 >= c)) break;
              f32x2 cu[4];
#pragma unroll
              for (int i = 0; i < 4; ++i) cu[i] = nx[i];
              if (grp < 7) {
#pragma unroll
                  for (int i = 0; i < 4; ++i) nx[i] = E[(d ? 27 - grp * 4 - i : grp * 4 + 4 + i) * 64];
              }
#pragma unroll
              for (int i = 0; i < 4; ++i) { const int cc = d ? 31 - grp * 4 - i : grp * 4 + i;
                  if (d ? (cc > c) : (cc < c)) { const float nr = P64.lr * xr - P64.li * xi + cu[i].x, ni = P64.lr * xi + P64.li * xr + cu[i].y; xr = nr; xi = ni; } }
          } }
        const float* cre = a.in[9] + ((size_t)((l * 2 + d) * 32 + g) * 16 + oh) * 64; const float* cim = a.in[10] + ((size_t)((l * 2 + d) * 32 + g) * 16 + oh) * 64;
#pragma unroll 1
        for (int sb = 0; sb < 4; ++sb) {
            for (int tt = 0; tt < 16; ++tt) {
                const int ts = sb * 16 + tt, t = d ? 63 - ts : ts;
                float ar = 0.f, ai = 0.f;
#pragma unroll
                for (int q = 0; q < 4; ++q) { const f32x4 u4 = *((const LAS f32x4*)(us + t * 16) + q);
#pragma unroll
                    for (int e = 0; e < 4; ++e) { ar += br[q * 4 + e] * u4[e]; ai += bi[q * 4 + e] * u4[e]; } }
                const float nr = P.lr * xr - P.li * xi + ar, ni = P.lr * xi + P.li * xr + ai; xr = nr; xi = ni;
                f32x2 o; o.x = xr; o.y = xi; *((LAS f32x2*)X + tt * 64 + p) = o;
            }
            LDS_WAIT(); asm volatile("" ::: "memory");
            float acc[4] = {0.f, 0.f, 0.f, 0.f};
            for (int pq = 0; pq < 16; ++pq) {
                const f32x4 c4r = *((const f32x4*)cre + pq), c4i = *((const f32x4*)cim + pq);
#pragma unroll
                for (int i = 0; i < 4; ++i) {
                    const LAS f32x4* xp = (const LAS f32x4*)(X + ((otq * 4 + i) * 64 + pq * 4) * 2);
                    const f32x4 xa = xp[0], xb = xp[1];
                    acc[i] += c4r[0] * xa[0] - c4i[0] * xa[1] + c4r[1] * xa[2] - c4i[1] * xa[3] + c4r[2] * xb[0] - c4i[2] * xb[1] + c4r[3] * xb[2] - c4i[3] * xb[3];
                }
            }
#pragma unroll
            for (int i = 0; i < 4; ++i) { const int ts = sb * 16 + otq * 4 + i, t = d ? 63 - ts : ts; yb[t * 16 + oh] += acc[i]; }
            LDS_WAIT(); asm volatile("" ::: "memory");
        }
    }
    const float* dsk = a.in[11] + (l * 32 + g) * 16;
    unsigned w[8];
#pragma unroll
    for (int h = 0; h < 16; h += 2) {
        const float y0 = gelu_tanh(yb[lane * 16 + h] + dsk[h] * us[lane * 16 + h]), y1 = gelu_tanh(yb[lane * 16 + h + 1] + dsk[h + 1] * us[lane * 16 + h + 1]);
        w[h >> 1] = pk2(y0, y1);
    }
    u32x4* dst = (u32x4*)((bf16_t*)(ws + WS_YGELU) + (size_t)(b * SEQ + c * 64 + lane) * 512 + g * 16);
    dst[0] = (u32x4){w[0], w[1], w[2], w[3]}; dst[1] = (u32x4){w[4], w[5], w[6], w[7]};
    LDS_WAIT(); asm volatile("" ::: "memory");
}

__device__ __forceinline__ void s5_tables(const Ctx& C, const AP& a) {
    unsigned char* ws = a.ws;
    f32x4* LAMT = (f32x4*)(ws + WS_S5T); bf16_t* BBop = (bf16_t*)(ws + WS_S5T + 131072); bf16_t* CBop = (bf16_t*)(ws + WS_S5T + 131072 + 1048576);
    for (int it = C.bx * NTHR + C.tid; it < 128 * 64; it += C.G * NTHR) {
        const int p = it & 63, ldg = it >> 6, g = ldg & 31, d = (ldg >> 5) & 1, l = ldg >> 6;
        const S5P P = s5_params(a, l, d, g, p, 1.f), P64 = s5_params(a, l, d, g, p, 64.f);
        LAMT[it] = (f32x4){P.lr, P.li, P64.lr, P64.li};
    }
    for (int it = C.bx * NTHR + C.tid; it < 128 * 8 * 64; it += C.G * NTHR) {
        const int lane = it & 63, nt = (it >> 6) & 7, ldg = it >> 9, g = ldg & 31, d = (ldg >> 5) & 1, l = ldg >> 6, fr = lane & 15, fq = lane >> 4;
        const int col = nt * 16 + fr, p = col >> 1, ri = col & 1;
        unsigned w[4] = {0u, 0u, 0u, 0u};
        if (fq < 2) {
            const S5P P = s5_params(a, l, d, g, p, 1.f);
            const float* bre = a.in[7] + ((size_t)ldg * 64 + p) * 16 + fq * 8; const float* bim = a.in[8] + ((size_t)ldg * 64 + p) * 16 + fq * 8;
            float v[8];
#pragma unroll
            for (int jj = 0; jj < 8; ++jj) v[jj] = ri ? (P.cr * bim[jj] + P.ci * bre[jj]) : (P.cr * bre[jj] - P.ci * bim[jj]);
            w[0] = pk2(v[0], v[1]); w[1] = pk2(v[2], v[3]); w[2] = pk2(v[4], v[5]); w[3] = pk2(v[6], v[7]);
        }
        *(u32x4*)(BBop + (size_t)it * 8) = (u32x4){w[0], w[1], w[2], w[3]};
    }
    for (int it = C.bx * NTHR + C.tid; it < 128 * 4 * 64; it += C.G * NTHR) {
        const int lane = it & 63, s2 = (it >> 6) & 3, ldg = it >> 8, fr = lane & 15, fq = lane >> 4;
        const float* cre = a.in[9] + ((size_t)ldg * 16 + fr) * 64 + 16 * s2 + fq * 4; const float* cim = a.in[10] + ((size_t)ldg * 16 + fr) * 64 + 16 * s2 + fq * 4;
        *(u32x4*)(CBop + (size_t)it * 8) = (u32x4){pk2(cre[0], -cim[0]), pk2(cre[1], -cim[1]), pk2(cre[2], -cim[2]), pk2(cre[3], -cim[3])};
    }
}
__device__ __forceinline__ void s5_load_u(const float* ur, LAS unsigned char* wl, int lane) {
    const f32x4 u0 = *((const f32x4*)ur + 0), u1 = *((const f32x4*)ur + 1), u2 = *((const f32x4*)ur + 2), u3 = *((const f32x4*)ur + 3);
    LAS u32x4* dst = (LAS u32x4*)(wl + lane * 32);
    dst[0] = (u32x4){pk2(u0.x, u0.y), pk2(u0.z, u0.w), pk2(u1.x, u1.y), pk2(u1.z, u1.w)}; dst[1] = (u32x4){pk2(u2.x, u2.y), pk2(u2.z, u2.w), pk2(u3.x, u3.y), pk2(u3.z, u3.w)};
}
__device__ __forceinline__ void s5_build_bb(const AP& a, int ldg, float cr, float ci, int lane, LAS unsigned char* wl, bf16x8_t (&bb)[8]) {
    const int fr = lane & 15, fq = lane >> 4;
    LAS f32x2* cf = (LAS f32x2*)(wl + 14848);
    f32x2 me; me.x = cr; me.y = ci; cf[lane] = me;
    LDS_WAIT(); asm volatile("" ::: "memory");
#pragma unroll
    for (int nt = 0; nt < 8; ++nt) {
        const int col = nt * 16 + fr, p = col >> 1, ri = col & 1;
        unsigned w_[4] = {0u, 0u, 0u, 0u};
        if (fq < 2) {
            const f32x2 c2 = cf[p];
            const f32x4* bre = (const f32x4*)(a.in[7] + ((size_t)ldg * 64 + p) * 16 + fq * 8); const f32x4* bim = (const f32x4*)(a.in[8] + ((size_t)ldg * 64 + p) * 16 + fq * 8);
            const f32x4 r0 = bre[0], r1 = bre[1], i0 = bim[0], i1 = bim[1];
            float v[8];
#pragma unroll
            for (int jj = 0; jj < 4; ++jj) { v[jj] = ri ? (c2.x * i0[jj] + c2.y * r0[jj]) : (c2.x * r0[jj] - c2.y * i0[jj]); v[4 + jj] = ri ? (c2.x * i1[jj] + c2.y * r1[jj]) : (c2.x * r1[jj] - c2.y * i1[jj]); }
            w_[0] = pk2(v[0], v[1]); w_[1] = pk2(v[2], v[3]); w_[2] = pk2(v[4], v[5]); w_[3] = pk2(v[6], v[7]);
        }
        bb[nt] = mk8(w_[0], w_[1], w_[2], w_[3]);
        asm volatile("" ::: "memory");
    }
}
template <bool FINAL>
__device__ __forceinline__ void s5_subblock(LAS unsigned char* wl, const bf16x8_t (&bb)[8], int d, int sb, int lane, float lr, float li, float& xr, float& xi) {
    const int fr = lane & 15, fq = lane >> 4;
    LAS float* BUs = (LAS float*)(wl + 2048); LAS bf16_t* Xb = (LAS bf16_t*)(wl + 10496);
    const int trow = d ? 63 - (sb * 16 + fr) : sb * 16 + fr;
    bf16x8_t aU = mk8(0u, 0u, 0u, 0u);
    if (fq < 2) aU = *(const LAS bf16x8_t*)(wl + trow * 32 + fq * 16);
    const f32x4 z4 = {0.f, 0.f, 0.f, 0.f};
#pragma unroll
    for (int nt = 0; nt < 8; ++nt) { const f32x4 bu = __builtin_amdgcn_mfma_f32_16x16x32_bf16(aU, bb[nt], z4, 0, 0, 0);
#pragma unroll
        for (int r = 0; r < 4; ++r) BUs[(fq * 4 + r) * 132 + nt * 16 + fr] = bu[r]; }
    LDS_WAIT(); asm volatile("" ::: "memory");
#pragma unroll
    for (int tt = 0; tt < 16; ++tt) {
        const f32x2 bq = *(const LAS f32x2*)(BUs + tt * 132 + 2 * lane);
        const float nr = lr * xr - li * xi + bq.x, ni = lr * xi + li * xr + bq.y; xr = nr; xi = ni;
        if (FINAL) *(LAS unsigned*)(Xb + (d ? 15 - tt : tt) * 136 + 2 * lane) = pk2(xr, xi);
    }
    LDS_WAIT(); asm volatile("" ::: "memory");
}
__device__ __forceinline__ void s5_ends_item_m(const AP& a, int l, int item, int lane, LAS unsigned char* wl) {
    unsigned char* ws = a.ws;
    const int c = item & 31, g = (item >> 5) & 31, b = item >> 10;
    s5_load_u((const float*)(ws + WS_PROJ) + ((size_t)(b * SEQ + c * 64 + lane)) * PROJ + 512 + g * 16, wl, lane);
    LDS_WAIT(); asm volatile("" ::: "memory");
#pragma unroll 1
    for (int d = 0; d < 2; ++d) {
        const int ldg = (l * 2 + d) * 32 + g;
        const S5P Pq = s5_params(a, l, d, g, lane, 1.f);
        const f32x4 lam = {Pq.lr, Pq.li, 0.f, 0.f};
        bf16x8_t bb[8]; s5_build_bb(a, ldg, Pq.cr, Pq.ci, lane, wl, bb);
        float xr = 0.f, xi = 0.f;
#pragma unroll 1
        for (int sb = 0; sb < 4; ++sb) s5_subblock<false>(wl, bb, d, sb, lane, lam[0], lam[1], xr, xi);
        f32x2 o; o.x = xr; o.y = xi;
        ((f32x2*)(ws + WS_S5E))[((size_t)((b * 32 + g) * 2 + d) * 32 + c) * 64 + lane] = o;
    }
}
__device__ __forceinline__ void s5_final_item_m(const AP& a, int l, int item, int lane, LAS unsigned char* wl) {
    unsigned char* ws = a.ws;
    const int c = item & 31, g = (item >> 5) & 31, b = item >> 10, fr = lane & 15, fq = lane >> 4;
    const float* ubase = (const float*)(ws + WS_PROJ) + ((size_t)(b * SEQ + c * 64)) * PROJ + 512 + g * 16;
    s5_load_u(ubase + (size_t)lane * PROJ, wl, lane);
    LDS_WAIT(); asm volatile("" ::: "memory");
    LAS bf16_t* Xb = (LAS bf16_t*)(wl + 10496);
    f32x4 yacc[4];
#pragma unroll
    for (int q = 0; q < 4; ++q) yacc[q] = (f32x4){0.f, 0.f, 0.f, 0.f};
#pragma unroll 1
    for (int d = 0; d < 2; ++d) {
        const int ldg = (l * 2 + d) * 32 + g;
        const S5P Pq = s5_params(a, l, d, g, lane, 1.f), P64 = s5_params(a, l, d, g, lane, 64.f);
        const f32x4 lam = {Pq.lr, Pq.li, P64.lr, P64.li};
        bf16x8_t bb[8], cb[4]; s5_build_bb(a, ldg, Pq.cr, Pq.ci, lane, wl, bb);
#pragma unroll
        for (int s2 = 0; s2 < 4; ++s2) {
            const f32x4 cr4 = *(const f32x4*)(a.in[9] + ((size_t)ldg * 16 + fr) * 64 + 16 * s2 + fq * 4), ci4 = *(const f32x4*)(a.in[10] + ((size_t)ldg * 16 + fr) * 64 + 16 * s2 + fq * 4);
            cb[s2] = mk8(pk2(cr4[0], -ci4[0]), pk2(cr4[1], -ci4[1]), pk2(cr4[2], -ci4[2]), pk2(cr4[3], -ci4[3])); }
        const f32x2* E = (const f32x2*)(ws + WS_S5E) + ((size_t)((b * 32 + g) * 2 + d) * 32) * 64 + lane;
        float xr = 0.f, xi = 0.f;
        { f32x2 nx[4];
#pragma unroll
          for (int i = 0; i < 4; ++i) nx[i] = E[(d ? 31 - i : i) * 64];
#pragma unroll 1
          for (int grp = 0; grp < 8; ++grp) {
              if (d ? (31 - grp * 4 <= c) : (grp * 4 >= c)) break;
              f32x2 cu[4];
#pragma unroll
              for (int i = 0; i < 4; ++i) cu[i] = nx[i];
              if (grp < 7) {
#pragma unroll
                  for (int i = 0; i < 4; ++i) nx[i] = E[(d ? 27 - grp * 4 - i : grp * 4 + 4 + i) * 64];
              }
#pragma unroll
              for (int i = 0; i < 4; ++i) { const int cc = d ? 31 - grp * 4 - i : grp * 4 + i;
                  if (d ? (cc > c) : (cc < c)) { const float nr = lam[2] * xr - lam[3] * xi + cu[i].x, ni = lam[2] * xi + lam[3] * xr + cu[i].y; xr = nr; xi = ni; } }
          } }
#pragma unroll
        for (int sb = 0; sb < 4; ++sb) {
            s5_subblock<true>(wl, bb, d, sb, lane, lam[0], lam[1], xr, xi);
            f32x4 acc = d ? yacc[3 - sb] : yacc[sb];
#pragma unroll
            for (int s2 = 0; s2 < 4; ++s2) acc = __builtin_amdgcn_mfma_f32_16x16x32_bf16(*(const LAS bf16x8_t*)(Xb + fr * 136 + s2 * 32 + fq * 8), cb[s2], acc, 0, 0, 0);
            if (d) yacc[3 - sb] = acc; else yacc[sb] = acc;
            LDS_WAIT(); asm volatile("" ::: "memory");
        }
    }
    const float dsk = a.in[11][(l * 32 + g) * 16 + fr];
#pragma unroll
    for (int q = 0; q < 4; ++q)
#pragma unroll
        for (int r = 0; r < 4; ++r) { const int t = q * 16 + fq * 4 + r;
            const float y = gelu_tanh(yacc[q][r] + dsk * ubase[(size_t)t * PROJ + fr]);
            ((bf16_t*)(ws + WS_YGELU))[(size_t)(b * SEQ + c * 64 + t) * 512 + g * 16 + fr] = (bf16_t)f2bf(y); }
}
__device__ __forceinline__ float gelu_tanh_fast(float x) { const float u2 = 1.5957691216057308f * (x + 0.044715f * x * x * x); return x / (1.f + __expf(-u2)); }
__device__ __forceinline__ void s5_final_item_h(const AP& a, int l, int item, int lane, LAS unsigned char* wl) {
    unsigned char* ws = a.ws;
    const int c = item & 31, g = (item >> 5) & 31, b = item >> 10, p = lane, fr = lane & 15, fq = lane >> 4;
    LAS float* us = (LAS float*)wl; LAS bf16_t* Xb = (LAS bf16_t*)(wl + 4096);
    const float* ur = (const float*)(ws + WS_PROJ) + ((size_t)(b * SEQ + c * 64 + lane)) * PROJ + 512 + g * 16;
#pragma unroll
    for (int q = 0; q < 4; ++q) *((LAS f32x4*)(us + lane * 16) + q) = *((const f32x4*)ur + q);
    LDS_WAIT(); asm volatile("" ::: "memory");
    f32x4 yacc[4];
#pragma unroll
    for (int q = 0; q < 4; ++q) yacc[q] = (f32x4){0.f, 0.f, 0.f, 0.f};
#pragma unroll 1
    for (int d = 0; d < 2; ++d) {
        const int ldg = (l * 2 + d) * 32 + g;
        const S5P P = s5_params(a, l, d, g, p, 1.f), P64 = s5_params(a, l, d, g, p, 64.f);
        f32x2 bb2[16];
        const float* bre = a.in[7] + ((size_t)ldg * 64 + p) * 16; const float* bim = a.in[8] + ((size_t)ldg * 64 + p) * 16;
#pragma unroll
        for (int h = 0; h < 16; ++h) { const float x = bre[h], y = bim[h]; bb2[h].x = P.cr * x - P.ci * y; bb2[h].y = P.cr * y + P.ci * x; }
        const f32x2 lam2 = {P.lr, P.lr}, lami = {-P.li, P.li};
        bf16x8_t cb[4];
#pragma unroll
        for (int s2 = 0; s2 < 4; ++s2) {
            const f32x4 cr4 = *(const f32x4*)(a.in[9] + ((size_t)ldg * 16 + fr) * 64 + 16 * s2 + fq * 4), ci4 = *(const f32x4*)(a.in[10] + ((size_t)ldg * 16 + fr) * 64 + 16 * s2 + fq * 4);
            cb[s2] = mk8(pk2(cr4[0], -ci4[0]), pk2(cr4[1], -ci4[1]), pk2(cr4[2], -ci4[2]), pk2(cr4[3], -ci4[3])); }
        const f32x2* E = (const f32x2*)(ws + WS_S5E) + ((size_t)((b * 32 + g) * 2 + d) * 32) * 64 + p;
        float xr = 0.f, xi = 0.f;
        { f32x2 nx[4];
#pragma unroll
          for (int i = 0; i < 4; ++i) nx[i] = E[(d ? 31 - i : i) * 64];
#pragma unroll 1
          for (int grp = 0; grp < 8; ++grp) {
              if (d ? (31 - grp * 4 <= c) : (grp * 4 >= c)) break;
              f32x2 cu[4];
#pragma unroll
              for (int i = 0; i < 4; ++i) cu[i] = nx[i];
              if (grp < 7) {
#pragma unroll
                  for (int i = 0; i < 4; ++i) nx[i] = E[(d ? 27 - grp * 4 - i : grp * 4 + 4 + i) * 64];
              }
#pragma unroll
              for (int i = 0; i < 4; ++i) { const int cc = d ? 31 - grp * 4 - i : grp * 4 + i;
                  if (d ? (cc > c) : (cc < c)) { const float nr = P64.lr * xr - P64.li * xi + cu[i].x, ni = P64.lr * xi + P64.li * xr + cu[i].y; xr = nr; xi = ni; } }
          } }
#pragma unroll
        for (int sb = 0; sb < 4; ++sb) {
#pragma unroll 4
            for (int tt = 0; tt < 16; ++tt) {
                const int ts = sb * 16 + tt, t = d ? 63 - ts : ts;
                f32x2 acc2 = {0.f, 0.f};
#pragma unroll
                for (int q = 0; q < 4; ++q) { const f32x4 u4 = *((const LAS f32x4*)(us + t * 16) + q);
#pragma unroll
                    for (int e = 0; e < 4; ++e) acc2 += bb2[q * 4 + e] * u4[e]; }
                { const f32x2 x2 = {xr, xi}, xs = {xi, xr}; const f32x2 n2 = lam2 * x2 + lami * xs + acc2; xr = n2.x; xi = n2.y; }
                *(LAS unsigned*)(Xb + (d ? 15 - tt : tt) * 136 + 2 * p) = pg8::cvt_pk_bf16(xr, xi);
            }
            LDS_WAIT(); asm volatile("" ::: "memory");
            f32x4 acc = d ? yacc[3 - sb] : yacc[sb];
#pragma unroll
            for (int s2 = 0; s2 < 4; ++s2) acc = __builtin_amdgcn_mfma_f32_16x16x32_bf16(*(const LAS bf16x8_t*)(Xb + fr * 136 + s2 * 32 + fq * 8), cb[s2], acc, 0, 0, 0);
            if (d) yacc[3 - sb] = acc; else yacc[sb] = acc;
            LDS_WAIT(); asm volatile("" ::: "memory");
        }
    }
    const float dsk = a.in[11][(l * 32 + g) * 16 + fr];
#pragma unroll
    for (int q = 0; q < 4; ++q)
#pragma unroll
        for (int r = 0; r < 4; ++r) { const int t = q * 16 + fq * 4 + r;
            const float y = gelu_tanh_fast(yacc[q][r] + dsk * us[t * 16 + fr]);
            ((bf16_t*)(ws + WS_YGELU))[(size_t)(b * SEQ + c * 64 + t) * 512 + g * 16 + fr] = (bf16_t)f2bf(y); }
    LDS_WAIT(); asm volatile("" ::: "memory");
}
__device__ __forceinline__ float shift3(float p, float c, float n, float m0, float m1) { return c + (p - c) * m0 + (n - c) * m1; }
__device__ __forceinline__ float dpp_ror4(float x) { return __builtin_bit_cast(float, __builtin_amdgcn_update_dpp(0, __builtin_bit_cast(int, x), 0x124, 0xF, 0xF, true)); }
__device__ __forceinline__ float dpp_ror8(float x) { return __builtin_bit_cast(float, __builtin_amdgcn_update_dpp(0, __builtin_bit_cast(int, x), 0x128, 0xF, 0xF, true)); }
__device__ __forceinline__ float dpp_q1(float x) { return __builtin_bit_cast(float, __builtin_amdgcn_update_dpp(0, __builtin_bit_cast(int, x), 0xB1, 0xF, 0xF, true)); }
__device__ __forceinline__ float dpp_q2(float x) { return __builtin_bit_cast(float, __builtin_amdgcn_update_dpp(0, __builtin_bit_cast(int, x), 0x4E, 0xF, 0xF, true)); }
__device__ __forceinline__ float row_sum16(float x) { x += dpp_q1(x); x += dpp_q2(x); x += dpp_ror4(x); x += dpp_ror8(x); return x; }
__device__ __forceinline__ void rwkv_prep_item(const Ctx& C, const AP& a, int l, int ti) {
    unsigned char* ws = a.ws;
    LAS bf16_t* zsb = (LAS bf16_t*)C.lds;
    LAS bf16_t* hidb = (LAS bf16_t*)(C.lds + 33280);
    const float* proj = (const float*)(ws + WS_PROJ);
    const int m0 = ti * 32, s0 = m0 & (SEQ - 1), tid = C.tid, lane = C.lane, w = C.wave;
    const float* mu = a.in[15] + (size_t)l * 4 * 2 * 512;
    float* RW = (float*)(ws + WS_RW); float* KS = (float*)(ws + WS_KS);
    {
        const int c = tid;
        const float mr0 = mu[0 * 512 + c], mr1 = mu[1 * 512 + c], mk0 = mu[2 * 512 + c], mk1 = mu[3 * 512 + c], mv0 = mu[4 * 512 + c], mv1 = mu[5 * 512 + c], mz0 = mu[6 * 512 + c], mz1 = mu[7 * 512 + c];
        const float kk_c = a.in[24][l * 512 + c];
#pragma unroll 1
        for (int hf = 0; hf < 2; ++hf) {
            const int tb0 = hf * 16;
            const float* rp = proj + (size_t)(m0 + tb0) * PROJ + 2048 + c;
            float rr[18], kr[18], vr[18], zr[18];
#pragma unroll
            for (int i = 0; i < 18; ++i) {
                const int sq = s0 + tb0 - 1 + i; const bool ok = (sq >= 0) && (sq < SEQ); const float* q = rp + (long)(i - 1) * PROJ;
                rr[i] = ok ? q[0] : 0.f; kr[i] = ok ? q[512] : 0.f; vr[i] = ok ? q[1024] : 0.f; zr[i] = ok ? q[1536] : 0.f;
            }
#pragma unroll
            for (int t = 0; t < 16; ++t) {
                const float rs = shift3(rr[t], rr[t + 1], rr[t + 2], mr0, mr1), ks = shift3(kr[t], kr[t + 1], kr[t + 2], mk0, mk1);
                const float vs = shift3(vr[t], vr[t + 1], vr[t + 2], mv0, mv1), zs = shift3(zr[t], zr[t + 1], zr[t + 2], mz0, mz1);
                const float kkr = ks * kk_c; const float kkn = kkr * rsqrtf(wave_sum(kkr * kkr) + 1e-12f);
                const size_t o = (size_t)(m0 + tb0 + t) * 512 + c;
                RW[(size_t)RW_R * RWSZ + o] = rs; RW[(size_t)RW_V * RWSZ + o] = vs; RW[(size_t)RW_KK * RWSZ + o] = kkn; KS[o] = ks;
                zsb[(tb0 + t) * 520 + c] = (bf16_t)f2bf(zs);
            }
        }
    }
    __syncthreads();
    const int fr = lane & 15, fq = lane >> 4;
    const bf16_t* W1T = (const bf16_t*)(ws + WS_LORA) + (size_t)l * 224 * 512; const bf16_t* g2T = (const bf16_t*)(ws + WS_LORA) + 2 * 224 * 512 + (size_t)l * 512 * 96;
    const bf16_t* w2T = (const bf16_t*)(ws + WS_LORA) + 2 * 224 * 512 + 2 * 512 * 96 + (size_t)l * 2 * 512 * 32; const bf16_t* a2T = w2T + 2 * 2 * 512 * 32;
    for (int tile = w; tile < 28; tile += 8) {
        const int mt = tile / 14, nt = tile % 14;
        f32x4 acc = {0.f, 0.f, 0.f, 0.f};
        const LAS bf16_t* ap = zsb + (mt * 16 + fr) * 520 + fq * 8; const bf16_t* bp = W1T + (size_t)(nt * 16 + fr) * 512 + fq * 8;
#pragma unroll
        for (int kk = 0; kk < 16; ++kk) acc = __builtin_amdgcn_mfma_f32_16x16x32_bf16(*(const LAS bf16x8_t*)(ap + kk * 32), *(const bf16x8_t*)(bp + kk * 32), acc, 0, 0, 0);
        const int hj = nt * 16 + fr;
#pragma unroll
        for (int j = 0; j < 4; ++j) { float v = acc[j]; if (hj < 96) v = sigmoidf_(v); else if (hj < 160) v = tanhf(v); hidb[(mt * 16 + fq * 4 + j) * 240 + hj] = (bf16_t)f2bf(v); }
    }
    __syncthreads();
#pragma unroll 1
    for (int mt = 0; mt < 2; ++mt) {
        bf16x8_t a7[7];
#pragma unroll
        for (int kk = 0; kk < 7; ++kk) a7[kk] = *(const LAS bf16x8_t*)(hidb + (mt * 16 + fr) * 240 + kk * 32 + fq * 8);
        float pb0[4] = {0.f, 0.f, 0.f, 0.f}, pb1[4] = {0.f, 0.f, 0.f, 0.f}, vsr[4][4];
        float cks[4], ckk[4], crs[4], nks[4], nkk[4], nrs[4];
#pragma unroll
        for (int j = 0; j < 4; ++j) { const size_t o = (size_t)(m0 + mt * 16 + fq * 4 + j) * 512 + w * 64 + fr;
            cks[j] = KS[o]; ckk[j] = RW[(size_t)RW_KK * RWSZ + o]; crs[j] = RW[(size_t)RW_R * RWSZ + o]; vsr[0][j] = RW[(size_t)RW_V * RWSZ + o]; }
#pragma unroll
        for (int nt = 0; nt < 4; ++nt) {
            if (nt < 3) {
#pragma unroll
                for (int j = 0; j < 4; ++j) { const size_t o = (size_t)(m0 + mt * 16 + fq * 4 + j) * 512 + w * 64 + (nt + 1) * 16 + fr;
                    nks[j] = KS[o]; nkk[j] = RW[(size_t)RW_KK * RWSZ + o]; nrs[j] = RW[(size_t)RW_R * RWSZ + o]; vsr[nt + 1][j] = RW[(size_t)RW_V * RWSZ + o]; }
            }
            const int ch = w * 64 + nt * 16 + fr;
            f32x4 ag = {0.f, 0.f, 0.f, 0.f}, aw0 = ag, aw1 = ag, aa0 = ag, aa1 = ag;
#pragma unroll
            for (int kk = 0; kk < 3; ++kk) ag = __builtin_amdgcn_mfma_f32_16x16x32_bf16(a7[kk], *(const bf16x8_t*)(g2T + (size_t)ch * 96 + kk * 32 + fq * 8), ag, 0, 0, 0);
            aw0 = __builtin_amdgcn_mfma_f32_16x16x32_bf16(a7[3], *(const bf16x8_t*)(w2T + (size_t)(0 * 512 + ch) * 32 + fq * 8), aw0, 0, 0, 0);
            aw1 = __builtin_amdgcn_mfma_f32_16x16x32_bf16(a7[4], *(const bf16x8_t*)(w2T + (size_t)(1 * 512 + ch) * 32 + fq * 8), aw1, 0, 0, 0);
            aa0 = __builtin_amdgcn_mfma_f32_16x16x32_bf16(a7[5], *(const bf16x8_t*)(a2T + (size_t)(0 * 512 + ch) * 32 + fq * 8), aa0, 0, 0, 0);
            aa1 = __builtin_amdgcn_mfma_f32_16x16x32_bf16(a7[6], *(const bf16x8_t*)(a2T + (size_t)(1 * 512 + ch) * 32 + fq * 8), aa1, 0, 0, 0);
            const float w00 = a.in[16][(l * 2 + 0) * 512 + ch], w01 = a.in[16][(l * 2 + 1) * 512 + ch], a00 = a.in[19][(l * 2 + 0) * 512 + ch], a01 = a.in[19][(l * 2 + 1) * 512 + ch];
            const float ka_c = a.in[25][l * 512 + ch], rk_c = a.in[26][l * 512 + ch];
#pragma unroll
            for (int j = 0; j < 4; ++j) {
                const size_t o = (size_t)(m0 + mt * 16 + fq * 4 + j) * 512 + ch;
                const float ks = cks[j], kkn = ckk[j], rs = crs[j];
#pragma unroll
                for (int d = 0; d < 2; ++d) {
                    const float wl = (d ? w01 : w00) + (d ? aw1[j] : aw0[j]);
                    const float nx = -wl, sp = fmaxf(nx, 0.f) + log1pf(__expf(-fabsf(nx)));
                    const float decay = __expf(-__expf(-sp - 0.5f));
                    const float av = sigmoidf_((d ? a01 : a00) + (d ? aa1[j] : aa0[j]));
                    const float kd = ks * (1.f + (av - 1.f) * ka_c), bb = kkn * av;
                    if (d) pb1[j] += rs * kd * rk_c; else pb0[j] += rs * kd * rk_c;
                    RW[(size_t)(RW_W0 + d) * RWSZ + o] = decay; RW[(size_t)(RW_KD0 + d) * RWSZ + o] = kd; RW[(size_t)(RW_B0 + d) * RWSZ + o] = bb;
                }
                RW[(size_t)RW_G * RWSZ + o] = ag[j];
            }
#pragma unroll
            for (int j = 0; j < 4; ++j) { cks[j] = nks[j]; ckk[j] = nkk[j]; crs[j] = nrs[j]; }
        }
#pragma unroll
        for (int j = 0; j < 4; ++j) { const float tb = row_sum16(pb0[j]) + row_sum16(pb1[j]);
#pragma unroll
            for (int nt = 0; nt < 4; ++nt) RW[(size_t)RW_BONUS * RWSZ + (size_t)(m0 + mt * 16 + fq * 4 + j) * 512 + w * 64 + nt * 16 + fr] = tb * vsr[nt][j]; }
    }
    __syncthreads();
}

__device__ __forceinline__ void rwkv_chunk_pre(const AP& a, int cid, int lane, LAS unsigned char* wl) {
    unsigned char* ws = a.ws;
    const int c = cid & 127, ci = cid >> 7, d = ci & 1, h = (ci >> 1) & 7, b = ci >> 4, fr = lane & 15, fq = lane >> 4;
    const float* RW = (const float*)(ws + WS_RW);
    unsigned char* rec = ws + WS_RWC + (size_t)cid * RWC_REC;
    LAS bf16_t* KH = (LAS bf16_t*)wl; LAS bf16_t* BC = KH + 1152; LAS bf16_t* KC = BC + 1152; LAS bf16_t* RH = KC + 1152;
    LAS bf16_t* KHT = RH + 1152;
    LAS float* Am = (LAS float*)(wl + 11264); LAS float* Bmm = Am + 256; LAS float* Abm = Bmm + 256; LAS float* Akm = Abm + 256; LAS float* Tm = Akm + 256;
    const size_t tok0 = (size_t)b * SEQ; const int colk = h * 64 + lane;
#define TOKI(i) (tok0 + (size_t)(d ? (SEQ - 1 - (c * 16 + (i))) : (c * 16 + (i))))
    {
        float W[16];
#pragma unroll
        for (int i = 0; i < 16; ++i) W[i] = RW[(size_t)(RW_W0 + d) * RWSZ + TOKI(i) * 512 + colk];
#pragma unroll
        for (int i = 1; i < 16; ++i) W[i] *= W[i - 1];
        const float W15 = W[15];
        unsigned zt[16];
#pragma unroll
        for (int i = 0; i < 16; ++i) {
            const size_t o = TOKI(i) * 512 + colk;
            const float kap = RW[(size_t)RW_KK * RWSZ + o], bv = RW[(size_t)(RW_B0 + d) * RWSZ + o], kdv = RW[(size_t)(RW_KD0 + d) * RWSZ + o], rv = RW[(size_t)RW_R * RWSZ + o];
            const float wm1 = i ? W[i - 1] : 1.f, iw = 1.f / W[i], wr = W15 * iw;
            const unsigned kh = f2bf(kap * wm1);
            KH[i * 72 + lane] = (bf16_t)kh; KHT[lane * 16 + i] = (bf16_t)kh;
            BC[i * 72 + lane] = (bf16_t)f2bf(bv * iw); KC[i * 72 + lane] = (bf16_t)f2bf(kdv * iw); RH[i * 72 + lane] = (bf16_t)f2bf(rv * W[i]);
            const unsigned bb = f2bf(bv * wr), kb = f2bf(kdv * wr);
            const int sb = (i >> 2) * 8 + (i & 3), sk = sb + 4;
            if (sb & 1) zt[sb >> 1] |= bb << 16; else zt[sb >> 1] = bb;
            if (sk & 1) zt[sk >> 1] |= kb << 16; else zt[sk >> 1] = kb;
        }
        u32x4* zp = (u32x4*)(rec + 4096 + lane * 64);
#pragma unroll
        for (int q = 0; q < 4; ++q) zp[q] = (u32x4){zt[q * 4], zt[q * 4 + 1], zt[q * 4 + 2], zt[q * 4 + 3]};
        ((float*)(rec + 8192))[lane] = W15;
    }
    float Vq[4][4];
#pragma unroll
    for (int nt = 0; nt < 4; ++nt) {
#pragma unroll
        for (int r = 0; r < 4; ++r) Vq[nt][r] = RW[(size_t)RW_V * RWSZ + TOKI(fq * 4 + r) * 512 + h * 64 + nt * 16 + fr];
        u32x2 pv; pv.x = pk2(Vq[nt][0], Vq[nt][1]); pv.y = pk2(Vq[nt][2], Vq[nt][3]);
        *(u32x2*)(rec + 12800 + (nt * 64 + lane) * 8) = pv;
    }
    LDS_WAIT(); asm volatile("" ::: "memory");
    {
        f32x4 cA = {0.f, 0.f, 0.f, 0.f}, cB = cA, cAb = cA, cAk = cA;
#pragma unroll
        for (int s2 = 0; s2 < 2; ++s2) {
            const int off = fr * 72 + s2 * 32 + fq * 8;
            const bf16x8_t fkh = *(const LAS bf16x8_t*)(KH + off), fbc = *(const LAS bf16x8_t*)(BC + off), fkc = *(const LAS bf16x8_t*)(KC + off), frh = *(const LAS bf16x8_t*)(RH + off);
            cA = __builtin_amdgcn_mfma_f32_16x16x32_bf16(fkh, fbc, cA, 0, 0, 0); cB = __builtin_amdgcn_mfma_f32_16x16x32_bf16(fkh, fkc, cB, 0, 0, 0);
            cAb = __builtin_amdgcn_mfma_f32_16x16x32_bf16(frh, fbc, cAb, 0, 0, 0); cAk = __builtin_amdgcn_mfma_f32_16x16x32_bf16(frh, fkc, cAk, 0, 0, 0);
        }
#pragma unroll
        for (int r = 0; r < 4; ++r) { const int i = fq * 4 + r, j = fr;
            Am[i * 16 + j] = j < i ? cA[r] : 0.f; Bmm[i * 16 + j] = j < i ? cB[r] : 0.f; Abm[i * 16 + j] = j <= i ? cAb[r] : 0.f; Akm[i * 16 + j] = j <= i ? cAk[r] : 0.f; }
    }
    LDS_WAIT(); asm volatile("" ::: "memory");
    {
        float x[16];
#pragma unroll
        for (int i = 0; i < 16; ++i) {
            float sacc = (i == fr) ? 1.f : 0.f;
#pragma unroll
            for (int jq = 0; jq < (i + 3) / 4; ++jq) { const f32x4 q = *(const LAS f32x4*)(Am + i * 16 + jq * 4);
#pragma unroll
                for (int e = 0; e < 4; ++e) if (jq * 4 + e < i) sacc -= q[e] * x[jq * 4 + e]; }
            x[i] = sacc;
        }
        if (fq == 0) {
#pragma unroll
            for (int i = 0; i < 16; ++i) Tm[i * 16 + fr] = x[i];
        }
    }
    LDS_WAIT(); asm volatile("" ::: "memory");
    {
        const f32x4 qT = *(const LAS f32x4*)(Tm + fr * 16 + fq * 4), qB = *(const LAS f32x4*)(Bmm + fr * 16 + fq * 4), qAb = *(const LAS f32x4*)(Abm + fr * 16 + fq * 4), qAk = *(const LAS f32x4*)(Akm + fr * 16 + fq * 4);
        const unsigned ab0 = pk2(qAb[0], qAb[1]), ab1 = pk2(qAb[2], qAb[3]);
        const bf16x8_t aT = mk8(pk2(qT[0], qT[1]), pk2(qT[2], qT[3]), 0u, 0u), aBm = mk8(pk2(qB[0], qB[1]), pk2(qB[2], qB[3]), 0u, 0u);
        const bf16x8_t aAb = mk8(ab0, ab1, 0u, 0u), aAbAk = mk8(ab0, ab1, pk2(qAk[0], qAk[1]), pk2(qAk[2], qAk[3]));
        const f32x4 z4 = {0.f, 0.f, 0.f, 0.f};
#pragma unroll
        for (int nt = 0; nt < 4; ++nt) {
            const u32x2 kq = *(const LAS u32x2*)(KHT + (nt * 16 + fr) * 16 + fq * 4);
            f32x4 ut = __builtin_amdgcn_mfma_f32_16x16x32_bf16(aT, mk8(kq.x, kq.y, 0u, 0u), z4, 0, 0, 0); ut = -ut;
            const unsigned v0 = pk2(Vq[nt][0], Vq[nt][1]), v1 = pk2(Vq[nt][2], Vq[nt][3]);
            const f32x4 bmv = __builtin_amdgcn_mfma_f32_16x16x32_bf16(aBm, mk8(v0, v1, 0u, 0u), z4, 0, 0, 0);
            f32x4 ul = __builtin_amdgcn_mfma_f32_16x16x32_bf16(aT, mk8(pk2(bmv[0], bmv[1]), pk2(bmv[2], bmv[3]), 0u, 0u), z4, 0, 0, 0); ul = -ul;
            const unsigned u0 = pk2(ut[0], ut[1]), u1 = pk2(ut[2], ut[3]);
            f32x4 yh = __builtin_amdgcn_mfma_f32_16x16x32_bf16(aAb, mk8(u0, u1, 0u, 0u), z4, 0, 0, 0);
#pragma unroll
            for (int r = 0; r < 4; ++r) yh[r] += bflo((unsigned)RH[(fq * 4 + r) * 72 + nt * 16 + fr]);
            const unsigned l0 = pk2(ul[0], ul[1]), l1 = pk2(ul[2], ul[3]);
            const f32x4 yl = __builtin_amdgcn_mfma_f32_16x16x32_bf16(aAbAk, mk8(l0, l1, v0, v1), z4, 0, 0, 0);
            const int s2 = nt >> 1, slot = (fr >> 2) * 8 + (fr & 3) + ((nt & 1) ? 4 : 0);
            bf16_t* m0p = (bf16_t*)rec + ((0 * 2 + s2) * 16) * 32 + slot; bf16_t* m1p = (bf16_t*)rec + ((1 * 2 + s2) * 16) * 32 + slot;
#pragma unroll
            for (int r = 0; r < 4; ++r) { m0p[(fq * 4 + r) * 32] = (bf16_t)((r & 1) ? (((r >> 1) ? u1 : u0) >> 16) : (((r >> 1) ? u1 : u0) & 0xffffu)); m1p[(fq * 4 + r) * 32] = (bf16_t)f2bf(yh[r]); }
            u32x2 pl; pl.x = l0; pl.y = l1; *(u32x2*)(rec + 8704 + (nt * 64 + lane) * 8) = pl;
            u32x2 py; py.x = pk2(yl[0], yl[1]); py.y = pk2(yl[2], yl[3]); *(u32x2*)(rec + 10752 + (nt * 64 + lane) * 8) = py;
        }
    }
    LDS_WAIT(); asm volatile("" ::: "memory");
#undef TOKI
}
__device__ __forceinline__ void vm_wait_chunks(int n) {
    switch (n) { case 0: asm volatile("s_waitcnt vmcnt(0)" ::: "memory"); break; case 1: asm volatile("s_waitcnt vmcnt(4)" ::: "memory"); break;
                 case 2: asm volatile("s_waitcnt vmcnt(8)" ::: "memory"); break; case 3: asm volatile("s_waitcnt vmcnt(12)" ::: "memory"); break;
                 case 4: asm volatile("s_waitcnt vmcnt(16)" ::: "memory"); break; case 5: asm volatile("s_waitcnt vmcnt(20)" ::: "memory"); break;
                 default: asm volatile("s_waitcnt vmcnt(24)" ::: "memory"); break; }
}
__device__ __forceinline__ void rwkv_seq_chain(const Ctx& C, const AP& a, int ci) {
    unsigned char* ws = a.ws;
    const int w = C.wave, lane = C.lane, fr = lane & 15, fq = lane >> 4, d = ci & 1, h = (ci >> 1) & 7, b = ci >> 4;
    const unsigned char* recs = ws + WS_RWC + (size_t)ci * 128 * RWC_REC;
    LAS unsigned char* ring = C.lds;
    const bool loader = w >= 4; const int lw = w - 4;
#define RWC_ISSUE(cc) do { _Pragma("unroll") for (int p_ = 0; p_ < 4; ++p_) { const int pc_ = (lw * 4 + p_) < 15 ? (lw * 4 + p_) : 14; \
        __builtin_amdgcn_global_load_lds((const unsigned*)(recs + (size_t)(cc) * RWC_REC + pc_ * 1024 + lane * 16), (LAS unsigned*)(ring + ((cc) & 7) * RWC_REC + pc_ * 1024), 16, 0, 0); } } while (0)
    if (loader) {
#pragma unroll 1
        for (int cc = 0; cc < 8; ++cc) RWC_ISSUE(cc);
        asm volatile("s_waitcnt vmcnt(28)" ::: "memory");
    }
    __builtin_amdgcn_s_barrier(); asm volatile("" ::: "memory");
    f32x4 ST[4];
#pragma unroll
    for (int kt = 0; kt < 4; ++kt) ST[kt] = (f32x4){0.f, 0.f, 0.f, 0.f};
    float* Y = (float*)(ws + WS_YRW) + (size_t)d * RWSZ + (size_t)b * SEQ * 512 + h * 64 + w * 16 + fr;
#pragma unroll 1
    for (int c = 0; c < 128; ++c) {
        if (!loader) {
            const LAS unsigned char* sl = ring + (c & 7) * RWC_REC;
            const bf16x8_t a00 = *(const LAS bf16x8_t*)(sl + (0 * 16 + fr) * 64 + fq * 16), a01 = *(const LAS bf16x8_t*)(sl + (1 * 16 + fr) * 64 + fq * 16);
            const bf16x8_t a10 = *(const LAS bf16x8_t*)(sl + (2 * 16 + fr) * 64 + fq * 16), a11 = *(const LAS bf16x8_t*)(sl + (3 * 16 + fr) * 64 + fq * 16);
            const u32x2 ulw = *(const LAS u32x2*)(sl + 8704 + (w * 64 + lane) * 8), ylw = *(const LAS u32x2*)(sl + 10752 + (w * 64 + lane) * 8), vpw = *(const LAS u32x2*)(sl + 12800 + (w * 64 + lane) * 8);
            const bf16x8_t bs0 = mk8(pk2(ST[0][0], ST[0][1]), pk2(ST[0][2], ST[0][3]), pk2(ST[1][0], ST[1][1]), pk2(ST[1][2], ST[1][3]));
            const bf16x8_t bs1 = mk8(pk2(ST[2][0], ST[2][1]), pk2(ST[2][2], ST[2][3]), pk2(ST[3][0], ST[3][1]), pk2(ST[3][2], ST[3][3]));
            const f32x4 z4 = {0.f, 0.f, 0.f, 0.f};
            f32x4 g0 = __builtin_amdgcn_mfma_f32_16x16x32_bf16(a00, bs0, z4, 0, 0, 0); g0 = __builtin_amdgcn_mfma_f32_16x16x32_bf16(a01, bs1, g0, 0, 0, 0);
            f32x4 g1 = __builtin_amdgcn_mfma_f32_16x16x32_bf16(a10, bs0, z4, 0, 0, 0); g1 = __builtin_amdgcn_mfma_f32_16x16x32_bf16(a11, bs1, g1, 0, 0, 0);
            const float uf0 = g0[0] + bflo(ulw.x), uf1 = g0[1] + bfhi(ulw.x), uf2 = g0[2] + bflo(ulw.y), uf3 = g0[3] + bfhi(ulw.y);
            const bf16x8_t xb = mk8(pk2(uf0, uf1), pk2(uf2, uf3), vpw.x, vpw.y);
#pragma unroll
            for (int kt = 0; kt < 4; ++kt) {
                const f32x4 dq = *(const LAS f32x4*)(sl + 8192 + (kt * 16 + fq * 4) * 4);
                const bf16x8_t az = *(const LAS bf16x8_t*)(sl + 4096 + (kt * 16 + fr) * 64 + fq * 16);
                ST[kt] = __builtin_amdgcn_mfma_f32_16x16x32_bf16(az, xb, ST[kt] * dq, 0, 0, 0);
            }
            const float y0 = g1[0] + bflo(ylw.x), y1 = g1[1] + bfhi(ylw.x), y2 = g1[2] + bflo(ylw.y), y3 = g1[3] + bfhi(ylw.y);
            const int sbase = c * 16 + fq * 4;
            Y[(size_t)(d ? SEQ - 1 - (sbase + 0) : sbase + 0) * 512] = y0; Y[(size_t)(d ? SEQ - 1 - (sbase + 1) : sbase + 1) * 512] = y1;
            Y[(size_t)(d ? SEQ - 1 - (sbase + 2) : sbase + 2) * 512] = y2; Y[(size_t)(d ? SEQ - 1 - (sbase + 3) : sbase + 3) * 512] = y3;
            asm volatile("s_waitcnt lgkmcnt(0)" ::: "memory");
        } else if (c + 1 < 128) {
            const int lastc = (c + 7 < 127) ? c + 7 : 127;
            vm_wait_chunks(lastc - (c + 1));
        }
        __builtin_amdgcn_s_barrier(); asm volatile("" ::: "memory");
        if (loader && c + 8 < 128) RWC_ISSUE(c + 8);
    }
    asm volatile("s_waitcnt vmcnt(0)" ::: "memory");
    __builtin_amdgcn_s_barrier(); asm volatile("" ::: "memory");
#undef RWC_ISSUE
}

__device__ __forceinline__ float dpp_sum8(float x) {
    x += __builtin_bit_cast(float, __builtin_amdgcn_update_dpp(0, __builtin_bit_cast(int, x), 0xB1, 0xF, 0xF, true));
    x += __builtin_bit_cast(float, __builtin_amdgcn_update_dpp(0, __builtin_bit_cast(int, x), 0x4E, 0xF, 0xF, true));
    x += __builtin_bit_cast(float, __builtin_amdgcn_update_dpp(0, __builtin_bit_cast(int, x), 0x141, 0xF, 0xF, true));
    return x;
}
__device__ __forceinline__ void rwkv_scan_item(const Ctx& C, const AP& a, int item) {
    unsigned char* ws = a.ws;
    const int d = item & 1, h = (item >> 1) & 7, b = item >> 4, tid = C.tid, v = tid >> 3, kq = tid & 7;
    const float* RW = (const float*)(ws + WS_RW);
    const float* arr[6] = { RW + (size_t)RW_KK * RWSZ, RW + (size_t)(RW_W0 + d) * RWSZ, RW + (size_t)(RW_B0 + d) * RWSZ, RW + (size_t)(RW_KD0 + d) * RWSZ, RW + (size_t)RW_R * RWSZ, RW + (size_t)RW_V * RWSZ };
    float* Y = (float*)(ws + WS_YRW) + (size_t)d * RWSZ;
    LAS float* buf = (LAS float*)C.lds;
    const int ls = tid >> 4, lq = tid & 15;
    f32x4 stg[6];
    const size_t colbase = (size_t)h * 64;
#define RW_LOAD(ch) do { const int s_ = (ch) * 32 + ls, t_ = d ? (SEQ - 1 - s_) : s_; const size_t o_ = ((size_t)(b * SEQ + t_)) * 512 + colbase + lq * 4; \
        _Pragma("unroll") for (int q_ = 0; q_ < 6; ++q_) stg[q_] = *(const f32x4*)(arr[q_] + o_); } while (0)
#define RW_WRITE(bi) do { _Pragma("unroll") for (int q_ = 0; q_ < 6; ++q_) *(LAS f32x4*)(buf + (((bi) * 6 + q_) * 32 + ls) * 64 + lq * 4) = stg[q_]; } while (0)
    float S[8];
#pragma unroll
    for (int j = 0; j < 8; ++j) S[j] = 0.f;
    RW_LOAD(0); RW_WRITE(0); __syncthreads();
    for (int ch = 0; ch < SEQ / 32; ++ch) {
        const int bi = ch & 1;
        if (ch + 1 < SEQ / 32) RW_LOAD(ch + 1);
        const LAS float* B0 = buf + (bi * 6) * 32 * 64;
        for (int st = 0; st < 32; ++st) {
            const LAS float* bp = B0 + st * 64 + kq * 8;
            const f32x4 k0 = *(const LAS f32x4*)(bp), k1 = *(const LAS f32x4*)(bp + 4);
            const f32x4 w0 = *(const LAS f32x4*)(bp + 2048), w1 = *(const LAS f32x4*)(bp + 2048 + 4);
            const f32x4 b0 = *(const LAS f32x4*)(bp + 4096), b1 = *(const LAS f32x4*)(bp + 4096 + 4);
            const f32x4 d0 = *(const LAS f32x4*)(bp + 6144), d1 = *(const LAS f32x4*)(bp + 6144 + 4);
            const f32x4 r0 = *(const LAS f32x4*)(bp + 8192), r1 = *(const LAS f32x4*)(bp + 8192 + 4);
            const float vv = B0[10240 + st * 64 + v];
            float sa = S[0] * k0[0] + S[1] * k0[1] + S[2] * k0[2] + S[3] * k0[3] + S[4] * k1[0] + S[5] * k1[1] + S[6] * k1[2] + S[7] * k1[3];
            sa = -dpp_sum8(sa);
            float y = 0.f;
#pragma unroll
            for (int j = 0; j < 4; ++j) { S[j] = S[j] * w0[j] + (sa * b0[j] + vv * d0[j]); y += S[j] * r0[j]; S[4 + j] = S[4 + j] * w1[j] + (sa * b1[j] + vv * d1[j]); y += S[4 + j] * r1[j]; }
            y = dpp_sum8(y);
            if (kq == 0) { const int s_ = ch * 32 + st, t_ = d ? (SEQ - 1 - s_) : s_; Y[((size_t)(b * SEQ + t_)) * 512 + colbase + v] = y; }
        }
        if (ch + 1 < SEQ / 32) RW_WRITE(bi ^ 1);
        __syncthreads();
    }
#undef RW_LOAD
#undef RW_WRITE
}
__device__ __forceinline__ void rwkv_post_item(const AP& a, int l, int item, int lane) {
    unsigned char* ws = a.ws;
    const int hh = item & 7, m = item >> 3, c = hh * 64 + lane; const size_t o = (size_t)m * 512 + c;
    const float* Y = (const float*)(ws + WS_YRW); const float* RW = (const float*)(ws + WS_RW);
    const float y = Y[o] + Y[RWSZ + o];
    const float mean = wave_sum(y) * (1.f / 64.f), dv = y - mean, var = wave_sum(dv * dv) * (1.f / 64.f);
    const float yn = dv * rsqrtf(var + 64e-5f) * a.in[27][l * 512 + c] + a.in[28][l * 512 + c];
    ((float*)(ws + WS_YA))[(size_t)3 * RWSZ + o] = (yn + RW[(size_t)RW_BONUS * RWSZ + o]) * RW[(size_t)RW_G * RWSZ + o];
}
__device__ __forceinline__ void c1_fold_item(const AP& a, int row, int lane) {
    const unsigned short* src = (const unsigned short*)(a.ws + WS_C1) + (size_t)row * 4096;
    unsigned short* dst = (unsigned short*)(a.ws + WS_C1F) + (size_t)row * 2048;
#pragma unroll 8
    for (int i = 0; i < 32; ++i) {
        const int j = i * 64 + lane; float v;
        if (j <= 1024) { const float x0 = __uint_as_float((unsigned)src[j] << 16); const int jm = (j >= 1 && j <= 1023) ? 2048 - j : j;
            const float x1 = __uint_as_float((unsigned)src[jm] << 16); v = (j >= 1 && j <= 1023) ? x0 + x1 : x0; }
        else { const int sidx = j - 1024; v = __uint_as_float((unsigned)src[2048 + sidx] << 16) - __uint_as_float((unsigned)src[2048 + 2048 - sidx] << 16); }
        dst[j] = (unsigned short)f2bf(v);
    }
}
__device__ __forceinline__ void branch_d_item(const AP& a, int l, int m, int lane) {
    unsigned char* ws = a.ws;
    const float* Y = (const float*)(ws + WS_YRW); const float* RW = (const float*)(ws + WS_RW);
    float o[8]; float ss = 0.f;
#pragma unroll
    for (int hh = 0; hh < 8; ++hh) {
        const int c = hh * 64 + lane; const size_t ix = (size_t)m * 512 + c;
        const float y = Y[ix] + Y[RWSZ + ix];
        const float mean = wave_sum(y) * (1.f / 64.f), dv = y - mean, var = wave_sum(dv * dv) * (1.f / 64.f);
        const float yn = dv * rsqrtf(var + 64e-5f) * a.in[27][l * 512 + c] + a.in[28][l * 512 + c];
        o[hh] = (yn + RW[(size_t)RW_BONUS * RWSZ + ix]) * RW[(size_t)RW_G * RWSZ + ix]; ss += o[hh] * o[hh];
    }
    const float rs = rsqrtf(wave_sum(ss) * (1.f / 512.f) + 1e-6f);
    bf16_t* dst = (bf16_t*)(ws + WS_HB) + (size_t)m * DM + 1536 + lane;
#pragma unroll
    for (int hh = 0; hh < 8; ++hh) dst[hh * 64] = (bf16_t)f2bf(o[hh] * rs);
}
__device__ __forceinline__ void branch_norm_item(const AP& a, int item, int lane) {
    unsigned char* ws = a.ws;
    const int br = item & 3, m = item >> 2;
    const f32x4* src = (const f32x4*)((const float*)(ws + WS_YA) + (size_t)br * RWSZ + (size_t)m * 512) + lane;
    const f32x4 v0 = src[0], v1 = src[64];
    const float ss = wave_sum(v0.x * v0.x + v0.y * v0.y + v0.z * v0.z + v0.w * v0.w + v1.x * v1.x + v1.y * v1.y + v1.z * v1.z + v1.w * v1.w);
    const float rs = rsqrtf(ss * (1.f / 512.f) + 1e-6f);
    u32x2* dst = (u32x2*)((bf16_t*)(ws + WS_HB) + (size_t)m * DM + br * 512) + lane;
    u32x2 w; w.x = pk2(v0.x * rs, v0.y * rs); w.y = pk2(v0.z * rs, v0.w * rs); dst[0] = w;
    w.x = pk2(v1.x * rs, v1.y * rs); w.y = pk2(v1.z * rs, v1.w * rs); dst[64] = w;
}

__device__ __forceinline__ unsigned fkey(float f) { const unsigned u = __float_as_uint(f); return (u & 0x80000000u) ? ~u : (u | 0x80000000u); }
__device__ __forceinline__ int lane_rank(unsigned long long m) { return __builtin_amdgcn_mbcnt_hi((unsigned)(m >> 32), __builtin_amdgcn_mbcnt_lo((unsigned)m, 0)); }
template <int N>
__device__ __forceinline__ void top16_select(const float (&val)[N], const int (&idx)[N], LAS float* lv, LAS int* li) {
    unsigned k[N];
#pragma unroll
    for (int e = 0; e < N; ++e) k[e] = fkey(val[e]);
    unsigned T = 0;
    for (int bit = 31; bit >= 0; --bit) {
        const unsigned cand = T | (1u << bit); int cnt = 0;
#pragma unroll
        for (int e = 0; e < N; ++e) cnt += __popcll(__ballot(k[e] >= cand));
        if (cnt >= 16) T = cand;
        if (cnt == 16) break;
    }
    int ngt = 0;
#pragma unroll
    for (int e = 0; e < N; ++e) ngt += __popcll(__ballot(k[e] > T));
    const int need = 16 - ngt; int eqbase = 0, posbase = 0;
#pragma unroll
    for (int e = 0; e < N; ++e) {
        const unsigned long long meq = __ballot(k[e] == T);
        const int eqrank = eqbase + lane_rank(meq);
        const bool sel = (k[e] > T) || (k[e] == T && eqrank < need);
        const unsigned long long msel = __ballot(sel);
        const int pos = posbase + lane_rank(msel);
        if (sel) { lv[pos] = val[e]; li[pos] = idx[e]; }
        eqbase += __popcll(meq); posbase += __popcll(msel);
    }
    LDS_WAIT(); asm volatile("" ::: "memory");
}
__device__ __forceinline__ float dpp_xor1(float x) { return __builtin_bit_cast(float, __builtin_amdgcn_update_dpp(0, __builtin_bit_cast(int, x), 0xB1, 0xF, 0xF, true)); }
__device__ __forceinline__ float dpp_xor2(float x) { return __builtin_bit_cast(float, __builtin_amdgcn_update_dpp(0, __builtin_bit_cast(int, x), 0x4E, 0xF, 0xF, true)); }
__device__ __forceinline__ float reduce8(const float (&v)[8], int lane) {
    const bool b0 = lane & 1, b1 = lane & 2, b2 = lane & 4;
    float w4[4], w2[2];
#pragma unroll
    for (int k = 0; k < 4; ++k) { const float keep = b0 ? v[4 + k] : v[k], send = b0 ? v[k] : v[4 + k]; w4[k] = keep + dpp_xor1(send); }
#pragma unroll
    for (int k = 0; k < 2; ++k) { const float keep = b1 ? w4[2 + k] : w4[k], send = b1 ? w4[k] : w4[2 + k]; w2[k] = keep + dpp_xor2(send); }
    const float keep = b2 ? w2[1] : w2[0], send = b2 ? w2[0] : w2[1];
    float r = keep + __shfl_xor(send, 4);
    r += __shfl_xor(r, 8); r += __shfl_xor(r, 16); r += __shfl_xor(r, 32);
    return r;
}
typedef float f32x2v __attribute__((ext_vector_type(2)));
__device__ __forceinline__ void split8(const f32x4 a0, const f32x4 a1, bf16x8_t& hi, bf16x8_t& lo) {
    unsigned h[4], l_[4];
#pragma unroll
    for (int i = 0; i < 4; ++i) { const float x0 = i < 2 ? a0[2 * i] : a1[2 * i - 4], x1 = i < 2 ? a0[2 * i + 1] : a1[2 * i - 3];
        const unsigned h0 = f2bf(x0), h1 = f2bf(x1); h[i] = h0 | (h1 << 16);
        l_[i] = pk2(x0 - __uint_as_float(h0 << 16), x1 - __uint_as_float(h1 << 16)); }
    hi = mk8(h[0], h[1], h[2], h[3]); lo = mk8(l_[0], l_[1], l_[2], l_[3]);
}
__device__ __forceinline__ void peer_select_head(const f32x2 s0, const f32x2 s1, int lane, LAS float* wl, LAS int* fe, LAS float* fg, int ci_i, int ci_j, bool cand_on) {
    { const float v0[2] = {s0.x, s0.y}; const int i0[2] = {2 * lane, 2 * lane + 1}; top16_select<2>(v0, i0, wl, (LAS int*)(wl + 16)); }
    { const float v1[2] = {s1.x, s1.y}; const int i1[2] = {2 * lane, 2 * lane + 1}; top16_select<2>(v1, i1, wl + 32, (LAS int*)(wl + 48)); }
    if (lane < 32) { const int lst = lane >> 4, ii = lane & 15; const LAS float* lv = wl + lst * 32;
      const float v = lv[ii]; const int ix = ((const LAS int*)lv)[16 + ii]; int rank = 0;
#pragma unroll
      for (int jq = 0; jq < 4; ++jq) { const f32x4 q = *(const LAS f32x4*)(lv + jq * 4);
#pragma unroll
          for (int e = 0; e < 4; ++e) rank += (q[e] > v || (q[e] == v && (jq * 4 + e) < ii)) ? 1 : 0; }
      wl[64 + lst * 32 + rank] = v; ((LAS int*)wl)[64 + lst * 32 + 16 + rank] = ix; }
    LDS_WAIT(); asm volatile("" ::: "memory");
    { const float cvv = cand_on ? wl[64 + ci_i] + wl[96 + ci_j] : -INFINITY;
      const float cv[1] = {cvv}; const int ci[1] = {ci_i * 16 + ci_j};
      top16_select<1>(cv, ci, wl + 128, (LAS int*)(wl + 144)); }
    { const bool act = lane < 16; const float sc = act ? wl[128 + lane] : -3.0e38f; const int fi = act ? ((LAS int*)wl)[144 + lane] : 0;
      const int e = ((LAS int*)wl)[80 + (fi >> 4)] * 128 + ((LAS int*)wl)[112 + (fi & 15)];
      const float mx = wave_max(sc), ex = act ? __expf(sc - mx) : 0.f, sm = wave_sum(ex);
      if (act) { fe[lane] = e; fg[lane] = ex / sm; } }
    LDS_WAIT(); asm volatile("" ::: "memory");
}
__device__ __forceinline__ void peer_tile(const Ctx& C, const AP& a, int l, int tile, const float* x1, float* xout, bool write_hb) {
    unsigned char* ws = a.ws;
    const int tid = C.tid, lane = C.lane, w = C.wave, tb = tile * 32;
    LAS float* keys = (LAS float*)C.lds;
    LAS int* rt_idx = (LAS int*)(C.lds + 65536);
    LAS float* rt_gate = (LAS float*)(C.lds + 81920);
    LAS float* wl = (LAS float*)(C.lds + 98304) + w * 256;
    LAS float* ssp = (LAS float*)(C.lds + 98304 + 8 * 1024);
    const float* qry = (const float*)(ws + WS_PROJ);
    int ci_i, ci_j; const bool cand_on = lane < 50;
    if (lane < 16) { ci_i = 0; ci_j = lane; } else if (lane < 24) { ci_i = 1; ci_j = lane - 16; } else if (lane < 29) { ci_i = 2; ci_j = lane - 24; }
    else if (lane < 33) { ci_i = 3; ci_j = lane - 29; } else if (lane < 36) { ci_i = 4; ci_j = lane - 33; } else if (lane < 38) { ci_i = 5; ci_j = lane - 36; }
    else if (lane < 40) { ci_i = 6; ci_j = lane - 38; } else if (lane < 42) { ci_i = 7; ci_j = lane - 40; } else if (lane < 50) { ci_i = lane - 34; ci_j = 0; } else { ci_i = 0; ci_j = 0; }
    float* Ssc = (float*)(ws + WS_RW) + (size_t)tile * 65536;
    { const int fr = lane & 15, fq = lane >> 4;
#pragma unroll 1
      for (int hp = 0; hp < 16; ++hp) {
        const int h = hp >> 1, pp = hp & 1;
        bf16x8_t ah[2][2], al[2][2], bh[2], bl[2];
#pragma unroll
        for (int ks = 0; ks < 2; ++ks) {
            const float* kp = a.in[33] + ((size_t)(((l * 8 + h) * 2 + pp) * 128 + 16 * w + fr)) * 64 + ks * 32 + fq * 8;
            split8(*(const f32x4*)kp, *(const f32x4*)(kp + 4), bh[ks], bl[ks]);
#pragma unroll
            for (int mt = 0; mt < 2; ++mt) { const float* qp = qry + (size_t)(tb + mt * 16 + fr) * 1024 + h * 128 + pp * 64 + ks * 32 + fq * 8;
                split8(*(const f32x4*)qp, *(const f32x4*)(qp + 4), ah[mt][ks], al[mt][ks]); }
        }
#pragma unroll
        for (int mt = 0; mt < 2; ++mt) { f32x4 acc = {0.f, 0.f, 0.f, 0.f};
#pragma unroll
            for (int ks = 0; ks < 2; ++ks) { acc = __builtin_amdgcn_mfma_f32_16x16x32_bf16(al[mt][ks], bh[ks], acc, 0, 0, 0); acc = __builtin_amdgcn_mfma_f32_16x16x32_bf16(ah[mt][ks], bl[ks], acc, 0, 0, 0);
                acc = __builtin_amdgcn_mfma_f32_16x16x32_bf16(ah[mt][ks], bh[ks], acc, 0, 0, 0); }
#pragma unroll
            for (int r = 0; r < 4; ++r) Ssc[(size_t)(hp * 32 + mt * 16 + fq * 4 + r) * 128 + 16 * w + fr] = acc[r]; }
      } }
    __syncthreads();
    const unsigned char* U6 = ws + WS_UB + (size_t)l * ETAB; const unsigned char* V4 = ws + WS_UB + 64 * MiB + (size_t)l * 16 * MiB;
    const float* Us = (const float*)(ws + WS_VB) + (0 * 2 + l) * 16384; const float* Vs = (const float*)(ws + WS_VB) + (1 * 2 + l) * 16384;
    bf16_t* hb = (bf16_t*)(ws + WS_HB);
    u32x4 ua[8]; u32x4 va[8]; float sul, svl, gl; float xf[32], acc[32];
#define PEER_IDS(mye_, ei_) _Pragma("unroll") for (int e = 0; e < 8; ++e) ei_[e] = __builtin_amdgcn_readlane(mye_, ((e >> 2) & 1) | (((e >> 1) & 1) << 1) | ((e & 1) << 2));
#define PEER_ISSUE_U(ei_, ln_) _Pragma("unroll") for (int e = 0; e < 8; ++e) ua[e] = ((const u32x4*)(U6 + (size_t)ei_[e] * 1024))[ln_];
#define PEER_ISSUE_V(ei_, ln_) _Pragma("unroll") for (int e = 0; e < 8; ++e) va[e] = ((const u32x4*)(V4 + (size_t)ei_[e] * 1024))[ln_];
#define PEER_DOTS(dot_) _Pragma("unroll") for (int e = 0; e < 8; ++e) { f32x2v s2 = {0.f, 0.f}; \
        _Pragma("unroll") for (int d4 = 0; d4 < 4; ++d4) { const unsigned wd = ua[e][d4]; \
            s2 = __builtin_elementwise_fma((f32x2v){xf[8 * d4 + 0], xf[8 * d4 + 1]}, __builtin_amdgcn_cvt_scalef32_pk_f32_fp4(wd, 1.0f, 0), s2); \
            s2 = __builtin_elementwise_fma((f32x2v){xf[8 * d4 + 2], xf[8 * d4 + 3]}, __builtin_amdgcn_cvt_scalef32_pk_f32_fp4(wd, 1.0f, 1), s2); \
            s2 = __builtin_elementwise_fma((f32x2v){xf[8 * d4 + 4], xf[8 * d4 + 5]}, __builtin_amdgcn_cvt_scalef32_pk_f32_fp4(wd, 1.0f, 2), s2); \
            s2 = __builtin_elementwise_fma((f32x2v){xf[8 * d4 + 6], xf[8 * d4 + 7]}, __builtin_amdgcn_cvt_scalef32_pk_f32_fp4(wd, 1.0f, 3), s2); } \
        dot_[e] = s2.x + s2.y; }
#define PEER_ACCUM(cfl_) _Pragma("unroll") for (int e = 0; e < 8; ++e) { \
        const int src = ((e >> 2) & 1) | (((e >> 1) & 1) << 1) | ((e & 1) << 2); \
        const float cf = __builtin_bit_cast(float, __builtin_amdgcn_readlane(__builtin_bit_cast(int, cfl_), src)); \
        _Pragma("unroll") for (int d4 = 0; d4 < 4; ++d4) { const unsigned wd = va[e][d4]; \
            const f32x2v p0 = __builtin_amdgcn_cvt_scalef32_pk_f32_fp4(wd, 1.0f, 0), p1 = __builtin_amdgcn_cvt_scalef32_pk_f32_fp4(wd, 1.0f, 1); \
            const f32x2v p2 = __builtin_amdgcn_cvt_scalef32_pk_f32_fp4(wd, 1.0f, 2), p3 = __builtin_amdgcn_cvt_scalef32_pk_f32_fp4(wd, 1.0f, 3); \
            acc[8 * d4 + 0] += cf * p0.x; acc[8 * d4 + 1] += cf * p0.y; acc[8 * d4 + 2] += cf * p1.x; acc[8 * d4 + 3] += cf * p1.y; \
            acc[8 * d4 + 4] += cf * p2.x; acc[8 * d4 + 5] += cf * p2.y; acc[8 * d4 + 6] += cf * p3.x; acc[8 * d4 + 7] += cf * p3.y; } \
        if (e < 7) {   \
            asm volatile("" : "+v"(va[e + 1][0]), "+v"(va[e + 1][1]) : "v"(acc[0]), "v"(acc[1]), "v"(acc[2]), "v"(acc[3]), "v"(acc[4]), "v"(acc[5]), "v"(acc[6]), "v"(acc[7]), \
                         "v"(acc[8]), "v"(acc[9]), "v"(acc[10]), "v"(acc[11]), "v"(acc[12]), "v"(acc[13]), "v"(acc[14]), "v"(acc[15])); \
            asm volatile("" : "+v"(va[e + 1][2]), "+v"(va[e + 1][3]) : "v"(acc[16]), "v"(acc[17]), "v"(acc[18]), "v"(acc[19]), "v"(acc[20]), "v"(acc[21]), "v"(acc[22]), "v"(acc[23]), \
                         "v"(acc[24]), "v"(acc[25]), "v"(acc[26]), "v"(acc[27]), "v"(acc[28]), "v"(acc[29]), "v"(acc[30]), "v"(acc[31])); } }
    {
        const int tokl = w * 4;
        peer_select_head(*(const f32x2*)(Ssc + (size_t)(0 * 32 + tokl) * 128 + 2 * lane), *(const f32x2*)(Ssc + (size_t)(1 * 32 + tokl) * 128 + 2 * lane), lane, wl, (LAS int*)(wl + 160), wl + 176, ci_i, ci_j, cand_on);
        int ln = lane; asm volatile("" : "+v"(ln)); const int el1 = ((ln >> 2) & 1) | (((ln >> 1) & 1) << 1) | ((ln & 1) << 2);
        const int mye = ((LAS int*)(wl + 160))[el1]; int ei[8]; PEER_IDS(mye, ei) PEER_ISSUE_U(ei, ln) PEER_ISSUE_V(ei, ln)
        sul = Us[mye]; svl = Vs[mye]; gl = (wl + 176)[el1];
    }
#pragma unroll 1
    for (int hh = 0; hh < 32; ++hh) {
        const int h = hh & 7, tokl = w * 4 + (hh >> 3), tok = tb + tokl;
        LAS int* fe = (LAS int*)(wl + 160 + (hh & 1) * 32); LAS float* fg = wl + 176 + (hh & 1) * 32;
        if (h == 0) {
            const u32x2* xp = (const u32x2*)(hb + (size_t)tok * DM) + lane;
#pragma unroll
            for (int j = 0; j < 8; ++j) { const u32x2 xw = xp[64 * j]; xf[j * 4 + 0] = bflo(xw.x); xf[j * 4 + 1] = bfhi(xw.x); xf[j * 4 + 2] = bflo(xw.y); xf[j * 4 + 3] = bfhi(xw.y); }
#pragma unroll
            for (int i = 0; i < 32; ++i) acc[i] = 0.f;
        }
        {
            float dot[8]; PEER_DOTS(dot)
            int ln = lane; asm volatile("" : "+v"(ln)); const int el1 = ((ln >> 2) & 1) | (((ln >> 1) & 1) << 1) | ((ln & 1) << 2);
            const int mye = fe[8 + el1]; int ei[8]; PEER_IDS(mye, ei) PEER_ISSUE_U(ei, ln)
            const float cfl = gl * gelu_erf(reduce8(dot, lane) * sul) * svl;
            PEER_ACCUM(cfl)
            f32x2 ns0 = {0.f, 0.f}, ns1 = {0.f, 0.f};
            if (hh < 31) { const int tk2 = w * 4 + ((hh + 1) >> 3), h2 = (hh + 1) & 7;
                ns0 = *(const f32x2*)(Ssc + (size_t)((h2 * 2 + 0) * 32 + tk2) * 128 + 2 * ln); ns1 = *(const f32x2*)(Ssc + (size_t)((h2 * 2 + 1) * 32 + tk2) * 128 + 2 * ln); }
            PEER_ISSUE_V(ei, ln)
            sul = Us[mye]; svl = Vs[mye]; gl = fg[8 + el1];
            if (hh < 31) peer_select_head(ns0, ns1, lane, wl, (LAS int*)(wl + 160 + ((hh + 1) & 1) * 32), wl + 176 + ((hh + 1) & 1) * 32, ci_i, ci_j, cand_on);
        }
        {
            float dot[8]; PEER_DOTS(dot)
            int ln = lane; asm volatile("" : "+v"(ln)); const int el1 = ((ln >> 2) & 1) | (((ln >> 1) & 1) << 1) | ((ln & 1) << 2);
            const int nofs = hh < 31 ? ((hh + 1) & 1) * 32 : (hh & 1) * 32 + 8;
            const int mye = ((LAS int*)(wl + 160 + nofs))[el1]; int ei[8]; PEER_IDS(mye, ei) PEER_ISSUE_U(ei, ln)
            const float cfl = gl * gelu_erf(reduce8(dot, lane) * sul) * svl;
            PEER_ACCUM(cfl)
            PEER_ISSUE_V(ei, ln)
            sul = Us[mye]; svl = Vs[mye]; gl = (wl + 176 + nofs)[el1];
        }
        if (h == 7) {
        f32x4 o[8]; float ssq = 0.f;
#pragma unroll
        for (int j = 0; j < 8; ++j) { o[j] = *((const f32x4*)(x1 + (size_t)tok * DM) + 64 * j + lane) + (f32x4){acc[j * 4 + 0], acc[j * 4 + 1], acc[j * 4 + 2], acc[j * 4 + 3]};
            *((f32x4*)(xout + (size_t)tok * DM) + 64 * j + lane) = o[j]; ssq += o[j].x * o[j].x + o[j].y * o[j].y + o[j].z * o[j].z + o[j].w * o[j].w; }
        if (write_hb) {
            const float rs = rsqrtf(wave_sum(ssq) * (1.f / DM) + 1e-6f);
#pragma unroll
            for (int j = 0; j < 8; ++j) { u32x2 pw; pw.x = pk2(o[j].x * rs, o[j].y * rs); pw.y = pk2(o[j].z * rs, o[j].w * rs); *((u32x2*)(hb + (size_t)tok * DM) + 64 * j + lane) = pw; }
        }
        }
    }
#undef PEER_IDS
#undef PEER_ISSUE_U
#undef PEER_ISSUE_V
#undef PEER_DOTS
#undef PEER_ACCUM
    __syncthreads();
}

constexpr int N_PHASES = 19;
template <int PH>
__device__ __forceinline__ void run_phase(unsigned char* lds_raw, const int wave0) {
    if constexpr (PH == 0) { if (PON(9)) { const Ctx C = fresh_ctx_w(lds_raw, wave0); const AP a = fresh_args(); phase_prep(C, a); } }
    else {
            constexpr int l = (PH - 1) / 9, k = (PH - 1) % 9;
            switch (k) {
            case 0: if (PON(0)) {
                const Ctx C = fresh_ctx_w(lds_raw, wave0); const AP a = fresh_args(); unsigned char* ws = a.ws;
                pg8::Gemm g{(const bf16_t*)(ws + WS_HB), (const bf16_t*)(ws + WS_WINT) + (size_t)l * PROJ * DM, DM};
                pg8::Order S; S.init(32, 16, 1, 0, 0, 0, C.G, C.bx);
                pg8::EpiInProj E{(bf16_t*)(ws + WS_PA), (float*)(ws + WS_PROJ)};
                pg8::gemm_phase(C.lds, g, S, E, C.tid);
            } break;
            case 1: if (PON(1)) {
                int bxo = blockIdx.x; asm volatile("" : "+s"(bxo));
                if (bxo < 128) { const Ctx C = fresh_ctx_w(lds_raw, wave0); const AP a = fresh_args();
                  for (int ti = C.bx; ti < MTOK / 32; ti += C.G) rwkv_prep_item(C, a, l, ti); }
                if (PON(11)) { const Ctx C = fresh_ctx_w(lds_raw, wave0); const AP a = fresh_args(); unsigned char* ws = a.ws;
                  pg8::Gemm g{(const bf16_t*)(ws + WS_WCST) + (size_t)l * 1024 * 512, (const bf16_t*)(ws + WS_PA), 512};
                  pg8::Order S; S.init(4, 32, 1, 0, 0, 0, C.G, C.bx);
                  pg8::EpiC1 E{(bf16_t*)(ws + WS_C1)};
                  pg8::gemm_phase(C.lds, g, S, E, C.tid); }
                __syncthreads();
                if (PON(12)) { const Ctx C = fresh_ctx_w(lds_raw, wave0); const AP a = fresh_args();
                  for (int m = C.gw; m < MTOK; m += C.ngw) qk_prep_token(a, l, m, C.lane); }
                if (PON(13)) { const Ctx C = fresh_ctx_w(lds_raw, wave0); const AP a = fresh_args();
                  for (int it = C.gw; it < 4096; it += C.ngw) s5_ends_item(a, l, it, C.lane, (LAS float*)(C.lds + C.wave * 4096)); }
                if (bxo >= 128) { __syncthreads(); const Ctx C = fresh_ctx_w(lds_raw, wave0); const AP a = fresh_args();
                  for (int ti = C.bx; ti < MTOK / 32; ti += C.G) rwkv_prep_item(C, a, l, ti); }
            } break;
            case 2: if (PON(2)) {
                if (PON(17)) { const Ctx C = fresh_ctx_w(lds_raw, wave0); const AP a = fresh_args();
                  volatile LAS int* qs = (volatile LAS int*)(C.lds + LDS_BYTES - 128);
                  unsigned* qctr = (unsigned*)(a.ws + WS_CTL) + 64 + l * 64;
#pragma unroll 1
                  for (;;) {
                    __syncthreads();
                    if (C.tid == 0) *qs = (int)__hip_atomic_fetch_add(qctr, 8u, __ATOMIC_RELAXED, __HIP_MEMORY_SCOPE_AGENT);
                    __syncthreads();
                    const int base = *qs; if (base >= 14336) break;
                    const int it = base + C.wave;
                    if (it < 4096) s5_final_item_h(a, l, it, C.lane, C.lds + C.wave * 16384);
                    else if (it < 12288) rwkv_chunk_pre(a, it - 4096, C.lane, C.lds + C.wave * 16384);
                    else c1_fold_item(a, it - 12288, C.lane);
                  } }
            } break;
            case 3: if (PON(3)) {
                int bx0 = blockIdx.x; asm volatile("" : "+s"(bx0));
                if (bx0 < 64) { const Ctx C = fresh_ctx_w(lds_raw, wave0); const AP a = fresh_args(); rwkv_seq_chain(C, a, C.bx); }
                else if (bx0 < 192) {
                    if (PON(15)) { const Ctx C = fresh_ctx_w(lds_raw, wave0); const AP a = fresh_args(); unsigned char* ws = a.ws;
                      const int au = C.bx - 64;
                      { const int qblk = au & 7, hq = (au >> 3) & 3, b = au >> 5;
                        const bf16_t* Q = (const bf16_t*)(ws + WS_QB) + ((size_t)(b * SEQ + qblk * 256)) * 512 + hq * 128;
                        const bf16_t* Kp = (const bf16_t*)(ws + WS_QB) + (size_t)MTOK * 512 + ((size_t)b * SEQ) * 256 + (hq >> 1) * 128;
                        const bf16_t* Vp = Kp + (size_t)MTOK * 256;
                        float* O = (float*)(ws + WS_YA) + (size_t)2 * RWSZ + ((size_t)(b * SEQ + qblk * 256)) * 512 + hq * 128;
                        att::attn_dense_body<att::bf16>(Q, Kp, Vp, O, SEQ, (char*)C.lds, C.tid);
                      } }
                } else {
                    { const Ctx C = fresh_ctx_w(lds_raw, wave0); const AP a = fresh_args(); unsigned char* ws = a.ws;
                        pg8::Gemm g{(const bf16_t*)(ws + WS_YGELU), (const bf16_t*)(ws + WS_WGLUT) + (size_t)l * 512 * 512, 512};
                        pg8::Order S; S.init(32, 2, 1, 0, 0, 0, 64, C.bx - 192);
                        pg8::EpiGlu E{(const bf16_t*)(ws + WS_YGELU), (float*)(ws + WS_YA) + RWSZ};
                        pg8::gemm_phase(C.lds, g, S, E, C.tid);
                        __syncthreads(); }
                    if (PON(16)) { const Ctx C = fresh_ctx_w(lds_raw, wave0); const AP a = fresh_args(); unsigned char* ws = a.ws;
                      pg8::Gemm g{(const bf16_t*)(ws + WS_DFT), (const bf16_t*)(ws + WS_C1F), 2048};
                      pg8::Order S; S.init(8, 2, 4, 0, 2, 8, 64, C.bx - 192);
                      pg8::EpiF32 E{(float*)(ws + WS_YA), 512};
                      pg8::gemm_phase(C.lds, g, S, E, C.tid); }
                }
            } break;
            case 4: if (PON(4)) {
                const Ctx C = fresh_ctx_w(lds_raw, wave0); const AP a = fresh_args();
                for (int m = C.gw; m < MTOK; m += C.ngw) {
                    branch_norm_item(a, m * 4 + 0, C.lane); branch_norm_item(a, m * 4 + 1, C.lane); branch_norm_item(a, m * 4 + 2, C.lane); branch_d_item(a, l, m, C.lane); }
            } break;
            case 5: if (PON(5)) {
                const Ctx C = fresh_ctx_w(lds_raw, wave0); const AP a = fresh_args(); unsigned char* ws = a.ws;
                const float* xin = l == 0 ? a.in[0] : (const float*)(ws + WS_X2);
                pg8::Gemm g{(const bf16_t*)(ws + WS_HB), (const bf16_t*)(ws + WS_WOUTT) + (size_t)l * DM * DM, DM};
                pg8::Order S; S.init(32, 8, 1, 0, 0, 0, C.G, C.bx);
                pg8::EpiResid E{xin, (float*)(ws + WS_X1), DM};
                pg8::gemm_phase(C.lds, g, S, E, C.tid);
            } break;
            case 6: if (PON(6)) {
                const Ctx C = fresh_ctx_w(lds_raw, wave0); const AP a = fresh_args(); unsigned char* ws = a.ws;
                for (int m = C.gw; m < MTOK; m += C.ngw) rms_row_to_bf16((const float*)(ws + WS_X1) + (size_t)m * DM, (bf16_t*)(ws + WS_HB) + (size_t)m * DM, C.lane);
            } break;
            case 7: if (PON(7)) {
                int bx0 = blockIdx.x; asm volatile("" : "+s"(bx0));
                if (bx0 < 128) {
                    const Ctx C = fresh_ctx_w(lds_raw, wave0); const AP a = fresh_args(); unsigned char* ws = a.ws;
                    pg8::Gemm g{(const bf16_t*)(ws + WS_HB), (const bf16_t*)(ws + WS_WQT) + (size_t)l * 1024 * DM, DM};
                    pg8::Order S; S.init(32, 4, 1, 0, 0, 0, 128, C.bx);
                    pg8::EpiF32 E{(float*)(ws + WS_PROJ), 1024};
                    pg8::gemm_phase(C.lds, g, S, E, C.tid);
                } else {
                    const Ctx C = fresh_ctx_w(lds_raw, wave0); const AP a = fresh_args();
#pragma unroll 1
                    for (int it = (C.bx - 128) * 8 + C.wave; it < 16384; it += 1024) { const int r2 = it * 2; expert_row_item2(a, r2 >> 14, l, r2 & 16383, C.lane); }
                }
            } break;
            case 8: if (PON(8)) {
                const Ctx C = fresh_ctx_w(lds_raw, wave0); const AP a = fresh_args(); unsigned char* ws = a.ws;
                float* xo = l == 0 ? (float*)(ws + WS_X2) : a.out;
                for (int tile = C.bx; tile < MTOK / 32; tile += C.G) peer_tile(C, a, l, tile, (const float*)(ws + WS_X1), xo, l == 0);
            } break;
            default: break;
            }
    }
}
__global__ void __launch_bounds__(NTHR, 2) fwd_kernel(Args a0) {
    extern __shared__ __attribute__((aligned(16))) unsigned char lds_raw[];
    cg::grid_group grid = cg::this_grid();
    const int wave0 = __builtin_amdgcn_readfirstlane((int)threadIdx.x >> 6);
    volatile LAS unsigned* bst = (volatile LAS unsigned*)((LAS unsigned char*)lds_raw + LDS_BYTES - 64);
    if (threadIdx.x < 2) bst[threadIdx.x] = 0u;
    __syncthreads();
    const XcdBarrier xbar = xcd_barrier_post((unsigned*)(a0.ws + WS_CTL) + 4096, bst);
    const int lo = a0.ph_lo, hi = a0.ph_hi;
    if (lo < 0) grid.sync();
#define MK_STEP(PH) if (lo <= (PH) && (PH) < hi) { run_phase<PH>(lds_raw, wave0); \
        if ((((unsigned)PROBE_REP_MASK >> (PH)) & 1u) != 0u) { xcd_barrier(xbar); run_phase<PH>(lds_raw, wave0); } \
        if ((PH) + 1 < hi) xcd_barrier(xbar); }
    MK_STEP(0) MK_STEP(1) MK_STEP(2) MK_STEP(3) MK_STEP(4) MK_STEP(5) MK_STEP(6) MK_STEP(7) MK_STEP(8) MK_STEP(9)
    MK_STEP(10) MK_STEP(11) MK_STEP(12) MK_STEP(13) MK_STEP(14) MK_STEP(15) MK_STEP(16) MK_STEP(17) MK_STEP(18)
#undef MK_STEP
}

extern "C" void kernel_launch(void* const* d_in, const int* in_sizes, int n_in, void* d_out, int out_size, void* d_ws, size_t ws_size, hipStream_t stream) {
    static int grid = 0;
    if (grid == 0) {
        if (n_in != 36 || in_sizes[0] != MTOK * DM || out_size != MTOK * DM || ws_size < WS_END) {
            fprintf(stderr, "kernel_launch: shape mismatch: n_in %d in0 %d out %d ws %zu (need %zu)\n", n_in, n_in > 0 ? in_sizes[0] : -1, out_size, ws_size, (size_t)WS_END); grid = -1; return; }
        int dev = 0, cus = 0, per_cu = 0;
        if (hipGetDevice(&dev) != hipSuccess || hipDeviceGetAttribute(&cus, hipDeviceAttributeMultiprocessorCount, dev) != hipSuccess) { fprintf(stderr, "kernel_launch: device query failed\n"); grid = -1; return; }
        if (hipFuncSetAttribute((const void*)fwd_kernel, hipFuncAttributeMaxDynamicSharedMemorySize, LDS_BYTES) != hipSuccess) { fprintf(stderr, "kernel_launch: hipFuncSetAttribute failed\n"); grid = -1; return; }
        if (hipOccupancyMaxActiveBlocksPerMultiprocessor(&per_cu, (const void*)fwd_kernel, NTHR, LDS_BYTES) != hipSuccess || per_cu < 1) { fprintf(stderr, "kernel_launch: occupancy query gives %d\n", per_cu); grid = -1; return; }
        grid = cus * per_cu; if (grid > 256) grid = 256;
        if (grid < 128) { fprintf(stderr, "kernel_launch: grid %d too small\n", grid); grid = -1; return; }
    }
    if (grid < 0) return;
    if (hipMemsetAsync((char*)d_ws + WS_CTL, 0, 65536, stream) != hipSuccess) { fprintf(stderr, "kernel_launch: memset failed\n"); return; }
    Args a{};
    for (int i = 0; i < 36; ++i) a.in[i] = (const float*)d_in[i];
    a.out = (float*)d_out; a.ws = (unsigned char*)d_ws;
#if MK_ONE_LAUNCH
    a.ph_lo = 0; a.ph_hi = N_PHASES;
    void* args[] = {&a};
    hipError_t e = hipLaunchCooperativeKernel((const void*)fwd_kernel, dim3(grid), dim3(NTHR), args, LDS_BYTES, stream);
    if (e != hipSuccess) fprintf(stderr, "kernel_launch: cooperative launch failed: %s (grid %d)\n", hipGetErrorString(e), grid);
#else
    for (int ph = 0; ph < N_PHASES; ++ph) {
        a.ph_lo = ph; a.ph_hi = ph + 1;
        hipLaunchKernelGGL(fwd_kernel, dim3(grid), dim3(NTHR), LDS_BYTES, stream, a);
    }
    hipError_t e = hipPeekAtLastError();
    if (e != hipSuccess) fprintf(stderr, "kernel_launch: launch failed: %s\n", hipGetErrorString(e));
#endif
}
```

```cpp
#include <hip/hip_runtime.h>
#include <hip/hip_cooperative_groups.h>
#include <cstdio>
#include <cstdint>
#include <cstddef>
namespace cg = cooperative_groups;

#ifndef MK_ONE_LAUNCH
#define MK_ONE_LAUNCH 1
#endif
#ifndef PHM
#define PHM 0x3ffff
#endif
#define PON(i) (((PHM) >> (i)) & 1)
#ifndef PROBE_REP_MASK
#define PROBE_REP_MASK 0u
#endif

namespace pg8 {
#define PG8_LAS __attribute__((address_space(3)))
typedef unsigned short bf16_t;
typedef short bf16x8 __attribute__((ext_vector_type(8)));
typedef float f32x4 __attribute__((ext_vector_type(4)));
typedef unsigned u32x4 __attribute__((ext_vector_type(4)));
typedef unsigned u32x2 __attribute__((ext_vector_type(2)));
constexpr int BM = 256, BK = 64, HALF = 128, HTB = HALF * BK * 2, STAGE_BYTES = 8 * HTB, NXCD = 8, WGM = 8;

__host__ __device__ __forceinline__ int lds_byte(int r, int c) { const int st = (r >> 4) * 2 + (c >> 5), rr = r & 15, cc = c & 31, ob = rr * 64 + cc * 2; return st * 1024 + (ob ^ (((ob >> 9) & 1) << 5)); }
__host__ __device__ __forceinline__ void stage_rc(int b, int& R, int& C) { const int st = b / 1024, sb = b % 1024, swz = sb ^ (((sb >> 9) & 1) << 5); R = (st >> 1) * 16 + swz / 64; C = (st & 1) * 32 + (swz % 64) / 2; }

struct Unit { int pm, pn, pa, pb; };
struct Gemm { const bf16_t* A; const bf16_t* Bt; int K; };

struct Order {
    int nM, nN, nb, nwg, G, c, aM, bN, oM;
    __device__ __forceinline__ void init(int nM_, int nN_, int nb_, int aM_, int bN_, int oM_, int G_, int c_) { nM = nM_; nN = nN_; nb = nb_; aM = aM_; bN = bN_; oM = oM_; nwg = nM * nN * nb; G = G_; c = c_; }
    __device__ __forceinline__ bool next(int i, Unit& u) const {
        const int L = i * G + c; if (L >= nwg || c < 0) return false;
        const int per = nM * nN, b = L / per; int wgid = L - b * per;
        { const int q = per / NXCD, r = per % NXCD, xcd = wgid % NXCD, off = wgid / NXCD; wgid = (xcd < r ? xcd * (q + 1) : r * (q + 1) + (xcd - r) * q) + off; }
        const int nig = WGM * nN, gid = wgid / nig, fm = gid * WGM, gsz = (nM - fm) < WGM ? (nM - fm) : WGM;
        const int pm = fm + ((wgid % nig) % gsz), pn = (wgid % nig) / gsz;
        u.pm = pm + b * oM; u.pn = pn; u.pa = pm + b * aM; u.pb = pn + b * bN; return true;
    }
};

__device__ __forceinline__ unsigned cvt_pk_bf16(float lo, float hi) { unsigned r; asm volatile("v_cvt_pk_bf16_f32 %0, %1, %2" : "=v"(r) : "v"(lo), "v"(hi)); return r; }

#define PG8_EPI_LOOP(...) \
    _Pragma("unroll") for (int ai = 0; ai < 2; ++ai) _Pragma("unroll") for (int m = 0; m < 4; ++m) { const int row = u.pm * BM + ai * HALF + wr * 64 + m * 16 + fr; \
        _Pragma("unroll") for (int bj = 0; bj < 2; ++bj) _Pragma("unroll") for (int n = 0; n < 2; ++n) { const int col = u.pn * BM + bj * HALF + wc * 32 + n * 16 + 4 * fq; const f32x4 v = acc[ai][bj][m][n]; __VA_ARGS__ } }

struct EpiF32 {
    float* out; int ldc;
    __device__ __forceinline__ void operator()(const f32x4 (&acc)[2][2][4][2], const Unit& u, int wr, int wc, int fr, int fq) const {
        PG8_EPI_LOOP( *(f32x4*)(out + (size_t)row * ldc + col) = v; )
    }
};
struct EpiResid {
    const float* base; float* out; int ldc;
    __device__ __forceinline__ void operator()(const f32x4 (&acc)[2][2][4][2], const Unit& u, int wr, int wc, int fr, int fq) const {
        PG8_EPI_LOOP( const f32x4 b = *(const f32x4*)(base + (size_t)row * ldc + col); *(f32x4*)(out + (size_t)row * ldc + col) = b + v; )
    }
};
struct EpiInProj {
    bf16_t* pa; float* proj;
    __device__ __forceinline__ void operator()(const f32x4 (&acc)[2][2][4][2], const Unit& u, int wr, int wc, int fr, int fq) const {
        if (u.pn < 2) { PG8_EPI_LOOP( u32x2 w; w.x = cvt_pk_bf16(v[0], v[1]); w.y = cvt_pk_bf16(v[2], v[3]); *(u32x2*)(pa + (size_t)row * 512 + col) = w; ) }
        else { PG8_EPI_LOOP( *(f32x4*)(proj + (size_t)row * 4096 + col) = v; ) }
    }
};
struct EpiC1 {
    bf16_t* c1;
    __device__ __forceinline__ void operator()(const f32x4 (&acc)[2][2][4][2], const Unit& u, int wr, int wc, int fr, int fq) const {
        PG8_EPI_LOOP( const int b = col >> 11, s = col & 2047; u32x2 w; w.x = cvt_pk_bf16(v[0], v[1]); w.y = cvt_pk_bf16(v[2], v[3]);
                      *(u32x2*)(c1 + ((size_t)b * 1024 + row) * 2048 + s) = w; )
    }
};
struct EpiGlu {
    const bf16_t* y; float* out;
    __device__ __forceinline__ void operator()(const f32x4 (&acc)[2][2][4][2], const Unit& u, int wr, int wc, int fr, int fq) const {
        PG8_EPI_LOOP( const u32x2 yw = *(const u32x2*)(y + (size_t)row * 512 + col);
                      f32x4 yv; yv[0] = __uint_as_float(yw.x << 16); yv[1] = __uint_as_float(yw.x & 0xffff0000u); yv[2] = __uint_as_float(yw.y << 16); yv[3] = __uint_as_float(yw.y & 0xffff0000u);
                      f32x4 o; _Pragma("unroll") for (int e = 0; e < 4; ++e) o[e] = yv[e] / (1.f + __expf(-v[e]));
                      *(f32x4*)(out + (size_t)row * 512 + col) = o; )
    }
};

template <class Epi, class Sched>
__device__ __forceinline__ void gemm_phase(PG8_LAS unsigned char* lds, const Gemm g, const Sched& S, const Epi& E, const int tid) {
    const int wid = __builtin_amdgcn_readfirstlane(tid >> 6), lane = tid & 63, wr = wid >> 2, wc = wid & 3, fr = lane & 15, fq = lane >> 4;
    const int K = g.K, nt = K / BK;
    unsigned voffA[2];
#pragma unroll
    for (int i = 0; i < 2; ++i) { int R, C; stage_rc(tid * 16 + i * 8192, R, C); voffA[i] = (unsigned)(R * K + C) * 2u; }
    const size_t kstep = (size_t)(BK * 2);
    const size_t hstep = (size_t)HALF * K * 2;
    const size_t tstep = 2 * hstep;
    const unsigned ldsw = (unsigned)wid * 1024u;
    const int aoff = lds_byte(wr * 64 + fr, fq * 8), boff = lds_byte(wc * 32 + fr, fq * 8);
#define PG8_SA(b, h) (((b) * 2 + (h)) * HTB)
#define PG8_SB(b, h) ((4 + (b) * 2 + (h)) * HTB)
#define PG8_STAGE(bufoff, gbase, voff) do { _Pragma("unroll") for (int _i = 0; _i < 2; ++_i) \
        __builtin_amdgcn_global_load_lds((const unsigned*)((const char*)(gbase) + (voff)[_i]), (PG8_LAS unsigned*)(lds + (bufoff) + ldsw + _i * 8192), 16, 0, 0); } while (0)
#define PG8_LDA(dst, b, h) do { _Pragma("unroll") for (int m = 0; m < 4; ++m) _Pragma("unroll") for (int k = 0; k < 2; ++k) dst[m][k] = *(const PG8_LAS bf16x8*)(lds + PG8_SA(b, h) + aoff + m * 2048 + k * 1024); } while (0)
#define PG8_LDB(dst, b, h) do { _Pragma("unroll") for (int n = 0; n < 2; ++n) _Pragma("unroll") for (int k = 0; k < 2; ++k) dst[n][k] = *(const PG8_LAS bf16x8*)(lds + PG8_SB(b, h) + boff + n * 2048 + k * 1024); } while (0)
#define PG8_MMA(ai, bj, At, Bt) do { __builtin_amdgcn_s_setprio(1); _Pragma("unroll") for (int m = 0; m < 4; ++m) _Pragma("unroll") for (int n = 0; n < 2; ++n) _Pragma("unroll") for (int k = 0; k < 2; ++k) \
        acc[ai][bj][m][n] = __builtin_amdgcn_mfma_f32_16x16x32_bf16(Bt[n][k], At[m][k], acc[ai][bj][m][n], 0, 0, 0); __builtin_amdgcn_s_setprio(0); } while (0)
#define PG8_WAIT_V(n) asm volatile("s_waitcnt vmcnt(" #n ")" ::: "memory")
#define PG8_WAIT_L(n) asm volatile("s_waitcnt lgkmcnt(" #n ")" ::: "memory")
#define PG8_BAR __builtin_amdgcn_s_barrier()
#define PG8_SCHED __builtin_amdgcn_sched_barrier(0)
    Unit cur, nxt; int ui = 0;
    if (!S.next(0, cur)) return;
    f32x4 acc[2][2][4][2];
#pragma unroll
    for (int a = 0; a < 2; ++a)
#pragma unroll
        for (int b = 0; b < 2; ++b)
#pragma unroll
            for (int m = 0; m < 4; ++m)
#pragma unroll
                for (int n = 0; n < 2; ++n) acc[a][b][m][n] = (f32x4){0.f, 0.f, 0.f, 0.f};
    bf16x8 At[4][2], B0[2][2], B1[2][2];
    const char* cA = (const char*)g.A + (size_t)cur.pa * tstep; const char* cB = (const char*)g.Bt + (size_t)cur.pb * tstep;
    PG8_STAGE(PG8_SB(0, 0), cB, voffA); PG8_STAGE(PG8_SB(0, 1), cB + hstep, voffA); PG8_STAGE(PG8_SA(0, 0), cA, voffA); PG8_STAGE(PG8_SA(0, 1), cA + hstep, voffA);
    if (wr == 1) PG8_BAR;
    PG8_WAIT_V(2); PG8_BAR;
    PG8_STAGE(PG8_SB(1, 0), cB + kstep, voffA); PG8_STAGE(PG8_SA(1, 0), cA + kstep, voffA); PG8_STAGE(PG8_SB(1, 1), cB + hstep + kstep, voffA);
    PG8_WAIT_V(6); PG8_BAR;
    for (;;) {
        const bool has_next = S.next(ui + 1, nxt);
        const char* nA = has_next ? (const char*)g.A + (size_t)nxt.pa * tstep : cA; const char* nB = has_next ? (const char*)g.Bt + (size_t)nxt.pb * tstep : cB;
        for (int t = 0; t < nt; t += 2) {
            const bool last = (t == nt - 2);
            const char* a1 = cA + (size_t)(t + 1) * kstep;
            const char* a2 = last ? nA : cA + (size_t)(t + 2) * kstep; const char* b2 = last ? nB : cB + (size_t)(t + 2) * kstep;
            const char* a3 = a2 + kstep; const char* b3 = b2 + kstep;
            PG8_LDB(B0, 0, 0); PG8_LDB(B1, 0, 1); PG8_SCHED; PG8_LDA(At, 0, 0); PG8_STAGE(PG8_SA(1, 1), a1 + hstep, voffA);
            PG8_WAIT_V(8); PG8_WAIT_L(0); PG8_BAR; PG8_MMA(0, 0, At, B0); PG8_MMA(0, 1, At, B1); PG8_BAR; PG8_SCHED;
            PG8_LDA(At, 0, 1); PG8_STAGE(PG8_SB(0, 0), b2, voffA); PG8_STAGE(PG8_SB(0, 1), b2 + hstep, voffA); PG8_STAGE(PG8_SA(0, 0), a2, voffA);
            PG8_WAIT_V(8); PG8_WAIT_L(0); PG8_BAR; PG8_MMA(1, 0, At, B0); PG8_MMA(1, 1, At, B1); PG8_BAR; PG8_SCHED;
            PG8_LDB(B0, 1, 0); PG8_LDB(B1, 1, 1); PG8_SCHED; PG8_LDA(At, 1, 0); PG8_STAGE(PG8_SA(0, 1), a2 + hstep, voffA);
            PG8_WAIT_V(8); PG8_WAIT_L(0); PG8_BAR; PG8_MMA(0, 0, At, B0); PG8_MMA(0, 1, At, B1); PG8_BAR; PG8_SCHED;
            PG8_LDA(At, 1, 1); PG8_STAGE(PG8_SB(1, 0), b3, voffA); PG8_STAGE(PG8_SB(1, 1), b3 + hstep, voffA); PG8_STAGE(PG8_SA(1, 0), a3, voffA);
            PG8_WAIT_V(8); PG8_WAIT_L(0); PG8_BAR; PG8_MMA(1, 0, At, B0); PG8_MMA(1, 1, At, B1); PG8_BAR; PG8_SCHED;
        }
        if (wr == 0) PG8_BAR;
        E(acc, cur, wr, wc, fr, fq);
        if (!has_next) break;
#pragma unroll
        for (int a = 0; a < 2; ++a)
#pragma unroll
            for (int b = 0; b < 2; ++b)
#pragma unroll
                for (int m = 0; m < 4; ++m)
#pragma unroll
                    for (int n = 0; n < 2; ++n) acc[a][b][m][n] = (f32x4){0.f, 0.f, 0.f, 0.f};
        cur = nxt; cA = nA; cB = nB; ++ui;
        if (wr == 1) PG8_BAR;
    }
    PG8_WAIT_V(0);
    PG8_BAR;
#undef PG8_SA
#undef PG8_SB
#undef PG8_STAGE
#undef PG8_LDA
#undef PG8_LDB
#undef PG8_MMA
#undef PG8_WAIT_V
#undef PG8_WAIT_L
#undef PG8_BAR
#undef PG8_SCHED
}
}

namespace att {
using bf16 = unsigned short;
constexpr int   D = 128, NW = 8, QBLK = 32, KVBLK = 64;
constexpr float SCALE = 0.088388347648318440f;
constexpr float THR = 8.f;
constexpr int SDEPTH = 1;
constexpr int LDQ = 512, LDK = 256, LDO = 512;
constexpr size_t SHM_V = KVBLK * D * 2, SHM_K = KVBLK * D * 2, SHM_ATTN = 2 * SHM_V + 2 * SHM_K + NW * 64 * 4;

using bf16x8 = __attribute__((ext_vector_type(8))) short;
using s16x4  = __attribute__((ext_vector_type(4))) short;
using f32x16 = __attribute__((ext_vector_type(16))) float;
using f32x8  = __attribute__((ext_vector_type(8))) float;
using u32x4  = __attribute__((ext_vector_type(4))) unsigned;
#define KSWZ(row, colB) ((row) * 256 + ((colB) ^ (((row) & 7) << 4)))
#define SBAR() __builtin_amdgcn_sched_barrier(0)
__device__ __forceinline__ int crow(int r, int hi) { return (r & 3) + 8 * (r >> 2) + 4 * hi; }
__device__ __forceinline__ unsigned cvtpk(float lo, float hi) {
  unsigned r; asm volatile("v_cvt_pk_bf16_f32 %0, %1, %2" : "=v"(r) : "v"(lo), "v"(hi)); return r;
}
template <typename TIn> struct Stage;
template <> struct Stage<bf16>  { using T = bf16x8;
  __device__ static __forceinline__ T ld8(const bf16* p) { return *reinterpret_cast<const bf16x8*>(p); }
  __device__ static __forceinline__ bf16x8 tobf(T x) { return x; } };

__device__ __forceinline__ void partialSM(f32x16& p0, f32x16& p1, float& m_reg, float& mn, float& alpha) {
  constexpr float C = SCALE * 1.4426950408889634f;
  float pmax = p0[0]; for (int r = 1; r < 16; ++r) pmax = fmaxf(pmax, p0[r]); for (int r = 0; r < 16; ++r) pmax = fmaxf(pmax, p1[r]);
  { auto rr = __builtin_amdgcn_permlane32_swap(__float_as_uint(pmax), __float_as_uint(pmax), false, false);
    pmax = fmaxf(__uint_as_float(rr[0]), __uint_as_float(rr[1])); }
  if (__builtin_expect(__all(pmax - m_reg <= THR / SCALE), 1)) { mn = m_reg; alpha = 1.f; }
  else { mn = fmaxf(m_reg, pmax); alpha = __builtin_amdgcn_exp2f((m_reg - mn) * C); m_reg = mn; }
  float mnC = -mn * C;
  for (int r = 0; r < 16; ++r) p0[r] = fmaf(p0[r], C, mnC); for (int r = 0; r < 16; ++r) p1[r] = fmaf(p1[r], C, mnC);
  for (int r = 0; r < 16; ++r) p0[r] = __builtin_amdgcn_exp2f(p0[r]);
}
__device__ __forceinline__ void finishSM(f32x16& p0, f32x16& p1, float alpha, float& l_reg, bf16x8& pa0, bf16x8& pa1, bf16x8& pa2, bf16x8& pa3) {
  for (int r = 0; r < 16; ++r) p1[r] = __builtin_amdgcn_exp2f(p1[r]);
  float ps = 0; for (int r = 0; r < 16; ++r) ps += p0[r]; for (int r = 0; r < 16; ++r) ps += p1[r];
  { auto rr = __builtin_amdgcn_permlane32_swap(__float_as_uint(ps), __float_as_uint(ps), false, false);
    ps = __uint_as_float(rr[0]) + __uint_as_float(rr[1]); }
  l_reg = l_reg * alpha + ps;
#define PK4(P, BASE, OUT) do { unsigned a0 = cvtpk(P[BASE + 0], P[BASE + 1]), a1 = cvtpk(P[BASE + 2], P[BASE + 3]);   \
    unsigned b0 = cvtpk(P[BASE + 4], P[BASE + 5]), b1 = cvtpk(P[BASE + 6], P[BASE + 7]);                              \
    auto r0 = __builtin_amdgcn_permlane32_swap(a0, b0, false, false); auto r1 = __builtin_amdgcn_permlane32_swap(a1, b1, false, false); \
    u32x4 w = {r0[0], r1[0], r0[1], r1[1]}; OUT = *reinterpret_cast<bf16x8*>(&w); } while (0)
  PK4(p0, 0, pa0); PK4(p0, 8, pa1); PK4(p1, 0, pa2); PK4(p1, 8, pa3);
#undef PK4
}
__device__ __forceinline__ void qkt(f32x16& p0, f32x16& p1, const bf16* Ks, const bf16x8* qr, int r32, int hi) {
  p0 = f32x16{}; p1 = f32x16{};
  for (int d0 = 0; d0 < 8; ++d0) { int cb = (d0 * 16 + hi * 8) * 2;
    bf16x8 b0 = *reinterpret_cast<const bf16x8*>((const char*)Ks + KSWZ(r32, cb));
    bf16x8 b1 = *reinterpret_cast<const bf16x8*>((const char*)Ks + KSWZ(32 + r32, cb));
    p0 = __builtin_amdgcn_mfma_f32_32x32x16_bf16(b0, qr[d0], p0, 0, 0, 0);
    p1 = __builtin_amdgcn_mfma_f32_32x32x16_bf16(b1, qr[d0], p1, 0, 0, 0); }
}
__device__ __forceinline__ int v_st(int k, int c) { const int kk = (k & ~0xC) | ((k & 4) << 1) | ((k & 8) >> 1); return ((kk >> 3) * 4 + (c >> 5)) * 512 + ((kk & 7) * 32 + (c & 31)) * 2; }
__device__ __forceinline__ int v_rd_base(int lane) { return ((lane & 3) << 3) | (((lane >> 2) & 3) << 6) | (((lane >> 4) & 1) << 5) | (((lane >> 5) & 1) << 8); }
constexpr int v_rd_off(int d0, int ks, int half) { return d0 * 512 + ks * 4096 + half * 2048; }
template <int OFF> __device__ __forceinline__ s16x4 tr_read(int vb) {
  s16x4 r; asm volatile("ds_read_b64_tr_b16 %0, %1 offset:%2" : "=&v"(r) : "v"(vb), "i"(OFF) : "memory"); return r;
}
template <int D0> __device__ __forceinline__ void pv_one(f32x16& od, int vb, bf16x8 pa0, bf16x8 pa1, bf16x8 pa2, bf16x8 pa3) {
  const s16x4 l0 = tr_read<v_rd_off(D0, 0, 0)>(vb), h0 = tr_read<v_rd_off(D0, 0, 1)>(vb), l1 = tr_read<v_rd_off(D0, 1, 0)>(vb), h1 = tr_read<v_rd_off(D0, 1, 1)>(vb);
  const s16x4 l2 = tr_read<v_rd_off(D0, 2, 0)>(vb), h2 = tr_read<v_rd_off(D0, 2, 1)>(vb), l3 = tr_read<v_rd_off(D0, 3, 0)>(vb), h3 = tr_read<v_rd_off(D0, 3, 1)>(vb);
  asm volatile("s_waitcnt lgkmcnt(0)" ::: "memory"); SBAR();
#define PK(L, H) (bf16x8){L[0], L[1], L[2], L[3], H[0], H[1], H[2], H[3]}
  od = __builtin_amdgcn_mfma_f32_32x32x16_bf16(pa0, PK(l0, h0), od, 0, 0, 0);
  od = __builtin_amdgcn_mfma_f32_32x32x16_bf16(pa1, PK(l1, h1), od, 0, 0, 0);
  od = __builtin_amdgcn_mfma_f32_32x32x16_bf16(pa2, PK(l2, h2), od, 0, 0, 0);
  od = __builtin_amdgcn_mfma_f32_32x32x16_bf16(pa3, PK(l3, h3), od, 0, 0, 0);
#undef PK
}
__device__ __forceinline__ void pv_d0(f32x16* o, int vb, bf16x8 pa0, bf16x8 pa1, bf16x8 pa2, bf16x8 pa3) {
  pv_one<0>(o[0], vb, pa0, pa1, pa2, pa3); pv_one<1>(o[1], vb, pa0, pa1, pa2, pa3); pv_one<2>(o[2], vb, pa0, pa1, pa2, pa3); pv_one<3>(o[3], vb, pa0, pa1, pa2, pa3);
}
template <typename TQ>
__device__ __forceinline__ void attn_dense_body(const TQ* __restrict__ Qb, const bf16* __restrict__ Kh, const bf16* __restrict__ Vh,
                                                float* __restrict__ Ob, int seq, char* lds, const int tid_) {
  using St = Stage<bf16>; using SQ = Stage<TQ>;
  int tid = tid_; asm volatile("" : "+v"(tid));
  const int wid = tid >> 6, lane = tid & 63, r32 = lane & 31, hi = lane >> 5;
  bf16* V_lds = (bf16*)lds; bf16* K_lds = (bf16*)(lds + 2 * SHM_V);
  float* ws = (float*)(lds + 2 * SHM_V + 2 * SHM_K) + wid * 64; float* li_l = ws; float* al_l = ws + 32;
  float m_reg = -1e30f, l_reg = 0; f32x16 o[4] = {}; bf16x8 qr[8];
  const TQ* Qw = Qb + (long)(wid * QBLK + r32) * LDQ + hi * 8;
#pragma unroll
  for (int d0 = 0; d0 < 8; ++d0) qr[d0] = SQ::tobf(SQ::ld8(Qw + d0 * 16));
  const int sr = tid >> 4, sc = (tid & 15) * 8, vst0 = v_st(sr, sc), vst1 = v_st(32 + sr, sc);
  const int vb0 = (int)(uintptr_t)V_lds + v_rd_base(lane);
  struct { typename St::T vs0, vs1, ks0, ks1; } sr_[SDEPTH];
  const unsigned loff = (unsigned)(sr * LDK + sc);
#define SLOAD(i, k0) do { const bf16* Vt_ = Vh + (size_t)(k0) * LDK; const bf16* Kt_ = Kh + (size_t)(k0) * LDK; \
    sr_[i].vs0 = St::ld8(Vt_ + loff); sr_[i].vs1 = St::ld8(Vt_ + 32 * LDK + loff); \
    sr_[i].ks0 = St::ld8(Kt_ + loff); sr_[i].ks1 = St::ld8(Kt_ + 32 * LDK + loff); } while (0)
#define SWRITE(b, i) do { *(bf16x8*)((char*)V_lds + (b) * SHM_V + vst0) = St::tobf(sr_[i].vs0);          \
    *(bf16x8*)((char*)V_lds + (b) * SHM_V + vst1) = St::tobf(sr_[i].vs1); int kc = sc * 2;               \
    *(bf16x8*)((char*)K_lds + (b) * SHM_K + KSWZ(sr, kc)) = St::tobf(sr_[i].ks0);                       \
    *(bf16x8*)((char*)K_lds + (b) * SHM_K + KSWZ(32 + sr, kc)) = St::tobf(sr_[i].ks1); } while (0)
#define SWAIT() do { if constexpr (SDEPTH == 2) asm volatile("s_waitcnt vmcnt(4)" ::: "memory"); else asm volatile("s_waitcnt vmcnt(0)" ::: "memory"); } while (0)
#define RESC(a) do { if (__any((a) < 1.f)) { if (hi == 0) al_l[r32] = (a); asm volatile("s_waitcnt lgkmcnt(0)" ::: "memory"); \
    for (int d = 0; d < 4; ++d) for (int r = 0; r < 16; ++r) o[d][r] *= al_l[crow(r, hi)]; } } while (0)
  f32x16 pA0, pA1, pB0, pB1; float mnA, mnB, alA, alB; bf16x8 pa0, pa1, pa2, pa3; const int NT = seq / KVBLK;
  constexpr int SE = 0, SO = SDEPTH - 1;
  SLOAD(SE, 0); asm volatile("s_waitcnt vmcnt(0)" ::: "memory"); SWRITE(0, SE); __syncthreads();
  qkt(pA0, pA1, K_lds, qr, r32, hi); partialSM(pA0, pA1, m_reg, mnA, alA);
  SLOAD(SO, KVBLK); if constexpr (SDEPTH == 2) { if (2 < NT) SLOAD(SE, 2 * KVBLK); }
  SWAIT(); SWRITE(1, SO); __syncthreads();
  for (int j = 1; j + 1 < NT; j += 2) {
    SBAR(); qkt(pB0, pB1, (bf16*)((char*)K_lds + SHM_K), qr, r32, hi);
    finishSM(pA0, pA1, alA, l_reg, pa0, pa1, pa2, pa3); SBAR();
    SLOAD(SO, (j + SDEPTH) * KVBLK); SBAR();
    pv_d0(o, vb0, pa0, pa1, pa2, pa3); partialSM(pB0, pB1, m_reg, mnB, alB);
    __syncthreads(); SWAIT(); SWRITE(0, SE);
    RESC(alB); __syncthreads();
    SBAR(); qkt(pA0, pA1, K_lds, qr, r32, hi);
    finishSM(pB0, pB1, alB, l_reg, pa0, pa1, pa2, pa3); SBAR();
    if (SDEPTH == 1 || j + 3 < NT) SLOAD(SE, (j + 1 + SDEPTH) * KVBLK); SBAR();
    pv_d0(o, vb0 + (int)SHM_V, pa0, pa1, pa2, pa3); partialSM(pA0, pA1, m_reg, mnA, alA);
    __syncthreads(); SWAIT(); SWRITE(1, SO);
    RESC(alA); __syncthreads();
  }
  SBAR(); qkt(pB0, pB1, (bf16*)((char*)K_lds + SHM_K), qr, r32, hi);
  finishSM(pA0, pA1, alA, l_reg, pa0, pa1, pa2, pa3); SBAR();
  pv_d0(o, vb0, pa0, pa1, pa2, pa3); partialSM(pB0, pB1, m_reg, mnB, alB);
  __syncthreads(); RESC(alB);
  finishSM(pB0, pB1, alB, l_reg, pa0, pa1, pa2, pa3); SBAR();
  pv_d0(o, vb0 + (int)SHM_V, pa0, pa1, pa2, pa3);
  if (hi == 0) li_l[r32] = l_reg; asm volatile("s_waitcnt lgkmcnt(0)" ::: "memory");
  float rli[16];
#pragma unroll
  for (int r = 0; r < 16; ++r) rli[r] = __builtin_amdgcn_rcpf(li_l[crow(r, hi)]);
  int le = lane; asm volatile("" : "+v"(le));
  float* Ow = Ob + (size_t)(wid * QBLK) * LDO; const unsigned eo = (unsigned)((le >> 5) * 4 * LDO + (le & 31));
#pragma unroll
  for (int r = 0; r < 16; ++r) { const unsigned ro = eo + (unsigned)(((r & 3) + 8 * (r >> 2)) * LDO);
#pragma unroll
    for (int d0 = 0; d0 < 4; ++d0) Ow[ro + d0 * 32] = o[d0][r] * rli[r]; }
#undef SLOAD
#undef SWRITE
#undef SWAIT
#undef RESC
}
}
#define LAS __attribute__((address_space(3)))
typedef unsigned short bf16_t;
typedef float f32x4 __attribute__((ext_vector_type(4)));
typedef float f32x2 __attribute__((ext_vector_type(2)));
typedef unsigned u32x4 __attribute__((ext_vector_type(4)));
typedef unsigned u32x2 __attribute__((ext_vector_type(2)));

typedef short bf16x8_t __attribute__((ext_vector_type(8)));
__device__ __forceinline__ bf16x8_t mk8(unsigned d0, unsigned d1, unsigned d2, unsigned d3) { const u32x4 w = {d0, d1, d2, d3}; return __builtin_bit_cast(bf16x8_t, w); }
constexpr int NTHR = 512, NWAVES = 8;
constexpr int MTOK = 8192, DM = 2048, SEQ = 2048, NBATCH = 4, PROJ = 4096, GW = 512;
constexpr int LDS_BYTES = 147456;

constexpr size_t MiB = 1u << 20;
constexpr size_t WS_CTL = 0;
constexpr size_t WS_WINT = 1 * MiB;
constexpr size_t WS_WOUTT = WS_WINT + 32 * MiB;
constexpr size_t WS_WQT = WS_WOUTT + 16 * MiB;
constexpr size_t WS_WGLUT = WS_WQT + 8 * MiB;
constexpr size_t WS_WCST = WS_WGLUT + 1 * MiB;
constexpr size_t WS_DFT = WS_WCST + 2 * MiB;
constexpr size_t WS_C1F = WS_DFT + 8 * MiB;
constexpr size_t WS_UB = WS_DFT + 16 * MiB;
constexpr size_t WS_VB = WS_UB + 128 * MiB;
constexpr size_t WS_KEYST = WS_VB + 128 * MiB;
constexpr size_t WS_ROPE = WS_KEYST + 1 * MiB;
constexpr size_t WS_HB = WS_ROPE + 1 * MiB;
constexpr size_t WS_PROJ = WS_HB + 32 * MiB;
constexpr size_t WS_PA = WS_PROJ + 128 * MiB;
constexpr size_t WS_C1 = WS_PA + 8 * MiB;
constexpr size_t WS_YA = WS_C1 + 16 * MiB;
constexpr size_t WS_QB = WS_YA + 64 * MiB;
constexpr size_t WS_S5E = WS_QB + 16 * MiB;
constexpr size_t WS_YGELU = WS_S5E + 4 * MiB;
constexpr size_t WS_RW = WS_YGELU + 8 * MiB;
constexpr size_t WS_YRW = WS_RW + 176 * MiB;
constexpr size_t WS_X1 = WS_YRW + 32 * MiB;
constexpr size_t WS_X2 = WS_X1 + 64 * MiB;
constexpr size_t WS_KS = WS_X2 + 64 * MiB;
constexpr size_t WS_S5T = WS_VB + 122 * MiB;
constexpr size_t WS_END = WS_KS + 16 * MiB;
static_assert(WS_END <= 1024 * MiB, "workspace map must fit 1 GiB");
constexpr size_t WS_LORA = WS_VB + 1 * MiB;
constexpr size_t WS_RWC = WS_VB + 2 * MiB;
constexpr int RWC_REC = 15360;
constexpr size_t RWSZ = (size_t)MTOK * GW;
enum { RW_R = 0, RW_V, RW_KK, RW_W0, RW_W1, RW_KD0, RW_KD1, RW_B0, RW_B1, RW_G, RW_BONUS };

struct Args { const float* in[36]; float* out; unsigned char* ws; int ph_lo, ph_hi; };

__device__ __forceinline__ unsigned f2bf(float f) { const unsigned u = __float_as_uint(f); return (u + 0x7fffu + ((u >> 16) & 1u)) >> 16; }
__device__ __forceinline__ unsigned pk2(float lo, float hi) { return f2bf(lo) | (f2bf(hi) << 16); }
__device__ __forceinline__ float bflo(unsigned w) { return __uint_as_float(w << 16); }
__device__ __forceinline__ float bfhi(unsigned w) { return __uint_as_float(w & 0xffff0000u); }
#define DPPF(x, ctrl) __builtin_bit_cast(float, __builtin_amdgcn_update_dpp(0, __builtin_bit_cast(int, (x)), (ctrl), 0xF, 0xF, true))
#define RDL(x, l) __builtin_bit_cast(float, __builtin_amdgcn_readlane(__builtin_bit_cast(int, (x)), (l)))
__device__ __forceinline__ float wave_sum(float v) {
    v += DPPF(v, 0xB1); v += DPPF(v, 0x4E); v += DPPF(v, 0x124); v += DPPF(v, 0x128);
    return (RDL(v, 0) + RDL(v, 16)) + (RDL(v, 32) + RDL(v, 48));
}
__device__ __forceinline__ float wave_max(float v) {
    v = fmaxf(v, DPPF(v, 0xB1)); v = fmaxf(v, DPPF(v, 0x4E)); v = fmaxf(v, DPPF(v, 0x124)); v = fmaxf(v, DPPF(v, 0x128));
    return fmaxf(fmaxf(RDL(v, 0), RDL(v, 16)), fmaxf(RDL(v, 32), RDL(v, 48)));
}
__device__ __forceinline__ float sigmoidf_(float x) { return 1.f / (1.f + __expf(-x)); }
__device__ __forceinline__ float gelu_tanh(float x) { const float u = 0.7978845608028654f * (x + 0.044715f * x * x * x); return 0.5f * x * (1.f + tanhf(u)); }
__device__ __forceinline__ float gelu_erf(float x) { return 0.5f * x * (1.f + erff(x * 0.7071067811865476f)); }
#define LDS_WAIT() asm volatile("s_waitcnt lgkmcnt(0)" ::: "memory")

struct Ctx {
    LAS unsigned char* lds; int tid, lane, wave, G, gw, ngw, bx;
};
__device__ __forceinline__ Ctx fresh_ctx_w(unsigned char* lds_raw, int wave0) {
    Ctx C; int ln = __builtin_amdgcn_mbcnt_hi(~0u, __builtin_amdgcn_mbcnt_lo(~0u, 0u)); asm volatile("" : "+v"(ln));
    int wv = wave0; asm volatile("" : "+s"(wv));
    int t = wv * 64 + ln;
    int bx = blockIdx.x, G = gridDim.x; asm volatile("" : "+s"(bx), "+s"(G));
    unsigned lo_ = 0u; asm volatile("" : "+s"(lo_));
    C.lds = (LAS unsigned char*)lds_raw + lo_; C.tid = t; C.lane = ln; C.wave = wv;
    C.G = G; C.bx = bx; C.gw = bx * NWAVES + C.wave; C.ngw = G * NWAVES; return C;
}
#define AS4 __attribute__((address_space(4)))
typedef const float* const AS4* InTab;
struct AP { InTab in; float* out; unsigned char* ws; };
static_assert(offsetof(Args, out) == 288 && offsetof(Args, ws) == 296, "Args layout");
__device__ __forceinline__ AP fresh_args() {
    unsigned long long p = (unsigned long long)__builtin_amdgcn_kernarg_segment_ptr(); asm volatile("" : "+s"(p));
    AP r; r.in = (InTab)p; r.out = *(float* const AS4*)(p + 288); r.ws = *(unsigned char* const AS4*)(p + 296); return r;
}

typedef __attribute__((address_space(1))) unsigned gu32;
#define RLX_AGENT __ATOMIC_RELAXED, __HIP_MEMORY_SCOPE_AGENT
#define XB_TMO      128
#define XB_XCNT(j)  (256  + 64 * (j))
#define XB_XSUB(j)  (1280 + 64 * (j))
#define XB_XGEN(j)  (2304 + 64 * (j))
#define XB_TOP      3328
#define XB_TOPGEN   3392
#define XCD_BAR_WORDS 3456
#define XB_SPIN_CAP (1u << 18)

__device__ __forceinline__ unsigned xb_ld(unsigned* p)              { return __hip_atomic_load(p, __ATOMIC_RELAXED, __HIP_MEMORY_SCOPE_AGENT); }
__device__ __forceinline__ unsigned xb_add(unsigned* p, unsigned v) { return __hip_atomic_fetch_add(p, v, __ATOMIC_RELAXED, __HIP_MEMORY_SCOPE_AGENT); }
__device__ __forceinline__ unsigned xb_xcc_id() { return (unsigned)__builtin_amdgcn_s_getreg((3 << 11) | 20) & 0xFu; }
#define XB_SPIN(cond, bar) do { unsigned _sp = 0; while (cond) { __builtin_amdgcn_s_sleep(1); \
    if ((++_sp & 255u) == 0u) { if (xb_ld(&(bar)[XB_TMO])) break; if (_sp > XB_SPIN_CAP) { atomicAdd(&(bar)[XB_TMO], 1u); break; } } } } while (0)

struct XcdBarrier {
    unsigned* bar; unsigned x;
    volatile LAS unsigned* st;
};

__device__ __forceinline__ XcdBarrier xcd_barrier_post(unsigned* bar, volatile LAS unsigned* st) {
    XcdBarrier b; b.bar = bar; b.x = xb_xcc_id(); b.st = st;
    if (threadIdx.x == 0) (void)xb_add(&bar[XB_XCNT(b.x)], 1u);
    return b;
}
__device__ __forceinline__ void xcd_barrier_complete(unsigned* bar, unsigned x, unsigned& nloc, unsigned& nx) {
    const unsigned G = gridDim.x * gridDim.y * gridDim.z;
    unsigned sum, cnt, mine, sp = 0u;
    for (;;) {
        sum = 0u; cnt = 0u; mine = 0u;
#pragma unroll
        for (unsigned j = 0; j < 16; ++j) { const unsigned c = xb_ld(&bar[XB_XCNT(j)]); sum += c; cnt += (c > 0u) ? 1u : 0u; mine = (j == x) ? c : mine; }
        if (sum == G) break;
        __builtin_amdgcn_s_sleep(1);
        if ((++sp & 255u) == 0u) { if (xb_ld(&bar[XB_TMO])) break; if (sp > XB_SPIN_CAP) { atomicAdd(&bar[XB_TMO], 1u); break; } }
    }
    nloc = mine > 0u ? mine : 1u; nx = cnt > 0u ? cnt : 1u;
}

__device__ __forceinline__ void xcd_barrier(const XcdBarrier& b) {
    asm volatile("s_waitcnt vmcnt(0)" ::: "memory");
    __syncthreads();
    if (threadIdx.x == 0) {
        unsigned* bar = b.bar;
        __builtin_amdgcn_s_waitcnt(0);
        unsigned nloc = b.st[0], nx = b.st[1];
        if (nloc == 0u) { xcd_barrier_complete(bar, b.x, nloc, nx); b.st[0] = nloc; b.st[1] = nx; }
        const unsigned old = xb_add(&bar[XB_XSUB(b.x)], 1u);
        const unsigned gen = old / nloc;
        if (old + 1u == (gen + 1u) * nloc) {
            __builtin_amdgcn_fence(__ATOMIC_RELEASE, "agent");
            asm volatile("s_waitcnt vmcnt(0)" ::: "memory");
            const unsigned og = xb_add(&bar[XB_TOP], 1u);
            const unsigned tg = og / nx;
            if (og + 1u == (tg + 1u) * nx) xb_add(&bar[XB_TOPGEN], 1u);
            else XB_SPIN(xb_ld(&bar[XB_TOPGEN]) == tg, bar);
            __builtin_amdgcn_fence(__ATOMIC_ACQUIRE, "agent");
            xb_add(&bar[XB_XGEN(b.x)], 1u);
            asm volatile("s_waitcnt vmcnt(0)" ::: "memory");
        } else {
            XB_SPIN(xb_ld(&bar[XB_XGEN(b.x)]) == gen, bar);
            __builtin_amdgcn_fence(__ATOMIC_ACQUIRE, "agent");
            asm volatile("s_waitcnt vmcnt(0)" ::: "memory");
        }
    }
    __syncthreads();
}

__device__ __forceinline__ void transpose_item(const float* W, const float* gain, int K, int N, bf16_t* WT, LAS float* scr, int item, int lane) {
    const int nblk = N / 64, kb = item / nblk, nb = item % nblk, k0 = 64 * kb, n0 = 64 * nb;
    const int lr = lane >> 4, lc = (lane & 15) * 4;
    f32x4 v[16];
#pragma unroll
    for (int i = 0; i < 16; ++i) v[i] = *(const f32x4*)(W + (size_t)(k0 + 4 * i + lr) * N + n0 + lc);
#pragma unroll
    for (int i = 0; i < 16; ++i) { const int kk = 4 * i + lr; const float g = gain ? gain[k0 + kk] : 1.f; LAS float* d = scr + kk * 65 + lc;
        d[0] = v[i].x * g; d[1] = v[i].y * g; d[2] = v[i].z * g; d[3] = v[i].w * g; }
    LDS_WAIT(); asm volatile("" ::: "memory");
#pragma unroll
    for (int c = 0; c < 8; ++c) { const LAS float* sp = scr + (8 * c) * 65 + lane;
        u32x4 o; o.x = pk2(sp[0 * 65], sp[1 * 65]); o.y = pk2(sp[2 * 65], sp[3 * 65]); o.z = pk2(sp[4 * 65], sp[5 * 65]); o.w = pk2(sp[6 * 65], sp[7 * 65]);
        *(u32x4*)(WT + (size_t)(n0 + lane) * K + k0 + 8 * c) = o; }
    LDS_WAIT(); asm volatile("" ::: "memory");
}
__device__ __forceinline__ void rms_row_to_bf16(const float* xrow, bf16_t* orow, int lane) {
    const f32x4* xr = (const f32x4*)xrow + lane;
    f32x4 v[8]; float s = 0.f;
#pragma unroll
    for (int j = 0; j < 8; ++j) { v[j] = xr[64 * j]; s += (v[j].x * v[j].x + v[j].y * v[j].y) + (v[j].z * v[j].z + v[j].w * v[j].w); }
    const float rs = rsqrtf(wave_sum(s) * (1.f / DM) + 1e-6f);
    u32x2* o8 = (u32x2*)orow + lane;
#pragma unroll
    for (int j = 0; j < 8; ++j) { u32x2 w; w.x = pk2(v[j].x * rs, v[j].y * rs); w.y = pk2(v[j].z * rs, v[j].w * rs); o8[64 * j] = w; }
}
__device__ __forceinline__ void s5_tables(const Ctx& C, const AP& a);
typedef float v16f_t __attribute__((ext_vector_type(16)));
typedef float v32f_t __attribute__((ext_vector_type(32)));
typedef unsigned v6u_t __attribute__((ext_vector_type(6)));
constexpr int EROW = 1536; constexpr size_t ETAB = (size_t)16384 * EROW;
__device__ __forceinline__ void expert_row_pack(const AP& a, int which, int l, int e, int lane, const f32x4 (&v)[8], float mx) {
    unsigned char* ws = a.ws;
    if (which) {
        const float sc4 = mx > 0.f ? 6.f / mx : 1.f;
        unsigned wv[4];
#pragma unroll
        for (int d4 = 0; d4 < 4; ++d4) { unsigned w_ = 0u;
            w_ = __builtin_amdgcn_cvt_scalef32_pk_fp4_f32(w_, v[2 * d4].x * sc4, v[2 * d4].y * sc4, 1.0f, 0); w_ = __builtin_amdgcn_cvt_scalef32_pk_fp4_f32(w_, v[2 * d4].z * sc4, v[2 * d4].w * sc4, 1.0f, 1);
            w_ = __builtin_amdgcn_cvt_scalef32_pk_fp4_f32(w_, v[2 * d4 + 1].x * sc4, v[2 * d4 + 1].y * sc4, 1.0f, 2); w_ = __builtin_amdgcn_cvt_scalef32_pk_fp4_f32(w_, v[2 * d4 + 1].z * sc4, v[2 * d4 + 1].w * sc4, 1.0f, 3);
            wv[d4] = w_; }
        ((u32x4*)(ws + WS_UB + 64 * MiB + (size_t)l * 16 * MiB + (size_t)e * 1024))[lane] = (u32x4){wv[0], wv[1], wv[2], wv[3]};
        if (lane == 0) ((float*)(ws + WS_VB))[(2 + l) * 16384 + e] = mx > 0.f ? mx * (1.f / 6.f) : 1.f;
        return;
    }
    if (true) {
        const float sc4 = mx > 0.f ? 6.f / mx : 1.f;
        unsigned wv[4];
#pragma unroll
        for (int d4 = 0; d4 < 4; ++d4) { unsigned w_ = 0u;
            w_ = __builtin_amdgcn_cvt_scalef32_pk_fp4_f32(w_, v[2 * d4].x * sc4, v[2 * d4].y * sc4, 1.0f, 0); w_ = __builtin_amdgcn_cvt_scalef32_pk_fp4_f32(w_, v[2 * d4].z * sc4, v[2 * d4].w * sc4, 1.0f, 1);
            w_ = __builtin_amdgcn_cvt_scalef32_pk_fp4_f32(w_, v[2 * d4 + 1].x * sc4, v[2 * d4 + 1].y * sc4, 1.0f, 2); w_ = __builtin_amdgcn_cvt_scalef32_pk_fp4_f32(w_, v[2 * d4 + 1].z * sc4, v[2 * d4 + 1].w * sc4, 1.0f, 3);
            wv[d4] = w_; }
        ((u32x4*)(ws + WS_UB + (size_t)l * ETAB + (size_t)e * 1024))[lane] = (u32x4){wv[0], wv[1], wv[2], wv[3]};
        if (lane == 0) ((float*)(ws + WS_VB))[(0 * 2 + l) * 16384 + e] = mx > 0.f ? mx * (1.f / 6.f) : 1.f;
        return;
    }
    const float sc = mx > 0.f ? 7.f / mx : 1.f;
    typedef unsigned v16u_t __attribute__((ext_vector_type(16))); typedef __bf16 v32bf_t __attribute__((ext_vector_type(32)));
    v16u_t pw;
#pragma unroll
    for (int j = 0; j < 8; ++j) { pw[j * 2] = pk2(v[j].x * sc, v[j].y * sc); pw[j * 2 + 1] = pk2(v[j].z * sc, v[j].w * sc); }
    const v6u_t w = __builtin_amdgcn_cvt_scalef32_pk32_fp6_bf16(__builtin_bit_cast(v32bf_t, pw), 1.0f);
    unsigned char* row = ws + WS_UB + (size_t)l * ETAB + (size_t)e * EROW;
    ((u32x4*)row)[lane] = (u32x4){w[0], w[1], w[2], w[3]}; ((u32x2*)(row + 1024))[lane] = (u32x2){w[4], w[5]};
    if (lane == 0) ((float*)(ws + WS_VB))[(0 * 2 + l) * 16384 + e] = mx > 0.f ? mx * (1.f / 7.f) : 1.f;
}
__device__ __forceinline__ void expert_row_item2(const AP& a, int which, int l, int e, int lane) {
    const f32x4* src = (const f32x4*)(a.in[which ? 35 : 34] + ((size_t)l * 16384 + e) * DM) + lane;
    const f32x4* gp = (const f32x4*)(a.in[31] + l * DM) + lane;
    f32x4 v0[8], v1[8]; float m0 = 0.f, m1 = 0.f;
#pragma unroll
    for (int j = 0; j < 8; ++j) { v0[j] = src[64 * j]; v1[j] = src[512 + 64 * j]; }
#pragma unroll
    for (int j = 0; j < 8; ++j) { if (!which) { const f32x4 g = gp[64 * j]; v0[j] = v0[j] * g; v1[j] = v1[j] * g; }
        m0 = fmaxf(m0, fmaxf(fmaxf(fabsf(v0[j].x), fabsf(v0[j].y)), fmaxf(fabsf(v0[j].z), fabsf(v0[j].w))));
        m1 = fmaxf(m1, fmaxf(fmaxf(fabsf(v1[j].x), fabsf(v1[j].y)), fmaxf(fabsf(v1[j].z), fabsf(v1[j].w)))); }
    m0 = wave_max(m0); m1 = wave_max(m1);
    expert_row_pack(a, which, l, e, lane, v0, m0); expert_row_pack(a, which, l, e + 1, lane, v1, m1);
}
__device__ __forceinline__ void phase_prep(const Ctx& C, const AP& a) {
    unsigned char* ws = a.ws;
    LAS float* scr = (LAS float*)(C.lds + C.wave * 16640);
    constexpr int I_IN = 32 * 64, I_OUT = 32 * 32, I_Q = 32 * 16, I_GLU = 8 * 8, I_L = I_IN + I_OUT + I_Q + I_GLU;
    for (int it = C.gw; it < 2 * I_L; it += C.ngw) {
        const int l = it / I_L; int r = it % I_L;
        if (r < I_IN) { transpose_item(a.in[2] + (size_t)l * DM * PROJ, a.in[1] + l * DM, DM, PROJ, (bf16_t*)(ws + WS_WINT) + (size_t)l * PROJ * DM, scr, r, C.lane); continue; } r -= I_IN;
        if (r < I_OUT) { transpose_item(a.in[30] + (size_t)l * DM * DM, a.in[29] + l * DM, DM, DM, (bf16_t*)(ws + WS_WOUTT) + (size_t)l * DM * DM, scr, r, C.lane); continue; } r -= I_OUT;
        if (r < I_Q) { transpose_item(a.in[32] + (size_t)l * DM * 1024, a.in[31] + l * DM, DM, 1024, (bf16_t*)(ws + WS_WQT) + (size_t)l * 1024 * DM, scr, r, C.lane); continue; } r -= I_Q;
        transpose_item(a.in[12] + (size_t)l * 512 * 512, nullptr, 512, 512, (bf16_t*)(ws + WS_WGLUT) + (size_t)l * 512 * 512, scr, r, C.lane);
    }
    {
        LAS float* tc = (LAS float*)(C.lds + 8 * 16640); LAS float* ts = tc + 128;
        if (C.tid < 128) { tc[C.tid] = cospif((float)C.tid / 64.f); ts[C.tid] = sinpif((float)C.tid / 64.f); }
        __syncthreads();
        for (int it = C.bx * NTHR + C.tid; it < 2 * 4 * 32 * 512; it += C.G * NTHR) {
            const int cp = it & 511, ccg = (it >> 9) & 31, blk = (it >> 14) & 3, l = it >> 16;
            const float* fw = a.in[3] + (size_t)l * 512 * 512 + (size_t)blk * 128 * 512 + cp;
            float sc[4] = {0.f, 0.f, 0.f, 0.f}, ss[4] = {0.f, 0.f, 0.f, 0.f};
#pragma unroll 8
            for (int m = 0; m < 128; ++m) { const float f = fw[(size_t)m * 512];
#pragma unroll
                for (int r = 0; r < 4; ++r) { const int ix = (m * (ccg * 4 + r)) & 127; sc[r] += tc[ix] * f; ss[r] += ts[ix] * f; } }
            bf16_t* o = (bf16_t*)(ws + WS_WCST) + (size_t)l * 1024 * 512; const int c0 = blk * 128 + ccg * 4;
            u32x2 w; w.x = pk2(sc[0] * (1.f / 512.f), sc[1] * (1.f / 512.f)); w.y = pk2(sc[2] * (1.f / 512.f), sc[3] * (1.f / 512.f)); *(u32x2*)(o + (size_t)(2 * cp) * 512 + c0) = w;
            w.x = pk2(ss[0] * (1.f / 512.f), ss[1] * (1.f / 512.f)); w.y = pk2(ss[2] * (1.f / 512.f), ss[3] * (1.f / 512.f)); *(u32x2*)(o + (size_t)(2 * cp + 1) * 512 + c0) = w;
        }
    }
    for (int it = C.bx * NTHR + C.tid; it < 2048 * 256; it += C.G * NTHR) {
        const int k = it >> 8, j0 = (it & 255) * 8; float v[8];
#pragma unroll
        for (int e = 0; e < 8; ++e) { const int j = j0 + e, s = j <= 1024 ? j : j - 1024; const float x = (float)((k * s) & 2047) * (1.f / 1024.f); v[e] = (j <= 1024) ? cospif(x) : -sinpif(x); }
        u32x4 w; w.x = pk2(v[0], v[1]); w.y = pk2(v[2], v[3]); w.z = pk2(v[4], v[5]); w.w = pk2(v[6], v[7]);
        *(u32x4*)((bf16_t*)(ws + WS_DFT) + (size_t)k * 2048 + j0) = w;
    }
    for (int it = C.bx * NTHR + C.tid; it < 2 * 8 * 2 * 64 * 128; it += C.G * NTHR) {
        const int key = it & 127, d = (it >> 7) & 63, lhp = it >> 13;
        ((float*)(ws + WS_KEYST))[it] = a.in[33][((size_t)lhp * 128 + key) * 64 + d];
    }
    for (int it = C.bx * NTHR + C.tid; it < 2048 * 64; it += C.G * NTHR) {
        const int pos = it >> 6, j = it & 63; const float inv = powf(10000.f, -(float)(2 * (j & 31)) / 64.f);
        const float ang = (float)(j < 32 ? (pos >> 6) : (pos & 63)) * inv;
        ((float*)(ws + WS_ROPE))[it] = cosf(ang); ((float*)(ws + WS_ROPE))[2048 * 64 + it] = sinf(ang);
    }
    {
        bf16_t* W1T = (bf16_t*)(ws + WS_LORA); bf16_t* g2T = W1T + 2 * 224 * 512; bf16_t* w2T = g2T + 2 * 512 * 96; bf16_t* a2T = w2T + 2 * 2 * 512 * 32;
        for (int it = C.bx * NTHR + C.tid; it < 2 * 224 * 512; it += C.G * NTHR) {
            const int k = it & 511, j = (it >> 9) % 224, l = it / (224 * 512); float v;
            if (j < 96) v = a.in[22][((size_t)l * 512 + k) * 96 + j];
            else if (j < 160) v = a.in[17][((size_t)(l * 2 + ((j - 96) >> 5)) * 512 + k) * 32 + ((j - 96) & 31)];
            else v = a.in[20][((size_t)(l * 2 + ((j - 160) >> 5)) * 512 + k) * 32 + ((j - 160) & 31)];
            W1T[it] = (bf16_t)f2bf(v);
        }
        for (int it = C.bx * NTHR + C.tid; it < 2 * 512 * 96; it += C.G * NTHR) {
            const int j = it % 96, ch = (it / 96) & 511, l = it / (96 * 512);
            g2T[it] = (bf16_t)f2bf(a.in[23][((size_t)l * 96 + j) * 512 + ch]);
        }
        for (int it = C.bx * NTHR + C.tid; it < 2 * 2 * 512 * 32; it += C.G * NTHR) {
            const int j = it & 31, ch = (it >> 5) & 511, ld = it >> 14;
            w2T[it] = (bf16_t)f2bf(a.in[18][((size_t)ld * 32 + j) * 512 + ch]); a2T[it] = (bf16_t)f2bf(a.in[21][((size_t)ld * 32 + j) * 512 + ch]);
        }
    }
    for (int m = C.gw; m < MTOK; m += C.ngw) rms_row_to_bf16(a.in[0] + (size_t)m * DM, (bf16_t*)(ws + WS_HB) + (size_t)m * DM, C.lane);
}

__device__ __forceinline__ void qk_prep_token(const AP& a, int l, int m, int lane) {
    unsigned char* ws = a.ws;
    const float* pr = (const float*)(ws + WS_PROJ) + (size_t)m * PROJ;
    const int pos = m & (SEQ - 1);
    const float cs = ((const float*)(ws + WS_ROPE))[pos * 64 + lane], sn = ((const float*)(ws + WS_ROPE))[2048 * 64 + pos * 64 + lane];
    bf16_t* qo = (bf16_t*)(ws + WS_QB) + (size_t)m * 512; bf16_t* ko = (bf16_t*)(ws + WS_QB) + (size_t)MTOK * 512 + (size_t)m * 256; bf16_t* vo = ko + (size_t)MTOK * 256;
#pragma unroll
    for (int hh = 0; hh < 6; ++hh) {
        const float* src = pr + 1024 + hh * 128;
        const float* gn = a.in[hh < 4 ? 13 : 14] + l * 128;
        const float x1 = src[lane], x2 = src[lane + 64];
        const float rs = rsqrtf(wave_sum(x1 * x1 + x2 * x2) * (1.f / 128.f) + 1e-6f);
        const float y1 = x1 * rs * gn[lane], y2 = x2 * rs * gn[lane + 64];
        bf16_t* dst = hh < 4 ? qo + hh * 128 : ko + (hh - 4) * 128;
        dst[lane] = (bf16_t)f2bf(y1 * cs - y2 * sn); dst[lane + 64] = (bf16_t)f2bf(y1 * sn + y2 * cs);
    }
    const f32x4 vv = *((const f32x4*)(pr + 1792) + lane);
    u32x2 w; w.x = pk2(vv.x, vv.y); w.y = pk2(vv.z, vv.w); *((u32x2*)vo + lane) = w;
}

struct S5P { float lr, li, cr, ci; };
__device__ __forceinline__ S5P s5_params(const AP& a, int l, int d, int g, int p, float mult) {
    const int ix = ((l * 2 + d) * 32 + g) * 64 + p;
    const float lre = a.in[4][ix], lim = a.in[5][ix], step = __expf(a.in[6][(l * 2 + d) * 32 + g]) * mult;
    const float er = __expf(lre * step); float sn, cs; sincosf(lim * step, &sn, &cs);
    S5P r; r.lr = er * cs; r.li = er * sn;
    const float nr = r.lr - 1.f, ni = r.li, den = 1.f / (lre * lre + lim * lim);
    r.cr = (nr * lre + ni * lim) * den; r.ci = (ni * lre - nr * lim) * den;
    return r;
}
__device__ __forceinline__ void s5_ends_item(const AP& a, int l, int item, int lane, LAS float* us) {
    unsigned char* ws = a.ws;
    const int c = item & 31, g = (item >> 5) & 31, b = item >> 10, p = lane;
    const float* ur = (const float*)(ws + WS_PROJ) + ((size_t)(b * SEQ + c * 64 + lane)) * PROJ + 512 + g * 16;
#pragma unroll
    for (int q = 0; q < 4; ++q) *((LAS f32x4*)(us + lane * 16) + q) = *((const f32x4*)ur + q);
    LDS_WAIT(); asm volatile("" ::: "memory");
#pragma unroll 1
    for (int d = 0; d < 2; ++d) {
        const S5P P = s5_params(a, l, d, g, p, 1.f);
        f32x2 bb2[16];
        const float* bre = a.in[7] + ((size_t)((l * 2 + d) * 32 + g) * 64 + p) * 16; const float* bim = a.in[8] + ((size_t)((l * 2 + d) * 32 + g) * 64 + p) * 16;
#pragma unroll
        for (int h = 0; h < 16; ++h) { const float x = bre[h], y = bim[h]; bb2[h].x = P.cr * x - P.ci * y; bb2[h].y = P.cr * y + P.ci * x; }
        const f32x2 lam2 = {P.lr, P.lr}, lami = {-P.li, P.li};
        float xr = 0.f, xi = 0.f;
#pragma unroll 4
        for (int tt = 0; tt < 64; ++tt) {
            const int t = d ? 63 - tt : tt;
            f32x2 acc2 = {0.f, 0.f};
#pragma unroll
            for (int q = 0; q < 4; ++q) { const f32x4 u4 = *((const LAS f32x4*)(us + t * 16) + q);
#pragma unroll
                for (int e = 0; e < 4; ++e) acc2 += bb2[q * 4 + e] * u4[e]; }
            const f32x2 x2 = {xr, xi}, xs = {xi, xr}; const f32x2 n2 = lam2 * x2 + lami * xs + acc2; xr = n2.x; xi = n2.y;
        }
        f32x2 o; o.x = xr; o.y = xi;
        ((f32x2*)(ws + WS_S5E))[((size_t)((b * 32 + g) * 2 + d) * 32 + c) * 64 + p] = o;
    }
    LDS_WAIT(); asm volatile("" ::: "memory");
}
__device__ __forceinline__ void s5_final_item(const AP& a, int l, int item, int lane, LAS float* us  , LAS float* yb  , LAS float* X  ) {
    unsigned char* ws = a.ws;
    const int c = item & 31, g = (item >> 5) & 31, b = item >> 10, p = lane;
    const float* ur = (const float*)(ws + WS_PROJ) + ((size_t)(b * SEQ + c * 64 + lane)) * PROJ + 512 + g * 16;
#pragma unroll
    for (int q = 0; q < 4; ++q) { *((LAS f32x4*)(us + lane * 16) + q) = *((const f32x4*)ur + q); *((LAS f32x4*)(yb + lane * 16) + q) = (f32x4){0.f, 0.f, 0.f, 0.f}; }
    LDS_WAIT(); asm volatile("" ::: "memory");
    const int oh = lane & 15, otq = lane >> 4;
#pragma unroll 1
    for (int d = 0; d < 2; ++d) {
        const S5P P = s5_params(a, l, d, g, p, 1.f);
        const S5P P64 = s5_params(a, l, d, g, p, 64.f);
        float br[16], bi[16];
        const float* bre = a.in[7] + ((size_t)((l * 2 + d) * 32 + g) * 64 + p) * 16; const float* bim = a.in[8] + ((size_t)((l * 2 + d) * 32 + g) * 64 + p) * 16;
#pragma unroll
        for (int h = 0; h < 16; ++h) { const float x = bre[h], y = bim[h]; br[h] = P.cr * x - P.ci * y; bi[h] = P.cr * y + P.ci * x; }
        const f32x2* E = (const f32x2*)(ws + WS_S5E) + ((size_t)((b * 32 + g) * 2 + d) * 32) * 64 + p;
        float xr = 0.f, xi = 0.f;
        { f32x2 nx[4];
#pragma unroll
          for (int i = 0; i < 4; ++i) nx[i] = E[(d ? 31 - i : i) * 64];
#pragma unroll 1
          for (int grp = 0; grp < 8; ++grp) {
              if (d ? (31 - grp * 4 <= c) : (grp * 4 >= c)) break;
              f32x2 cu[4];
#pragma unroll
              for (int i = 0; i < 4; ++i) cu[i] = nx[i];
              if (grp < 7) {
#pragma unroll
                  for (int i = 0; i < 4; ++i) nx[i] = E[(d ? 27 - grp * 4 - i : grp * 4 + 4 + i) * 64];
              }
#pragma unroll
              for (int i = 0; i < 4; ++i) { const int cc = d ? 31 - grp * 4 - i : grp * 4 + i;
                  if (d ? (cc > c) : (cc < c)) { const float nr = P64.lr * xr - P64.li * xi + cu[i].x, ni = P64.lr * xi + P64.li * xr + cu[i].y; xr = nr; xi = ni; } }
          } }
        const float* cre = a.in[9] + ((size_t)((l * 2 + d) * 32 + g) * 16 + oh) * 64; const float* cim = a.in[10] + ((size_t)((l * 2 + d) * 32 + g) * 16 + oh) * 64;
#pragma unroll 1
        for (int sb = 0; sb < 4; ++sb) {
            for (int tt = 0; tt < 16; ++tt) {
                const int ts = sb * 16 + tt, t = d ? 63 - ts : ts;
                float ar = 0.f, ai = 0.f;
#pragma unroll
                for (int q = 0; q < 4; ++q) { const f32x4 u4 = *((const LAS f32x4*)(us + t * 16) + q);
#pragma unroll
                    for (int e = 0; e < 4; ++e) { ar += br[q * 4 + e] * u4[e]; ai += bi[q * 4 + e] * u4[e]; } }
                const float nr = P.lr * xr - P.li * xi + ar, ni = P.lr * xi + P.li * xr + ai; xr = nr; xi = ni;
                f32x2 o; o.x = xr; o.y = xi; *((LAS f32x2*)X + tt * 64 + p) = o;
            }
            LDS_WAIT(); asm volatile("" ::: "memory");
            float acc[4] = {0.f, 0.f, 0.f, 0.f};
            for (int pq = 0; pq < 16; ++pq) {
                const f32x4 c4r = *((const f32x4*)cre + pq), c4i = *((const f32x4*)cim + pq);
#pragma unroll
                for (int i = 0; i < 4; ++i) {
                    const LAS f32x4* xp = (const LAS f32x4*)(X + ((otq * 4 + i) * 64 + pq * 4) * 2);
                    const f32x4 xa = xp[0], xb = xp[1];
                    acc[i] += c4r[0] * xa[0] - c4i[0] * xa[1] + c4r[1] * xa[2] - c4i[1] * xa[3] + c4r[2] * xb[0] - c4i[2] * xb[1] + c4r[3] * xb[2] - c4i[3] * xb[3];
                }
            }
#pragma unroll
            for (int i = 0; i < 4; ++i) { const int ts = sb * 16 + otq * 4 + i, t = d ? 63 - ts : ts; yb[t * 16 + oh] += acc[i]; }
            LDS_WAIT(); asm volatile("" ::: "memory");
        }
    }
    const float* dsk = a.in[11] + (l * 32 + g) * 16;
    unsigned w[8];
#pragma unroll
    for (int h = 0; h < 16; h += 2) {
        const float y0 = gelu_tanh(yb[lane * 16 + h] + dsk[h] * us[lane * 16 + h]), y1 = gelu_tanh(yb[lane * 16 + h + 1] + dsk[h + 1] * us[lane * 16 + h + 1]);
        w[h >> 1] = pk2(y0, y1);
    }
    u32x4* dst = (u32x4*)((bf16_t*)(ws + WS_YGELU) + (size_t)(b * SEQ + c * 64 + lane) * 512 + g * 16);
    dst[0] = (u32x4){w[0], w[1], w[2], w[3]}; dst[1] = (u32x4){w[4], w[5], w[6], w[7]};
    LDS_WAIT(); asm volatile("" ::: "memory");
}

__device__ __forceinline__ void s5_tables(const Ctx& C, const AP& a) {
    unsigned char* ws = a.ws;
    f32x4* LAMT = (f32x4*)(ws + WS_S5T); bf16_t* BBop = (bf16_t*)(ws + WS_S5T + 131072); bf16_t* CBop = (bf16_t*)(ws + WS_S5T + 131072 + 1048576);
    for (int it = C.bx * NTHR + C.tid; it < 128 * 64; it += C.G * NTHR) {
        const int p = it & 63, ldg = it >> 6, g = ldg & 31, d = (ldg >> 5) & 1, l = ldg >> 6;
        const S5P P = s5_params(a, l, d, g, p, 1.f), P64 = s5_params(a, l, d, g, p, 64.f);
        LAMT[it] = (f32x4){P.lr, P.li, P64.lr, P64.li};
    }
    for (int it = C.bx * NTHR + C.tid; it < 128 * 8 * 64; it += C.G * NTHR) {
        const int lane = it & 63, nt = (it >> 6) & 7, ldg = it >> 9, g = ldg & 31, d = (ldg >> 5) & 1, l = ldg >> 6, fr = lane & 15, fq = lane >> 4;
        const int col = nt * 16 + fr, p = col >> 1, ri = col & 1;
        unsigned w[4] = {0u, 0u, 0u, 0u};
        if (fq < 2) {
            const S5P P = s5_params(a, l, d, g, p, 1.f);
            const float* bre = a.in[7] + ((size_t)ldg * 64 + p) * 16 + fq * 8; const float* bim = a.in[8] + ((size_t)ldg * 64 + p) * 16 + fq * 8;
            float v[8];
#pragma unroll
            for (int jj = 0; jj < 8; ++jj) v[jj] = ri ? (P.cr * bim[jj] + P.ci * bre[jj]) : (P.cr * bre[jj] - P.ci * bim[jj]);
            w[0] = pk2(v[0], v[1]); w[1] = pk2(v[2], v[3]); w[2] = pk2(v[4], v[5]); w[3] = pk2(v[6], v[7]);
        }
        *(u32x4*)(BBop + (size_t)it * 8) = (u32x4){w[0], w[1], w[2], w[3]};
    }
    for (int it = C.bx * NTHR + C.tid; it < 128 * 4 * 64; it += C.G * NTHR) {
        const int lane = it & 63, s2 = (it >> 6) & 3, ldg = it >> 8, fr = lane & 15, fq = lane >> 4;
        const float* cre = a.in[9] + ((size_t)ldg * 16 + fr) * 64 + 16 * s2 + fq * 4; const float* cim = a.in[10] + ((size_t)ldg * 16 + fr) * 64 + 16 * s2 + fq * 4;
        *(u32x4*)(CBop + (size_t)it * 8) = (u32x4){pk2(cre[0], -cim[0]), pk2(cre[1], -cim[1]), pk2(cre[2], -cim[2]), pk2(cre[3], -cim[3])};
    }
}
__device__ __forceinline__ void s5_load_u(const float* ur, LAS unsigned char* wl, int lane) {
    const f32x4 u0 = *((const f32x4*)ur + 0), u1 = *((const f32x4*)ur + 1), u2 = *((const f32x4*)ur + 2), u3 = *((const f32x4*)ur + 3);
    LAS u32x4* dst = (LAS u32x4*)(wl + lane * 32);
    dst[0] = (u32x4){pk2(u0.x, u0.y), pk2(u0.z, u0.w), pk2(u1.x, u1.y), pk2(u1.z, u1.w)}; dst[1] = (u32x4){pk2(u2.x, u2.y), pk2(u2.z, u2.w), pk2(u3.x, u3.y), pk2(u3.z, u3.w)};
}
__device__ __forceinline__ void s5_build_bb(const AP& a, int ldg, float cr, float ci, int lane, LAS unsigned char* wl, bf16x8_t (&bb)[8]) {
    const int fr = lane & 15, fq = lane >> 4;
    LAS f32x2* cf = (LAS f32x2*)(wl + 14848);
    f32x2 me; me.x = cr; me.y = ci; cf[lane] = me;
    LDS_WAIT(); asm volatile("" ::: "memory");
#pragma unroll
    for (int nt = 0; nt < 8; ++nt) {
        const int col = nt * 16 + fr, p = col >> 1, ri = col & 1;
        unsigned w_[4] = {0u, 0u, 0u, 0u};
        if (fq < 2) {
            const f32x2 c2 = cf[p];
            const f32x4* bre = (const f32x4*)(a.in[7] + ((size_t)ldg * 64 + p) * 16 + fq * 8); const f32x4* bim = (const f32x4*)(a.in[8] + ((size_t)ldg * 64 + p) * 16 + fq * 8);
            const f32x4 r0 = bre[0], r1 = bre[1], i0 = bim[0], i1 = bim[1];
            float v[8];
#pragma unroll
            for (int jj = 0; jj < 4; ++jj) { v[jj] = ri ? (c2.x * i0[jj] + c2.y * r0[jj]) : (c2.x * r0[jj] - c2.y * i0[jj]); v[4 + jj] = ri ? (c2.x * i1[jj] + c2.y * r1[jj]) : (c2.x * r1[jj] - c2.y * i1[jj]); }
            w_[0] = pk2(v[0], v[1]); w_[1] = pk2(v[2], v[3]); w_[2] = pk2(v[4], v[5]); w_[3] = pk2(v[6], v[7]);
        }
        bb[nt] = mk8(w_[0], w_[1], w_[2], w_[3]);
        asm volatile("" ::: "memory");
    }
}
template <bool FINAL>
__device__ __forceinline__ void s5_subblock(LAS unsigned char* wl, const bf16x8_t (&bb)[8], int d, int sb, int lane, float lr, float li, float& xr, float& xi) {
    const int fr = lane & 15, fq = lane >> 4;
    LAS float* BUs = (LAS float*)(wl + 2048); LAS bf16_t* Xb = (LAS bf16_t*)(wl + 10496);
    const int trow = d ? 63 - (sb * 16 + fr) : sb * 16 + fr;
    bf16x8_t aU = mk8(0u, 0u, 0u, 0u);
    if (fq < 2) aU = *(const LAS bf16x8_t*)(wl + trow * 32 + fq * 16);
    const f32x4 z4 = {0.f, 0.f, 0.f, 0.f};
#pragma unroll
    for (int nt = 0; nt < 8; ++nt) { const f32x4 bu = __builtin_amdgcn_mfma_f32_16x16x32_bf16(aU, bb[nt], z4, 0, 0, 0);
#pragma unroll
        for (int r = 0; r < 4; ++r) BUs[(fq * 4 + r) * 132 + nt * 16 + fr] = bu[r]; }
    LDS_WAIT(); asm volatile("" ::: "memory");
#pragma unroll
    for (int tt = 0; tt < 16; ++tt) {
        const f32x2 bq = *(const LAS f32x2*)(BUs + tt * 132 + 2 * lane);
        const float nr = lr * xr - li * xi + bq.x, ni = lr * xi + li * xr + bq.y; xr = nr; xi = ni;
        if (FINAL) *(LAS unsigned*)(Xb + (d ? 15 - tt : tt) * 136 + 2 * lane) = pk2(xr, xi);
    }
    LDS_WAIT(); asm volatile("" ::: "memory");
}
__device__ __forceinline__ void s5_ends_item_m(const AP& a, int l, int item, int lane, LAS unsigned char* wl) {
    unsigned char* ws = a.ws;
    const int c = item & 31, g = (item >> 5) & 31, b = item >> 10;
    s5_load_u((const float*)(ws + WS_PROJ) + ((size_t)(b * SEQ + c * 64 + lane)) * PROJ + 512 + g * 16, wl, lane);
    LDS_WAIT(); asm volatile("" ::: "memory");
#pragma unroll 1
    for (int d = 0; d < 2; ++d) {
        const int ldg = (l * 2 + d) * 32 + g;
        const S5P Pq = s5_params(a, l, d, g, lane, 1.f);
        const f32x4 lam = {Pq.lr, Pq.li, 0.f, 0.f};
        bf16x8_t bb[8]; s5_build_bb(a, ldg, Pq.cr, Pq.ci, lane, wl, bb);
        float xr = 0.f, xi = 0.f;
#pragma unroll 1
        for (int sb = 0; sb < 4; ++sb) s5_subblock<false>(wl, bb, d, sb, lane, lam[0], lam[1], xr, xi);
        f32x2 o; o.x = xr; o.y = xi;
        ((f32x2*)(ws + WS_S5E))[((size_t)((b * 32 + g) * 2 + d) * 32 + c) * 64 + lane] = o;
    }
}
__device__ __forceinline__ void s5_final_item_m(const AP& a, int l, int item, int lane, LAS unsigned char* wl) {
    unsigned char* ws = a.ws;
    const int c = item & 31, g = (item >> 5) & 31, b = item >> 10, fr = lane & 15, fq = lane >> 4;
    const float* ubase = (const float*)(ws + WS_PROJ) + ((size_t)(b * SEQ + c * 64)) * PROJ + 512 + g * 16;
    s5_load_u(ubase + (size_t)lane * PROJ, wl, lane);
    LDS_WAIT(); asm volatile("" ::: "memory");
    LAS bf16_t* Xb = (LAS bf16_t*)(wl + 10496);
    f32x4 yacc[4];
#pragma unroll
    for (int q = 0; q < 4; ++q) yacc[q] = (f32x4){0.f, 0.f, 0.f, 0.f};
#pragma unroll 1
    for (int d = 0; d < 2; ++d) {
        const int ldg = (l * 2 + d) * 32 + g;
        const S5P Pq = s5_params(a, l, d, g, lane, 1.f), P64 = s5_params(a, l, d, g, lane, 64.f);
        const f32x4 lam = {Pq.lr, Pq.li, P64.lr, P64.li};
        bf16x8_t bb[8], cb[4]; s5_build_bb(a, ldg, Pq.cr, Pq.ci, lane, wl, bb);
#pragma unroll
        for (int s2 = 0; s2 < 4; ++s2) {
            const f32x4 cr4 = *(const f32x4*)(a.in[9] + ((size_t)ldg * 16 + fr) * 64 + 16 * s2 + fq * 4), ci4 = *(const f32x4*)(a.in[10] + ((size_t)ldg * 16 + fr) * 64 + 16 * s2 + fq * 4);
            cb[s2] = mk8(pk2(cr4[0], -ci4[0]), pk2(cr4[1], -ci4[1]), pk2(cr4[2], -ci4[2]), pk2(cr4[3], -ci4[3])); }
        const f32x2* E = (const f32x2*)(ws + WS_S5E) + ((size_t)((b * 32 + g) * 2 + d) * 32) * 64 + lane;
        float xr = 0.f, xi = 0.f;
        { f32x2 nx[4];
#pragma unroll
          for (int i = 0; i < 4; ++i) nx[i] = E[(d ? 31 - i : i) * 64];
#pragma unroll 1
          for (int grp = 0; grp < 8; ++grp) {
              if (d ? (31 - grp * 4 <= c) : (grp * 4 >= c)) break;
              f32x2 cu[4];
#pragma unroll
              for (int i = 0; i < 4; ++i) cu[i] = nx[i];
              if (grp < 7) {
#pragma unroll
                  for (int i = 0; i < 4; ++i) nx[i] = E[(d ? 27 - grp * 4 - i : grp * 4 + 4 + i) * 64];
              }
#pragma unroll
              for (int i = 0; i < 4; ++i) { const int cc = d ? 31 - grp * 4 - i : grp * 4 + i;
                  if (d ? (cc > c) : (cc < c)) { const float nr = lam[2] * xr - lam[3] * xi + cu[i].x, ni = lam[2] * xi + lam[3] * xr + cu[i].y; xr = nr; xi = ni; } }
          } }
#pragma unroll
        for (int sb = 0; sb < 4; ++sb) {
            s5_subblock<true>(wl, bb, d, sb, lane, lam[0], lam[1], xr, xi);
            f32x4 acc = d ? yacc[3 - sb] : yacc[sb];
#pragma unroll
            for (int s2 = 0; s2 < 4; ++s2) acc = __builtin_amdgcn_mfma_f32_16x16x32_bf16(*(const LAS bf16x8_t*)(Xb + fr * 136 + s2 * 32 + fq * 8), cb[s2], acc, 0, 0, 0);
            if (d) yacc[3 - sb] = acc; else yacc[sb] = acc;
            LDS_WAIT(); asm volatile("" ::: "memory");
        }
    }
    const float dsk = a.in[11][(l * 32 + g) * 16 + fr];
#pragma unroll
    for (int q = 0; q < 4; ++q)
#pragma unroll
        for (int r = 0; r < 4; ++r) { const int t = q * 16 + fq * 4 + r;
            const float y = gelu_tanh(yacc[q][r] + dsk * ubase[(size_t)t * PROJ + fr]);
            ((bf16_t*)(ws + WS_YGELU))[(size_t)(b * SEQ + c * 64 + t) * 512 + g * 16 + fr] = (bf16_t)f2bf(y); }
}
__device__ __forceinline__ float gelu_tanh_fast(float x) { const float u2 = 1.5957691216057308f * (x + 0.044715f * x * x * x); return x / (1.f + __expf(-u2)); }
__device__ __forceinline__ void s5_final_item_h(const AP& a, int l, int item, int lane, LAS unsigned char* wl) {
    unsigned char* ws = a.ws;
    const int c = item & 31, g = (item >> 5) & 31, b = item >> 10, p = lane, fr = lane & 15, fq = lane >> 4;
    LAS float* us = (LAS float*)wl; LAS bf16_t* Xb = (LAS bf16_t*)(wl + 4096);
    const float* ur = (const float*)(ws + WS_PROJ) + ((size_t)(b * SEQ + c * 64 + lane)) * PROJ + 512 + g * 16;
#pragma unroll
    for (int q = 0; q < 4; ++q) *((LAS f32x4*)(us + lane * 16) + q) = *((const f32x4*)ur + q);
    LDS_WAIT(); asm volatile("" ::: "memory");
    f32x4 yacc[4];
#pragma unroll
    for (int q = 0; q < 4; ++q) yacc[q] = (f32x4){0.f, 0.f, 0.f, 0.f};
#pragma unroll 1
    for (int d = 0; d < 2; ++d) {
        const int ldg = (l * 2 + d) * 32 + g;
        const S5P P = s5_params(a, l, d, g, p, 1.f), P64 = s5_params(a, l, d, g, p, 64.f);
        f32x2 bb2[16];
        const float* bre = a.in[7] + ((size_t)ldg * 64 + p) * 16; const float* bim = a.in[8] + ((size_t)ldg * 64 + p) * 16;
#pragma unroll
        for (int h = 0; h < 16; ++h) { const float x = bre[h], y = bim[h]; bb2[h].x = P.cr * x - P.ci * y; bb2[h].y = P.cr * y + P.ci * x; }
        const f32x2 lam2 = {P.lr, P.lr}, lami = {-P.li, P.li};
        bf16x8_t cb[4];
#pragma unroll
        for (int s2 = 0; s2 < 4; ++s2) {
            const f32x4 cr4 = *(const f32x4*)(a.in[9] + ((size_t)ldg * 16 + fr) * 64 + 16 * s2 + fq * 4), ci4 = *(const f32x4*)(a.in[10] + ((size_t)ldg * 16 + fr) * 64 + 16 * s2 + fq * 4);
            cb[s2] = mk8(pk2(cr4[0], -ci4[0]), pk2(cr4[1], -ci4[1]), pk2(cr4[2], -ci4[2]), pk2(cr4[3], -ci4[3])); }
        const f32x2* E = (const f32x2*)(ws + WS_S5E) + ((size_t)((b * 32 + g) * 2 + d) * 32) * 64 + p;
        float xr = 0.f, xi = 0.f;
        { f32x2 nx[4];
#pragma unroll
          for (int i = 0; i < 4; ++i) nx[i] = E[(d ? 31 - i : i) * 64];
#pragma unroll 1
          for (int grp = 0; grp < 8; ++grp) {
              if (d ? (31 - grp * 4 <= c) : (grp * 4 >= c)) break;
              f32x2 cu[4];
#pragma unroll
              for (int i = 0; i < 4; ++i) cu[i] = nx[i];
              if (grp < 7) {
#pragma unroll
                  for (int i = 0; i < 4; ++i) nx[i] = E[(d ? 27 - grp * 4 - i : grp * 4 + 4 + i) * 64];
              }
#pragma unroll
              for (int i = 0; i < 4; ++i) { const int cc = d ? 31 - grp * 4 - i : grp * 4 + i;
                  if (d ? (cc > c) : (cc < c)) { const float nr = P64.lr * xr - P64.li * xi + cu[i].x, ni = P64.lr * xi + P64.li * xr + cu[i].y; xr = nr; xi = ni; } }
          } }
#pragma unroll
        for (int sb = 0; sb < 4; ++sb) {
#pragma unroll 4
            for (int tt = 0; tt < 16; ++tt) {
                const int ts = sb * 16 + tt, t = d ? 63 - ts : ts;
                f32x2 acc2 = {0.f, 0.f};
#pragma unroll
                for (int q = 0; q < 4; ++q) { const f32x4 u4 = *((const LAS f32x4*)(us + t * 16) + q);
#pragma unroll
                    for (int e = 0; e < 4; ++e) acc2 += bb2[q * 4 + e] * u4[e]; }
                { const f32x2 x2 = {xr, xi}, xs = {xi, xr}; const f32x2 n2 = lam2 * x2 + lami * xs + acc2; xr = n2.x; xi = n2.y; }
                *(LAS unsigned*)(Xb + (d ? 15 - tt : tt) * 136 + 2 * p) = pg8::cvt_pk_bf16(xr, xi);
            }
            LDS_WAIT(); asm volatile("" ::: "memory");
            f32x4 acc = d ? yacc[3 - sb] : yacc[sb];
#pragma unroll
            for (int s2 = 0; s2 < 4; ++s2) acc = __builtin_amdgcn_mfma_f32_16x16x32_bf16(*(const LAS bf16x8_t*)(Xb + fr * 136 + s2 * 32 + fq * 8), cb[s2], acc, 0, 0, 0);
            if (d) yacc[3 - sb] = acc; else yacc[sb] = acc;
            LDS_WAIT(); asm volatile("" ::: "memory");
        }
    }
    const float dsk = a.in[11][(l * 32 + g) * 16 + fr];
#pragma unroll
    for (int q = 0; q < 4; ++q)
#pragma unroll
        for (int r = 0; r < 4; ++r) { const int t = q * 16 + fq * 4 + r;
            const float y = gelu_tanh_fast(yacc[q][r] + dsk * us[t * 16 + fr]);
            ((bf16_t*)(ws + WS_YGELU))[(size_t)(b * SEQ + c * 64 + t) * 512 + g * 16 + fr] = (bf16_t)f2bf(y); }
    LDS_WAIT(); asm volatile("" ::: "memory");
}
__device__ __forceinline__ float shift3(float p, float c, float n, float m0, float m1) { return c + (p - c) * m0 + (n - c) * m1; }
__device__ __forceinline__ float dpp_ror4(float x) { return __builtin_bit_cast(float, __builtin_amdgcn_update_dpp(0, __builtin_bit_cast(int, x), 0x124, 0xF, 0xF, true)); }
__device__ __forceinline__ float dpp_ror8(float x) { return __builtin_bit_cast(float, __builtin_amdgcn_update_dpp(0, __builtin_bit_cast(int, x), 0x128, 0xF, 0xF, true)); }
__device__ __forceinline__ float dpp_q1(float x) { return __builtin_bit_cast(float, __builtin_amdgcn_update_dpp(0, __builtin_bit_cast(int, x), 0xB1, 0xF, 0xF, true)); }
__device__ __forceinline__ float dpp_q2(float x) { return __builtin_bit_cast(float, __builtin_amdgcn_update_dpp(0, __builtin_bit_cast(int, x), 0x4E, 0xF, 0xF, true)); }
__device__ __forceinline__ float row_sum16(float x) { x += dpp_q1(x); x += dpp_q2(x); x += dpp_ror4(x); x += dpp_ror8(x); return x; }
__device__ __forceinline__ void rwkv_prep_item(const Ctx& C, const AP& a, int l, int ti) {
    unsigned char* ws = a.ws;
    LAS bf16_t* zsb = (LAS bf16_t*)C.lds;
    LAS bf16_t* hidb = (LAS bf16_t*)(C.lds + 33280);
    const float* proj = (const float*)(ws + WS_PROJ);
    const int m0 = ti * 32, s0 = m0 & (SEQ - 1), tid = C.tid, lane = C.lane, w = C.wave;
    const float* mu = a.in[15] + (size_t)l * 4 * 2 * 512;
    float* RW = (float*)(ws + WS_RW); float* KS = (float*)(ws + WS_KS);
    {
        const int c = tid;
        const float mr0 = mu[0 * 512 + c], mr1 = mu[1 * 512 + c], mk0 = mu[2 * 512 + c], mk1 = mu[3 * 512 + c], mv0 = mu[4 * 512 + c], mv1 = mu[5 * 512 + c], mz0 = mu[6 * 512 + c], mz1 = mu[7 * 512 + c];
        const float kk_c = a.in[24][l * 512 + c];
#pragma unroll 1
        for (int hf = 0; hf < 2; ++hf) {
            const int tb0 = hf * 16;
            const float* rp = proj + (size_t)(m0 + tb0) * PROJ + 2048 + c;
            float rr[18], kr[18], vr[18], zr[18];
#pragma unroll
            for (int i = 0; i < 18; ++i) {
                const int sq = s0 + tb0 - 1 + i; const bool ok = (sq >= 0) && (sq < SEQ); const float* q = rp + (long)(i - 1) * PROJ;
                rr[i] = ok ? q[0] : 0.f; kr[i] = ok ? q[512] : 0.f; vr[i] = ok ? q[1024] : 0.f; zr[i] = ok ? q[1536] : 0.f;
            }
#pragma unroll
            for (int t = 0; t < 16; ++t) {
                const float rs = shift3(rr[t], rr[t + 1], rr[t + 2], mr0, mr1), ks = shift3(kr[t], kr[t + 1], kr[t + 2], mk0, mk1);
                const float vs = shift3(vr[t], vr[t + 1], vr[t + 2], mv0, mv1), zs = shift3(zr[t], zr[t + 1], zr[t + 2], mz0, mz1);
                const float kkr = ks * kk_c; const float kkn = kkr * rsqrtf(wave_sum(kkr * kkr) + 1e-12f);
                const size_t o = (size_t)(m0 + tb0 + t) * 512 + c;
                RW[(size_t)RW_R * RWSZ + o] = rs; RW[(size_t)RW_V * RWSZ + o] = vs; RW[(size_t)RW_KK * RWSZ + o] = kkn; KS[o] = ks;
                zsb[(tb0 + t) * 520 + c] = (bf16_t)f2bf(zs);
            }
        }
    }
    __syncthreads();
    const int fr = lane & 15, fq = lane >> 4;
    const bf16_t* W1T = (const bf16_t*)(ws + WS_LORA) + (size_t)l * 224 * 512; const bf16_t* g2T = (const bf16_t*)(ws + WS_LORA) + 2 * 224 * 512 + (size_t)l * 512 * 96;
    const bf16_t* w2T = (const bf16_t*)(ws + WS_LORA) + 2 * 224 * 512 + 2 * 512 * 96 + (size_t)l * 2 * 512 * 32; const bf16_t* a2T = w2T + 2 * 2 * 512 * 32;
    for (int tile = w; tile < 28; tile += 8) {
        const int mt = tile / 14, nt = tile % 14;
        f32x4 acc = {0.f, 0.f, 0.f, 0.f};
        const LAS bf16_t* ap = zsb + (mt * 16 + fr) * 520 + fq * 8; const bf16_t* bp = W1T + (size_t)(nt * 16 + fr) * 512 + fq * 8;
#pragma unroll
        for (int kk = 0; kk < 16; ++kk) acc = __builtin_amdgcn_mfma_f32_16x16x32_bf16(*(const LAS bf16x8_t*)(ap + kk * 32), *(const bf16x8_t*)(bp + kk * 32), acc, 0, 0, 0);
        const int hj = nt * 16 + fr;
#pragma unroll
        for (int j = 0; j < 4; ++j) { float v = acc[j]; if (hj < 96) v = sigmoidf_(v); else if (hj < 160) v = tanhf(v); hidb[(mt * 16 + fq * 4 + j) * 240 + hj] = (bf16_t)f2bf(v); }
    }
    __syncthreads();
#pragma unroll 1
    for (int mt = 0; mt < 2; ++mt) {
        bf16x8_t a7[7];
#pragma unroll
        for (int kk = 0; kk < 7; ++kk) a7[kk] = *(const LAS bf16x8_t*)(hidb + (mt * 16 + fr) * 240 + kk * 32 + fq * 8);
        float pb0[4] = {0.f, 0.f, 0.f, 0.f}, pb1[4] = {0.f, 0.f, 0.f, 0.f}, vsr[4][4];
        float cks[4], ckk[4], crs[4], nks[4], nkk[4], nrs[4];
#pragma unroll
        for (int j = 0; j < 4; ++j) { const size_t o = (size_t)(m0 + mt * 16 + fq * 4 + j) * 512 + w * 64 + fr;
            cks[j] = KS[o]; ckk[j] = RW[(size_t)RW_KK * RWSZ + o]; crs[j] = RW[(size_t)RW_R * RWSZ + o]; vsr[0][j] = RW[(size_t)RW_V * RWSZ + o]; }
#pragma unroll
        for (int nt = 0; nt < 4; ++nt) {
            if (nt < 3) {
#pragma unroll
                for (int j = 0; j < 4; ++j) { const size_t o = (size_t)(m0 + mt * 16 + fq * 4 + j) * 512 + w * 64 + (nt + 1) * 16 + fr;
                    nks[j] = KS[o]; nkk[j] = RW[(size_t)RW_KK * RWSZ + o]; nrs[j] = RW[(size_t)RW_R * RWSZ + o]; vsr[nt + 1][j] = RW[(size_t)RW_V * RWSZ + o]; }
            }
            const int ch = w * 64 + nt * 16 + fr;
            f32x4 ag = {0.f, 0.f, 0.f, 0.f}, aw0 = ag, aw1 = ag, aa0 = ag, aa1 = ag;
#pragma unroll
            for (int kk = 0; kk < 3; ++kk) ag = __builtin_amdgcn_mfma_f32_16x16x32_bf16(a7[kk], *(const bf16x8_t*)(g2T + (size_t)ch * 96 + kk * 32 + fq * 8), ag, 0, 0, 0);
            aw0 = __builtin_amdgcn_mfma_f32_16x16x32_bf16(a7[3], *(const bf16x8_t*)(w2T + (size_t)(0 * 512 + ch) * 32 + fq * 8), aw0, 0, 0, 0);
            aw1 = __builtin_amdgcn_mfma_f32_16x16x32_bf16(a7[4], *(const bf16x8_t*)(w2T + (size_t)(1 * 512 + ch) * 32 + fq * 8), aw1, 0, 0, 0);
            aa0 = __builtin_amdgcn_mfma_f32_16x16x32_bf16(a7[5], *(const bf16x8_t*)(a2T + (size_t)(0 * 512 + ch) * 32 + fq * 8), aa0, 0, 0, 0);
            aa1 = __builtin_amdgcn_mfma_f32_16x16x32_bf16(a7[6], *(const bf16x8_t*)(a2T + (size_t)(1 * 512 + ch) * 32 + fq * 8), aa1, 0, 0, 0);
            const float w00 = a.in[16][(l * 2 + 0) * 512 + ch], w01 = a.in[16][(l * 2 + 1) * 512 + ch], a00 = a.in[19][(l * 2 + 0) * 512 + ch], a01 = a.in[19][(l * 2 + 1) * 512 + ch];
            const float ka_c = a.in[25][l * 512 + ch], rk_c = a.in[26][l * 512 + ch];
#pragma unroll
            for (int j = 0; j < 4; ++j) {
                const size_t o = (size_t)(m0 + mt * 16 + fq * 4 + j) * 512 + ch;
                const float ks = cks[j], kkn = ckk[j], rs = crs[j];
#pragma unroll
                for (int d = 0; d < 2; ++d) {
                    const float wl = (d ? w01 : w00) + (d ? aw1[j] : aw0[j]);
                    const float nx = -wl, sp = fmaxf(nx, 0.f) + log1pf(__expf(-fabsf(nx)));
                    const float decay = __expf(-__expf(-sp - 0.5f));
                    const float av = sigmoidf_((d ? a01 : a00) + (d ? aa1[j] : aa0[j]));
                    const float kd = ks * (1.f + (av - 1.f) * ka_c), bb = kkn * av;
                    if (d) pb1[j] += rs * kd * rk_c; else pb0[j] += rs * kd * rk_c;
                    RW[(size_t)(RW_W0 + d) * RWSZ + o] = decay; RW[(size_t)(RW_KD0 + d) * RWSZ + o] = kd; RW[(size_t)(RW_B0 + d) * RWSZ + o] = bb;
                }
                RW[(size_t)RW_G * RWSZ + o] = ag[j];
            }
#pragma unroll
            for (int j = 0; j < 4; ++j) { cks[j] = nks[j]; ckk[j] = nkk[j]; crs[j] = nrs[j]; }
        }
#pragma unroll
        for (int j = 0; j < 4; ++j) { const float tb = row_sum16(pb0[j]) + row_sum16(pb1[j]);
#pragma unroll
            for (int nt = 0; nt < 4; ++nt) RW[(size_t)RW_BONUS * RWSZ + (size_t)(m0 + mt * 16 + fq * 4 + j) * 512 + w * 64 + nt * 16 + fr] = tb * vsr[nt][j]; }
    }
    __syncthreads();
}

__device__ __forceinline__ void rwkv_chunk_pre(const AP& a, int cid, int lane, LAS unsigned char* wl) {
    unsigned char* ws = a.ws;
    const int c = cid & 127, ci = cid >> 7, d = ci & 1, h = (ci >> 1) & 7, b = ci >> 4, fr = lane & 15, fq = lane >> 4;
    const float* RW = (const float*)(ws + WS_RW);
    unsigned char* rec = ws + WS_RWC + (size_t)cid * RWC_REC;
    LAS bf16_t* KH = (LAS bf16_t*)wl; LAS bf16_t* BC = KH + 1152; LAS bf16_t* KC = BC + 1152; LAS bf16_t* RH = KC + 1152;
    LAS bf16_t* KHT = RH + 1152;
    LAS float* Am = (LAS float*)(wl + 11264); LAS float* Bmm = Am + 256; LAS float* Abm = Bmm + 256; LAS float* Akm = Abm + 256; LAS float* Tm = Akm + 256;
    const size_t tok0 = (size_t)b * SEQ; const int colk = h * 64 + lane;
#define TOKI(i) (tok0 + (size_t)(d ? (SEQ - 1 - (c * 16 + (i))) : (c * 16 + (i))))
    {
        float W[16];
#pragma unroll
        for (int i = 0; i < 16; ++i) W[i] = RW[(size_t)(RW_W0 + d) * RWSZ + TOKI(i) * 512 + colk];
#pragma unroll
        for (int i = 1; i < 16; ++i) W[i] *= W[i - 1];
        const float W15 = W[15];
        unsigned zt[16];
#pragma unroll
        for (int i = 0; i < 16; ++i) {
            const size_t o = TOKI(i) * 512 + colk;
            const float kap = RW[(size_t)RW_KK * RWSZ + o], bv = RW[(size_t)(RW_B0 + d) * RWSZ + o], kdv = RW[(size_t)(RW_KD0 + d) * RWSZ + o], rv = RW[(size_t)RW_R * RWSZ + o];
            const float wm1 = i ? W[i - 1] : 1.f, iw = 1.f / W[i], wr = W15 * iw;
            const unsigned kh = f2bf(kap * wm1);
            KH[i * 72 + lane] = (bf16_t)kh; KHT[lane * 16 + i] = (bf16_t)kh;
            BC[i * 72 + lane] = (bf16_t)f2bf(bv * iw); KC[i * 72 + lane] = (bf16_t)f2bf(kdv * iw); RH[i * 72 + lane] = (bf16_t)f2bf(rv * W[i]);
            const unsigned bb = f2bf(bv * wr), kb = f2bf(kdv * wr);
            const int sb = (i >> 2) * 8 + (i & 3), sk = sb + 4;
            if (sb & 1) zt[sb >> 1] |= bb << 16; else zt[sb >> 1] = bb;
            if (sk & 1) zt[sk >> 1] |= kb << 16; else zt[sk >> 1] = kb;
        }
        u32x4* zp = (u32x4*)(rec + 4096 + lane * 64);
#pragma unroll
        for (int q = 0; q < 4; ++q) zp[q] = (u32x4){zt[q * 4], zt[q * 4 + 1], zt[q * 4 + 2], zt[q * 4 + 3]};
        ((float*)(rec + 8192))[lane] = W15;
    }
    float Vq[4][4];
#pragma unroll
    for (int nt = 0; nt < 4; ++nt) {
#pragma unroll
        for (int r = 0; r < 4; ++r) Vq[nt][r] = RW[(size_t)RW_V * RWSZ + TOKI(fq * 4 + r) * 512 + h * 64 + nt * 16 + fr];
        u32x2 pv; pv.x = pk2(Vq[nt][0], Vq[nt][1]); pv.y = pk2(Vq[nt][2], Vq[nt][3]);
        *(u32x2*)(rec + 12800 + (nt * 64 + lane) * 8) = pv;
    }
    LDS_WAIT(); asm volatile("" ::: "memory");
    {
        f32x4 cA = {0.f, 0.f, 0.f, 0.f}, cB = cA, cAb = cA, cAk = cA;
#pragma unroll
        for (int s2 = 0; s2 < 2; ++s2) {
            const int off = fr * 72 + s2 * 32 + fq * 8;
            const bf16x8_t fkh = *(const LAS bf16x8_t*)(KH + off), fbc = *(const LAS bf16x8_t*)(BC + off), fkc = *(const LAS bf16x8_t*)(KC + off), frh = *(const LAS bf16x8_t*)(RH + off);
            cA = __builtin_amdgcn_mfma_f32_16x16x32_bf16(fkh, fbc, cA, 0, 0, 0); cB = __builtin_amdgcn_mfma_f32_16x16x32_bf16(fkh, fkc, cB, 0, 0, 0);
            cAb = __builtin_amdgcn_mfma_f32_16x16x32_bf16(frh, fbc, cAb, 0, 0, 0); cAk = __builtin_amdgcn_mfma_f32_16x16x32_bf16(frh, fkc, cAk, 0, 0, 0);
        }
#pragma unroll
        for (int r = 0; r < 4; ++r) { const int i = fq * 4 + r, j = fr;
            Am[i * 16 + j] = j < i ? cA[r] : 0.f; Bmm[i * 16 + j] = j < i ? cB[r] : 0.f; Abm[i * 16 + j] = j <= i ? cAb[r] : 0.f; Akm[i * 16 + j] = j <= i ? cAk[r] : 0.f; }
    }
    LDS_WAIT(); asm volatile("" ::: "memory");
    {
        float x[16];
#pragma unroll
        for (int i = 0; i < 16; ++i) {
            float sacc = (i == fr) ? 1.f : 0.f;
#pragma unroll
            for (int jq = 0; jq < (i + 3) / 4; ++jq) { const f32x4 q = *(const LAS f32x4*)(Am + i * 16 + jq * 4);
#pragma unroll
                for (int e = 0; e < 4; ++e) if (jq * 4 + e < i) sacc -= q[e] * x[jq * 4 + e]; }
            x[i] = sacc;
        }
        if (fq == 0) {
#pragma unroll
            for (int i = 0; i < 16; ++i) Tm[i * 16 + fr] = x[i];
        }
    }
    LDS_WAIT(); asm volatile("" ::: "memory");
    {
        const f32x4 qT = *(const LAS f32x4*)(Tm + fr * 16 + fq * 4), qB = *(const LAS f32x4*)(Bmm + fr * 16 + fq * 4), qAb = *(const LAS f32x4*)(Abm + fr * 16 + fq * 4), qAk = *(const LAS f32x4*)(Akm + fr * 16 + fq * 4);
        const unsigned ab0 = pk2(qAb[0], qAb[1]), ab1 = pk2(qAb[2], qAb[3]);
        const bf16x8_t aT = mk8(pk2(qT[0], qT[1]), pk2(qT[2], qT[3]), 0u, 0u), aBm = mk8(pk2(qB[0], qB[1]), pk2(qB[2], qB[3]), 0u, 0u);
        const bf16x8_t aAb = mk8(ab0, ab1, 0u, 0u), aAbAk = mk8(ab0, ab1, pk2(qAk[0], qAk[1]), pk2(qAk[2], qAk[3]));
        const f32x4 z4 = {0.f, 0.f, 0.f, 0.f};
#pragma unroll
        for (int nt = 0; nt < 4; ++nt) {
            const u32x2 kq = *(const LAS u32x2*)(KHT + (nt * 16 + fr) * 16 + fq * 4);
            f32x4 ut = __builtin_amdgcn_mfma_f32_16x16x32_bf16(aT, mk8(kq.x, kq.y, 0u, 0u), z4, 0, 0, 0); ut = -ut;
            const unsigned v0 = pk2(Vq[nt][0], Vq[nt][1]), v1 = pk2(Vq[nt][2], Vq[nt][3]);
            const f32x4 bmv = __builtin_amdgcn_mfma_f32_16x16x32_bf16(aBm, mk8(v0, v1, 0u, 0u), z4, 0, 0, 0);
            f32x4 ul = __builtin_amdgcn_mfma_f32_16x16x32_bf16(aT, mk8(pk2(bmv[0], bmv[1]), pk2(bmv[2], bmv[3]), 0u, 0u), z4, 0, 0, 0); ul = -ul;
            const unsigned u0 = pk2(ut[0], ut[1]), u1 = pk2(ut[2], ut[3]);
            f32x4 yh = __builtin_amdgcn_mfma_f32_16x16x32_bf16(aAb, mk8(u0, u1, 0u, 0u), z4, 0, 0, 0);
#pragma unroll
            for (int r = 0; r < 4; ++r) yh[r] += bflo((unsigned)RH[(fq * 4 + r) * 72 + nt * 16 + fr]);
            const unsigned l0 = pk2(ul[0], ul[1]), l1 = pk2(ul[2], ul[3]);
            const f32x4 yl = __builtin_amdgcn_mfma_f32_16x16x32_bf16(aAbAk, mk8(l0, l1, v0, v1), z4, 0, 0, 0);
            const int s2 = nt >> 1, slot = (fr >> 2) * 8 + (fr & 3) + ((nt & 1) ? 4 : 0);
            bf16_t* m0p = (bf16_t*)rec + ((0 * 2 + s2) * 16) * 32 + slot; bf16_t* m1p = (bf16_t*)rec + ((1 * 2 + s2) * 16) * 32 + slot;
#pragma unroll
            for (int r = 0; r < 4; ++r) { m0p[(fq * 4 + r) * 32] = (bf16_t)((r & 1) ? (((r >> 1) ? u1 : u0) >> 16) : (((r >> 1) ? u1 : u0) & 0xffffu)); m1p[(fq * 4 + r) * 32] = (bf16_t)f2bf(yh[r]); }
            u32x2 pl; pl.x = l0; pl.y = l1; *(u32x2*)(rec + 8704 + (nt * 64 + lane) * 8) = pl;
            u32x2 py; py.x = pk2(yl[0], yl[1]); py.y = pk2(yl[2], yl[3]); *(u32x2*)(rec + 10752 + (nt * 64 + lane) * 8) = py;
        }
    }
    LDS_WAIT(); asm volatile("" ::: "memory");
#undef TOKI
}
__device__ __forceinline__ void vm_wait_chunks(int n) {
    switch (n) { case 0: asm volatile("s_waitcnt vmcnt(0)" ::: "memory"); break; case 1: asm volatile("s_waitcnt vmcnt(4)" ::: "memory"); break;
                 case 2: asm volatile("s_waitcnt vmcnt(8)" ::: "memory"); break; case 3: asm volatile("s_waitcnt vmcnt(12)" ::: "memory"); break;
                 case 4: asm volatile("s_waitcnt vmcnt(16)" ::: "memory"); break; case 5: asm volatile("s_waitcnt vmcnt(20)" ::: "memory"); break;
                 default: asm volatile("s_waitcnt vmcnt(24)" ::: "memory"); break; }
}
__device__ __forceinline__ void rwkv_seq_chain(const Ctx& C, const AP& a, int ci) {
    unsigned char* ws = a.ws;
    const int w = C.wave, lane = C.lane, fr = lane & 15, fq = lane >> 4, d = ci & 1, h = (ci >> 1) & 7, b = ci >> 4;
    const unsigned char* recs = ws + WS_RWC + (size_t)ci * 128 * RWC_REC;
    LAS unsigned char* ring = C.lds;
    const bool loader = w >= 4; const int lw = w - 4;
#define RWC_ISSUE(cc) do { _Pragma("unroll") for (int p_ = 0; p_ < 4; ++p_) { const int pc_ = (lw * 4 + p_) < 15 ? (lw * 4 + p_) : 14; \
        __builtin_amdgcn_global_load_lds((const unsigned*)(recs + (size_t)(cc) * RWC_REC + pc_ * 1024 + lane * 16), (LAS unsigned*)(ring + ((cc) & 7) * RWC_REC + pc_ * 1024), 16, 0, 0); } } while (0)
    if (loader) {
#pragma unroll 1
        for (int cc = 0; cc < 8; ++cc) RWC_ISSUE(cc);
        asm volatile("s_waitcnt vmcnt(28)" ::: "memory");
    }
    __builtin_amdgcn_s_barrier(); asm volatile("" ::: "memory");
    f32x4 ST[4];
#pragma unroll
    for (int kt = 0; kt < 4; ++kt) ST[kt] = (f32x4){0.f, 0.f, 0.f, 0.f};
    float* Y = (float*)(ws + WS_YRW) + (size_t)d * RWSZ + (size_t)b * SEQ * 512 + h * 64 + w * 16 + fr;
#pragma unroll 1
    for (int c = 0; c < 128; ++c) {
        if (!loader) {
            const LAS unsigned char* sl = ring + (c & 7) * RWC_REC;
            const bf16x8_t a00 = *(const LAS bf16x8_t*)(sl + (0 * 16 + fr) * 64 + fq * 16), a01 = *(const LAS bf16x8_t*)(sl + (1 * 16 + fr) * 64 + fq * 16);
            const bf16x8_t a10 = *(const LAS bf16x8_t*)(sl + (2 * 16 + fr) * 64 + fq * 16), a11 = *(const LAS bf16x8_t*)(sl + (3 * 16 + fr) * 64 + fq * 16);
            const u32x2 ulw = *(const LAS u32x2*)(sl + 8704 + (w * 64 + lane) * 8), ylw = *(const LAS u32x2*)(sl + 10752 + (w * 64 + lane) * 8), vpw = *(const LAS u32x2*)(sl + 12800 + (w * 64 + lane) * 8);
            const bf16x8_t bs0 = mk8(pk2(ST[0][0], ST[0][1]), pk2(ST[0][2], ST[0][3]), pk2(ST[1][0], ST[1][1]), pk2(ST[1][2], ST[1][3]));
            const bf16x8_t bs1 = mk8(pk2(ST[2][0], ST[2][1]), pk2(ST[2][2], ST[2][3]), pk2(ST[3][0], ST[3][1]), pk2(ST[3][2], ST[3][3]));
            const f32x4 z4 = {0.f, 0.f, 0.f, 0.f};
            f32x4 g0 = __builtin_amdgcn_mfma_f32_16x16x32_bf16(a00, bs0, z4, 0, 0, 0); g0 = __builtin_amdgcn_mfma_f32_16x16x32_bf16(a01, bs1, g0, 0, 0, 0);
            f32x4 g1 = __builtin_amdgcn_mfma_f32_16x16x32_bf16(a10, bs0, z4, 0, 0, 0); g1 = __builtin_amdgcn_mfma_f32_16x16x32_bf16(a11, bs1, g1, 0, 0, 0);
            const float uf0 = g0[0] + bflo(ulw.x), uf1 = g0[1] + bfhi(ulw.x), uf2 = g0[2] + bflo(ulw.y), uf3 = g0[3] + bfhi(ulw.y);
            const bf16x8_t xb = mk8(pk2(uf0, uf1), pk2(uf2, uf3), vpw.x, vpw.y);
#pragma unroll
            for (int kt = 0; kt < 4; ++kt) {
                const f32x4 dq = *(const LAS f32x4*)(sl + 8192 + (kt * 16 + fq * 4) * 4);
                const bf16x8_t az = *(const LAS bf16x8_t*)(sl + 4096 + (kt * 16 + fr) * 64 + fq * 16);
                ST[kt] = __builtin_amdgcn_mfma_f32_16x16x32_bf16(az, xb, ST[kt] * dq, 0, 0, 0);
            }
            const float y0 = g1[0] + bflo(ylw.x), y1 = g1[1] + bfhi(ylw.x), y2 = g1[2] + bflo(ylw.y), y3 = g1[3] + bfhi(ylw.y);
            const int sbase = c * 16 + fq * 4;
            Y[(size_t)(d ? SEQ - 1 - (sbase + 0) : sbase + 0) * 512] = y0; Y[(size_t)(d ? SEQ - 1 - (sbase + 1) : sbase + 1) * 512] = y1;
            Y[(size_t)(d ? SEQ - 1 - (sbase + 2) : sbase + 2) * 512] = y2; Y[(size_t)(d ? SEQ - 1 - (sbase + 3) : sbase + 3) * 512] = y3;
            asm volatile("s_waitcnt lgkmcnt(0)" ::: "memory");
        } else if (c + 1 < 128) {
            const int lastc = (c + 7 < 127) ? c + 7 : 127;
            vm_wait_chunks(lastc - (c + 1));
        }
        __builtin_amdgcn_s_barrier(); asm volatile("" ::: "memory");
        if (loader && c + 8 < 128) RWC_ISSUE(c + 8);
    }
    asm volatile("s_waitcnt vmcnt(0)" ::: "memory");
    __builtin_amdgcn_s_barrier(); asm volatile("" ::: "memory");
#undef RWC_ISSUE
}

__device__ __forceinline__ float dpp_sum8(float x) {
    x += __builtin_bit_cast(float, __builtin_amdgcn_update_dpp(0, __builtin_bit_cast(int, x), 0xB1, 0xF, 0xF, true));
    x += __builtin_bit_cast(float, __builtin_amdgcn_update_dpp(0, __builtin_bit_cast(int, x), 0x4E, 0xF, 0xF, true));
    x += __builtin_bit_cast(float, __builtin_amdgcn_update_dpp(0, __builtin_bit_cast(int, x), 0x141, 0xF, 0xF, true));
    return x;
}
__device__ __forceinline__ void rwkv_scan_item(const Ctx& C, const AP& a, int item) {
    unsigned char* ws = a.ws;
    const int d = item & 1, h = (item >> 1) & 7, b = item >> 4, tid = C.tid, v = tid >> 3, kq = tid & 7;
    const float* RW = (const float*)(ws + WS_RW);
    const float* arr[6] = { RW + (size_t)RW_KK * RWSZ, RW + (size_t)(RW_W0 + d) * RWSZ, RW + (size_t)(RW_B0 + d) * RWSZ, RW + (size_t)(RW_KD0 + d) * RWSZ, RW + (size_t)RW_R * RWSZ, RW + (size_t)RW_V * RWSZ };
    float* Y = (float*)(ws + WS_YRW) + (size_t)d * RWSZ;
    LAS float* buf = (LAS float*)C.lds;
    const int ls = tid >> 4, lq = tid & 15;
    f32x4 stg[6];
    const size_t colbase = (size_t)h * 64;
#define RW_LOAD(ch) do { const int s_ = (ch) * 32 + ls, t_ = d ? (SEQ - 1 - s_) : s_; const size_t o_ = ((size_t)(b * SEQ + t_)) * 512 + colbase + lq * 4; \
        _Pragma("unroll") for (int q_ = 0; q_ < 6; ++q_) stg[q_] = *(const f32x4*)(arr[q_] + o_); } while (0)
#define RW_WRITE(bi) do { _Pragma("unroll") for (int q_ = 0; q_ < 6; ++q_) *(LAS f32x4*)(buf + (((bi) * 6 + q_) * 32 + ls) * 64 + lq * 4) = stg[q_]; } while (0)
    float S[8];
#pragma unroll
    for (int j = 0; j < 8; ++j) S[j] = 0.f;
    RW_LOAD(0); RW_WRITE(0); __syncthreads();
    for (int ch = 0; ch < SEQ / 32; ++ch) {
        const int bi = ch & 1;
        if (ch + 1 < SEQ / 32) RW_LOAD(ch + 1);
        const LAS float* B0 = buf + (bi * 6) * 32 * 64;
        for (int st = 0; st < 32; ++st) {
            const LAS float* bp = B0 + st * 64 + kq * 8;
            const f32x4 k0 = *(const LAS f32x4*)(bp), k1 = *(const LAS f32x4*)(bp + 4);
            const f32x4 w0 = *(const LAS f32x4*)(bp + 2048), w1 = *(const LAS f32x4*)(bp + 2048 + 4);
            const f32x4 b0 = *(const LAS f32x4*)(bp + 4096), b1 = *(const LAS f32x4*)(bp + 4096 + 4);
            const f32x4 d0 = *(const LAS f32x4*)(bp + 6144), d1 = *(const LAS f32x4*)(bp + 6144 + 4);
            const f32x4 r0 = *(const LAS f32x4*)(bp + 8192), r1 = *(const LAS f32x4*)(bp + 8192 + 4);
            const float vv = B0[10240 + st * 64 + v];
            float sa = S[0] * k0[0] + S[1] * k0[1] + S[2] * k0[2] + S[3] * k0[3] + S[4] * k1[0] + S[5] * k1[1] + S[6] * k1[2] + S[7] * k1[3];
            sa = -dpp_sum8(sa);
            float y = 0.f;
#pragma unroll
            for (int j = 0; j < 4; ++j) { S[j] = S[j] * w0[j] + (sa * b0[j] + vv * d0[j]); y += S[j] * r0[j]; S[4 + j] = S[4 + j] * w1[j] + (sa * b1[j] + vv * d1[j]); y += S[4 + j] * r1[j]; }
            y = dpp_sum8(y);
            if (kq == 0) { const int s_ = ch * 32 + st, t_ = d ? (SEQ - 1 - s_) : s_; Y[((size_t)(b * SEQ + t_)) * 512 + colbase + v] = y; }
        }
        if (ch + 1 < SEQ / 32) RW_WRITE(bi ^ 1);
        __syncthreads();
    }
#undef RW_LOAD
#undef RW_WRITE
}
__device__ __forceinline__ void rwkv_post_item(const AP& a, int l, int item, int lane) {
    unsigned char* ws = a.ws;
    const int hh = item & 7, m = item >> 3, c = hh * 64 + lane; const size_t o = (size_t)m * 512 + c;
    const float* Y = (const float*)(ws + WS_YRW); const float* RW = (const float*)(ws + WS_RW);
    const float y = Y[o] + Y[RWSZ + o];
    const float mean = wave_sum(y) * (1.f / 64.f), dv = y - mean, var = wave_sum(dv * dv) * (1.f / 64.f);
    const float yn = dv * rsqrtf(var + 64e-5f) * a.in[27][l * 512 + c] + a.in[28][l * 512 + c];
    ((float*)(ws + WS_YA))[(size_t)3 * RWSZ + o] = (yn + RW[(size_t)RW_BONUS * RWSZ + o]) * RW[(size_t)RW_G * RWSZ + o];
}
__device__ __forceinline__ void c1_fold_item(const AP& a, int row, int lane) {
    const unsigned short* src = (const unsigned short*)(a.ws + WS_C1) + (size_t)row * 4096;
    unsigned short* dst = (unsigned short*)(a.ws + WS_C1F) + (size_t)row * 2048;
#pragma unroll 8
    for (int i = 0; i < 32; ++i) {
        const int j = i * 64 + lane; float v;
        if (j <= 1024) { const float x0 = __uint_as_float((unsigned)src[j] << 16); const int jm = (j >= 1 && j <= 1023) ? 2048 - j : j;
            const float x1 = __uint_as_float((unsigned)src[jm] << 16); v = (j >= 1 && j <= 1023) ? x0 + x1 : x0; }
        else { const int sidx = j - 1024; v = __uint_as_float((unsigned)src[2048 + sidx] << 16) - __uint_as_float((unsigned)src[2048 + 2048 - sidx] << 16); }
        dst[j] = (unsigned short)f2bf(v);
    }
}
__device__ __forceinline__ void branch_d_item(const AP& a, int l, int m, int lane) {
    unsigned char* ws = a.ws;
    const float* Y = (const float*)(ws + WS_YRW); const float* RW = (const float*)(ws + WS_RW);
    float o[8]; float ss = 0.f;
#pragma unroll
    for (int hh = 0; hh < 8; ++hh) {
        const int c = hh * 64 + lane; const size_t ix = (size_t)m * 512 + c;
        const float y = Y[ix] + Y[RWSZ + ix];
        const float mean = wave_sum(y) * (1.f / 64.f), dv = y - mean, var = wave_sum(dv * dv) * (1.f / 64.f);
        const float yn = dv * rsqrtf(var + 64e-5f) * a.in[27][l * 512 + c] + a.in[28][l * 512 + c];
        o[hh] = (yn + RW[(size_t)RW_BONUS * RWSZ + ix]) * RW[(size_t)RW_G * RWSZ + ix]; ss += o[hh] * o[hh];
    }
    const float rs = rsqrtf(wave_sum(ss) * (1.f / 512.f) + 1e-6f);
    bf16_t* dst = (bf16_t*)(ws + WS_HB) + (size_t)m * DM + 1536 + lane;
#pragma unroll
    for (int hh = 0; hh < 8; ++hh) dst[hh * 64] = (bf16_t)f2bf(o[hh] * rs);
}
__device__ __forceinline__ void branch_norm_item(const AP& a, int item, int lane) {
    unsigned char* ws = a.ws;
    const int br = item & 3, m = item >> 2;
    const f32x4* src = (const f32x4*)((const float*)(ws + WS_YA) + (size_t)br * RWSZ + (size_t)m * 512) + lane;
    const f32x4 v0 = src[0], v1 = src[64];
    const float ss = wave_sum(v0.x * v0.x + v0.y * v0.y + v0.z * v0.z + v0.w * v0.w + v1.x * v1.x + v1.y * v1.y + v1.z * v1.z + v1.w * v1.w);
    const float rs = rsqrtf(ss * (1.f / 512.f) + 1e-6f);
    u32x2* dst = (u32x2*)((bf16_t*)(ws + WS_HB) + (size_t)m * DM + br * 512) + lane;
    u32x2 w; w.x = pk2(v0.x * rs, v0.y * rs); w.y = pk2(v0.z * rs, v0.w * rs); dst[0] = w;
    w.x = pk2(v1.x * rs, v1.y * rs); w.y = pk2(v1.z * rs, v1.w * rs); dst[64] = w;
}

__device__ __forceinline__ unsigned fkey(float f) { const unsigned u = __float_as_uint(f); return (u & 0x80000000u) ? ~u : (u | 0x80000000u); }
__device__ __forceinline__ int lane_rank(unsigned long long m) { return __builtin_amdgcn_mbcnt_hi((unsigned)(m >> 32), __builtin_amdgcn_mbcnt_lo((unsigned)m, 0)); }
template <int N>
__device__ __forceinline__ void top16_select(const float (&val)[N], const int (&idx)[N], LAS float* lv, LAS int* li) {
    unsigned k[N];
#pragma unroll
    for (int e = 0; e < N; ++e) k[e] = fkey(val[e]);
    unsigned T = 0;
    for (int bit = 31; bit >= 0; --bit) {
        const unsigned cand = T | (1u << bit); int cnt = 0;
#pragma unroll
        for (int e = 0; e < N; ++e) cnt += __popcll(__ballot(k[e] >= cand));
        if (cnt >= 16) T = cand;
        if (cnt == 16) break;
    }
    int ngt = 0;
#pragma unroll
    for (int e = 0; e < N; ++e) ngt += __popcll(__ballot(k[e] > T));
    const int need = 16 - ngt; int eqbase = 0, posbase = 0;
#pragma unroll
    for (int e = 0; e < N; ++e) {
        const unsigned long long meq = __ballot(k[e] == T);
        const int eqrank = eqbase + lane_rank(meq);
        const bool sel = (k[e] > T) || (k[e] == T && eqrank < need);
        const unsigned long long msel = __ballot(sel);
        const int pos = posbase + lane_rank(msel);
        if (sel) { lv[pos] = val[e]; li[pos] = idx[e]; }
        eqbase += __popcll(meq); posbase += __popcll(msel);
    }
    LDS_WAIT(); asm volatile("" ::: "memory");
}
__device__ __forceinline__ float dpp_xor1(float x) { return __builtin_bit_cast(float, __builtin_amdgcn_update_dpp(0, __builtin_bit_cast(int, x), 0xB1, 0xF, 0xF, true)); }
__device__ __forceinline__ float dpp_xor2(float x) { return __builtin_bit_cast(float, __builtin_amdgcn_update_dpp(0, __builtin_bit_cast(int, x), 0x4E, 0xF, 0xF, true)); }
__device__ __forceinline__ float reduce8(const float (&v)[8], int lane) {
    const bool b0 = lane & 1, b1 = lane & 2, b2 = lane & 4;
    float w4[4], w2[2];
#pragma unroll
    for (int k = 0; k < 4; ++k) { const float keep = b0 ? v[4 + k] : v[k], send = b0 ? v[k] : v[4 + k]; w4[k] = keep + dpp_xor1(send); }
#pragma unroll
    for (int k = 0; k < 2; ++k) { const float keep = b1 ? w4[2 + k] : w4[k], send = b1 ? w4[k] : w4[2 + k]; w2[k] = keep + dpp_xor2(send); }
    const float keep = b2 ? w2[1] : w2[0], send = b2 ? w2[0] : w2[1];
    float r = keep + __shfl_xor(send, 4);
    r += __shfl_xor(r, 8); r += __shfl_xor(r, 16); r += __shfl_xor(r, 32);
    return r;
}
typedef float f32x2v __attribute__((ext_vector_type(2)));
__device__ __forceinline__ void split8(const f32x4 a0, const f32x4 a1, bf16x8_t& hi, bf16x8_t& lo) {
    unsigned h[4], l_[4];
#pragma unroll
    for (int i = 0; i < 4; ++i) { const float x0 = i < 2 ? a0[2 * i] : a1[2 * i - 4], x1 = i < 2 ? a0[2 * i + 1] : a1[2 * i - 3];
        const unsigned h0 = f2bf(x0), h1 = f2bf(x1); h[i] = h0 | (h1 << 16);
        l_[i] = pk2(x0 - __uint_as_float(h0 << 16), x1 - __uint_as_float(h1 << 16)); }
    hi = mk8(h[0], h[1], h[2], h[3]); lo = mk8(l_[0], l_[1], l_[2], l_[3]);
}
__device__ __forceinline__ void peer_select_head(const f32x2 s0, const f32x2 s1, int lane, LAS float* wl, LAS int* fe, LAS float* fg, int ci_i, int ci_j, bool cand_on) {
    { const float v0[2] = {s0.x, s0.y}; const int i0[2] = {2 * lane, 2 * lane + 1}; top16_select<2>(v0, i0, wl, (LAS int*)(wl + 16)); }
    { const float v1[2] = {s1.x, s1.y}; const int i1[2] = {2 * lane, 2 * lane + 1}; top16_select<2>(v1, i1, wl + 32, (LAS int*)(wl + 48)); }
    if (lane < 32) { const int lst = lane >> 4, ii = lane & 15; const LAS float* lv = wl + lst * 32;
      const float v = lv[ii]; const int ix = ((const LAS int*)lv)[16 + ii]; int rank = 0;
#pragma unroll
      for (int jq = 0; jq < 4; ++jq) { const f32x4 q = *(const LAS f32x4*)(lv + jq * 4);
#pragma unroll
          for (int e = 0; e < 4; ++e) rank += (q[e] > v || (q[e] == v && (jq * 4 + e) < ii)) ? 1 : 0; }
      wl[64 + lst * 32 + rank] = v; ((LAS int*)wl)[64 + lst * 32 + 16 + rank] = ix; }
    LDS_WAIT(); asm volatile("" ::: "memory");
    { const float cvv = cand_on ? wl[64 + ci_i] + wl[96 + ci_j] : -INFINITY;
      const float cv[1] = {cvv}; const int ci[1] = {ci_i * 16 + ci_j};
      top16_select<1>(cv, ci, wl + 128, (LAS int*)(wl + 144)); }
    { const bool act = lane < 16; const float sc = act ? wl[128 + lane] : -3.0e38f; const int fi = act ? ((LAS int*)wl)[144 + lane] : 0;
      const int e = ((LAS int*)wl)[80 + (fi >> 4)] * 128 + ((LAS int*)wl)[112 + (fi & 15)];
      const float mx = wave_max(sc), ex = act ? __expf(sc - mx) : 0.f, sm = wave_sum(ex);
      if (act) { fe[lane] = e; fg[lane] = ex / sm; } }
    LDS_WAIT(); asm volatile("" ::: "memory");
}
__device__ __forceinline__ void peer_tile(const Ctx& C, const AP& a, int l, int tile, const float* x1, float* xout, bool write_hb) {
    unsigned char* ws = a.ws;
    const int tid = C.tid, lane = C.lane, w = C.wave, tb = tile * 32;
    LAS float* keys = (LAS float*)C.lds;
    LAS int* rt_idx = (LAS int*)(C.lds + 65536);
    LAS float* rt_gate = (LAS float*)(C.lds + 81920);
    LAS float* wl = (LAS float*)(C.lds + 98304) + w * 256;
    LAS float* ssp = (LAS float*)(C.lds + 98304 + 8 * 1024);
    const float* qry = (const float*)(ws + WS_PROJ);
    int ci_i, ci_j; const bool cand_on = lane < 50;
    if (lane < 16) { ci_i = 0; ci_j = lane; } else if (lane < 24) { ci_i = 1; ci_j = lane - 16; } else if (lane < 29) { ci_i = 2; ci_j = lane - 24; }
    else if (lane < 33) { ci_i = 3; ci_j = lane - 29; } else if (lane < 36) { ci_i = 4; ci_j = lane - 33; } else if (lane < 38) { ci_i = 5; ci_j = lane - 36; }
    else if (lane < 40) { ci_i = 6; ci_j = lane - 38; } else if (lane < 42) { ci_i = 7; ci_j = lane - 40; } else if (lane < 50) { ci_i = lane - 34; ci_j = 0; } else { ci_i = 0; ci_j = 0; }
    float* Ssc = (float*)(ws + WS_RW) + (size_t)tile * 65536;
    { const int fr = lane & 15, fq = lane >> 4;
#pragma unroll 1
      for (int hp = 0; hp < 16; ++hp) {
        const int h = hp >> 1, pp = hp & 1;
        bf16x8_t ah[2][2], al[2][2], bh[2], bl[2];
#pragma unroll
        for (int ks = 0; ks < 2; ++ks) {
            const float* kp = a.in[33] + ((size_t)(((l * 8 + h) * 2 + pp) * 128 + 16 * w + fr)) * 64 + ks * 32 + fq * 8;
            split8(*(const f32x4*)kp, *(const f32x4*)(kp + 4), bh[ks], bl[ks]);
#pragma unroll
            for (int mt = 0; mt < 2; ++mt) { const float* qp = qry + (size_t)(tb + mt * 16 + fr) * 1024 + h * 128 + pp * 64 + ks * 32 + fq * 8;
                split8(*(const f32x4*)qp, *(const f32x4*)(qp + 4), ah[mt][ks], al[mt][ks]); }
        }
#pragma unroll
        for (int mt = 0; mt < 2; ++mt) { f32x4 acc = {0.f, 0.f, 0.f, 0.f};
#pragma unroll
            for (int ks = 0; ks < 2; ++ks) { acc = __builtin_amdgcn_mfma_f32_16x16x32_bf16(al[mt][ks], bh[ks], acc, 0, 0, 0); acc = __builtin_amdgcn_mfma_f32_16x16x32_bf16(ah[mt][ks], bl[ks], acc, 0, 0, 0);
                acc = __builtin_amdgcn_mfma_f32_16x16x32_bf16(ah[mt][ks], bh[ks], acc, 0, 0, 0); }
#pragma unroll
            for (int r = 0; r < 4; ++r) Ssc[(size_t)(hp * 32 + mt * 16 + fq * 4 + r) * 128 + 16 * w + fr] = acc[r]; }
      } }
    __syncthreads();
    const unsigned char* U6 = ws + WS_UB + (size_t)l * ETAB; const unsigned char* V4 = ws + WS_UB + 64 * MiB + (size_t)l * 16 * MiB;
    const float* Us = (const float*)(ws + WS_VB) + (0 * 2 + l) * 16384; const float* Vs = (const float*)(ws + WS_VB) + (1 * 2 + l) * 16384;
    bf16_t* hb = (bf16_t*)(ws + WS_HB);
    u32x4 ua[8]; u32x4 va[8]; float sul, svl, gl; float xf[32], acc[32];
#define PEER_IDS(mye_, ei_) _Pragma("unroll") for (int e = 0; e < 8; ++e) ei_[e] = __builtin_amdgcn_readlane(mye_, ((e >> 2) & 1) | (((e >> 1) & 1) << 1) | ((e & 1) << 2));
#define PEER_ISSUE_U(ei_, ln_) _Pragma("unroll") for (int e = 0; e < 8; ++e) ua[e] = ((const u32x4*)(U6 + (size_t)ei_[e] * 1024))[ln_];
#define PEER_ISSUE_V(ei_, ln_) _Pragma("unroll") for (int e = 0; e < 8; ++e) va[e] = ((const u32x4*)(V4 + (size_t)ei_[e] * 1024))[ln_];
#define PEER_DOTS(dot_) _Pragma("unroll") for (int e = 0; e < 8; ++e) { f32x2v s2 = {0.f, 0.f}; \
        _Pragma("unroll") for (int d4 = 0; d4 < 4; ++d4) { const unsigned wd = ua[e][d4]; \
            s2 = __builtin_elementwise_fma((f32x2v){xf[8 * d4 + 0], xf[8 * d4 + 1]}, __builtin_amdgcn_cvt_scalef32_pk_f32_fp4(wd, 1.0f, 0), s2); \
            s2 = __builtin_elementwise_fma((f32x2v){xf[8 * d4 + 2], xf[8 * d4 + 3]}, __builtin_amdgcn_cvt_scalef32_pk_f32_fp4(wd, 1.0f, 1), s2); \
            s2 = __builtin_elementwise_fma((f32x2v){xf[8 * d4 + 4], xf[8 * d4 + 5]}, __builtin_amdgcn_cvt_scalef32_pk_f32_fp4(wd, 1.0f, 2), s2); \
            s2 = __builtin_elementwise_fma((f32x2v){xf[8 * d4 + 6], xf[8 * d4 + 7]}, __builtin_amdgcn_cvt_scalef32_pk_f32_fp4(wd, 1.0f, 3), s2); } \
        dot_[e] = s2.x + s2.y; }
#define PEER_ACCUM(cfl_) _Pragma("unroll") for (int e = 0; e < 8; ++e) { \
        const int src = ((e >> 2) & 1) | (((e >> 1) & 1) << 1) | ((e & 1) << 2); \
        const float cf = __builtin_bit_cast(float, __builtin_amdgcn_readlane(__builtin_bit_cast(int, cfl_), src)); \
        _Pragma("unroll") for (int d4 = 0; d4 < 4; ++d4) { const unsigned wd = va[e][d4]; \
            const f32x2v p0 = __builtin_amdgcn_cvt_scalef32_pk_f32_fp4(wd, 1.0f, 0), p1 = __builtin_amdgcn_cvt_scalef32_pk_f32_fp4(wd, 1.0f, 1); \
            const f32x2v p2 = __builtin_amdgcn_cvt_scalef32_pk_f32_fp4(wd, 1.0f, 2), p3 = __builtin_amdgcn_cvt_scalef32_pk_f32_fp4(wd, 1.0f, 3); \
            acc[8 * d4 + 0] += cf * p0.x; acc[8 * d4 + 1] += cf * p0.y; acc[8 * d4 + 2] += cf * p1.x; acc[8 * d4 + 3] += cf * p1.y; \
            acc[8 * d4 + 4] += cf * p2.x; acc[8 * d4 + 5] += cf * p2.y; acc[8 * d4 + 6] += cf * p3.x; acc[8 * d4 + 7] += cf * p3.y; } \
        if (e < 7) {   \
            asm volatile("" : "+v"(va[e + 1][0]), "+v"(va[e + 1][1]) : "v"(acc[0]), "v"(acc[1]), "v"(acc[2]), "v"(acc[3]), "v"(acc[4]), "v"(acc[5]), "v"(acc[6]), "v"(acc[7]), \
                         "v"(acc[8]), "v"(acc[9]), "v"(acc[10]), "v"(acc[11]), "v"(acc[12]), "v"(acc[13]), "v"(acc[14]), "v"(acc[15])); \
            asm volatile("" : "+v"(va[e + 1][2]), "+v"(va[e + 1][3]) : "v"(acc[16]), "v"(acc[17]), "v"(acc[18]), "v"(acc[19]), "v"(acc[20]), "v"(acc[21]), "v"(acc[22]), "v"(acc[23]), \
                         "v"(acc[24]), "v"(acc[25]), "v"(acc[26]), "v"(acc[27]), "v"(acc[28]), "v"(acc[29]), "v"(acc[30]), "v"(acc[31])); } }
    {
        const int tokl = w * 4;
        peer_select_head(*(const f32x2*)(Ssc + (size_t)(0 * 32 + tokl) * 128 + 2 * lane), *(const f32x2*)(Ssc + (size_t)(1 * 32 + tokl) * 128 + 2 * lane), lane, wl, (LAS int*)(wl + 160), wl + 176, ci_i, ci_j, cand_on);
        int ln = lane; asm volatile("" : "+v"(ln)); const int el1 = ((ln >> 2) & 1) | (((ln >> 1) & 1) << 1) | ((ln & 1) << 2);
        const int mye = ((LAS int*)(wl + 160))[el1]; int ei[8]; PEER_IDS(mye, ei) PEER_ISSUE_U(ei, ln) PEER_ISSUE_V(ei, ln)
        sul = Us[mye]; svl = Vs[mye]; gl = (wl + 176)[el1];
    }
#pragma unroll 1
    for (int hh = 0; hh < 32; ++hh) {
        const int h = hh & 7, tokl = w * 4 + (hh >> 3), tok = tb + tokl;
        LAS int* fe = (LAS int*)(wl + 160 + (hh & 1) * 32); LAS float* fg = wl + 176 + (hh & 1) * 32;
        if (h == 0) {
            const u32x2* xp = (const u32x2*)(hb + (size_t)tok * DM) + lane;
#pragma unroll
            for (int j = 0; j < 8; ++j) { const u32x2 xw = xp[64 * j]; xf[j * 4 + 0] = bflo(xw.x); xf[j * 4 + 1] = bfhi(xw.x); xf[j * 4 + 2] = bflo(xw.y); xf[j * 4 + 3] = bfhi(xw.y); }
#pragma unroll
            for (int i = 0; i < 32; ++i) acc[i] = 0.f;
        }
        {
            float dot[8]; PEER_DOTS(dot)
            int ln = lane; asm volatile("" : "+v"(ln)); const int el1 = ((ln >> 2) & 1) | (((ln >> 1) & 1) << 1) | ((ln & 1) << 2);
            const int mye = fe[8 + el1]; int ei[8]; PEER_IDS(mye, ei) PEER_ISSUE_U(ei, ln)
            const float cfl = gl * gelu_erf(reduce8(dot, lane) * sul) * svl;
            PEER_ACCUM(cfl)
            f32x2 ns0 = {0.f, 0.f}, ns1 = {0.f, 0.f};
            if (hh < 31) { const int tk2 = w * 4 + ((hh + 1) >> 3), h2 = (hh + 1) & 7;
                ns0 = *(const f32x2*)(Ssc + (size_t)((h2 * 2 + 0) * 32 + tk2) * 128 + 2 * ln); ns1 = *(const f32x2*)(Ssc + (size_t)((h2 * 2 + 1) * 32 + tk2) * 128 + 2 * ln); }
            PEER_ISSUE_V(ei, ln)
            sul = Us[mye]; svl = Vs[mye]; gl = fg[8 + el1];
            if (hh < 31) peer_select_head(ns0, ns1, lane, wl, (LAS int*)(wl + 160 + ((hh + 1) & 1) * 32), wl + 176 + ((hh + 1) & 1) * 32, ci_i, ci_j, cand_on);
        }
        {
            float dot[8]; PEER_DOTS(dot)
            int ln = lane; asm volatile("" : "+v"(ln)); const int el1 = ((ln >> 2) & 1) | (((ln >> 1) & 1) << 1) | ((ln & 1) << 2);
            const int nofs = hh < 31 ? ((hh + 1) & 1) * 32 : (hh & 1) * 32 + 8;
            const int mye = ((LAS int*)(wl + 160 + nofs))[el1]; int ei[8]; PEER_IDS(mye, ei) PEER_ISSUE_U(ei, ln)
            const float cfl = gl * gelu_erf(reduce8(dot, lane) * sul) * svl;
            PEER_ACCUM(cfl)
            PEER_ISSUE_V(ei, ln)
            sul = Us[mye]; svl = Vs[mye]; gl = (wl + 176 + nofs)[el1];
        }
        if (h == 7) {
        f32x4 o[8]; float ssq = 0.f;
#pragma unroll
        for (int j = 0; j < 8; ++j) { o[j] = *((const f32x4*)(x1 + (size_t)tok * DM) + 64 * j + lane) + (f32x4){acc[j * 4 + 0], acc[j * 4 + 1], acc[j * 4 + 2], acc[j * 4 + 3]};
            *((f32x4*)(xout + (size_t)tok * DM) + 64 * j + lane) = o[j]; ssq += o[j].x * o[j].x + o[j].y * o[j].y + o[j].z * o[j].z + o[j].w * o[j].w; }
        if (write_hb) {
            const float rs = rsqrtf(wave_sum(ssq) * (1.f / DM) + 1e-6f);
#pragma unroll
            for (int j = 0; j < 8; ++j) { u32x2 pw; pw.x = pk2(o[j].x * rs, o[j].y * rs); pw.y = pk2(o[j].z * rs, o[j].w * rs); *((u32x2*)(hb + (size_t)tok * DM) + 64 * j + lane) = pw; }
        }
        }
    }
#undef PEER_IDS
#undef PEER_ISSUE_U
#undef PEER_ISSUE_V
#undef PEER_DOTS
#undef PEER_ACCUM
    __syncthreads();
}

constexpr int N_PHASES = 19;
template <int PH>
__device__ __forceinline__ void run_phase(unsigned char* lds_raw, const int wave0) {
    if constexpr (PH == 0) { if (PON(9)) { const Ctx C = fresh_ctx_w(lds_raw, wave0); const AP a = fresh_args(); phase_prep(C, a); } }
    else {
            constexpr int l = (PH - 1) / 9, k = (PH - 1) % 9;
            switch (k) {
            case 0: if (PON(0)) {
                const Ctx C = fresh_ctx_w(lds_raw, wave0); const AP a = fresh_args(); unsigned char* ws = a.ws;
                pg8::Gemm g{(const bf16_t*)(ws + WS_HB), (const bf16_t*)(ws + WS_WINT) + (size_t)l * PROJ * DM, DM};
                pg8::Order S; S.init(32, 16, 1, 0, 0, 0, C.G, C.bx);
                pg8::EpiInProj E{(bf16_t*)(ws + WS_PA), (float*)(ws + WS_PROJ)};
                pg8::gemm_phase(C.lds, g, S, E, C.tid);
            } break;
            case 1: if (PON(1)) {
                int bxo = blockIdx.x; asm volatile("" : "+s"(bxo));
                if (bxo < 128) { const Ctx C = fresh_ctx_w(lds_raw, wave0); const AP a = fresh_args();
                  for (int ti = C.bx; ti < MTOK / 32; ti += C.G) rwkv_prep_item(C, a, l, ti); }
                if (PON(11)) { const Ctx C = fresh_ctx_w(lds_raw, wave0); const AP a = fresh_args(); unsigned char* ws = a.ws;
                  pg8::Gemm g{(const bf16_t*)(ws + WS_WCST) + (size_t)l * 1024 * 512, (const bf16_t*)(ws + WS_PA), 512};
                  pg8::Order S; S.init(4, 32, 1, 0, 0, 0, C.G, C.bx);
                  pg8::EpiC1 E{(bf16_t*)(ws + WS_C1)};
                  pg8::gemm_phase(C.lds, g, S, E, C.tid); }
                __syncthreads();
                if (PON(12)) { const Ctx C = fresh_ctx_w(lds_raw, wave0); const AP a = fresh_args();
                  const int m0 = C.bx < 128 ? C.gw : 2048 + C.gw, m1 = C.bx < 128 ? 3072 : MTOK;
                  for (int m = m0; m < m1; m += 1024) qk_prep_token(a, l, m, C.lane); }
                if (PON(13)) { const Ctx C = fresh_ctx_w(lds_raw, wave0); const AP a = fresh_args();
                  const int i1 = C.bx < 128 ? 1024 : 4096;
                  for (int it = C.gw; it < i1; it += 1024) s5_ends_item(a, l, it, C.lane, (LAS float*)(C.lds + C.wave * 4096)); }
                if (bxo >= 128) { __syncthreads(); const Ctx C = fresh_ctx_w(lds_raw, wave0); const AP a = fresh_args();
                  for (int ti = C.bx; ti < MTOK / 32; ti += C.G) rwkv_prep_item(C, a, l, ti); }
            } break;
            case 2: if (PON(2)) {
                if (PON(17)) { const Ctx C = fresh_ctx_w(lds_raw, wave0); const AP a = fresh_args();
                  volatile LAS int* qs = (volatile LAS int*)(C.lds + LDS_BYTES - 128);
                  unsigned* qctr = (unsigned*)(a.ws + WS_CTL) + 64 + l * 64;
#pragma unroll 1
                  for (;;) {
                    __syncthreads();
                    if (C.tid == 0) *qs = (int)__hip_atomic_fetch_add(qctr, 8u, __ATOMIC_RELAXED, __HIP_MEMORY_SCOPE_AGENT);
                    __syncthreads();
                    const int base = *qs; if (base >= 14336) break;
                    const int it = base + C.wave;
                    if (it < 4096) s5_final_item_h(a, l, it, C.lane, C.lds + C.wave * 16384);
                    else if (it < 12288) rwkv_chunk_pre(a, it - 4096, C.lane, C.lds + C.wave * 16384);
                    else c1_fold_item(a, it - 12288, C.lane);
                  } }
            } break;
            case 3: if (PON(3)) {
                int bx0 = blockIdx.x; asm volatile("" : "+s"(bx0));
                if (bx0 < 64) { const Ctx C = fresh_ctx_w(lds_raw, wave0); const AP a = fresh_args(); rwkv_seq_chain(C, a, C.bx); }
                else if (bx0 < 192) {
                    if (PON(15)) { const Ctx C = fresh_ctx_w(lds_raw, wave0); const AP a = fresh_args(); unsigned char* ws = a.ws;
                      const int au = C.bx - 64;
                      { const int qblk = au & 7, hq = (au >> 3) & 3, b = au >> 5;
                        const bf16_t* Q = (const bf16_t*)(ws + WS_QB) + ((size_t)(b * SEQ + qblk * 256)) * 512 + hq * 128;
                        const bf16_t* Kp = (const bf16_t*)(ws + WS_QB) + (size_t)MTOK * 512 + ((size_t)b * SEQ) * 256 + (hq >> 1) * 128;
                        const bf16_t* Vp = Kp + (size_t)MTOK * 256;
                        float* O = (float*)(ws + WS_YA) + (size_t)2 * RWSZ + ((size_t)(b * SEQ + qblk * 256)) * 512 + hq * 128;
                        att::attn_dense_body<att::bf16>(Q, Kp, Vp, O, SEQ, (char*)C.lds, C.tid);
                      } }
                } else {
                    { const Ctx C = fresh_ctx_w(lds_raw, wave0); const AP a = fresh_args(); unsigned char* ws = a.ws;
                        pg8::Gemm g{(const bf16_t*)(ws + WS_YGELU), (const bf16_t*)(ws + WS_WGLUT) + (size_t)l * 512 * 512, 512};
                        pg8::Order S; S.init(32, 2, 1, 0, 0, 0, 64, C.bx - 192);
                        pg8::EpiGlu E{(const bf16_t*)(ws + WS_YGELU), (float*)(ws + WS_YA) + RWSZ};
                        pg8::gemm_phase(C.lds, g, S, E, C.tid);
                        __syncthreads(); }
                    if (PON(16)) { const Ctx C = fresh_ctx_w(lds_raw, wave0); const AP a = fresh_args(); unsigned char* ws = a.ws;
                      pg8::Gemm g{(const bf16_t*)(ws + WS_DFT), (const bf16_t*)(ws + WS_C1F), 2048};
                      pg8::Order S; S.init(8, 2, 4, 0, 2, 8, 64, C.bx - 192);
                      pg8::EpiF32 E{(float*)(ws + WS_YA), 512};
                      pg8::gemm_phase(C.lds, g, S, E, C.tid); }
                }
            } break;
            case 4: if (PON(4)) {
                const Ctx C = fresh_ctx_w(lds_raw, wave0); const AP a = fresh_args();
                for (int m = C.gw; m < MTOK; m += C.ngw) {
                    branch_norm_item(a, m * 4 + 0, C.lane); branch_norm_item(a, m * 4 + 1, C.lane); branch_norm_item(a, m * 4 + 2, C.lane); branch_d_item(a, l, m, C.lane); }
            } break;
            case 5: if (PON(5)) {
                const Ctx C = fresh_ctx_w(lds_raw, wave0); const AP a = fresh_args(); unsigned char* ws = a.ws;
                const float* xin = l == 0 ? a.in[0] : (const float*)(ws + WS_X2);
                pg8::Gemm g{(const bf16_t*)(ws + WS_HB), (const bf16_t*)(ws + WS_WOUTT) + (size_t)l * DM * DM, DM};
                pg8::Order S; S.init(32, 8, 1, 0, 0, 0, C.G, C.bx);
                pg8::EpiResid E{xin, (float*)(ws + WS_X1), DM};
                pg8::gemm_phase(C.lds, g, S, E, C.tid);
            } break;
            case 6: if (PON(6)) {
                const Ctx C = fresh_ctx_w(lds_raw, wave0); const AP a = fresh_args(); unsigned char* ws = a.ws;
                for (int m = C.gw; m < MTOK; m += C.ngw) rms_row_to_bf16((const float*)(ws + WS_X1) + (size_t)m * DM, (bf16_t*)(ws + WS_HB) + (size_t)m * DM, C.lane);
            } break;
            case 7: if (PON(7)) {
                int bx0 = blockIdx.x; asm volatile("" : "+s"(bx0));
                if (bx0 < 128) {
                    const Ctx C = fresh_ctx_w(lds_raw, wave0); const AP a = fresh_args(); unsigned char* ws = a.ws;
                    pg8::Gemm g{(const bf16_t*)(ws + WS_HB), (const bf16_t*)(ws + WS_WQT) + (size_t)l * 1024 * DM, DM};
                    pg8::Order S; S.init(32, 4, 1, 0, 0, 0, 128, C.bx);
                    pg8::EpiF32 E{(float*)(ws + WS_PROJ), 1024};
                    pg8::gemm_phase(C.lds, g, S, E, C.tid);
                } else {
                    const Ctx C = fresh_ctx_w(lds_raw, wave0); const AP a = fresh_args();
#pragma unroll 1
                    for (int it = (C.bx - 128) * 8 + C.wave; it < 16384; it += 1024) { const int r2 = it * 2; expert_row_item2(a, r2 >> 14, l, r2 & 16383, C.lane); }
                }
            } break;
            case 8: if (PON(8)) {
                const Ctx C = fresh_ctx_w(lds_raw, wave0); const AP a = fresh_args(); unsigned char* ws = a.ws;
                float* xo = l == 0 ? (float*)(ws + WS_X2) : a.out;
                for (int tile = C.bx; tile < MTOK / 32; tile += C.G) peer_tile(C, a, l, tile, (const float*)(ws + WS_X1), xo, l == 0);
            } break;
            default: break;
            }
    }
}
__global__ void __launch_bounds__(NTHR, 2) fwd_kernel(Args a0) {
    extern __shared__ __attribute__((aligned(16))) unsigned char lds_raw[];
    cg::grid_group grid = cg::this_grid();
    const int wave0 = __builtin_amdgcn_readfirstlane((int)threadIdx.x >> 6);
    volatile LAS unsigned* bst = (volatile LAS unsigned*)((LAS unsigned char*)lds_raw + LDS_BYTES - 64);
    if (threadIdx.x < 2) bst[threadIdx.x] = 0u;
    __syncthreads();
    const XcdBarrier xbar = xcd_barrier_post((unsigned*)(a0.ws + WS_CTL) + 4096, bst);
    const int lo = a0.ph_lo, hi = a0.ph_hi;
    if (lo < 0) grid.sync();
#define MK_STEP(PH) if (lo <= (PH) && (PH) < hi) { run_phase<PH>(lds_raw, wave0); \
        if ((((unsigned)PROBE_REP_MASK >> (PH)) & 1u) != 0u) { xcd_barrier(xbar); run_phase<PH>(lds_raw, wave0); } \
        if ((PH) + 1 < hi) xcd_barrier(xbar); }
    MK_STEP(0) MK_STEP(1) MK_STEP(2) MK_STEP(3) MK_STEP(4) MK_STEP(5) MK_STEP(6) MK_STEP(7) MK_STEP(8) MK_STEP(9)
    MK_STEP(10) MK_STEP(11) MK_STEP(12) MK_STEP(13) MK_STEP(14) MK_STEP(15) MK_STEP(16) MK_STEP(17) MK_STEP(18)
#undef MK_STEP
}

extern "C" void kernel_launch(void* const* d_in, const int* in_sizes, int n_in, void* d_out, int out_size, void* d_ws, size_t ws_size, hipStream_t stream) {
    static int grid = 0;
    if (grid == 0) {
        if (n_in != 36 || in_sizes[0] != MTOK * DM || out_size != MTOK * DM || ws_size < WS_END) {
            fprintf(stderr, "kernel_launch: shape mismatch: n_in %d in0 %d out %d ws %zu (need %zu)\n", n_in, n_in > 0 ? in_sizes[0] : -1, out_size, ws_size, (size_t)WS_END); grid = -1; return; }
        int dev = 0, cus = 0, per_cu = 0;
        if (hipGetDevice(&dev) != hipSuccess || hipDeviceGetAttribute(&cus, hipDeviceAttributeMultiprocessorCount, dev) != hipSuccess) { fprintf(stderr, "kernel_launch: device query failed\n"); grid = -1; return; }
        if (hipFuncSetAttribute((const void*)fwd_kernel, hipFuncAttributeMaxDynamicSharedMemorySize, LDS_BYTES) != hipSuccess) { fprintf(stderr, "kernel_launch: hipFuncSetAttribute failed\n"); grid = -1; return; }
        if (hipOccupancyMaxActiveBlocksPerMultiprocessor(&per_cu, (const void*)fwd_kernel, NTHR, LDS_BYTES) != hipSuccess || per_cu < 1) { fprintf(stderr, "kernel_launch: occupancy query gives %d\n", per_cu); grid = -1; return; }
        grid = cus * per_cu; if (grid > 256) grid = 256;
        if (grid < 128) { fprintf(stderr, "kernel_launch: grid %d too small\n", grid); grid = -1; return; }
    }
    if (grid < 0) return;
    if (hipMemsetAsync((char*)d_ws + WS_CTL, 0, 65536, stream) != hipSuccess) { fprintf(stderr, "kernel_launch: memset failed\n"); return; }
    Args a{};
    for (int i = 0; i < 36; ++i) a.in[i] = (const float*)d_in[i];
    a.out = (float*)d_out; a.ws = (unsigned char*)d_ws;
#if MK_ONE_LAUNCH
    a.ph_lo = 0; a.ph_hi = N_PHASES;
    void* args[] = {&a};
    hipError_t e = hipLaunchCooperativeKernel((const void*)fwd_kernel, dim3(grid), dim3(NTHR), args, LDS_BYTES, stream);
    if (e != hipSuccess) fprintf(stderr, "kernel_launch: cooperative launch failed: %s (grid %d)\n", hipGetErrorString(e), grid);
#else
    for (int ph = 0; ph < N_PHASES; ++ph) {
        a.ph_lo = ph; a.ph_hi = ph + 1;
        hipLaunchKernelGGL(fwd_kernel, dim3(grid), dim3(NTHR), LDS_BYTES, stream, a);
    }
    hipError_t e = hipPeekAtLastError();
    if (e != hipSuccess) fprintf(stderr, "kernel_launch: launch failed: %s\n", hipGetErrorString(e));
#endif
}
```

```cpp
#include <hip/hip_runtime.h>
#include <hip/hip_cooperative_groups.h>
#include <cstdio>
#include <cstdint>
#include <cstddef>
namespace cg = cooperative_groups;

#ifndef MK_ONE_LAUNCH
#define MK_ONE_LAUNCH 1
#endif
#ifndef PHM
#define PHM 0x3ffff
#endif
#define PON(i) (((PHM) >> (i)) & 1)
#ifndef PROBE_REP_MASK
#define PROBE_REP_MASK 0u
#endif

namespace pg8 {
#define PG8_LAS __attribute__((address_space(3)))
typedef unsigned short bf16_t;
typedef short bf16x8 __attribute__((ext_vector_type(8)));
typedef float f32x4 __attribute__((ext_vector_type(4)));
typedef unsigned u32x4 __attribute__((ext_vector_type(4)));
typedef unsigned u32x2 __attribute__((ext_vector_type(2)));
constexpr int BM = 256, BK = 64, HALF = 128, HTB = HALF * BK * 2, STAGE_BYTES = 8 * HTB, NXCD = 8, WGM = 8;

__host__ __device__ __forceinline__ int lds_byte(int r, int c) { const int st = (r >> 4) * 2 + (c >> 5), rr = r & 15, cc = c & 31, ob = rr * 64 + cc * 2; return st * 1024 + (ob ^ (((ob >> 9) & 1) << 5)); }
__host__ __device__ __forceinline__ void stage_rc(int b, int& R, int& C) { const int st = b / 1024, sb = b % 1024, swz = sb ^ (((sb >> 9) & 1) << 5); R = (st >> 1) * 16 + swz / 64; C = (st & 1) * 32 + (swz % 64) / 2; }

struct Unit { int pm, pn, pa, pb; };
struct Gemm { const bf16_t* A; const bf16_t* Bt; int K; };

struct Order {
    int nM, nN, nb, nwg, G, c, aM, bN, oM;
    __device__ __forceinline__ void init(int nM_, int nN_, int nb_, int aM_, int bN_, int oM_, int G_, int c_) { nM = nM_; nN = nN_; nb = nb_; aM = aM_; bN = bN_; oM = oM_; nwg = nM * nN * nb; G = G_; c = c_; }
    __device__ __forceinline__ bool next(int i, Unit& u) const {
        const int L = i * G + c; if (L >= nwg || c < 0) return false;
        const int per = nM * nN, b = L / per; int wgid = L - b * per;
        { const int q = per / NXCD, r = per % NXCD, xcd = wgid % NXCD, off = wgid / NXCD; wgid = (xcd < r ? xcd * (q + 1) : r * (q + 1) + (xcd - r) * q) + off; }
        const int nig = WGM * nN, gid = wgid / nig, fm = gid * WGM, gsz = (nM - fm) < WGM ? (nM - fm) : WGM;
        const int pm = fm + ((wgid % nig) % gsz), pn = (wgid % nig) / gsz;
        u.pm = pm + b * oM; u.pn = pn; u.pa = pm + b * aM; u.pb = pn + b * bN; return true;
    }
};

__device__ __forceinline__ unsigned cvt_pk_bf16(float lo, float hi) { unsigned r; asm volatile("v_cvt_pk_bf16_f32 %0, %1, %2" : "=v"(r) : "v"(lo), "v"(hi)); return r; }

#define PG8_EPI_LOOP(...) \
    _Pragma("unroll") for (int ai = 0; ai < 2; ++ai) _Pragma("unroll") for (int m = 0; m < 4; ++m) { const int row = u.pm * BM + ai * HALF + wr * 64 + m * 16 + fr; \
        _Pragma("unroll") for (int bj = 0; bj < 2; ++bj) _Pragma("unroll") for (int n = 0; n < 2; ++n) { const int col = u.pn * BM + bj * HALF + wc * 32 + n * 16 + 4 * fq; const f32x4 v = acc[ai][bj][m][n]; __VA_ARGS__ } }

struct EpiF32 {
    float* out; int ldc;
    __device__ __forceinline__ void operator()(const f32x4 (&acc)[2][2][4][2], const Unit& u, int wr, int wc, int fr, int fq) const {
        PG8_EPI_LOOP( *(f32x4*)(out + (size_t)row * ldc + col) = v; )
    }
};
struct EpiResid {
    const float* base; float* out; int ldc;
    __device__ __forceinline__ void operator()(const f32x4 (&acc)[2][2][4][2], const Unit& u, int wr, int wc, int fr, int fq) const {
        PG8_EPI_LOOP( const f32x4 b = *(const f32x4*)(base + (size_t)row * ldc + col); *(f32x4*)(out + (size_t)row * ldc + col) = b + v; )
    }
};
struct EpiInProj {
    bf16_t* pa; float* proj;
    __device__ __forceinline__ void operator()(const f32x4 (&acc)[2][2][4][2], const Unit& u, int wr, int wc, int fr, int fq) const {
        if (u.pn < 2) { PG8_EPI_LOOP( u32x2 w; w.x = cvt_pk_bf16(v[0], v[1]); w.y = cvt_pk_bf16(v[2], v[3]); *(u32x2*)(pa + (size_t)row * 512 + col) = w; ) }
        else { PG8_EPI_LOOP( *(f32x4*)(proj + (size_t)row * 4096 + col) = v; ) }
    }
};
struct EpiC1 {
    bf16_t* c1;
    __device__ __forceinline__ void operator()(const f32x4 (&acc)[2][2][4][2], const Unit& u, int wr, int wc, int fr, int fq) const {
        PG8_EPI_LOOP( const int b = col >> 11, s = col & 2047; u32x2 w; w.x = cvt_pk_bf16(v[0], v[1]); w.y = cvt_pk_bf16(v[2], v[3]);
                      *(u32x2*)(c1 + ((size_t)b * 1024 + row) * 2048 + s) = w; )
    }
};
struct EpiGlu {
    const bf16_t* y; float* out;
    __device__ __forceinline__ void operator()(const f32x4 (&acc)[2][2][4][2], const Unit& u, int wr, int wc, int fr, int fq) const {
        PG8_EPI_LOOP( const u32x2 yw = *(const u32x2*)(y + (size_t)row * 512 + col);
                      f32x4 yv; yv[0] = __uint_as_float(yw.x << 16); yv[1] = __uint_as_float(yw.x & 0xffff0000u); yv[2] = __uint_as_float(yw.y << 16); yv[3] = __uint_as_float(yw.y & 0xffff0000u);
                      f32x4 o; _Pragma("unroll") for (int e = 0; e < 4; ++e) o[e] = yv[e] / (1.f + __expf(-v[e]));
                      *(f32x4*)(out + (size_t)row * 512 + col) = o; )
    }
};

template <class Epi, class Sched>
__device__ __forceinline__ void gemm_phase(PG8_LAS unsigned char* lds, const Gemm g, const Sched& S, const Epi& E, const int tid) {
    const int wid = __builtin_amdgcn_readfirstlane(tid >> 6), lane = tid & 63, wr = wid >> 2, wc = wid & 3, fr = lane & 15, fq = lane >> 4;
    const int K = g.K, nt = K / BK;
    unsigned voffA[2];
#pragma unroll
    for (int i = 0; i < 2; ++i) { int R, C; stage_rc(tid * 16 + i * 8192, R, C); voffA[i] = (unsigned)(R * K + C) * 2u; }
    const size_t kstep = (size_t)(BK * 2);
    const size_t hstep = (size_t)HALF * K * 2;
    const size_t tstep = 2 * hstep;
    const unsigned ldsw = (unsigned)wid * 1024u;
    const int aoff = lds_byte(wr * 64 + fr, fq * 8), boff = lds_byte(wc * 32 + fr, fq * 8);
#define PG8_SA(b, h) (((b) * 2 + (h)) * HTB)
#define PG8_SB(b, h) ((4 + (b) * 2 + (h)) * HTB)
#define PG8_STAGE(bufoff, gbase, voff) do { _Pragma("unroll") for (int _i = 0; _i < 2; ++_i) \
        __builtin_amdgcn_global_load_lds((const unsigned*)((const char*)(gbase) + (voff)[_i]), (PG8_LAS unsigned*)(lds + (bufoff) + ldsw + _i * 8192), 16, 0, 0); } while (0)
#define PG8_LDA(dst, b, h) do { _Pragma("unroll") for (int m = 0; m < 4; ++m) _Pragma("unroll") for (int k = 0; k < 2; ++k) dst[m][k] = *(const PG8_LAS bf16x8*)(lds + PG8_SA(b, h) + aoff + m * 2048 + k * 1024); } while (0)
#define PG8_LDB(dst, b, h) do { _Pragma("unroll") for (int n = 0; n < 2; ++n) _Pragma("unroll") for (int k = 0; k < 2; ++k) dst[n][k] = *(const PG8_LAS bf16x8*)(lds + PG8_SB(b, h) + boff + n * 2048 + k * 1024); } while (0)
#define PG8_MMA(ai, bj, At, Bt) do { __builtin_amdgcn_s_setprio(1); _Pragma("unroll") for (int m = 0; m < 4; ++m) _Pragma("unroll") for (int n = 0; n < 2; ++n) _Pragma("unroll") for (int k = 0; k < 2; ++k) \
        acc[ai][bj][m][n] = __builtin_amdgcn_mfma_f32_16x16x32_bf16(Bt[n][k], At[m][k], acc[ai][bj][m][n], 0, 0, 0); __builtin_amdgcn_s_setprio(0); } while (0)
#define PG8_WAIT_V(n) asm volatile("s_waitcnt vmcnt(" #n ")" ::: "memory")
#define PG8_WAIT_L(n) asm volatile("s_waitcnt lgkmcnt(" #n ")" ::: "memory")
#define PG8_BAR __builtin_amdgcn_s_barrier()
#define PG8_SCHED __builtin_amdgcn_sched_barrier(0)
    Unit cur, nxt; int ui = 0;
    if (!S.next(0, cur)) return;
    f32x4 acc[2][2][4][2];
#pragma unroll
    for (int a = 0; a < 2; ++a)
#pragma unroll
        for (int b = 0; b < 2; ++b)
#pragma unroll
            for (int m = 0; m < 4; ++m)
#pragma unroll
                for (int n = 0; n < 2; ++n) acc[a][b][m][n] = (f32x4){0.f, 0.f, 0.f, 0.f};
    bf16x8 At[4][2], B0[2][2], B1[2][2];
    const char* cA = (const char*)g.A + (size_t)cur.pa * tstep; const char* cB = (const char*)g.Bt + (size_t)cur.pb * tstep;
    PG8_STAGE(PG8_SB(0, 0), cB, voffA); PG8_STAGE(PG8_SB(0, 1), cB + hstep, voffA); PG8_STAGE(PG8_SA(0, 0), cA, voffA); PG8_STAGE(PG8_SA(0, 1), cA + hstep, voffA);
    if (wr == 1) PG8_BAR;
    PG8_WAIT_V(2); PG8_BAR;
    PG8_STAGE(PG8_SB(1, 0), cB + kstep, voffA); PG8_STAGE(PG8_SA(1, 0), cA + kstep, voffA); PG8_STAGE(PG8_SB(1, 1), cB + hstep + kstep, voffA);
    PG8_WAIT_V(6); PG8_BAR;
    for (;;) {
        const bool has_next = S.next(ui + 1, nxt);
        const char* nA = has_next ? (const char*)g.A + (size_t)nxt.pa * tstep : cA; const char* nB = has_next ? (const char*)g.Bt + (size_t)nxt.pb * tstep : cB;
        for (int t = 0; t < nt; t += 2) {
            const bool last = (t == nt - 2);
            const char* a1 = cA + (size_t)(t + 1) * kstep;
            const char* a2 = last ? nA : cA + (size_t)(t + 2) * kstep; const char* b2 = last ? nB : cB + (size_t)(t + 2) * kstep;
            const char* a3 = a2 + kstep; const char* b3 = b2 + kstep;
            PG8_LDB(B0, 0, 0); PG8_LDB(B1, 0, 1); PG8_SCHED; PG8_LDA(At, 0, 0); PG8_STAGE(PG8_SA(1, 1), a1 + hstep, voffA);
            PG8_WAIT_V(8); PG8_WAIT_L(0); PG8_BAR; PG8_MMA(0, 0, At, B0); PG8_MMA(0, 1, At, B1); PG8_BAR; PG8_SCHED;
            PG8_LDA(At, 0, 1); PG8_STAGE(PG8_SB(0, 0), b2, voffA); PG8_STAGE(PG8_SB(0, 1), b2 + hstep, voffA); PG8_STAGE(PG8_SA(0, 0), a2, voffA);
            PG8_WAIT_V(8); PG8_WAIT_L(0); PG8_BAR; PG8_MMA(1, 0, At, B0); PG8_MMA(1, 1, At, B1); PG8_BAR; PG8_SCHED;
            PG8_LDB(B0, 1, 0); PG8_LDB(B1, 1, 1); PG8_SCHED; PG8_LDA(At, 1, 0); PG8_STAGE(PG8_SA(0, 1), a2 + hstep, voffA);
            PG8_WAIT_V(8); PG8_WAIT_L(0); PG8_BAR; PG8_MMA(0, 0, At, B0); PG8_MMA(0, 1, At, B1); PG8_BAR; PG8_SCHED;
            PG8_LDA(At, 1, 1); PG8_STAGE(PG8_SB(1, 0), b3, voffA); PG8_STAGE(PG8_SB(1, 1), b3 + hstep, voffA); PG8_STAGE(PG8_SA(1, 0), a3, voffA);
            PG8_WAIT_V(8); PG8_WAIT_L(0); PG8_BAR; PG8_MMA(1, 0, At, B0); PG8_MMA(1, 1, At, B1); PG8_BAR; PG8_SCHED;
        }
        if (wr == 0) PG8_BAR;
        E(acc, cur, wr, wc, fr, fq);
        if (!has_next) break;
#pragma unroll
        for (int a = 0; a < 2; ++a)
#pragma unroll
            for (int b = 0; b < 2; ++b)
#pragma unroll
                for (int m = 0; m < 4; ++m)
#pragma unroll
                    for (int n = 0; n < 2; ++n) acc[a][b][m][n] = (f32x4){0.f, 0.f, 0.f, 0.f};
        cur = nxt; cA = nA; cB = nB; ++ui;
        if (wr == 1) PG8_BAR;
    }
    PG8_WAIT_V(0);
    PG8_BAR;
#undef PG8_SA
#undef PG8_SB
#undef PG8_STAGE
#undef PG8_LDA
#undef PG8_LDB
#undef PG8_MMA
#undef PG8_WAIT_V
#undef PG8_WAIT_L
#undef PG8_BAR
#undef PG8_SCHED
}
}

namespace att {
using bf16 = unsigned short;
constexpr int   D = 128, NW = 8, QBLK = 32, KVBLK = 64;
constexpr float SCALE = 0.088388347648318440f;
constexpr float THR = 8.f;
constexpr int SDEPTH = 1;
constexpr int LDQ = 512, LDK = 256, LDO = 512;
constexpr size_t SHM_V = KVBLK * D * 2, SHM_K = KVBLK * D * 2, SHM_ATTN = 2 * SHM_V + 2 * SHM_K + NW * 64 * 4;

using bf16x8 = __attribute__((ext_vector_type(8))) short;
using s16x4  = __attribute__((ext_vector_type(4))) short;
using f32x16 = __attribute__((ext_vector_type(16))) float;
using f32x8  = __attribute__((ext_vector_type(8))) float;
using u32x4  = __attribute__((ext_vector_type(4))) unsigned;
#define KSWZ(row, colB) ((row) * 256 + ((colB) ^ (((row) & 7) << 4)))
#define SBAR() __builtin_amdgcn_sched_barrier(0)
__device__ __forceinline__ int crow(int r, int hi) { return (r & 3) + 8 * (r >> 2) + 4 * hi; }
__device__ __forceinline__ unsigned cvtpk(float lo, float hi) {
  unsigned r; asm volatile("v_cvt_pk_bf16_f32 %0, %1, %2" : "=v"(r) : "v"(lo), "v"(hi)); return r;
}
template <typename TIn> struct Stage;
template <> struct Stage<bf16>  { using T = bf16x8;
  __device__ static __forceinline__ T ld8(const bf16* p) { return *reinterpret_cast<const bf16x8*>(p); }
  __device__ static __forceinline__ bf16x8 tobf(T x) { return x; } };

__device__ __forceinline__ void partialSM(f32x16& p0, f32x16& p1, float& m_reg, float& mn, float& alpha) {
  constexpr float C = SCALE * 1.4426950408889634f;
  float pmax = p0[0]; for (int r = 1; r < 16; ++r) pmax = fmaxf(pmax, p0[r]); for (int r = 0; r < 16; ++r) pmax = fmaxf(pmax, p1[r]);
  { auto rr = __builtin_amdgcn_permlane32_swap(__float_as_uint(pmax), __float_as_uint(pmax), false, false);
    pmax = fmaxf(__uint_as_float(rr[0]), __uint_as_float(rr[1])); }
  if (__builtin_expect(__all(pmax - m_reg <= THR / SCALE), 1)) { mn = m_reg; alpha = 1.f; }
  else { mn = fmaxf(m_reg, pmax); alpha = __builtin_amdgcn_exp2f((m_reg - mn) * C); m_reg = mn; }
  float mnC = -mn * C;
  for (int r = 0; r < 16; ++r) p0[r] = fmaf(p0[r], C, mnC); for (int r = 0; r < 16; ++r) p1[r] = fmaf(p1[r], C, mnC);
  for (int r = 0; r < 16; ++r) p0[r] = __builtin_amdgcn_exp2f(p0[r]);
}
__device__ __forceinline__ void finishSM(f32x16& p0, f32x16& p1, float alpha, float& l_reg, bf16x8& pa0, bf16x8& pa1, bf16x8& pa2, bf16x8& pa3) {
  for (int r = 0; r < 16; ++r) p1[r] = __builtin_amdgcn_exp2f(p1[r]);
  float ps = 0; for (int r = 0; r < 16; ++r) ps += p0[r]; for (int r = 0; r < 16; ++r) ps += p1[r];
  { auto rr = __builtin_amdgcn_permlane32_swap(__float_as_uint(ps), __float_as_uint(ps), false, false);
    ps = __uint_as_float(rr[0]) + __uint_as_float(rr[1]); }
  l_reg = l_reg * alpha + ps;
#define PK4(P, BASE, OUT) do { unsigned a0 = cvtpk(P[BASE + 0], P[BASE + 1]), a1 = cvtpk(P[BASE + 2], P[BASE + 3]);   \
    unsigned b0 = cvtpk(P[BASE + 4], P[BASE + 5]), b1 = cvtpk(P[BASE + 6], P[BASE + 7]);                              \
    auto r0 = __builtin_amdgcn_permlane32_swap(a0, b0, false, false); auto r1 = __builtin_amdgcn_permlane32_swap(a1, b1, false, false); \
    u32x4 w = {r0[0], r1[0], r0[1], r1[1]}; OUT = *reinterpret_cast<bf16x8*>(&w); } while (0)
  PK4(p0, 0, pa0); PK4(p0, 8, pa1); PK4(p1, 0, pa2); PK4(p1, 8, pa3);
#undef PK4
}
__device__ __forceinline__ void qkt(f32x16& p0, f32x16& p1, const bf16* Ks, const bf16x8* qr, int r32, int hi) {
  p0 = f32x16{}; p1 = f32x16{};
  for (int d0 = 0; d0 < 8; ++d0) { int cb = (d0 * 16 + hi * 8) * 2;
    bf16x8 b0 = *reinterpret_cast<const bf16x8*>((const char*)Ks + KSWZ(r32, cb));
    bf16x8 b1 = *reinterpret_cast<const bf16x8*>((const char*)Ks + KSWZ(32 + r32, cb));
    p0 = __builtin_amdgcn_mfma_f32_32x32x16_bf16(b0, qr[d0], p0, 0, 0, 0);
    p1 = __builtin_amdgcn_mfma_f32_32x32x16_bf16(b1, qr[d0], p1, 0, 0, 0); }
}
__device__ __forceinline__ int v_st(int k, int c) { const int kk = (k & ~0xC) | ((k & 4) << 1) | ((k & 8) >> 1); return ((kk >> 3) * 4 + (c >> 5)) * 512 + ((kk & 7) * 32 + (c & 31)) * 2; }
__device__ __forceinline__ int v_rd_base(int lane) { return ((lane & 3) << 3) | (((lane >> 2) & 3) << 6) | (((lane >> 4) & 1) << 5) | (((lane >> 5) & 1) << 8); }
constexpr int v_rd_off(int d0, int ks, int half) { return d0 * 512 + ks * 4096 + half * 2048; }
template <int OFF> __device__ __forceinline__ s16x4 tr_read(int vb) {
  s16x4 r; asm volatile("ds_read_b64_tr_b16 %0, %1 offset:%2" : "=&v"(r) : "v"(vb), "i"(OFF) : "memory"); return r;
}
template <int D0> __device__ __forceinline__ void pv_one(f32x16& od, int vb, bf16x8 pa0, bf16x8 pa1, bf16x8 pa2, bf16x8 pa3) {
  const s16x4 l0 = tr_read<v_rd_off(D0, 0, 0)>(vb), h0 = tr_read<v_rd_off(D0, 0, 1)>(vb), l1 = tr_read<v_rd_off(D0, 1, 0)>(vb), h1 = tr_read<v_rd_off(D0, 1, 1)>(vb);
  const s16x4 l2 = tr_read<v_rd_off(D0, 2, 0)>(vb), h2 = tr_read<v_rd_off(D0, 2, 1)>(vb), l3 = tr_read<v_rd_off(D0, 3, 0)>(vb), h3 = tr_read<v_rd_off(D0, 3, 1)>(vb);
  asm volatile("s_waitcnt lgkmcnt(0)" ::: "memory"); SBAR();
#define PK(L, H) (bf16x8){L[0], L[1], L[2], L[3], H[0], H[1], H[2], H[3]}
  od = __builtin_amdgcn_mfma_f32_32x32x16_bf16(pa0, PK(l0, h0), od, 0, 0, 0);
  od = __builtin_amdgcn_mfma_f32_32x32x16_bf16(pa1, PK(l1, h1), od, 0, 0, 0);
  od = __builtin_amdgcn_mfma_f32_32x32x16_bf16(pa2, PK(l2, h2), od, 0, 0, 0);
  od = __builtin_amdgcn_mfma_f32_32x32x16_bf16(pa3, PK(l3, h3), od, 0, 0, 0);
#undef PK
}
__device__ __forceinline__ void pv_d0(f32x16* o, int vb, bf16x8 pa0, bf16x8 pa1, bf16x8 pa2, bf16x8 pa3) {
  pv_one<0>(o[0], vb, pa0, pa1, pa2, pa3); pv_one<1>(o[1], vb, pa0, pa1, pa2, pa3); pv_one<2>(o[2], vb, pa0, pa1, pa2, pa3); pv_one<3>(o[3], vb, pa0, pa1, pa2, pa3);
}
template <typename TQ>
__device__ __forceinline__ void attn_dense_body(const TQ* __restrict__ Qb, const bf16* __restrict__ Kh, const bf16* __restrict__ Vh,
                                                float* __restrict__ Ob, int seq, char* lds, const int tid_) {
  using St = Stage<bf16>; using SQ = Stage<TQ>;
  int tid = tid_; asm volatile("" : "+v"(tid));
  const int wid = tid >> 6, lane = tid & 63, r32 = lane & 31, hi = lane >> 5;
  bf16* V_lds = (bf16*)lds; bf16* K_lds = (bf16*)(lds + 2 * SHM_V);
  float* ws = (float*)(lds + 2 * SHM_V + 2 * SHM_K) + wid * 64; float* li_l = ws; float* al_l = ws + 32;
  float m_reg = -1e30f, l_reg = 0; f32x16 o[4] = {}; bf16x8 qr[8];
  const TQ* Qw = Qb + (long)(wid * QBLK + r32) * LDQ + hi * 8;
#pragma unroll
  for (int d0 = 0; d0 < 8; ++d0) qr[d0] = SQ::tobf(SQ::ld8(Qw + d0 * 16));
  const int sr = tid >> 4, sc = (tid & 15) * 8, vst0 = v_st(sr, sc), vst1 = v_st(32 + sr, sc);
  const int vb0 = (int)(uintptr_t)V_lds + v_rd_base(lane);
  struct { typename St::T vs0, vs1, ks0, ks1; } sr_[SDEPTH];
  const unsigned loff = (unsigned)(sr * LDK + sc);
#define SLOAD(i, k0) do { const bf16* Vt_ = Vh + (size_t)(k0) * LDK; const bf16* Kt_ = Kh + (size_t)(k0) * LDK; \
    sr_[i].vs0 = St::ld8(Vt_ + loff); sr_[i].vs1 = St::ld8(Vt_ + 32 * LDK + loff); \
    sr_[i].ks0 = St::ld8(Kt_ + loff); sr_[i].ks1 = St::ld8(Kt_ + 32 * LDK + loff); } while (0)
#define SWRITE(b, i) do { *(bf16x8*)((char*)V_lds + (b) * SHM_V + vst0) = St::tobf(sr_[i].vs0);          \
    *(bf16x8*)((char*)V_lds + (b) * SHM_V + vst1) = St::tobf(sr_[i].vs1); int kc = sc * 2;               \
    *(bf16x8*)((char*)K_lds + (b) * SHM_K + KSWZ(sr, kc)) = St::tobf(sr_[i].ks0);                       \
    *(bf16x8*)((char*)K_lds + (b) * SHM_K + KSWZ(32 + sr, kc)) = St::tobf(sr_[i].ks1); } while (0)
#define SWAIT() do { if constexpr (SDEPTH == 2) asm volatile("s_waitcnt vmcnt(4)" ::: "memory"); else asm volatile("s_waitcnt vmcnt(0)" ::: "memory"); } while (0)
#define RESC(a) do { if (__any((a) < 1.f)) { if (hi == 0) al_l[r32] = (a); asm volatile("s_waitcnt lgkmcnt(0)" ::: "memory"); \
    for (int d = 0; d < 4; ++d) for (int r = 0; r < 16; ++r) o[d][r] *= al_l[crow(r, hi)]; } } while (0)
  f32x16 pA0, pA1, pB0, pB1; float mnA, mnB, alA, alB; bf16x8 pa0, pa1, pa2, pa3; const int NT = seq / KVBLK;
  constexpr int SE = 0, SO = SDEPTH - 1;
  SLOAD(SE, 0); asm volatile("s_waitcnt vmcnt(0)" ::: "memory"); SWRITE(0, SE); __syncthreads();
  qkt(pA0, pA1, K_lds, qr, r32, hi); partialSM(pA0, pA1, m_reg, mnA, alA);
  SLOAD(SO, KVBLK); if constexpr (SDEPTH == 2) { if (2 < NT) SLOAD(SE, 2 * KVBLK); }
  SWAIT(); SWRITE(1, SO); __syncthreads();
  for (int j = 1; j + 1 < NT; j += 2) {
    SBAR(); qkt(pB0, pB1, (bf16*)((char*)K_lds + SHM_K), qr, r32, hi);
    finishSM(pA0, pA1, alA, l_reg, pa0, pa1, pa2, pa3); SBAR();
    SLOAD(SO, (j + SDEPTH) * KVBLK); SBAR();
    pv_d0(o, vb0, pa0, pa1, pa2, pa3); partialSM(pB0, pB1, m_reg, mnB, alB);
    __syncthreads(); SWAIT(); SWRITE(0, SE);
    RESC(alB); __syncthreads();
    SBAR(); qkt(pA0, pA1, K_lds, qr, r32, hi);
    finishSM(pB0, pB1, alB, l_reg, pa0, pa1, pa2, pa3); SBAR();
    if (SDEPTH == 1 || j + 3 < NT) SLOAD(SE, (j + 1 + SDEPTH) * KVBLK); SBAR();
    pv_d0(o, vb0 + (int)SHM_V, pa0, pa1, pa2, pa3); partialSM(pA0, pA1, m_reg, mnA, alA);
    __syncthreads(); SWAIT(); SWRITE(1, SO);
    RESC(alA); __syncthreads();
  }
  SBAR(); qkt(pB0, pB1, (bf16*)((char*)K_lds + SHM_K), qr, r32, hi);
  finishSM(pA0, pA1, alA, l_reg, pa0, pa1, pa2, pa3); SBAR();
  pv_d0(o, vb0, pa0, pa1, pa2, pa3); partialSM(pB0, pB1, m_reg, mnB, alB);
  __syncthreads(); RESC(alB);
  finishSM(pB0, pB1, alB, l_reg, pa0, pa1, pa2, pa3); SBAR();
  pv_d0(o, vb0 + (int)SHM_V, pa0, pa1, pa2, pa3);
  if (hi == 0) li_l[r32] = l_reg; asm volatile("s_waitcnt lgkmcnt(0)" ::: "memory");
  float rli[16];
#pragma unroll
  for (int r = 0; r < 16; ++r) rli[r] = __builtin_amdgcn_rcpf(li_l[crow(r, hi)]);
  int le = lane; asm volatile("" : "+v"(le));
  float* Ow = Ob + (size_t)(wid * QBLK) * LDO; const unsigned eo = (unsigned)((le >> 5) * 4 * LDO + (le & 31));
#pragma unroll
  for (int r = 0; r < 16; ++r) { const unsigned ro = eo + (unsigned)(((r & 3) + 8 * (r >> 2)) * LDO);
#pragma unroll
    for (int d0 = 0; d0 < 4; ++d0) Ow[ro + d0 * 32] = o[d0][r] * rli[r]; }
#undef SLOAD
#undef SWRITE
#undef SWAIT
#undef RESC
}
}
#define LAS __attribute__((address_space(3)))
typedef unsigned short bf16_t;
typedef float f32x4 __attribute__((ext_vector_type(4)));
typedef float f32x2 __attribute__((ext_vector_type(2)));
typedef unsigned u32x4 __attribute__((ext_vector_type(4)));
typedef unsigned u32x2 __attribute__((ext_vector_type(2)));

typedef short bf16x8_t __attribute__((ext_vector_type(8)));
__device__ __forceinline__ bf16x8_t mk8(unsigned d0, unsigned d1, unsigned d2, unsigned d3) { const u32x4 w = {d0, d1, d2, d3}; return __builtin_bit_cast(bf16x8_t, w); }
constexpr int NTHR = 512, NWAVES = 8;
constexpr int MTOK = 8192, DM = 2048, SEQ = 2048, NBATCH = 4, PROJ = 4096, GW = 512;
constexpr int LDS_BYTES = 147456;

constexpr size_t MiB = 1u << 20;
constexpr size_t WS_CTL = 0;
constexpr size_t WS_WINT = 1 * MiB;
constexpr size_t WS_WOUTT = WS_WINT + 32 * MiB;
constexpr size_t WS_WQT = WS_WOUTT + 16 * MiB;
constexpr size_t WS_WGLUT = WS_WQT + 8 * MiB;
constexpr size_t WS_WCST = WS_WGLUT + 1 * MiB;
constexpr size_t WS_DFT = WS_WCST + 2 * MiB;
constexpr size_t WS_C1F = WS_DFT + 8 * MiB;
constexpr size_t WS_UB = WS_DFT + 16 * MiB;
constexpr size_t WS_VB = WS_UB + 128 * MiB;
constexpr size_t WS_KEYST = WS_VB + 128 * MiB;
constexpr size_t WS_ROPE = WS_KEYST + 1 * MiB;
constexpr size_t WS_HB = WS_ROPE + 1 * MiB;
constexpr size_t WS_PROJ = WS_HB + 32 * MiB;
constexpr size_t WS_PA = WS_PROJ + 128 * MiB;
constexpr size_t WS_C1 = WS_PA + 8 * MiB;
constexpr size_t WS_YA = WS_C1 + 16 * MiB;
constexpr size_t WS_QB = WS_YA + 64 * MiB;
constexpr size_t WS_S5E = WS_QB + 16 * MiB;
constexpr size_t WS_YGELU = WS_S5E + 4 * MiB;
constexpr size_t WS_RW = WS_YGELU + 8 * MiB;
constexpr size_t WS_YRW = WS_RW + 176 * MiB;
constexpr size_t WS_X1 = WS_YRW + 32 * MiB;
constexpr size_t WS_X2 = WS_X1 + 64 * MiB;
constexpr size_t WS_KS = WS_X2 + 64 * MiB;
constexpr size_t WS_S5T = WS_VB + 122 * MiB;
constexpr size_t WS_END = WS_KS + 16 * MiB;
static_assert(WS_END <= 1024 * MiB, "workspace map must fit 1 GiB");
constexpr size_t WS_LORA = WS_VB + 1 * MiB;
constexpr size_t WS_RWC = WS_VB + 2 * MiB;
constexpr int RWC_REC = 15360;
constexpr size_t RWSZ = (size_t)MTOK * GW;
enum { RW_R = 0, RW_V, RW_KK, RW_W0, RW_W1, RW_KD0, RW_KD1, RW_B0, RW_B1, RW_G, RW_BONUS };

struct Args { const float* in[36]; float* out; unsigned char* ws; int ph_lo, ph_hi; };

__device__ __forceinline__ unsigned f2bf(float f) { const unsigned u = __float_as_uint(f); return (u + 0x7fffu + ((u >> 16) & 1u)) >> 16; }
__device__ __forceinline__ unsigned pk2(float lo, float hi) { return f2bf(lo) | (f2bf(hi) << 16); }
__device__ __forceinline__ float bflo(unsigned w) { return __uint_as_float(w << 16); }
__device__ __forceinline__ float bfhi(unsigned w) { return __uint_as_float(w & 0xffff0000u); }
#define DPPF(x, ctrl) __builtin_bit_cast(float, __builtin_amdgcn_update_dpp(0, __builtin_bit_cast(int, (x)), (ctrl), 0xF, 0xF, true))
#define RDL(x, l) __builtin_bit_cast(float, __builtin_amdgcn_readlane(__builtin_bit_cast(int, (x)), (l)))
__device__ __forceinline__ float wave_sum(float v) {
    v += DPPF(v, 0xB1); v += DPPF(v, 0x4E); v += DPPF(v, 0x124); v += DPPF(v, 0x128);
    return (RDL(v, 0) + RDL(v, 16)) + (RDL(v, 32) + RDL(v, 48));
}
__device__ __forceinline__ float wave_max(float v) {
    v = fmaxf(v, DPPF(v, 0xB1)); v = fmaxf(v, DPPF(v, 0x4E)); v = fmaxf(v, DPPF(v, 0x124)); v = fmaxf(v, DPPF(v, 0x128));
    return fmaxf(fmaxf(RDL(v, 0), RDL(v, 16)), fmaxf(RDL(v, 32), RDL(v, 48)));
}
__device__ __forceinline__ float sigmoidf_(float x) { return 1.f / (1.f + __expf(-x)); }
__device__ __forceinline__ float gelu_tanh(float x) { const float u = 0.7978845608028654f * (x + 0.044715f * x * x * x); return 0.5f * x * (1.f + tanhf(u)); }
__device__ __forceinline__ float gelu_erf(float x) { return 0.5f * x * (1.f + erff(x * 0.7071067811865476f)); }
#define LDS_WAIT() asm volatile("s_waitcnt lgkmcnt(0)" ::: "memory")

struct Ctx {
    LAS unsigned char* lds; int tid, lane, wave, G, gw, ngw, bx;
};
__device__ __forceinline__ Ctx fresh_ctx_w(unsigned char* lds_raw, int wave0) {
    Ctx C; int ln = __builtin_amdgcn_mbcnt_hi(~0u, __builtin_amdgcn_mbcnt_lo(~0u, 0u)); asm volatile("" : "+v"(ln));
    int wv = wave0; asm volatile("" : "+s"(wv));
    int t = wv * 64 + ln;
    int bx = blockIdx.x, G = gridDim.x; asm volatile("" : "+s"(bx), "+s"(G));
    unsigned lo_ = 0u; asm volatile("" : "+s"(lo_));
    C.lds = (LAS unsigned char*)lds_raw + lo_; C.tid = t; C.lane = ln; C.wave = wv;
    C.G = G; C.bx = bx; C.gw = bx * NWAVES + C.wave; C.ngw = G * NWAVES; return C;
}
#define AS4 __attribute__((address_space(4)))
typedef const float* const AS4* InTab;
struct AP { InTab in; float* out; unsigned char* ws; };
static_assert(offsetof(Args, out) == 288 && offsetof(Args, ws) == 296, "Args layout");
__device__ __forceinline__ AP fresh_args() {
    unsigned long long p = (unsigned long long)__builtin_amdgcn_kernarg_segment_ptr(); asm volatile("" : "+s"(p));
    AP r; r.in = (InTab)p; r.out = *(float* const AS4*)(p + 288); r.ws = *(unsigned char* const AS4*)(p + 296); return r;
}

typedef __attribute__((address_space(1))) unsigned gu32;
#define RLX_AGENT __ATOMIC_RELAXED, __HIP_MEMORY_SCOPE_AGENT
#define XB_TMO      128
#define XB_XCNT(j)  (256  + 64 * (j))
#define XB_XSUB(j)  (1280 + 64 * (j))
#define XB_XGEN(j)  (2304 + 64 * (j))
#define XB_TOP      3328
#define XB_TOPGEN   3392
#define XCD_BAR_WORDS 3456
#define XB_SPIN_CAP (1u << 18)

__device__ __forceinline__ unsigned xb_ld(unsigned* p)              { return __hip_atomic_load(p, __ATOMIC_RELAXED, __HIP_MEMORY_SCOPE_AGENT); }
__device__ __forceinline__ unsigned xb_add(unsigned* p, unsigned v) { return __hip_atomic_fetch_add(p, v, __ATOMIC_RELAXED, __HIP_MEMORY_SCOPE_AGENT); }
__device__ __forceinline__ unsigned xb_xcc_id() { return (unsigned)__builtin_amdgcn_s_getreg((3 << 11) | 20) & 0xFu; }
#define XB_SPIN(cond, bar) do { unsigned _sp = 0; while (cond) { __builtin_amdgcn_s_sleep(1); \
    if ((++_sp & 255u) == 0u) { if (xb_ld(&(bar)[XB_TMO])) break; if (_sp > XB_SPIN_CAP) { atomicAdd(&(bar)[XB_TMO], 1u); break; } } } } while (0)

struct XcdBarrier {
    unsigned* bar; unsigned x;
    volatile LAS unsigned* st;
};

__device__ __forceinline__ XcdBarrier xcd_barrier_post(unsigned* bar, volatile LAS unsigned* st) {
    XcdBarrier b; b.bar = bar; b.x = xb_xcc_id(); b.st = st;
    if (threadIdx.x == 0) (void)xb_add(&bar[XB_XCNT(b.x)], 1u);
    return b;
}
__device__ __forceinline__ void xcd_barrier_complete(unsigned* bar, unsigned x, unsigned& nloc, unsigned& nx) {
    const unsigned G = gridDim.x * gridDim.y * gridDim.z;
    unsigned sum, cnt, mine, sp = 0u;
    for (;;) {
        sum = 0u; cnt = 0u; mine = 0u;
#pragma unroll
        for (unsigned j = 0; j < 16; ++j) { const unsigned c = xb_ld(&bar[XB_XCNT(j)]); sum += c; cnt += (c > 0u) ? 1u : 0u; mine = (j == x) ? c : mine; }
        if (sum == G) break;
        __builtin_amdgcn_s_sleep(1);
        if ((++sp & 255u) == 0u) { if (xb_ld(&bar[XB_TMO])) break; if (sp > XB_SPIN_CAP) { atomicAdd(&bar[XB_TMO], 1u); break; } }
    }
    nloc = mine > 0u ? mine : 1u; nx = cnt > 0u ? cnt : 1u;
}

__device__ __forceinline__ void xcd_barrier(const XcdBarrier& b) {
    asm volatile("s_waitcnt vmcnt(0)" ::: "memory");
    __syncthreads();
    if (threadIdx.x == 0) {
        unsigned* bar = b.bar;
        __builtin_amdgcn_s_waitcnt(0);
        unsigned nloc = b.st[0], nx = b.st[1];
        if (nloc == 0u) { xcd_barrier_complete(bar, b.x, nloc, nx); b.st[0] = nloc; b.st[1] = nx; }
        const unsigned old = xb_add(&bar[XB_XSUB(b.x)], 1u);
        const unsigned gen = old / nloc;
        if (old + 1u == (gen + 1u) * nloc) {
            __builtin_amdgcn_fence(__ATOMIC_RELEASE, "agent");
            asm volatile("s_waitcnt vmcnt(0)" ::: "memory");
            const unsigned og = xb_add(&bar[XB_TOP], 1u);
            const unsigned tg = og / nx;
            if (og + 1u == (tg + 1u) * nx) xb_add(&bar[XB_TOPGEN], 1u);
            else XB_SPIN(xb_ld(&bar[XB_TOPGEN]) == tg, bar);
            __builtin_amdgcn_fence(__ATOMIC_ACQUIRE, "agent");
            xb_add(&bar[XB_XGEN(b.x)], 1u);
            asm volatile("s_waitcnt vmcnt(0)" ::: "memory");
        } else {
            XB_SPIN(xb_ld(&bar[XB_XGEN(b.x)]) == gen, bar);
            __builtin_amdgcn_fence(__ATOMIC_ACQUIRE, "agent");
            asm volatile("s_waitcnt vmcnt(0)" ::: "memory");
        }
    }
    __syncthreads();
}

__device__ __forceinline__ void transpose_item(const float* W, const float* gain, int K, int N, bf16_t* WT, LAS float* scr, int item, int lane) {
    const int nblk = N / 64, kb = item / nblk, nb = item % nblk, k0 = 64 * kb, n0 = 64 * nb;
    const int lr = lane >> 4, lc = (lane & 15) * 4;
    f32x4 v[16];
#pragma unroll
    for (int i = 0; i < 16; ++i) v[i] = *(const f32x4*)(W + (size_t)(k0 + 4 * i + lr) * N + n0 + lc);
#pragma unroll
    for (int i = 0; i < 16; ++i) { const int kk = 4 * i + lr; const float g = gain ? gain[k0 + kk] : 1.f; LAS float* d = scr + kk * 65 + lc;
        d[0] = v[i].x * g; d[1] = v[i].y * g; d[2] = v[i].z * g; d[3] = v[i].w * g; }
    LDS_WAIT(); asm volatile("" ::: "memory");
#pragma unroll
    for (int c = 0; c < 8; ++c) { const LAS float* sp = scr + (8 * c) * 65 + lane;
        u32x4 o; o.x = pk2(sp[0 * 65], sp[1 * 65]); o.y = pk2(sp[2 * 65], sp[3 * 65]); o.z = pk2(sp[4 * 65], sp[5 * 65]); o.w = pk2(sp[6 * 65], sp[7 * 65]);
        *(u32x4*)(WT + (size_t)(n0 + lane) * K + k0 + 8 * c) = o; }
    LDS_WAIT(); asm volatile("" ::: "memory");
}
__device__ __forceinline__ void rms_row_to_bf16(const float* xrow, bf16_t* orow, int lane) {
    const f32x4* xr = (const f32x4*)xrow + lane;
    f32x4 v[8]; float s = 0.f;
#pragma unroll
    for (int j = 0; j < 8; ++j) { v[j] = xr[64 * j]; s += (v[j].x * v[j].x + v[j].y * v[j].y) + (v[j].z * v[j].z + v[j].w * v[j].w); }
    const float rs = rsqrtf(wave_sum(s) * (1.f / DM) + 1e-6f);
    u32x2* o8 = (u32x2*)orow + lane;
#pragma unroll
    for (int j = 0; j < 8; ++j) { u32x2 w; w.x = pk2(v[j].x * rs, v[j].y * rs); w.y = pk2(v[j].z * rs, v[j].w * rs); o8[64 * j] = w; }
}
__device__ __forceinline__ void s5_tables(const Ctx& C, const AP& a);
typedef float v16f_t __attribute__((ext_vector_type(16)));
typedef float v32f_t __attribute__((ext_vector_type(32)));
typedef unsigned v6u_t __attribute__((ext_vector_type(6)));
constexpr int EROW = 1536; constexpr size_t ETAB = (size_t)16384 * EROW;
__device__ __forceinline__ void expert_row_pack(const AP& a, int which, int l, int e, int lane, const f32x4 (&v)[8], float mx) {
    unsigned char* ws = a.ws;
    if (which) {
        const float sc4 = mx > 0.f ? 6.f / mx : 1.f;
        unsigned wv[4];
#pragma unroll
        for (int d4 = 0; d4 < 4; ++d4) { unsigned w_ = 0u;
            w_ = __builtin_amdgcn_cvt_scalef32_pk_fp4_f32(w_, v[2 * d4].x * sc4, v[2 * d4].y * sc4, 1.0f, 0); w_ = __builtin_amdgcn_cvt_scalef32_pk_fp4_f32(w_, v[2 * d4].z * sc4, v[2 * d4].w * sc4, 1.0f, 1);
            w_ = __builtin_amdgcn_cvt_scalef32_pk_fp4_f32(w_, v[2 * d4 + 1].x * sc4, v[2 * d4 + 1].y * sc4, 1.0f, 2); w_ = __builtin_amdgcn_cvt_scalef32_pk_fp4_f32(w_, v[2 * d4 + 1].z * sc4, v[2 * d4 + 1].w * sc4, 1.0f, 3);
            wv[d4] = w_; }
        ((u32x4*)(ws + WS_UB + 64 * MiB + (size_t)l * 16 * MiB + (size_t)e * 1024))[lane] = (u32x4){wv[0], wv[1], wv[2], wv[3]};
        if (lane == 0) ((float*)(ws + WS_VB))[(2 + l) * 16384 + e] = mx > 0.f ? mx * (1.f / 6.f) : 1.f;
        return;
    }
    if (true) {
        const float sc4 = mx > 0.f ? 6.f / mx : 1.f;
        unsigned wv[4];
#pragma unroll
        for (int d4 = 0; d4 < 4; ++d4) { unsigned w_ = 0u;
            w_ = __builtin_amdgcn_cvt_scalef32_pk_fp4_f32(w_, v[2 * d4].x * sc4, v[2 * d4].y * sc4, 1.0f, 0); w_ = __builtin_amdgcn_cvt_scalef32_pk_fp4_f32(w_, v[2 * d4].z * sc4, v[2 * d4].w * sc4, 1.0f, 1);
            w_ = __builtin_amdgcn_cvt_scalef32_pk_fp4_f32(w_, v[2 * d4 + 1].x * sc4, v[2 * d4 + 1].y * sc4, 1.0f, 2); w_ = __builtin_amdgcn_cvt_scalef32_pk_fp4_f32(w_, v[2 * d4 + 1].z * sc4, v[2 * d4 + 1].w * sc4, 1.0f, 3);
            wv[d4] = w_; }
        ((u32x4*)(ws + WS_UB + (size_t)l * ETAB + (size_t)e * 1024))[lane] = (u32x4){wv[0], wv[1], wv[2], wv[3]};
        if (lane == 0) ((float*)(ws + WS_VB))[(0 * 2 + l) * 16384 + e] = mx > 0.f ? mx * (1.f / 6.f) : 1.f;
        return;
    }
    const float sc = mx > 0.f ? 7.f / mx : 1.f;
    typedef unsigned v16u_t __attribute__((ext_vector_type(16))); typedef __bf16 v32bf_t __attribute__((ext_vector_type(32)));
    v16u_t pw;
#pragma unroll
    for (int j = 0; j < 8; ++j) { pw[j * 2] = pk2(v[j].x * sc, v[j].y * sc); pw[j * 2 + 1] = pk2(v[j].z * sc, v[j].w * sc); }
    const v6u_t w = __builtin_amdgcn_cvt_scalef32_pk32_fp6_bf16(__builtin_bit_cast(v32bf_t, pw), 1.0f);
    unsigned char* row = ws + WS_UB + (size_t)l * ETAB + (size_t)e * EROW;
    ((u32x4*)row)[lane] = (u32x4){w[0], w[1], w[2], w[3]}; ((u32x2*)(row + 1024))[lane] = (u32x2){w[4], w[5]};
    if (lane == 0) ((float*)(ws + WS_VB))[(0 * 2 + l) * 16384 + e] = mx > 0.f ? mx * (1.f / 7.f) : 1.f;
}
__device__ __forceinline__ void expert_row_item2(const AP& a, int which, int l, int e, int lane) {
    const f32x4* src = (const f32x4*)(a.in[which ? 35 : 34] + ((size_t)l * 16384 + e) * DM) + lane;
    const f32x4* gp = (const f32x4*)(a.in[31] + l * DM) + lane;
    f32x4 v0[8], v1[8]; float m0 = 0.f, m1 = 0.f;
#pragma unroll
    for (int j = 0; j < 8; ++j) { v0[j] = src[64 * j]; v1[j] = src[512 + 64 * j]; }
#pragma unroll
    for (int j = 0; j < 8; ++j) { if (!which) { const f32x4 g = gp[64 * j]; v0[j] = v0[j] * g; v1[j] = v1[j] * g; }
        m0 = fmaxf(m0, fmaxf(fmaxf(fabsf(v0[j].x), fabsf(v0[j].y)), fmaxf(fabsf(v0[j].z), fabsf(v0[j].w))));
        m1 = fmaxf(m1, fmaxf(fmaxf(fabsf(v1[j].x), fabsf(v1[j].y)), fmaxf(fabsf(v1[j].z), fabsf(v1[j].w)))); }
    m0 = wave_max(m0); m1 = wave_max(m1);
    expert_row_pack(a, which, l, e, lane, v0, m0); expert_row_pack(a, which, l, e + 1, lane, v1, m1);
}
__device__ __forceinline__ void phase_prep(const Ctx& C, const AP& a) {
    unsigned char* ws = a.ws;
    LAS float* scr = (LAS float*)(C.lds + C.wave * 16640);
    constexpr int I_IN = 32 * 64, I_OUT = 32 * 32, I_Q = 32 * 16, I_GLU = 8 * 8, I_L = I_IN + I_OUT + I_Q + I_GLU;
    for (int it = C.gw; it < 2 * I_L; it += C.ngw) {
        const int l = it / I_L; int r = it % I_L;
        if (r < I_IN) { transpose_item(a.in[2] + (size_t)l * DM * PROJ, a.in[1] + l * DM, DM, PROJ, (bf16_t*)(ws + WS_WINT) + (size_t)l * PROJ * DM, scr, r, C.lane); continue; } r -= I_IN;
        if (r < I_OUT) { transpose_item(a.in[30] + (size_t)l * DM * DM, a.in[29] + l * DM, DM, DM, (bf16_t*)(ws + WS_WOUTT) + (size_t)l * DM * DM, scr, r, C.lane); continue; } r -= I_OUT;
        if (r < I_Q) { transpose_item(a.in[32] + (size_t)l * DM * 1024, a.in[31] + l * DM, DM, 1024, (bf16_t*)(ws + WS_WQT) + (size_t)l * 1024 * DM, scr, r, C.lane); continue; } r -= I_Q;
        transpose_item(a.in[12] + (size_t)l * 512 * 512, nullptr, 512, 512, (bf16_t*)(ws + WS_WGLUT) + (size_t)l * 512 * 512, scr, r, C.lane);
    }
    {
        LAS float* tc = (LAS float*)(C.lds + 8 * 16640); LAS float* ts = tc + 128;
        if (C.tid < 128) { tc[C.tid] = cospif((float)C.tid / 64.f); ts[C.tid] = sinpif((float)C.tid / 64.f); }
        __syncthreads();
        for (int it = C.bx * NTHR + C.tid; it < 2 * 4 * 32 * 512; it += C.G * NTHR) {
            const int cp = it & 511, ccg = (it >> 9) & 31, blk = (it >> 14) & 3, l = it >> 16;
            const float* fw = a.in[3] + (size_t)l * 512 * 512 + (size_t)blk * 128 * 512 + cp;
            float sc[4] = {0.f, 0.f, 0.f, 0.f}, ss[4] = {0.f, 0.f, 0.f, 0.f};
#pragma unroll 8
            for (int m = 0; m < 128; ++m) { const float f = fw[(size_t)m * 512];
#pragma unroll
                for (int r = 0; r < 4; ++r) { const int ix = (m * (ccg * 4 + r)) & 127; sc[r] += tc[ix] * f; ss[r] += ts[ix] * f; } }
            bf16_t* o = (bf16_t*)(ws + WS_WCST) + (size_t)l * 1024 * 512; const int c0 = blk * 128 + ccg * 4;
            u32x2 w; w.x = pk2(sc[0] * (1.f / 512.f), sc[1] * (1.f / 512.f)); w.y = pk2(sc[2] * (1.f / 512.f), sc[3] * (1.f / 512.f)); *(u32x2*)(o + (size_t)(2 * cp) * 512 + c0) = w;
            w.x = pk2(ss[0] * (1.f / 512.f), ss[1] * (1.f / 512.f)); w.y = pk2(ss[2] * (1.f / 512.f), ss[3] * (1.f / 512.f)); *(u32x2*)(o + (size_t)(2 * cp + 1) * 512 + c0) = w;
        }
    }
    for (int it = C.bx * NTHR + C.tid; it < 2048 * 256; it += C.G * NTHR) {
        const int k = it >> 8, j0 = (it & 255) * 8; float v[8];
#pragma unroll
        for (int e = 0; e < 8; ++e) { const int j = j0 + e, s = j <= 1024 ? j : j - 1024; const float x = (float)((k * s) & 2047) * (1.f / 1024.f); v[e] = (j <= 1024) ? cospif(x) : -sinpif(x); }
        u32x4 w; w.x = pk2(v[0], v[1]); w.y = pk2(v[2], v[3]); w.z = pk2(v[4], v[5]); w.w = pk2(v[6], v[7]);
        *(u32x4*)((bf16_t*)(ws + WS_DFT) + (size_t)k * 2048 + j0) = w;
    }
    for (int it = C.bx * NTHR + C.tid; it < 2 * 8 * 2 * 64 * 128; it += C.G * NTHR) {
        const int key = it & 127, d = (it >> 7) & 63, lhp = it >> 13;
        ((float*)(ws + WS_KEYST))[it] = a.in[33][((size_t)lhp * 128 + key) * 64 + d];
    }
    for (int it = C.bx * NTHR + C.tid; it < 2048 * 64; it += C.G * NTHR) {
        const int pos = it >> 6, j = it & 63; const float inv = powf(10000.f, -(float)(2 * (j & 31)) / 64.f);
        const float ang = (float)(j < 32 ? (pos >> 6) : (pos & 63)) * inv;
        ((float*)(ws + WS_ROPE))[it] = cosf(ang); ((float*)(ws + WS_ROPE))[2048 * 64 + it] = sinf(ang);
    }
    {
        bf16_t* W1T = (bf16_t*)(ws + WS_LORA); bf16_t* g2T = W1T + 2 * 224 * 512; bf16_t* w2T = g2T + 2 * 512 * 96; bf16_t* a2T = w2T + 2 * 2 * 512 * 32;
        for (int it = C.bx * NTHR + C.tid; it < 2 * 224 * 512; it += C.G * NTHR) {
            const int k = it & 511, j = (it >> 9) % 224, l = it / (224 * 512); float v;
            if (j < 96) v = a.in[22][((size_t)l * 512 + k) * 96 + j];
            else if (j < 160) v = a.in[17][((size_t)(l * 2 + ((j - 96) >> 5)) * 512 + k) * 32 + ((j - 96) & 31)];
            else v = a.in[20][((size_t)(l * 2 + ((j - 160) >> 5)) * 512 + k) * 32 + ((j - 160) & 31)];
            W1T[it] = (bf16_t)f2bf(v);
        }
        for (int it = C.bx * NTHR + C.tid; it < 2 * 512 * 96; it += C.G * NTHR) {
            const int j = it % 96, ch = (it / 96) & 511, l = it / (96 * 512);
            g2T[it] = (bf16_t)f2bf(a.in[23][((size_t)l * 96 + j) * 512 + ch]);
        }
        for (int it = C.bx * NTHR + C.tid; it < 2 * 2 * 512 * 32; it += C.G * NTHR) {
            const int j = it & 31, ch = (it >> 5) & 511, ld = it >> 14;
            w2T[it] = (bf16_t)f2bf(a.in[18][((size_t)ld * 32 + j) * 512 + ch]); a2T[it] = (bf16_t)f2bf(a.in[21][((size_t)ld * 32 + j) * 512 + ch]);
        }
    }
    for (int m = C.gw; m < MTOK; m += C.ngw) rms_row_to_bf16(a.in[0] + (size_t)m * DM, (bf16_t*)(ws + WS_HB) + (size_t)m * DM, C.lane);
}

__device__ __forceinline__ void qk_prep_token(const AP& a, int l, int m, int lane) {
    unsigned char* ws = a.ws;
    const float* pr = (const float*)(ws + WS_PROJ) + (size_t)m * PROJ;
    const int pos = m & (SEQ - 1);
    const float cs = ((const float*)(ws + WS_ROPE))[pos * 64 + lane], sn = ((const float*)(ws + WS_ROPE))[2048 * 64 + pos * 64 + lane];
    bf16_t* qo = (bf16_t*)(ws + WS_QB) + (size_t)m * 512; bf16_t* ko = (bf16_t*)(ws + WS_QB) + (size_t)MTOK * 512 + (size_t)m * 256; bf16_t* vo = ko + (size_t)MTOK * 256;
#pragma unroll
    for (int hh = 0; hh < 6; ++hh) {
        const float* src = pr + 1024 + hh * 128;
        const float* gn = a.in[hh < 4 ? 13 : 14] + l * 128;
        const float x1 = src[lane], x2 = src[lane + 64];
        const float rs = rsqrtf(wave_sum(x1 * x1 + x2 * x2) * (1.f / 128.f) + 1e-6f);
        const float y1 = x1 * rs * gn[lane], y2 = x2 * rs * gn[lane + 64];
        bf16_t* dst = hh < 4 ? qo + hh * 128 : ko + (hh - 4) * 128;
        dst[lane] = (bf16_t)f2bf(y1 * cs - y2 * sn); dst[lane + 64] = (bf16_t)f2bf(y1 * sn + y2 * cs);
    }
    const f32x4 vv = *((const f32x4*)(pr + 1792) + lane);
    u32x2 w; w.x = pk2(vv.x, vv.y); w.y = pk2(vv.z, vv.w); *((u32x2*)vo + lane) = w;
}

struct S5P { float lr, li, cr, ci; };
__device__ __forceinline__ S5P s5_params(const AP& a, int l, int d, int g, int p, float mult) {
    const int ix = ((l * 2 + d) * 32 + g) * 64 + p;
    const float lre = a.in[4][ix], lim = a.in[5][ix], step = __expf(a.in[6][(l * 2 + d) * 32 + g]) * mult;
    const float er = __expf(lre * step); float sn, cs; sincosf(lim * step, &sn, &cs);
    S5P r; r.lr = er * cs; r.li = er * sn;
    const float nr = r.lr - 1.f, ni = r.li, den = 1.f / (lre * lre + lim * lim);
    r.cr = (nr * lre + ni * lim) * den; r.ci = (ni * lre - nr * lim) * den;
    return r;
}
__device__ __forceinline__ void s5_ends_item(const AP& a, int l, int item, int lane, LAS float* us) {
    unsigned char* ws = a.ws;
    const int c = item & 31, g = (item >> 5) & 31, b = item >> 10, p = lane;
    const float* ur = (const float*)(ws + WS_PROJ) + ((size_t)(b * SEQ + c * 64 + lane)) * PROJ + 512 + g * 16;
#pragma unroll
    for (int q = 0; q < 4; ++q) *((LAS f32x4*)(us + lane * 16) + q) = *((const f32x4*)ur + q);
    LDS_WAIT(); asm volatile("" ::: "memory");
#pragma unroll 1
    for (int d = 0; d < 2; ++d) {
        const S5P P = s5_params(a, l, d, g, p, 1.f);
        f32x2 bb2[16];
        const float* bre = a.in[7] + ((size_t)((l * 2 + d) * 32 + g) * 64 + p) * 16; const float* bim = a.in[8] + ((size_t)((l * 2 + d) * 32 + g) * 64 + p) * 16;
#pragma unroll
        for (int h = 0; h < 16; ++h) { const float x = bre[h], y = bim[h]; bb2[h].x = P.cr * x - P.ci * y; bb2[h].y = P.cr * y + P.ci * x; }
        const f32x2 lam2 = {P.lr, P.lr}, lami = {-P.li, P.li};
        float xr = 0.f, xi = 0.f;
#pragma unroll 4
        for (int tt = 0; tt < 64; ++tt) {
            const int t = d ? 63 - tt : tt;
            f32x2 acc2 = {0.f, 0.f};
#pragma unroll
            for (int q = 0; q < 4; ++q) { const f32x4 u4 = *((const LAS f32x4*)(us + t * 16) + q);
#pragma unroll
                for (int e = 0; e < 4; ++e) acc2 += bb2[q * 4 + e] * u4[e]; }
            const f32x2 x2 = {xr, xi}, xs = {xi, xr}; const f32x2 n2 = lam2 * x2 + lami * xs + acc2; xr = n2.x; xi = n2.y;
        }
        f32x2 o; o.x = xr; o.y = xi;
        ((f32x2*)(ws + WS_S5E))[((size_t)((b * 32 + g) * 2 + d) * 32 + c) * 64 + p] = o;
    }
    LDS_WAIT(); asm volatile("" ::: "memory");
}
__device__ __forceinline__ void s5_final_item(const AP& a, int l, int item, int lane, LAS float* us  , LAS float* yb  , LAS float* X  ) {
    unsigned char* ws = a.ws;
    const int c = item & 31, g = (item >> 5) & 31, b = item >> 10, p = lane;
    const float* ur = (const float*)(ws + WS_PROJ) + ((size_t)(b * SEQ + c * 64 + lane)) * PROJ + 512 + g * 16;
#pragma unroll
    for (int q = 0; q < 4; ++q) { *((LAS f32x4*)(us + lane * 16) + q) = *((const f32x4*)ur + q); *((LAS f32x4*)(yb + lane * 16) + q) = (f32x4){0.f, 0.f, 0.f, 0.f}; }
    LDS_WAIT(); asm volatile("" ::: "memory");
    const int oh = lane & 15, otq = lane >> 4;
#pragma unroll 1
    for (int d = 0; d < 2; ++d) {
        const S5P P = s5_params(a, l, d, g, p, 1.f);
        const S5P P64 = s5_params(a, l, d, g, p, 64.f);
        float br[16], bi[16];
        const float* bre = a.in[7] + ((size_t)((l * 2 + d) * 32 + g) * 64 + p) * 16; const float* bim = a.in[8] + ((size_t)((l * 2 + d) * 32 + g) * 64 + p) * 16;
#pragma unroll
        for (int h = 0; h < 16; ++h) { const float x = bre[h], y = bim[h]; br[h] = P.cr * x - P.ci * y; bi[h] = P.cr * y + P.ci * x; }
        const f32x2* E = (const f32x2*)(ws + WS_S5E) + ((size_t)((b * 32 + g) * 2 + d) * 32) * 64 + p;
        float xr = 0.f, xi = 0.f;
        { f32x2 nx[4];
#pragma unroll
          for (int i = 0; i < 4; ++i) nx[i] = E[(d ? 31 - i : i) * 64];
#pragma unroll 1
          for (int grp = 0; grp < 8; ++grp) {
              if (d ? (31 - grp * 4 <= c) : (grp * 4 >= c)) break;
              f32x2 cu[4];
#pragma unroll
              for (int i = 0; i < 4; ++i) cu[i] = nx[i];
              if (grp < 7) {
#pragma unroll
                  for (int i = 0; i < 4; ++i) nx[i] = E[(d ? 27 - grp * 4 - i : grp * 4 + 4 + i) * 64];
              }
#pragma unroll
              for (int i = 0; i < 4; ++i) { const int cc = d ? 31 - grp * 4 - i : grp * 4 + i;
                  if (d ? (cc > c) : (cc < c)) { const float nr = P64.lr * xr - P64.li * xi + cu[i].x, ni = P64.lr * xi + P64.li * xr + cu[i].y; xr = nr; xi = ni; } }
          } }
        const float* cre = a.in[9] + ((size_t)((l * 2 + d) * 32 + g) * 16 + oh) * 64; const float* cim = a.in[10] + ((size_t)((l * 2 + d) * 32 + g) * 16 + oh) * 64;
#pragma unroll 1
        for (int sb = 0; sb < 4; ++sb) {
            for (int tt = 0; tt < 16; ++tt) {
                const int ts = sb * 16 + tt, t = d ? 63 - ts : ts;
                float ar = 0.f, ai = 0.f;
#pragma unroll
                for (int q = 0; q < 4; ++q) { const f32x4 u4 = *((const LAS f32x4*)(us + t * 16) + q);
#pragma unroll
                    for (int e = 0; e < 4; ++e) { ar += br[q * 4 + e] * u4[e]; ai += bi[q * 4 + e] * u4[e]; } }
                const float nr = P.lr * xr - P.li * xi + ar, ni = P.lr * xi + P.li * xr + ai; xr = nr; xi = ni;
                f32x2 o; o.x = xr; o.y = xi; *((LAS f32x2*)X + tt * 64 + p) = o;
            }
            LDS_WAIT(); asm volatile("" ::: "memory");
            float acc[4] = {0.f, 0.f, 0.f, 0.f};
            for (int pq = 0; pq < 16; ++pq) {
                const f32x4 c4r = *((const f32x4*)cre + pq), c4i = *((const f32x4*)cim + pq);
#pragma unroll
                for (int i = 0; i < 4; ++i) {
                    const LAS f32x4* xp = (const LAS f32x4*)(X + ((otq * 4 + i) * 64 + pq * 4) * 2);
                    const f32x4 xa = xp[0], xb = xp[1];
                    acc[i] += c4r[0] * xa[0] - c4i[0] * xa[1] + c4r[1] * xa[2] - c4i[1] * xa[3] + c4r[2] * xb[0] - c4i[2] * xb[1] + c4r[3] * xb[2] - c4i[3] * xb[3];
                }
            }
#pragma unroll
            for (int i = 0; i < 4; ++i) { const int ts = sb * 16 + otq * 4 + i, t = d ? 63 - ts : ts; yb[t * 16 + oh] += acc[i]; }
            LDS_WAIT(); asm volatile("" ::: "memory");
        }
    }
    const float* dsk = a.in[11] + (l * 32 + g) * 16;
    unsigned w[8];
#pragma unroll
    for (int h = 0; h < 16; h += 2) {
        const float y0 = gelu_tanh(yb[lane * 16 + h] + dsk[h] * us[lane * 16 + h]), y1 = gelu_tanh(yb[lane * 16 + h + 1] + dsk[h + 1] * us[lane * 16 + h + 1]);
        w[h >> 1] = pk2(y0, y1);
    }
    u32x4* dst = (u32x4*)((bf16_t*)(ws + WS_YGELU) + (size_t)(b * SEQ + c * 64 + lane) * 512 + g * 16);
    dst[0] = (u32x4){w[0], w[1], w[2], w[3]}; dst[1] = (u32x4){w[4], w[5], w[6], w[7]};
    LDS_WAIT(); asm volatile("" ::: "memory");
}

__device__ __forceinline__ void s5_tables(const Ctx& C, const AP& a) {
    unsigned char* ws = a.ws;
    f32x4* LAMT = (f32x4*)(ws + WS_S5T); bf16_t* BBop = (bf16_t*)(ws + WS_S5T + 131072); bf16_t* CBop = (bf16_t*)(ws + WS_S5T + 131072 + 1048576);
    for (int it = C.bx * NTHR + C.tid; it < 128 * 64; it += C.G * NTHR) {
        const int p = it & 63, ldg = it >> 6, g = ldg & 31, d = (ldg >> 5) & 1, l = ldg >> 6;
        const S5P P = s5_params(a, l, d, g, p, 1.f), P64 = s5_params(a, l, d, g, p, 64.f);
        LAMT[it] = (f32x4){P.lr, P.li, P64.lr, P64.li};
    }
    for (int it = C.bx * NTHR + C.tid; it < 128 * 8 * 64; it += C.G * NTHR) {
        const int lane = it & 63, nt = (it >> 6) & 7, ldg = it >> 9, g = ldg & 31, d = (ldg >> 5) & 1, l = ldg >> 6, fr = lane & 15, fq = lane >> 4;
        const int col = nt * 16 + fr, p = col >> 1, ri = col & 1;
        unsigned w[4] = {0u, 0u, 0u, 0u};
        if (fq < 2) {
            const S5P P = s5_params(a, l, d, g, p, 1.f);
            const float* bre = a.in[7] + ((size_t)ldg * 64 + p) * 16 + fq * 8; const float* bim = a.in[8] + ((size_t)ldg * 64 + p) * 16 + fq * 8;
            float v[8];
#pragma unroll
            for (int jj = 0; jj < 8; ++jj) v[jj] = ri ? (P.cr * bim[jj] + P.ci * bre[jj]) : (P.cr * bre[jj] - P.ci * bim[jj]);
            w[0] = pk2(v[0], v[1]); w[1] = pk2(v[2], v[3]); w[2] = pk2(v[4], v[5]); w[3] = pk2(v[6], v[7]);
        }
        *(u32x4*)(BBop + (size_t)it * 8) = (u32x4){w[0], w[1], w[2], w[3]};
    }
    for (int it = C.bx * NTHR + C.tid; it < 128 * 4 * 64; it += C.G * NTHR) {
        const int lane = it & 63, s2 = (it >> 6) & 3, ldg = it >> 8, fr = lane & 15, fq = lane >> 4;
        const float* cre = a.in[9] + ((size_t)ldg * 16 + fr) * 64 + 16 * s2 + fq * 4; const float* cim = a.in[10] + ((size_t)ldg * 16 + fr) * 64 + 16 * s2 + fq * 4;
        *(u32x4*)(CBop + (size_t)it * 8) = (u32x4){pk2(cre[0], -cim[0]), pk2(cre[1], -cim[1]), pk2(cre[2], -cim[2]), pk2(cre[3], -cim[3])};
    }
}
__device__ __forceinline__ void s5_load_u(const float* ur, LAS unsigned char* wl, int lane) {
    const f32x4 u0 = *((const f32x4*)ur + 0), u1 = *((const f32x4*)ur + 1), u2 = *((const f32x4*)ur + 2), u3 = *((const f32x4*)ur + 3);
    LAS u32x4* dst = (LAS u32x4*)(wl + lane * 32);
    dst[0] = (u32x4){pk2(u0.x, u0.y), pk2(u0.z, u0.w), pk2(u1.x, u1.y), pk2(u1.z, u1.w)}; dst[1] = (u32x4){pk2(u2.x, u2.y), pk2(u2.z, u2.w), pk2(u3.x, u3.y), pk2(u3.z, u3.w)};
}
__device__ __forceinline__ void s5_build_bb(const AP& a, int ldg, float cr, float ci, int lane, LAS unsigned char* wl, bf16x8_t (&bb)[8]) {
    const int fr = lane & 15, fq = lane >> 4;
    LAS f32x2* cf = (LAS f32x2*)(wl + 14848);
    f32x2 me; me.x = cr; me.y = ci; cf[lane] = me;
    LDS_WAIT(); asm volatile("" ::: "memory");
#pragma unroll
    for (int nt = 0; nt < 8; ++nt) {
        const int col = nt * 16 + fr, p = col >> 1, ri = col & 1;
        unsigned w_[4] = {0u, 0u, 0u, 0u};
        if (fq < 2) {
            const f32x2 c2 = cf[p];
            const f32x4* bre = (const f32x4*)(a.in[7] + ((size_t)ldg * 64 + p) * 16 + fq * 8); const f32x4* bim = (const f32x4*)(a.in[8] + ((size_t)ldg * 64 + p) * 16 + fq * 8);
            const f32x4 r0 = bre[0], r1 = bre[1], i0 = bim[0], i1 = bim[1];
            float v[8];
#pragma unroll
            for (int jj = 0; jj < 4; ++jj) { v[jj] = ri ? (c2.x * i0[jj] + c2.y * r0[jj]) : (c2.x * r0[jj] - c2.y * i0[jj]); v[4 + jj] = ri ? (c2.x * i1[jj] + c2.y * r1[jj]) : (c2.x * r1[jj] - c2.y * i1[jj]); }
            w_[0] = pk2(v[0], v[1]); w_[1] = pk2(v[2], v[3]); w_[2] = pk2(v[4], v[5]); w_[3] = pk2(v[6], v[7]);
        }
        bb[nt] = mk8(w_[0], w_[1], w_[2], w_[3]);
        asm volatile("" ::: "memory");
    }
}
template <bool FINAL>
__device__ __forceinline__ void s5_subblock(LAS unsigned char* wl, const bf16x8_t (&bb)[8], int d, int sb, int lane, float lr, float li, float& xr, float& xi) {
    const int fr = lane & 15, fq = lane >> 4;
    LAS float* BUs = (LAS float*)(wl + 2048); LAS bf16_t* Xb = (LAS bf16_t*)(wl + 10496);
    const int trow = d ? 63 - (sb * 16 + fr) : sb * 16 + fr;
    bf16x8_t aU = mk8(0u, 0u, 0u, 0u);
    if (fq < 2) aU = *(const LAS bf16x8_t*)(wl + trow * 32 + fq * 16);
    const f32x4 z4 = {0.f, 0.f, 0.f, 0.f};
#pragma unroll
    for (int nt = 0; nt < 8; ++nt) { const f32x4 bu = __builtin_amdgcn_mfma_f32_16x16x32_bf16(aU, bb[nt], z4, 0, 0, 0);
#pragma unroll
        for (int r = 0; r < 4; ++r) BUs[(fq * 4 + r) * 132 + nt * 16 + fr] = bu[r]; }
    LDS_WAIT(); asm volatile("" ::: "memory");
#pragma unroll
    for (int tt = 0; tt < 16; ++tt) {
        const f32x2 bq = *(const LAS f32x2*)(BUs + tt * 132 + 2 * lane);
        const float nr = lr * xr - li * xi + bq.x, ni = lr * xi + li * xr + bq.y; xr = nr; xi = ni;
        if (FINAL) *(LAS unsigned*)(Xb + (d ? 15 - tt : tt) * 136 + 2 * lane) = pk2(xr, xi);
    }
    LDS_WAIT(); asm volatile("" ::: "memory");
}
__device__ __forceinline__ void s5_ends_item_m(const AP& a, int l, int item, int lane, LAS unsigned char* wl) {
    unsigned char* ws = a.ws;
    const int c = item & 31, g = (item >> 5) & 31, b = item >> 10;
    s5_load_u((const float*)(ws + WS_PROJ) + ((size_t)(b * SEQ + c * 64 + lane)) * PROJ + 512 + g * 16, wl, lane);
    LDS_WAIT(); asm volatile("" ::: "memory");
#pragma unroll 1
    for (int d = 0; d < 2; ++d) {
        const int ldg = (l * 2 + d) * 32 + g;
        const S5P Pq = s5_params(a, l, d, g, lane, 1.f);
        const f32x4 lam = {Pq.lr, Pq.li, 0.f, 0.f};
        bf16x8_t bb[8]; s5_build_bb(a, ldg, Pq.cr, Pq.ci, lane, wl, bb);
        float xr = 0.f, xi = 0.f;
#pragma unroll 1
        for (int sb = 0; sb < 4; ++sb) s5_subblock<false>(wl, bb, d, sb, lane, lam[0], lam[1], xr, xi);
        f32x2 o; o.x = xr; o.y = xi;
        ((f32x2*)(ws + WS_S5E))[((size_t)((b * 32 + g) * 2 + d) * 32 + c) * 64 + lane] = o;
    }
}
__device__ __forceinline__ void s5_final_item_m(const AP& a, int l, int item, int lane, LAS unsigned char* wl) {
    unsigned char* ws = a.ws;
    const int c = item & 31, g = (item >> 5) & 31, b = item >> 10, fr = lane & 15, fq = lane >> 4;
    const float* ubase = (const float*)(ws + WS_PROJ) + ((size_t)(b * SEQ + c * 64)) * PROJ + 512 + g * 16;
    s5_load_u(ubase + (size_t)lane * PROJ, wl, lane);
    LDS_WAIT(); asm volatile("" ::: "memory");
    LAS bf16_t* Xb = (LAS bf16_t*)(wl + 10496);
    f32x4 yacc[4];
#pragma unroll
    for (int q = 0; q < 4; ++q) yacc[q] = (f32x4){0.f, 0.f, 0.f, 0.f};
#pragma unroll 1
    for (int d = 0; d < 2; ++d) {
        const int ldg = (l * 2 + d) * 32 + g;
        const S5P Pq = s5_params(a, l, d, g, lane, 1.f), P64 = s5_params(a, l, d, g, lane, 64.f);
        const f32x4 lam = {Pq.lr, Pq.li, P64.lr, P64.li};
        bf16x8_t bb[8], cb[4]; s5_build_bb(a, ldg, Pq.cr, Pq.ci, lane, wl, bb);
#pragma unroll
        for (int s2 = 0; s2 < 4; ++s2) {
            const f32x4 cr4 = *(const f32x4*)(a.in[9] + ((size_t)ldg * 16 + fr) * 64 + 16 * s2 + fq * 4), ci4 = *(const f32x4*)(a.in[10] + ((size_t)ldg * 16 + fr) * 64 + 16 * s2 + fq * 4);
            cb[s2] = mk8(pk2(cr4[0], -ci4[0]), pk2(cr4[1], -ci4[1]), pk2(cr4[2], -ci4[2]), pk2(cr4[3], -ci4[3])); }
        const f32x2* E = (const f32x2*)(ws + WS_S5E) + ((size_t)((b * 32 + g) * 2 + d) * 32) * 64 + lane;
        float xr = 0.f, xi = 0.f;
        { f32x2 nx[4];
#pragma unroll
          for (int i = 0; i < 4; ++i) nx[i] = E[(d ? 31 - i : i) * 64];
#pragma unroll 1
          for (int grp = 0; grp < 8; ++grp) {
              if (d ? (31 - grp * 4 <= c) : (grp * 4 >= c)) break;
              f32x2 cu[4];
#pragma unroll
              for (int i = 0; i < 4; ++i) cu[i] = nx[i];
              if (grp < 7) {
#pragma unroll
                  for (int i = 0; i < 4; ++i) nx[i] = E[(d ? 27 - grp * 4 - i : grp * 4 + 4 + i) * 64];
              }
#pragma unroll
              for (int i = 0; i < 4; ++i) { const int cc = d ? 31 - grp * 4 - i : grp * 4 + i;
                  if (d ? (cc > c) : (cc < c)) { const float nr = lam[2] * xr - lam[3] * xi + cu[i].x, ni = lam[2] * xi + lam[3] * xr + cu[i].y; xr = nr; xi = ni; } }
          } }
#pragma unroll
        for (int sb = 0; sb < 4; ++sb) {
            s5_subblock<true>(wl, bb, d, sb, lane, lam[0], lam[1], xr, xi);
            f32x4 acc = d ? yacc[3 - sb] : yacc[sb];
#pragma unroll
            for (int s2 = 0; s2 < 4; ++s2) acc = __builtin_amdgcn_mfma_f32_16x16x32_bf16(*(const LAS bf16x8_t*)(Xb + fr * 136 + s2 * 32 + fq * 8), cb[s2], acc, 0, 0, 0);
            if (d) yacc[3 - sb] = acc; else yacc[sb] = acc;
            LDS_WAIT(); asm volatile("" ::: "memory");
        }
    }
    const float dsk = a.in[11][(l * 32 + g) * 16 + fr];
#pragma unroll
    for (int q = 0; q < 4; ++q)
#pragma unroll
        for (int r = 0; r < 4; ++r) { const int t = q * 16 + fq * 4 + r;
            const float y = gelu_tanh(yacc[q][r] + dsk * ubase[(size_t)t * PROJ + fr]);
            ((bf16_t*)(ws + WS_YGELU))[(size_t)(b * SEQ + c * 64 + t) * 512 + g * 16 + fr] = (bf16_t)f2bf(y); }
}
__device__ __forceinline__ float gelu_tanh_fast(float x) { const float u2 = 1.5957691216057308f * (x + 0.044715f * x * x * x); return x / (1.f + __expf(-u2)); }
__device__ __forceinline__ void s5_final_item_h(const AP& a, int l, int item, int lane, LAS unsigned char* wl) {
    unsigned char* ws = a.ws;
    const int c = item & 31, g = (item >> 5) & 31, b = item >> 10, p = lane, fr = lane & 15, fq = lane >> 4;
    LAS float* us = (LAS float*)wl; LAS bf16_t* Xb = (LAS bf16_t*)(wl + 4096);
    const float* ur = (const float*)(ws + WS_PROJ) + ((size_t)(b * SEQ + c * 64 + lane)) * PROJ + 512 + g * 16;
#pragma unroll
    for (int q = 0; q < 4; ++q) *((LAS f32x4*)(us + lane * 16) + q) = *((const f32x4*)ur + q);
    LDS_WAIT(); asm volatile("" ::: "memory");
    f32x4 yacc[4];
#pragma unroll
    for (int q = 0; q < 4; ++q) yacc[q] = (f32x4){0.f, 0.f, 0.f, 0.f};
#pragma unroll 1
    for (int d = 0; d < 2; ++d) {
        const int ldg = (l * 2 + d) * 32 + g;
        const S5P P = s5_params(a, l, d, g, p, 1.f), P64 = s5_params(a, l, d, g, p, 64.f);
        f32x2 bb2[16];
        const float* bre = a.in[7] + ((size_t)ldg * 64 + p) * 16; const float* bim = a.in[8] + ((size_t)ldg * 64 + p) * 16;
#pragma unroll
        for (int h = 0; h < 16; ++h) { const float x = bre[h], y = bim[h]; bb2[h].x = P.cr * x - P.ci * y; bb2[h].y = P.cr * y + P.ci * x; }
        const f32x2 lam2 = {P.lr, P.lr}, lami = {-P.li, P.li};
        bf16x8_t cb[4];
#pragma unroll
        for (int s2 = 0; s2 < 4; ++s2) {
            const f32x4 cr4 = *(const f32x4*)(a.in[9] + ((size_t)ldg * 16 + fr) * 64 + 16 * s2 + fq * 4), ci4 = *(const f32x4*)(a.in[10] + ((size_t)ldg * 16 + fr) * 64 + 16 * s2 + fq * 4);
            cb[s2] = mk8(pk2(cr4[0], -ci4[0]), pk2(cr4[1], -ci4[1]), pk2(cr4[2], -ci4[2]), pk2(cr4[3], -ci4[3])); }
        const f32x2* E = (const f32x2*)(ws + WS_S5E) + ((size_t)((b * 32 + g) * 2 + d) * 32) * 64 + p;
        float xr = 0.f, xi = 0.f;
        { f32x2 nx[4];
#pragma unroll
          for (int i = 0; i < 4; ++i) nx[i] = E[(d ? 31 - i : i) * 64];
#pragma unroll 1
          for (int grp = 0; grp < 8; ++grp) {
              if (d ? (31 - grp * 4 <= c) : (grp * 4 >= c)) break;
              f32x2 cu[4];
#pragma unroll
              for (int i = 0; i < 4; ++i) cu[i] = nx[i];
              if (grp < 7) {
#pragma unroll
                  for (int i = 0; i < 4; ++i) nx[i] = E[(d ? 27 - grp * 4 - i : grp * 4 + 4 + i) * 64];
              }
#pragma unroll
              for (int i = 0; i < 4; ++i) { const int cc = d ? 31 - grp * 4 - i : grp * 4 + i;
                  if (d ? (cc > c) : (cc < c)) { const float nr = P64.lr * xr - P64.li * xi + cu[i].x, ni = P64.lr * xi + P64.li * xr + cu[i].y; xr = nr; xi = ni; } }
          } }
#pragma unroll
        for (int sb = 0; sb < 4; ++sb) {
#pragma unroll 4
            for (int tt = 0; tt < 16; ++tt) {
                const int ts = sb * 16 + tt, t = d ? 63 - ts : ts;
                f32x2 acc2 = {0.f, 0.f};
#pragma unroll
                for (int q = 0; q < 4; ++q) { const f32x4 u4 = *((const LAS f32x4*)(us + t * 16) + q);
#pragma unroll
                    for (int e = 0; e < 4; ++e) acc2 += bb2[q * 4 + e] * u4[e]; }
                { const f32x2 x2 = {xr, xi}, xs = {xi, xr}; const f32x2 n2 = lam2 * x2 + lami * xs + acc2; xr = n2.x; xi = n2.y; }
                *(LAS unsigned*)(Xb + (d ? 15 - tt : tt) * 136 + 2 * p) = pg8::cvt_pk_bf16(xr, xi);
            }
            LDS_WAIT(); asm volatile("" ::: "memory");
            f32x4 acc = d ? yacc[3 - sb] : yacc[sb];
#pragma unroll
            for (int s2 = 0; s2 < 4; ++s2) acc = __builtin_amdgcn_mfma_f32_16x16x32_bf16(*(const LAS bf16x8_t*)(Xb + fr * 136 + s2 * 32 + fq * 8), cb[s2], acc, 0, 0, 0);
            if (d) yacc[3 - sb] = acc; else yacc[sb] = acc;
            LDS_WAIT(); asm volatile("" ::: "memory");
        }
    }
    const float dsk = a.in[11][(l * 32 + g) * 16 + fr];
#pragma unroll
    for (int q = 0; q < 4; ++q)
#pragma unroll
        for (int r = 0; r < 4; ++r) { const int t = q * 16 + fq * 4 + r;
            const float y = gelu_tanh_fast(yacc[q][r] + dsk * us[t * 16 + fr]);
            ((bf16_t*)(ws + WS_YGELU))[(size_t)(b * SEQ + c * 64 + t) * 512 + g * 16 + fr] = (bf16_t)f2bf(y); }
    LDS_WAIT(); asm volatile("" ::: "memory");
}
__device__ __forceinline__ float shift3(float p, float c, float n, float m0, float m1) { return c + (p - c) * m0 + (n - c) * m1; }
__device__ __forceinline__ float dpp_ror4(float x) { return __builtin_bit_cast(float, __builtin_amdgcn_update_dpp(0, __builtin_bit_cast(int, x), 0x124, 0xF, 0xF, true)); }
__device__ __forceinline__ float dpp_ror8(float x) { return __builtin_bit_cast(float, __builtin_amdgcn_update_dpp(0, __builtin_bit_cast(int, x), 0x128, 0xF, 0xF, true)); }
__device__ __forceinline__ float dpp_q1(float x) { return __builtin_bit_cast(float, __builtin_amdgcn_update_dpp(0, __builtin_bit_cast(int, x), 0xB1, 0xF, 0xF, true)); }
__device__ __forceinline__ float dpp_q2(float x) { return __builtin_bit_cast(float, __builtin_amdgcn_update_dpp(0, __builtin_bit_cast(int, x), 0x4E, 0xF, 0xF, true)); }
__device__ __forceinline__ float row_sum16(float x) { x += dpp_q1(x); x += dpp_q2(x); x += dpp_ror4(x); x += dpp_ror8(x); return x; }
__device__ __forceinline__ void rwkv_prep_item(const Ctx& C, const AP& a, int l, int ti) {
    unsigned char* ws = a.ws;
    LAS bf16_t* zsb = (LAS bf16_t*)C.lds;
    LAS bf16_t* hidb = (LAS bf16_t*)(C.lds + 33280);
    const float* proj = (const float*)(ws + WS_PROJ);
    const int m0 = ti * 32, s0 = m0 & (SEQ - 1), tid = C.tid, lane = C.lane, w = C.wave;
    const float* mu = a.in[15] + (size_t)l * 4 * 2 * 512;
    float* RW = (float*)(ws + WS_RW); float* KS = (float*)(ws + WS_KS);
    {
        const int c = tid;
        const float mr0 = mu[0 * 512 + c], mr1 = mu[1 * 512 + c], mk0 = mu[2 * 512 + c], mk1 = mu[3 * 512 + c], mv0 = mu[4 * 512 + c], mv1 = mu[5 * 512 + c], mz0 = mu[6 * 512 + c], mz1 = mu[7 * 512 + c];
        const float kk_c = a.in[24][l * 512 + c];
#pragma unroll 1
        for (int hf = 0; hf < 2; ++hf) {
            const int tb0 = hf * 16;
            const float* rp = proj + (size_t)(m0 + tb0) * PROJ + 2048 + c;
            float rr[18], kr[18], vr[18], zr[18];
#pragma unroll
            for (int i = 0; i < 18; ++i) {
                const int sq = s0 + tb0 - 1 + i; const bool ok = (sq >= 0) && (sq < SEQ); const float* q = rp + (long)(i - 1) * PROJ;
                rr[i] = ok ? q[0] : 0.f; kr[i] = ok ? q[512] : 0.f; vr[i] = ok ? q[1024] : 0.f; zr[i] = ok ? q[1536] : 0.f;
            }
#pragma unroll
            for (int t = 0; t < 16; ++t) {
                const float rs = shift3(rr[t], rr[t + 1], rr[t + 2], mr0, mr1), ks = shift3(kr[t], kr[t + 1], kr[t + 2], mk0, mk1);
                const float vs = shift3(vr[t], vr[t + 1], vr[t + 2], mv0, mv1), zs = shift3(zr[t], zr[t + 1], zr[t + 2], mz0, mz1);
                const float kkr = ks * kk_c; const float kkn = kkr * rsqrtf(wave_sum(kkr * kkr) + 1e-12f);
                const size_t o = (size_t)(m0 + tb0 + t) * 512 + c;
                RW[(size_t)RW_R * RWSZ + o] = rs; RW[(size_t)RW_V * RWSZ + o] = vs; RW[(size_t)RW_KK * RWSZ + o] = kkn; KS[o] = ks;
                zsb[(tb0 + t) * 520 + c] = (bf16_t)f2bf(zs);
            }
        }
    }
    __syncthreads();
    const int fr = lane & 15, fq = lane >> 4;
    const bf16_t* W1T = (const bf16_t*)(ws + WS_LORA) + (size_t)l * 224 * 512; const bf16_t* g2T = (const bf16_t*)(ws + WS_LORA) + 2 * 224 * 512 + (size_t)l * 512 * 96;
    const bf16_t* w2T = (const bf16_t*)(ws + WS_LORA) + 2 * 224 * 512 + 2 * 512 * 96 + (size_t)l * 2 * 512 * 32; const bf16_t* a2T = w2T + 2 * 2 * 512 * 32;
    for (int tile = w; tile < 28; tile += 8) {
        const int mt = tile / 14, nt = tile % 14;
        f32x4 acc = {0.f, 0.f, 0.f, 0.f};
        const LAS bf16_t* ap = zsb + (mt * 16 + fr) * 520 + fq * 8; const bf16_t* bp = W1T + (size_t)(nt * 16 + fr) * 512 + fq * 8;
#pragma unroll
        for (int kk = 0; kk < 16; ++kk) acc = __builtin_amdgcn_mfma_f32_16x16x32_bf16(*(const LAS bf16x8_t*)(ap + kk * 32), *(const bf16x8_t*)(bp + kk * 32), acc, 0, 0, 0);
        const int hj = nt * 16 + fr;
#pragma unroll
        for (int j = 0; j < 4; ++j) { float v = acc[j]; if (hj < 96) v = sigmoidf_(v); else if (hj < 160) v = tanhf(v); hidb[(mt * 16 + fq * 4 + j) * 240 + hj] = (bf16_t)f2bf(v); }
    }
    __syncthreads();
#pragma unroll 1
    for (int mt = 0; mt < 2; ++mt) {
        bf16x8_t a7[7];
#pragma unroll
        for (int kk = 0; kk < 7; ++kk) a7[kk] = *(const LAS bf16x8_t*)(hidb + (mt * 16 + fr) * 240 + kk * 32 + fq * 8);
        float pb0[4] = {0.f, 0.f, 0.f, 0.f}, pb1[4] = {0.f, 0.f, 0.f, 0.f}, vsr[4][4];
        float cks[4], ckk[4], crs[4], nks[4], nkk[4], nrs[4];
#pragma unroll
        for (int j = 0; j < 4; ++j) { const size_t o = (size_t)(m0 + mt * 16 + fq * 4 + j) * 512 + w * 64 + fr;
            cks[j] = KS[o]; ckk[j] = RW[(size_t)RW_KK * RWSZ + o]; crs[j] = RW[(size_t)RW_R * RWSZ + o]; vsr[0][j] = RW[(size_t)RW_V * RWSZ + o]; }
#pragma unroll
        for (int nt = 0; nt < 4; ++nt) {
            if (nt < 3) {
#pragma unroll
                for (int j = 0; j < 4; ++j) { const size_t o = (size_t)(m0 + mt * 16 + fq * 4 + j) * 512 + w * 64 + (nt + 1) * 16 + fr;
                    nks[j] = KS[o]; nkk[j] = RW[(size_t)RW_KK * RWSZ + o]; nrs[j] = RW[(size_t)RW_R * RWSZ + o]; vsr[nt + 1][j] = RW[(size_t)RW_V * RWSZ + o]; }
            }
            const int ch = w * 64 + nt * 16 + fr;
            f32x4 ag = {0.f, 0.f, 0.f, 0.f}, aw0 = ag, aw1 = ag, aa0 = ag, aa1 = ag;
#pragma unroll
            for (int kk = 0; kk < 3; ++kk) ag = __builtin_amdgcn_mfma_f32_16x16x32_bf16(a7[kk], *(const bf16x8_t*)(g2T + (size_t)ch * 96 + kk * 32 + fq * 8), ag, 0, 0, 0);
            aw0 = __builtin_amdgcn_mfma_f32_16x16x32_bf16(a7[3], *(const bf16x8_t*)(w2T + (size_t)(0 * 512 + ch) * 32 + fq * 8), aw0, 0, 0, 0);
            aw1 = __builtin_amdgcn_mfma_f32_16x16x32_bf16(a7[4], *(const bf16x8_t*)(w2T + (size_t)(1 * 512 + ch) * 32 + fq * 8), aw1, 0, 0, 0);
            aa0 = __builtin_amdgcn_mfma_f32_16x16x32_bf16(a7[5], *(const bf16x8_t*)(a2T + (size_t)(0 * 512 + ch) * 32 + fq * 8), aa0, 0, 0, 0);
            aa1 = __builtin_amdgcn_mfma_f32_16x16x32_bf16(a7[6], *(const bf16x8_t*)(a2T + (size_t)(1 * 512 + ch) * 32 + fq * 8), aa1, 0, 0, 0);
            const float w00 = a.in[16][(l * 2 + 0) * 512 + ch], w01 = a.in[16][(l * 2 + 1) * 512 + ch], a00 = a.in[19][(l * 2 + 0) * 512 + ch], a01 = a.in[19][(l * 2 + 1) * 512 + ch];
            const float ka_c = a.in[25][l * 512 + ch], rk_c = a.in[26][l * 512 + ch];
#pragma unroll
            for (int j = 0; j < 4; ++j) {
                const size_t o = (size_t)(m0 + mt * 16 + fq * 4 + j) * 512 + ch;
                const float ks = cks[j], kkn = ckk[j], rs = crs[j];
#pragma unroll
                for (int d = 0; d < 2; ++d) {
                    const float wl = (d ? w01 : w00) + (d ? aw1[j] : aw0[j]);
                    const float nx = -wl, sp = fmaxf(nx, 0.f) + log1pf(__expf(-fabsf(nx)));
                    const float decay = __expf(-__expf(-sp - 0.5f));
                    const float av = sigmoidf_((d ? a01 : a00) + (d ? aa1[j] : aa0[j]));
                    const float kd = ks * (1.f + (av - 1.f) * ka_c), bb = kkn * av;
                    if (d) pb1[j] += rs * kd * rk_c; else pb0[j] += rs * kd * rk_c;
                    RW[(size_t)(RW_W0 + d) * RWSZ + o] = decay; RW[(size_t)(RW_KD0 + d) * RWSZ + o] = kd; RW[(size_t)(RW_B0 + d) * RWSZ + o] = bb;
                }
                RW[(size_t)RW_G * RWSZ + o] = ag[j];
            }
#pragma unroll
            for (int j = 0; j < 4; ++j) { cks[j] = nks[j]; ckk[j] = nkk[j]; crs[j] = nrs[j]; }
        }
#pragma unroll
        for (int j = 0; j < 4; ++j) { const float tb = row_sum16(pb0[j]) + row_sum16(pb1[j]);
#pragma unroll
            for (int nt = 0; nt < 4; ++nt) RW[(size_t)RW_BONUS * RWSZ + (size_t)(m0 + mt * 16 + fq * 4 + j) * 512 + w * 64 + nt * 16 + fr] = tb * vsr[nt][j]; }
    }
    __syncthreads();
}

__device__ __forceinline__ void rwkv_chunk_pre(const AP& a, int cid, int lane, LAS unsigned char* wl) {
    unsigned char* ws = a.ws;
    const int c = cid & 127, ci = cid >> 7, d = ci & 1, h = (ci >> 1) & 7, b = ci >> 4, fr = lane & 15, fq = lane >> 4;
    const float* RW = (const float*)(ws + WS_RW);
    unsigned char* rec = ws + WS_RWC + (size_t)cid * RWC_REC;
    LAS bf16_t* KH = (LAS bf16_t*)wl; LAS bf16_t* BC = KH + 1152; LAS bf16_t* KC = BC + 1152; LAS bf16_t* RH = KC + 1152;
    LAS bf16_t* KHT = RH + 1152;
    LAS float* Am = (LAS float*)(wl + 11264); LAS float* Bmm = Am + 256; LAS float* Abm = Bmm + 256; LAS float* Akm = Abm + 256; LAS float* Tm = Akm + 256;
    const size_t tok0 = (size_t)b * SEQ; const int colk = h * 64 + lane;
#define TOKI(i) (tok0 + (size_t)(d ? (SEQ - 1 - (c * 16 + (i))) : (c * 16 + (i))))
    {
        float W[16];
#pragma unroll
        for (int i = 0; i < 16; ++i) W[i] = RW[(size_t)(RW_W0 + d) * RWSZ + TOKI(i) * 512 + colk];
#pragma unroll
        for (int i = 1; i < 16; ++i) W[i] *= W[i - 1];
        const float W15 = W[15];
        unsigned zt[16];
#pragma unroll
        for (int i = 0; i < 16; ++i) {
            const size_t o = TOKI(i) * 512 + colk;
            const float kap = RW[(size_t)RW_KK * RWSZ + o], bv = RW[(size_t)(RW_B0 + d) * RWSZ + o], kdv = RW[(size_t)(RW_KD0 + d) * RWSZ + o], rv = RW[(size_t)RW_R * RWSZ + o];
            const float wm1 = i ? W[i - 1] : 1.f, iw = 1.f / W[i], wr = W15 * iw;
            const unsigned kh = f2bf(kap * wm1);
            KH[i * 72 + lane] = (bf16_t)kh; KHT[lane * 16 + i] = (bf16_t)kh;
            BC[i * 72 + lane] = (bf16_t)f2bf(bv * iw); KC[i * 72 + lane] = (bf16_t)f2bf(kdv * iw); RH[i * 72 + lane] = (bf16_t)f2bf(rv * W[i]);
            const unsigned bb = f2bf(bv * wr), kb = f2bf(kdv * wr);
            const int sb = (i >> 2) * 8 + (i & 3), sk = sb + 4;
            if (sb & 1) zt[sb >> 1] |= bb << 16; else zt[sb >> 1] = bb;
            if (sk & 1) zt[sk >> 1] |= kb << 16; else zt[sk >> 1] = kb;
        }
        u32x4* zp = (u32x4*)(rec + 4096 + lane * 64);
#pragma unroll
        for (int q = 0; q < 4; ++q) zp[q] = (u32x4){zt[q * 4], zt[q * 4 + 1], zt[q * 4 + 2], zt[q * 4 + 3]};
        ((float*)(rec + 8192))[lane] = W15;
    }
    float Vq[4][4];
#pragma unroll
    for (int nt = 0; nt < 4; ++nt) {
#pragma unroll
        for (int r = 0; r < 4; ++r) Vq[nt][r] = RW[(size_t)RW_V * RWSZ + TOKI(fq * 4 + r) * 512 + h * 64 + nt * 16 + fr];
        u32x2 pv; pv.x = pk2(Vq[nt][0], Vq[nt][1]); pv.y = pk2(Vq[nt][2], Vq[nt][3]);
        *(u32x2*)(rec + 12800 + (nt * 64 + lane) * 8) = pv;
    }
    LDS_WAIT(); asm volatile("" ::: "memory");
    {
        f32x4 cA = {0.f, 0.f, 0.f, 0.f}, cB = cA, cAb = cA, cAk = cA;
#pragma unroll
        for (int s2 = 0; s2 < 2; ++s2) {
            const int off = fr * 72 + s2 * 32 + fq * 8;
            const bf16x8_t fkh = *(const LAS bf16x8_t*)(KH + off), fbc = *(const LAS bf16x8_t*)(BC + off), fkc = *(const LAS bf16x8_t*)(KC + off), frh = *(const LAS bf16x8_t*)(RH + off);
            cA = __builtin_amdgcn_mfma_f32_16x16x32_bf16(fkh, fbc, cA, 0, 0, 0); cB = __builtin_amdgcn_mfma_f32_16x16x32_bf16(fkh, fkc, cB, 0, 0, 0);
            cAb = __builtin_amdgcn_mfma_f32_16x16x32_bf16(frh, fbc, cAb, 0, 0, 0); cAk = __builtin_amdgcn_mfma_f32_16x16x32_bf16(frh, fkc, cAk, 0, 0, 0);
        }
#pragma unroll
        for (int r = 0; r < 4; ++r) { const int i = fq * 4 + r, j = fr;
            Am[i * 16 + j] = j < i ? cA[r] : 0.f; Bmm[i * 16 + j] = j < i ? cB[r] : 0.f; Abm[i * 16 + j] = j <= i ? cAb[r] : 0.f; Akm[i * 16 + j] = j <= i ? cAk[r] : 0.f; }
    }
    LDS_WAIT(); asm volatile("" ::: "memory");
    {
        float x[16];
#pragma unroll
        for (int i = 0; i < 16; ++i) {
            float sacc = (i == fr) ? 1.f : 0.f;
#pragma unroll
            for (int jq = 0; jq < (i + 3) / 4; ++jq) { const f32x4 q = *(const LAS f32x4*)(Am + i * 16 + jq * 4);
#pragma unroll
                for (int e = 0; e < 4; ++e) if (jq * 4 + e < i) sacc -= q[e] * x[jq * 4 + e]; }
            x[i] = sacc;
        }
        if (fq == 0) {
#pragma unroll
            for (int i = 0; i < 16; ++i) Tm[i * 16 + fr] = x[i];
        }
    }
    LDS_WAIT(); asm volatile("" ::: "memory");
    {
        const f32x4 qT = *(const LAS f32x4*)(Tm + fr * 16 + fq * 4), qB = *(const LAS f32x4*)(Bmm + fr * 16 + fq * 4), qAb = *(const LAS f32x4*)(Abm + fr * 16 + fq * 4), qAk = *(const LAS f32x4*)(Akm + fr * 16 + fq * 4);
        const unsigned ab0 = pk2(qAb[0], qAb[1]), ab1 = pk2(qAb[2], qAb[3]);
        const bf16x8_t aT = mk8(pk2(qT[0], qT[1]), pk2(qT[2], qT[3]), 0u, 0u), aBm = mk8(pk2(qB[0], qB[1]), pk2(qB[2], qB[3]), 0u, 0u);
        const bf16x8_t aAb = mk8(ab0, ab1, 0u, 0u), aAbAk = mk8(ab0, ab1, pk2(qAk[0], qAk[1]), pk2(qAk[2], qAk[3]));
        const f32x4 z4 = {0.f, 0.f, 0.f, 0.f};
#pragma unroll
        for (int nt = 0; nt < 4; ++nt) {
            const u32x2 kq = *(const LAS u32x2*)(KHT + (nt * 16 + fr) * 16 + fq * 4);
            f32x4 ut = __builtin_amdgcn_mfma_f32_16x16x32_bf16(aT, mk8(kq.x, kq.y, 0u, 0u), z4, 0, 0, 0); ut = -ut;
            const unsigned v0 = pk2(Vq[nt][0], Vq[nt][1]), v1 = pk2(Vq[nt][2], Vq[nt][3]);
            const f32x4 bmv = __builtin_amdgcn_mfma_f32_16x16x32_bf16(aBm, mk8(v0, v1, 0u, 0u), z4, 0, 0, 0);
            f32x4 ul = __builtin_amdgcn_mfma_f32_16x16x32_bf16(aT, mk8(pk2(bmv[0], bmv[1]), pk2(bmv[2], bmv[3]), 0u, 0u), z4, 0, 0, 0); ul = -ul;
            const unsigned u0 = pk2(ut[0], ut[1]), u1 = pk2(ut[2], ut[3]);
            f32x4 yh = __builtin_amdgcn_mfma_f32_16x16x32_bf16(aAb, mk8(u0, u1, 0u, 0u), z4, 0, 0, 0);
#pragma unroll
            for (int r = 0; r < 4; ++r) yh[r] += bflo((unsigned)RH[(fq * 4 + r) * 72 + nt * 16 + fr]);
            const unsigned l0 = pk2(ul[0], ul[1]), l1 = pk2(ul[2], ul[3]);
            const f32x4 yl = __builtin_amdgcn_mfma_f32_16x16x32_bf16(aAbAk, mk8(l0, l1, v0, v1), z4, 0, 0, 0);
            const int s2 = nt >> 1, slot = (fr >> 2) * 8 + (fr & 3) + ((nt & 1) ? 4 : 0);
            bf16_t* m0p = (bf16_t*)rec + ((0 * 2 + s2) * 16) * 32 + slot; bf16_t* m1p = (bf16_t*)rec + ((1 * 2 + s2) * 16) * 32 + slot;
#pragma unroll
            for (int r = 0; r < 4; ++r) { m0p[(fq * 4 + r) * 32] = (bf16_t)((r & 1) ? (((r >> 1) ? u1 : u0) >> 16) : (((r >> 1) ? u1 : u0) & 0xffffu)); m1p[(fq * 4 + r) * 32] = (bf16_t)f2bf(yh[r]); }
            u32x2 pl; pl.x = l0; pl.y = l1; *(u32x2*)(rec + 8704 + (nt * 64 + lane) * 8) = pl;
            u32x2 py; py.x = pk2(yl[0], yl[1]); py.y = pk2(yl[2], yl[3]); *(u32x2*)(rec + 10752 + (nt * 64 + lane) * 8) = py;
        }
    }
    LDS_WAIT(); asm volatile("" ::: "memory");
#undef TOKI
}
__device__ __forceinline__ void vm_wait_chunks(int n) {
    switch (n) { case 0: asm volatile("s_waitcnt vmcnt(0)" ::: "memory"); break; case 1: asm volatile("s_waitcnt vmcnt(4)" ::: "memory"); break;
                 case 2: asm volatile("s_waitcnt vmcnt(8)" ::: "memory"); break; case 3: asm volatile("s_waitcnt vmcnt(12)" ::: "memory"); break;
                 case 4: asm volatile("s_waitcnt vmcnt(16)" ::: "memory"); break; case 5: asm volatile("s_waitcnt vmcnt(20)" ::: "memory"); break;
                 default: asm volatile("s_waitcnt vmcnt(24)" ::: "memory"); break; }
}
__device__ __forceinline__ void rwkv_seq_chain(const Ctx& C, const AP& a, int ci) {
    unsigned char* ws = a.ws;
    const int w = C.wave, lane = C.lane, fr = lane & 15, fq = lane >> 4, d = ci & 1, h = (ci >> 1) & 7, b = ci >> 4;
    const unsigned char* recs = ws + WS_RWC + (size_t)ci * 128 * RWC_REC;
    LAS unsigned char* ring = C.lds;
    const bool loader = w >= 4; const int lw = w - 4;
#define RWC_ISSUE(cc) do { _Pragma("unroll") for (int p_ = 0; p_ < 4; ++p_) { const int pc_ = (lw * 4 + p_) < 15 ? (lw * 4 + p_) : 14; \
        __builtin_amdgcn_global_load_lds((const unsigned*)(recs + (size_t)(cc) * RWC_REC + pc_ * 1024 + lane * 16), (LAS unsigned*)(ring + ((cc) & 7) * RWC_REC + pc_ * 1024), 16, 0, 0); } } while (0)
    if (loader) {
#pragma unroll 1
        for (int cc = 0; cc < 8; ++cc) RWC_ISSUE(cc);
        asm volatile("s_waitcnt vmcnt(28)" ::: "memory");
    }
    __builtin_amdgcn_s_barrier(); asm volatile("" ::: "memory");
    f32x4 ST[4];
#pragma unroll
    for (int kt = 0; kt < 4; ++kt) ST[kt] = (f32x4){0.f, 0.f, 0.f, 0.f};
    float* Y = (float*)(ws + WS_YRW) + (size_t)d * RWSZ + (size_t)b * SEQ * 512 + h * 64 + w * 16 + fr;
#pragma unroll 1
    for (int c = 0; c < 128; ++c) {
        if (!loader) {
            const LAS unsigned char* sl = ring + (c & 7) * RWC_REC;
            const bf16x8_t a00 = *(const LAS bf16x8_t*)(sl + (0 * 16 + fr) * 64 + fq * 16), a01 = *(const LAS bf16x8_t*)(sl + (1 * 16 + fr) * 64 + fq * 16);
            const bf16x8_t a10 = *(const LAS bf16x8_t*)(sl + (2 * 16 + fr) * 64 + fq * 16), a11 = *(const LAS bf16x8_t*)(sl + (3 * 16 + fr) * 64 + fq * 16);
            const u32x2 ulw = *(const LAS u32x2*)(sl + 8704 + (w * 64 + lane) * 8), ylw = *(const LAS u32x2*)(sl + 10752 + (w * 64 + lane) * 8), vpw = *(const LAS u32x2*)(sl + 12800 + (w * 64 + lane) * 8);
            const bf16x8_t bs0 = mk8(pk2(ST[0][0], ST[0][1]), pk2(ST[0][2], ST[0][3]), pk2(ST[1][0], ST[1][1]), pk2(ST[1][2], ST[1][3]));
            const bf16x8_t bs1 = mk8(pk2(ST[2][0], ST[2][1]), pk2(ST[2][2], ST[2][3]), pk2(ST[3][0], ST[3][1]), pk2(ST[3][2], ST[3][3]));
            const f32x4 z4 = {0.f, 0.f, 0.f, 0.f};
            f32x4 g0 = __builtin_amdgcn_mfma_f32_16x16x32_bf16(a00, bs0, z4, 0, 0, 0); g0 = __builtin_amdgcn_mfma_f32_16x16x32_bf16(a01, bs1, g0, 0, 0, 0);
            f32x4 g1 = __builtin_amdgcn_mfma_f32_16x16x32_bf16(a10, bs0, z4, 0, 0, 0); g1 = __builtin_amdgcn_mfma_f32_16x16x32_bf16(a11, bs1, g1, 0, 0, 0);
            const float uf0 = g0[0] + bflo(ulw.x), uf1 = g0[1] + bfhi(ulw.x), uf2 = g0[2] + bflo(ulw.y), uf3 = g0[3] + bfhi(ulw.y);
            const bf16x8_t xb = mk8(pk2(uf0, uf1), pk2(uf2, uf3), vpw.x, vpw.y);
#pragma unroll
            for (int kt = 0; kt < 4; ++kt) {
                const f32x4 dq = *(const LAS f32x4*)(sl + 8192 + (kt * 16 + fq * 4) * 4);
                const bf16x8_t az = *(const LAS bf16x8_t*)(sl + 4096 + (kt * 16 + fr) * 64 + fq * 16);
                ST[kt] = __builtin_amdgcn_mfma_f32_16x16x32_bf16(az, xb, ST[kt] * dq, 0, 0, 0);
            }
            const float y0 = g1[0] + bflo(ylw.x), y1 = g1[1] + bfhi(ylw.x), y2 = g1[2] + bflo(ylw.y), y3 = g1[3] + bfhi(ylw.y);
            const int sbase = c * 16 + fq * 4;
            Y[(size_t)(d ? SEQ - 1 - (sbase + 0) : sbase + 0) * 512] = y0; Y[(size_t)(d ? SEQ - 1 - (sbase + 1) : sbase + 1) * 512] = y1;
            Y[(size_t)(d ? SEQ - 1 - (sbase + 2) : sbase + 2) * 512] = y2; Y[(size_t)(d ? SEQ - 1 - (sbase + 3) : sbase + 3) * 512] = y3;
            asm volatile("s_waitcnt lgkmcnt(0)" ::: "memory");
        } else if (c + 1 < 128) {
            const int lastc = (c + 7 < 127) ? c + 7 : 127;
            vm_wait_chunks(lastc - (c + 1));
        }
        __builtin_amdgcn_s_barrier(); asm volatile("" ::: "memory");
        if (loader && c + 8 < 128) RWC_ISSUE(c + 8);
    }
    asm volatile("s_waitcnt vmcnt(0)" ::: "memory");
    __builtin_amdgcn_s_barrier(); asm volatile("" ::: "memory");
#undef RWC_ISSUE
}

__device__ __forceinline__ float dpp_sum8(float x) {
    x += __builtin_bit_cast(float, __builtin_amdgcn_update_dpp(0, __builtin_bit_cast(int, x), 0xB1, 0xF, 0xF, true));
    x += __builtin_bit_cast(float, __builtin_amdgcn_update_dpp(0, __builtin_bit_cast(int, x), 0x4E, 0xF, 0xF, true));
    x += __builtin_bit_cast(float, __builtin_amdgcn_update_dpp(0, __builtin_bit_cast(int, x), 0x141, 0xF, 0xF, true));
    return x;
}
__device__ __forceinline__ void rwkv_scan_item(const Ctx& C, const AP& a, int item) {
    unsigned char* ws = a.ws;
    const int d = item & 1, h = (item >> 1) & 7, b = item >> 4, tid = C.tid, v = tid >> 3, kq = tid & 7;
    const float* RW = (const float*)(ws + WS_RW);
    const float* arr[6] = { RW + (size_t)RW_KK * RWSZ, RW + (size_t)(RW_W0 + d) * RWSZ, RW + (size_t)(RW_B0 + d) * RWSZ, RW + (size_t)(RW_KD0 + d) * RWSZ, RW + (size_t)RW_R * RWSZ, RW + (size_t)RW_V * RWSZ };
    float* Y = (float*)(ws + WS_YRW) + (size_t)d * RWSZ;
    LAS float* buf = (LAS float*)C.lds;
    const int ls = tid >> 4, lq = tid & 15;
    f32x4 stg[6];
    const size_t colbase = (size_t)h * 64;
#define RW_LOAD(ch) do { const int s_ = (ch) * 32 + ls, t_ = d ? (SEQ - 1 - s_) : s_; const size_t o_ = ((size_t)(b * SEQ + t_)) * 512 + colbase + lq * 4; \
        _Pragma("unroll") for (int q_ = 0; q_ < 6; ++q_) stg[q_] = *(const f32x4*)(arr[q_] + o_); } while (0)
#define RW_WRITE(bi) do { _Pragma("unroll") for (int q_ = 0; q_ < 6; ++q_) *(LAS f32x4*)(buf + (((bi) * 6 + q_) * 32 + ls) * 64 + lq * 4) = stg[q_]; } while (0)
    float S[8];
#pragma unroll
    for (int j = 0; j < 8; ++j) S[j] = 0.f;
    RW_LOAD(0); RW_WRITE(0); __syncthreads();
    for (int ch = 0; ch < SEQ / 32; ++ch) {
        const int bi = ch & 1;
        if (ch + 1 < SEQ / 32) RW_LOAD(ch + 1);
        const LAS float* B0 = buf + (bi * 6) * 32 * 64;
        for (int st = 0; st < 32; ++st) {
            const LAS float* bp = B0 + st * 64 + kq * 8;
            const f32x4 k0 = *(const LAS f32x4*)(bp), k1 = *(const LAS f32x4*)(bp + 4);
            const f32x4 w0 = *(const LAS f32x4*)(bp + 2048), w1 = *(const LAS f32x4*)(bp + 2048 + 4);
            const f32x4 b0 = *(const LAS f32x4*)(bp + 4096), b1 = *(const LAS f32x4*)(bp + 4096 + 4);
            const f32x4 d0 = *(const LAS f32x4*)(bp + 6144), d1 = *(const LAS f32x4*)(bp + 6144 + 4);
            const f32x4 r0 = *(const LAS f32x4*)(bp + 8192), r1 = *(const LAS f32x4*)(bp + 8192 + 4);
            const float vv = B0[10240 + st * 64 + v];
            float sa = S[0] * k0[0] + S[1] * k0[1] + S[2] * k0[2] + S[3] * k0[3] + S[4] * k1[0] + S[5] * k1[1] + S[6] * k1[2] + S[7] * k1[3];
            sa = -dpp_sum8(sa);
            float y = 0.f;
#pragma unroll
            for (int j = 0; j < 4; ++j) { S[j] = S[j] * w0[j] + (sa * b0[j] + vv * d0[j]); y += S[j] * r0[j]; S[4 + j] = S[4 + j] * w1[j] + (sa * b1[j] + vv * d1[j]); y += S[4 + j] * r1[j]; }
            y = dpp_sum8(y);
            if (kq == 0) { const int s_ = ch * 32 + st, t_ = d ? (SEQ - 1 - s_) : s_; Y[((size_t)(b * SEQ + t_)) * 512 + colbase + v] = y; }
        }
        if (ch + 1 < SEQ / 32) RW_WRITE(bi ^ 1);
        __syncthreads();
    }
#undef RW_LOAD
#undef RW_WRITE
}
__device__ __forceinline__ void rwkv_post_item(const AP& a, int l, int item, int lane) {
    unsigned char* ws = a.ws;
    const int hh = item & 7, m = item >> 3, c = hh * 64 + lane; const size_t o = (size_t)m * 512 + c;
    const float* Y = (const float*)(ws + WS_YRW); const float* RW = (const float*)(ws + WS_RW);
    const float y = Y[o] + Y[RWSZ + o];
    const float mean = wave_sum(y) * (1.f / 64.f), dv = y - mean, var = wave_sum(dv * dv) * (1.f / 64.f);
    const float yn = dv * rsqrtf(var + 64e-5f) * a.in[27][l * 512 + c] + a.in[28][l * 512 + c];
    ((float*)(ws + WS_YA))[(size_t)3 * RWSZ + o] = (yn + RW[(size_t)RW_BONUS * RWSZ + o]) * RW[(size_t)RW_G * RWSZ + o];
}
__device__ __forceinline__ void c1_fold_item(const AP& a, int row, int lane) {
    const unsigned short* src = (const unsigned short*)(a.ws + WS_C1) + (size_t)row * 4096;
    unsigned short* dst = (unsigned short*)(a.ws + WS_C1F) + (size_t)row * 2048;
#pragma unroll 8
    for (int i = 0; i < 32; ++i) {
        const int j = i * 64 + lane; float v;
        if (j <= 1024) { const float x0 = __uint_as_float((unsigned)src[j] << 16); const int jm = (j >= 1 && j <= 1023) ? 2048 - j : j;
            const float x1 = __uint_as_float((unsigned)src[jm] << 16); v = (j >= 1 && j <= 1023) ? x0 + x1 : x0; }
        else { const int sidx = j - 1024; v = __uint_as_float((unsigned)src[2048 + sidx] << 16) - __uint_as_float((unsigned)src[2048 + 2048 - sidx] << 16); }
        dst[j] = (unsigned short)f2bf(v);
    }
}
__device__ __forceinline__ void branch_d_item(const AP& a, int l, int m, int lane) {
    unsigned char* ws = a.ws;
    const float* Y = (const float*)(ws + WS_YRW); const float* RW = (const float*)(ws + WS_RW);
    float o[8]; float ss = 0.f;
#pragma unroll
    for (int hh = 0; hh < 8; ++hh) {
        const int c = hh * 64 + lane; const size_t ix = (size_t)m * 512 + c;
        const float y = Y[ix] + Y[RWSZ + ix];
        const float mean = wave_sum(y) * (1.f / 64.f), dv = y - mean, var = wave_sum(dv * dv) * (1.f / 64.f);
        const float yn = dv * rsqrtf(var + 64e-5f) * a.in[27][l * 512 + c] + a.in[28][l * 512 + c];
        o[hh] = (yn + RW[(size_t)RW_BONUS * RWSZ + ix]) * RW[(size_t)RW_G * RWSZ + ix]; ss += o[hh] * o[hh];
    }
    const float rs = rsqrtf(wave_sum(ss) * (1.f / 512.f) + 1e-6f);
    bf16_t* dst = (bf16_t*)(ws + WS_HB) + (size_t)m * DM + 1536 + lane;
#pragma unroll
    for (int hh = 0; hh < 8; ++hh) dst[hh * 64] = (bf16_t)f2bf(o[hh] * rs);
}
__device__ __forceinline__ void branch_norm_item(const AP& a, int item, int lane) {
    unsigned char* ws = a.ws;
    const int br = item & 3, m = item >> 2;
    const f32x4* src = (const f32x4*)((const float*)(ws + WS_YA) + (size_t)br * RWSZ + (size_t)m * 512) + lane;
    const f32x4 v0 = src[0], v1 = src[64];
    const float ss = wave_sum(v0.x * v0.x + v0.y * v0.y + v0.z * v0.z + v0.w * v0.w + v1.x * v1.x + v1.y * v1.y + v1.z * v1.z + v1.w * v1.w);
    const float rs = rsqrtf(ss * (1.f / 512.f) + 1e-6f);
    u32x2* dst = (u32x2*)((bf16_t*)(ws + WS_HB) + (size_t)m * DM + br * 512) + lane;
    u32x2 w; w.x = pk2(v0.x * rs, v0.y * rs); w.y = pk2(v0.z * rs, v0.w * rs); dst[0] = w;
    w.x = pk2(v1.x * rs, v1.y * rs); w.y = pk2(v1.z * rs, v1.w * rs); dst[64] = w;
}

__device__ __forceinline__ unsigned fkey(float f) { const unsigned u = __float_as_uint(f); return (u & 0x80000000u) ? ~u : (u | 0x80000000u); }
__device__ __forceinline__ int lane_rank(unsigned long long m) { return __builtin_amdgcn_mbcnt_hi((unsigned)(m >> 32), __builtin_amdgcn_mbcnt_lo((unsigned)m, 0)); }
template <int N>
__device__ __forceinline__ void top16_select(const float (&val)[N], const int (&idx)[N], LAS float* lv, LAS int* li) {
    unsigned k[N];
#pragma unroll
    for (int e = 0; e < N; ++e) k[e] = fkey(val[e]);
    unsigned T = 0;
    for (int bit = 31; bit >= 0; --bit) {
        const unsigned cand = T | (1u << bit); int cnt = 0;
#pragma unroll
        for (int e = 0; e < N; ++e) cnt += __popcll(__ballot(k[e] >= cand));
        if (cnt >= 16) T = cand;
        if (cnt == 16) break;
    }
    int ngt = 0;
#pragma unroll
    for (int e = 0; e < N; ++e) ngt += __popcll(__ballot(k[e] > T));
    const int need = 16 - ngt; int eqbase = 0, posbase = 0;
#pragma unroll
    for (int e = 0; e < N; ++e) {
        const unsigned long long meq = __ballot(k[e] == T);
        const int eqrank = eqbase + lane_rank(meq);
        const bool sel = (k[e] > T) || (k[e] == T && eqrank < need);
        const unsigned long long msel = __ballot(sel);
        const int pos = posbase + lane_rank(msel);
        if (sel) { lv[pos] = val[e]; li[pos] = idx[e]; }
        eqbase += __popcll(meq); posbase += __popcll(msel);
    }
    LDS_WAIT(); asm volatile("" ::: "memory");
}
__device__ __forceinline__ float dpp_xor1(float x) { return __builtin_bit_cast(float, __builtin_amdgcn_update_dpp(0, __builtin_bit_cast(int, x), 0xB1, 0xF, 0xF, true)); }
__device__ __forceinline__ float dpp_xor2(float x) { return __builtin_bit_cast(float, __builtin_amdgcn_update_dpp(0, __builtin_bit_cast(int, x), 0x4E, 0xF, 0xF, true)); }
__device__ __forceinline__ float reduce8(const float (&v)[8], int lane) {
    const bool b0 = lane & 1, b1 = lane & 2, b2 = lane & 4;
    float w4[4], w2[2];
#pragma unroll
    for (int k = 0; k < 4; ++k) { const float keep = b0 ? v[4 + k] : v[k], send = b0 ? v[k] : v[4 + k]; w4[k] = keep + dpp_xor1(send); }
#pragma unroll
    for (int k = 0; k < 2; ++k) { const float keep = b1 ? w4[2 + k] : w4[k], send = b1 ? w4[k] : w4[2 + k]; w2[k] = keep + dpp_xor2(send); }
    const float keep = b2 ? w2[1] : w2[0], send = b2 ? w2[0] : w2[1];
    float r = keep + __shfl_xor(send, 4);
    r += __shfl_xor(r, 8); r += __shfl_xor(r, 16); r += __shfl_xor(r, 32);
    return r;
}
typedef float f32x2v __attribute__((ext_vector_type(2)));
__device__ __forceinline__ void split8(const f32x4 a0, const f32x4 a1, bf16x8_t& hi, bf16x8_t& lo) {
    unsigned h[4], l_[4];
#pragma unroll
    for (int i = 0; i < 4; ++i) { const float x0 = i < 2 ? a0[2 * i] : a1[2 * i - 4], x1 = i < 2 ? a0[2 * i + 1] : a1[2 * i - 3];
        const unsigned h0 = f2bf(x0), h1 = f2bf(x1); h[i] = h0 | (h1 << 16);
        l_[i] = pk2(x0 - __uint_as_float(h0 << 16), x1 - __uint_as_float(h1 << 16)); }
    hi = mk8(h[0], h[1], h[2], h[3]); lo = mk8(l_[0], l_[1], l_[2], l_[3]);
}
__device__ __forceinline__ void peer_select_head(const f32x2 s0, const f32x2 s1, int lane, LAS float* wl, LAS int* fe, LAS float* fg, int ci_i, int ci_j, bool cand_on) {
    { const float v0[2] = {s0.x, s0.y}; const int i0[2] = {2 * lane, 2 * lane + 1}; top16_select<2>(v0, i0, wl, (LAS int*)(wl + 16)); }
    { const float v1[2] = {s1.x, s1.y}; const int i1[2] = {2 * lane, 2 * lane + 1}; top16_select<2>(v1, i1, wl + 32, (LAS int*)(wl + 48)); }
    if (lane < 32) { const int lst = lane >> 4, ii = lane & 15; const LAS float* lv = wl + lst * 32;
      const float v = lv[ii]; const int ix = ((const LAS int*)lv)[16 + ii]; int rank = 0;
#pragma unroll
      for (int jq = 0; jq < 4; ++jq) { const f32x4 q = *(const LAS f32x4*)(lv + jq * 4);
#pragma unroll
          for (int e = 0; e < 4; ++e) rank += (q[e] > v || (q[e] == v && (jq * 4 + e) < ii)) ? 1 : 0; }
      wl[64 + lst * 32 + rank] = v; ((LAS int*)wl)[64 + lst * 32 + 16 + rank] = ix; }
    LDS_WAIT(); asm volatile("" ::: "memory");
    { const float cvv = cand_on ? wl[64 + ci_i] + wl[96 + ci_j] : -INFINITY;
      const float cv[1] = {cvv}; const int ci[1] = {ci_i * 16 + ci_j};
      top16_select<1>(cv, ci, wl + 128, (LAS int*)(wl + 144)); }
    { const bool act = lane < 16; const float sc = act ? wl[128 + lane] : -3.0e38f; const int fi = act ? ((LAS int*)wl)[144 + lane] : 0;
      const int e = ((LAS int*)wl)[80 + (fi >> 4)] * 128 + ((LAS int*)wl)[112 + (fi & 15)];
      const float mx = wave_max(sc), ex = act ? __expf(sc - mx) : 0.f, sm = wave_sum(ex);
      if (act) { fe[lane] = e; fg[lane] = ex / sm; } }
    LDS_WAIT(); asm volatile("" ::: "memory");
}
__device__ __forceinline__ void peer_tile(const Ctx& C, const AP& a, int l, int tile, const float* x1, float* xout, bool write_hb) {
    unsigned char* ws = a.ws;
    const int tid = C.tid, lane = C.lane, w = C.wave, tb = tile * 32;
    LAS float* keys = (LAS float*)C.lds;
    LAS int* rt_idx = (LAS int*)(C.lds + 65536);
    LAS float* rt_gate = (LAS float*)(C.lds + 81920);
    LAS float* wl = (LAS float*)(C.lds + 98304) + w * 256;
    LAS float* ssp = (LAS float*)(C.lds + 98304 + 8 * 1024);
    const float* qry = (const float*)(ws + WS_PROJ);
    int ci_i, ci_j; const bool cand_on = lane < 50;
    if (lane < 16) { ci_i = 0; ci_j = lane; } else if (lane < 24) { ci_i = 1; ci_j = lane - 16; } else if (lane < 29) { ci_i = 2; ci_j = lane - 24; }
    else if (lane < 33) { ci_i = 3; ci_j = lane - 29; } else if (lane < 36) { ci_i = 4; ci_j = lane - 33; } else if (lane < 38) { ci_i = 5; ci_j = lane - 36; }
    else if (lane < 40) { ci_i = 6; ci_j = lane - 38; } else if (lane < 42) { ci_i = 7; ci_j = lane - 40; } else if (lane < 50) { ci_i = lane - 34; ci_j = 0; } else { ci_i = 0; ci_j = 0; }
    float* Ssc = (float*)(ws + WS_RW) + (size_t)tile * 65536;
    { const int fr = lane & 15, fq = lane >> 4;
#pragma unroll 1
      for (int hp = 0; hp < 16; ++hp) {
        const int h = hp >> 1, pp = hp & 1;
        bf16x8_t ah[2][2], al[2][2], bh[2], bl[2];
#pragma unroll
        for (int ks = 0; ks < 2; ++ks) {
            const float* kp = a.in[33] + ((size_t)(((l * 8 + h) * 2 + pp) * 128 + 16 * w + fr)) * 64 + ks * 32 + fq * 8;
            split8(*(const f32x4*)kp, *(const f32x4*)(kp + 4), bh[ks], bl[ks]);
#pragma unroll
            for (int mt = 0; mt < 2; ++mt) { const float* qp = qry + (size_t)(tb + mt * 16 + fr) * 1024 + h * 128 + pp * 64 + ks * 32 + fq * 8;
                split8(*(const f32x4*)qp, *(const f32x4*)(qp + 4), ah[mt][ks], al[mt][ks]); }
        }
#pragma unroll
        for (int mt = 0; mt < 2; ++mt) { f32x4 acc = {0.f, 0.f, 0.f, 0.f};
#pragma unroll
            for (int ks = 0; ks < 2; ++ks) { acc = __builtin_amdgcn_mfma_f32_16x16x32_bf16(al[mt][ks], bh[ks], acc, 0, 0, 0); acc = __builtin_amdgcn_mfma_f32_16x16x32_bf16(ah[mt][ks], bl[ks], acc, 0, 0, 0);
                acc = __builtin_amdgcn_mfma_f32_16x16x32_bf16(ah[mt][ks], bh[ks], acc, 0, 0, 0); }
#pragma unroll
            for (int r = 0; r < 4; ++r) Ssc[(size_t)(hp * 32 + mt * 16 + fq * 4 + r) * 128 + 16 * w + fr] = acc[r]; }
      } }
    __syncthreads();
    const unsigned char* U6 = ws + WS_UB + (size_t)l * ETAB; const unsigned char* V4 = ws + WS_UB + 64 * MiB + (size_t)l * 16 * MiB;
    const float* Us = (const float*)(ws + WS_VB) + (0 * 2 + l) * 16384; const float* Vs = (const float*)(ws + WS_VB) + (1 * 2 + l) * 16384;
    bf16_t* hb = (bf16_t*)(ws + WS_HB);
    u32x4 ua[8]; u32x4 va[8]; float sul, svl, gl; float xf[32], acc[32];
#define PEER_IDS(mye_, ei_) _Pragma("unroll") for (int e = 0; e < 8; ++e) ei_[e] = __builtin_amdgcn_readlane(mye_, ((e >> 2) & 1) | (((e >> 1) & 1) << 1) | ((e & 1) << 2));
#define PEER_ISSUE_U(ei_, ln_) _Pragma("unroll") for (int e = 0; e < 8; ++e) ua[e] = ((const u32x4*)(U6 + (size_t)ei_[e] * 1024))[ln_];
#define PEER_ISSUE_V(ei_, ln_) _Pragma("unroll") for (int e = 0; e < 8; ++e) va[e] = ((const u32x4*)(V4 + (size_t)ei_[e] * 1024))[ln_];
#define PEER_DOTS(dot_) _Pragma("unroll") for (int e = 0; e < 8; ++e) { f32x2v s2 = {0.f, 0.f}; \
        _Pragma("unroll") for (int d4 = 0; d4 < 4; ++d4) { const unsigned wd = ua[e][d4]; \
            s2 = __builtin_elementwise_fma((f32x2v){xf[8 * d4 + 0], xf[8 * d4 + 1]}, __builtin_amdgcn_cvt_scalef32_pk_f32_fp4(wd, 1.0f, 0), s2); \
            s2 = __builtin_elementwise_fma((f32x2v){xf[8 * d4 + 2], xf[8 * d4 + 3]}, __builtin_amdgcn_cvt_scalef32_pk_f32_fp4(wd, 1.0f, 1), s2); \
            s2 = __builtin_elementwise_fma((f32x2v){xf[8 * d4 + 4], xf[8 * d4 + 5]}, __builtin_amdgcn_cvt_scalef32_pk_f32_fp4(wd, 1.0f, 2), s2); \
            s2 = __builtin_elementwise_fma((f32x2v){xf[8 * d4 + 6], xf[8 * d4 + 7]}, __builtin_amdgcn_cvt_scalef32_pk_f32_fp4(wd, 1.0f, 3), s2); } \
        dot_[e] = s2.x + s2.y; }
#define PEER_ACCUM(cfl_) _Pragma("unroll") for (int e = 0; e < 8; ++e) { \
        const int src = ((e >> 2) & 1) | (((e >> 1) & 1) << 1) | ((e & 1) << 2); \
        const float cf = __builtin_bit_cast(float, __builtin_amdgcn_readlane(__builtin_bit_cast(int, cfl_), src)); \
        _Pragma("unroll") for (int d4 = 0; d4 < 4; ++d4) { const unsigned wd = va[e][d4]; \
            const f32x2v p0 = __builtin_amdgcn_cvt_scalef32_pk_f32_fp4(wd, 1.0f, 0), p1 = __builtin_amdgcn_cvt_scalef32_pk_f32_fp4(wd, 1.0f, 1); \
            const f32x2v p2 = __builtin_amdgcn_cvt_scalef32_pk_f32_fp4(wd, 1.0f, 2), p3 = __builtin_amdgcn_cvt_scalef32_pk_f32_fp4(wd, 1.0f, 3); \
            acc[8 * d4 + 0] += cf * p0.x; acc[8 * d4 + 1] += cf * p0.y; acc[8 * d4 + 2] += cf * p1.x; acc[8 * d4 + 3] += cf * p1.y; \
            acc[8 * d4 + 4] += cf * p2.x; acc[8 * d4 + 5] += cf * p2.y; acc[8 * d4 + 6] += cf * p3.x; acc[8 * d4 + 7] += cf * p3.y; } \
        if (e < 7) {   \
            asm volatile("" : "+v"(va[e + 1][0]), "+v"(va[e + 1][1]) : "v"(acc[0]), "v"(acc[1]), "v"(acc[2]), "v"(acc[3]), "v"(acc[4]), "v"(acc[5]), "v"(acc[6]), "v"(acc[7]), \
                         "v"(acc[8]), "v"(acc[9]), "v"(acc[10]), "v"(acc[11]), "v"(acc[12]), "v"(acc[13]), "v"(acc[14]), "v"(acc[15])); \
            asm volatile("" : "+v"(va[e + 1][2]), "+v"(va[e + 1][3]) : "v"(acc[16]), "v"(acc[17]), "v"(acc[18]), "v"(acc[19]), "v"(acc[20]), "v"(acc[21]), "v"(acc[22]), "v"(acc[23]), \
                         "v"(acc[24]), "v"(acc[25]), "v"(acc[26]), "v"(acc[27]), "v"(acc[28]), "v"(acc[29]), "v"(acc[30]), "v"(acc[31])); } }
    {
        const int tokl = w * 4;
        peer_select_head(*(const f32x2*)(Ssc + (size_t)(0 * 32 + tokl) * 128 + 2 * lane), *(const f32x2*)(Ssc + (size_t)(1 * 32 + tokl) * 128 + 2 * lane), lane, wl, (LAS int*)(wl + 160), wl + 176, ci_i, ci_j, cand_on);
        int ln = lane; asm volatile("" : "+v"(ln)); const int el1 = ((ln >> 2) & 1) | (((ln >> 1) & 1) << 1) | ((ln & 1) << 2);
        const int mye = ((LAS int*)(wl + 160))[el1]; int ei[8]; PEER_IDS(mye, ei) PEER_ISSUE_U(ei, ln) PEER_ISSUE_V(ei, ln)
        sul = Us[mye]; svl = Vs[mye]; gl = (wl + 176)[el1];
    }
#pragma unroll 1
    for (int hh = 0; hh < 32; ++hh) {
        const int h = hh & 7, tokl = w * 4 + (hh >> 3), tok = tb + tokl;
        LAS int* fe = (LAS int*)(wl + 160 + (hh & 1) * 32); LAS float* fg = wl + 176 + (hh & 1) * 32;
        if (h == 0) {
            const u32x2* xp = (const u32x2*)(hb + (size_t)tok * DM) + lane;
#pragma unroll
            for (int j = 0; j < 8; ++j) { const u32x2 xw = xp[64 * j]; xf[j * 4 + 0] = bflo(xw.x); xf[j * 4 + 1] = bfhi(xw.x); xf[j * 4 + 2] = bflo(xw.y); xf[j * 4 + 3] = bfhi(xw.y); }
#pragma unroll
            for (int i = 0; i < 32; ++i) acc[i] = 0.f;
        }
        {
            float dot[8]; PEER_DOTS(dot)
            int ln = lane; asm volatile("" : "+v"(ln)); const int el1 = ((ln >> 2) & 1) | (((ln >> 1) & 1) << 1) | ((ln & 1) << 2);
            const int mye = fe[8 + el1]; int ei[8]; PEER_IDS(mye, ei) PEER_ISSUE_U(ei, ln)
            const float cfl = gl * gelu_erf(reduce8(dot, lane) * sul) * svl;
            PEER_ACCUM(cfl)
            f32x2 ns0 = {0.f, 0.f}, ns1 = {0.f, 0.f};
            if (hh < 31) { const int tk2 = w * 4 + ((hh + 1) >> 3), h2 = (hh + 1) & 7;
                ns0 = *(const f32x2*)(Ssc + (size_t)((h2 * 2 + 0) * 32 + tk2) * 128 + 2 * ln); ns1 = *(const f32x2*)(Ssc + (size_t)((h2 * 2 + 1) * 32 + tk2) * 128 + 2 * ln); }
            PEER_ISSUE_V(ei, ln)
            sul = Us[mye]; svl = Vs[mye]; gl = fg[8 + el1];
            if (hh < 31) peer_select_head(ns0, ns1, lane, wl, (LAS int*)(wl + 160 + ((hh + 1) & 1) * 32), wl + 176 + ((hh + 1) & 1) * 32, ci_i, ci_j, cand_on);
        }
        {
            float dot[8]; PEER_DOTS(dot)
            int ln = lane; asm volatile("" : "+v"(ln)); const int el1 = ((ln >> 2) & 1) | (((ln >> 1) & 1) << 1) | ((ln & 1) << 2);
            const int nofs = hh < 31 ? ((hh + 1) & 1) * 32 : (hh & 1) * 32 + 8;
            const int mye = ((LAS int*)(wl + 160 + nofs))[el1]; int ei[8]; PEER_IDS(mye, ei) PEER_ISSUE_U(ei, ln)
            const float cfl = gl * gelu_erf(reduce8(dot, lane) * sul) * svl;
            PEER_ACCUM(cfl)
            PEER_ISSUE_V(ei, ln)
            sul = Us[mye]; svl = Vs[mye]; gl = (wl + 176 + nofs)[el1];
        }
        if (h == 7) {
        f32x4 o[8]; float ssq = 0.f;
#pragma unroll
        for (int j = 0; j < 8; ++j) { o[j] = *((const f32x4*)(x1 + (size_t)tok * DM) + 64 * j + lane) + (f32x4){acc[j * 4 + 0], acc[j * 4 + 1], acc[j * 4 + 2], acc[j * 4 + 3]};
            *((f32x4*)(xout + (size_t)tok * DM) + 64 * j + lane) = o[j]; ssq += o[j].x * o[j].x + o[j].y * o[j].y + o[j].z * o[j].z + o[j].w * o[j].w; }
        if (write_hb) {
            const float rs = rsqrtf(wave_sum(ssq) * (1.f / DM) + 1e-6f);
#pragma unroll
            for (int j = 0; j < 8; ++j) { u32x2 pw; pw.x = pk2(o[j].x * rs, o[j].y * rs); pw.y = pk2(o[j].z * rs, o[j].w * rs); *((u32x2*)(hb + (size_t)tok * DM) + 64 * j + lane) = pw; }
        }
        }
    }
#undef PEER_IDS
#undef PEER_ISSUE_U
#undef PEER_ISSUE_V
#undef PEER_DOTS
#undef PEER_ACCUM
    __syncthreads();
}

constexpr int N_PHASES = 19;
template <int PH>
__device__ __forceinline__ void run_phase(unsigned char* lds_raw, const int wave0) {
    if constexpr (PH == 0) { if (PON(9)) { const Ctx C = fresh_ctx_w(lds_raw, wave0); const AP a = fresh_args(); phase_prep(C, a); } }
    else {
            constexpr int l = (PH - 1) / 9, k = (PH - 1) % 9;
            switch (k) {
            case 0: if (PON(0)) {
                const Ctx C = fresh_ctx_w(lds_raw, wave0); const AP a = fresh_args(); unsigned char* ws = a.ws;
                pg8::Gemm g{(const bf16_t*)(ws + WS_HB), (const bf16_t*)(ws + WS_WINT) + (size_t)l * PROJ * DM, DM};
                pg8::Order S; S.init(32, 16, 1, 0, 0, 0, C.G, C.bx);
                pg8::EpiInProj E{(bf16_t*)(ws + WS_PA), (float*)(ws + WS_PROJ)};
                pg8::gemm_phase(C.lds, g, S, E, C.tid);
            } break;
            case 1: if (PON(1)) {
                int bxo = blockIdx.x; asm volatile("" : "+s"(bxo));
                if (bxo < 128) { const Ctx C = fresh_ctx_w(lds_raw, wave0); const AP a = fresh_args();
                  for (int ti = C.bx; ti < MTOK / 32; ti += C.G) rwkv_prep_item(C, a, l, ti); }
                if (PON(11)) { const Ctx C = fresh_ctx_w(lds_raw, wave0); const AP a = fresh_args(); unsigned char* ws = a.ws;
                  pg8::Gemm g{(const bf16_t*)(ws + WS_WCST) + (size_t)l * 1024 * 512, (const bf16_t*)(ws + WS_PA), 512};
                  pg8::Order S; S.init(4, 32, 1, 0, 0, 0, C.G, C.bx);
                  pg8::EpiC1 E{(bf16_t*)(ws + WS_C1)};
                  pg8::gemm_phase(C.lds, g, S, E, C.tid); }
                __syncthreads();
                if (PON(12)) { const Ctx C = fresh_ctx_w(lds_raw, wave0); const AP a = fresh_args();
                  const int m0 = C.bx < 128 ? C.gw : 2048 + C.gw, m1 = C.bx < 128 ? 3072 : MTOK;
                  for (int m = m0; m < m1; m += 1024) qk_prep_token(a, l, m, C.lane); }
                if (PON(13)) { const Ctx C = fresh_ctx_w(lds_raw, wave0); const AP a = fresh_args();
                  const int i1 = C.bx < 128 ? 1024 : 4096;
                  for (int it = C.gw; it < i1; it += 1024) s5_ends_item(a, l, it, C.lane, (LAS float*)(C.lds + C.wave * 4096)); }
                if (bxo >= 128) { __syncthreads(); const Ctx C = fresh_ctx_w(lds_raw, wave0); const AP a = fresh_args();
                  for (int ti = C.bx; ti < MTOK / 32; ti += C.G) rwkv_prep_item(C, a, l, ti); }
            } break;
            case 2: if (PON(2)) {
                if (PON(17)) { const Ctx C = fresh_ctx_w(lds_raw, wave0); const AP a = fresh_args();
                  volatile LAS int* qs = (volatile LAS int*)(C.lds + LDS_BYTES - 128);
                  unsigned* q0 = (unsigned*)(a.ws + WS_CTL) + 64 + l * 64; unsigned* q1 = q0 + 2;
                  const int order = (C.bx >> 3) & 1; int stage = 0;
#pragma unroll 1
                  for (;;) {
                    __syncthreads();
                    if (C.tid == 0) {
                        int nb = -1;
                        while (stage < 2) {
                            const int q = stage ^ order;
                            const int t = (int)__hip_atomic_fetch_add(q ? q1 : q0, 8u, __ATOMIC_RELAXED, __HIP_MEMORY_SCOPE_AGENT);
                            const int b2 = q ? 4096 + t : t;
                            if (b2 < (q ? 14336 : 4096)) { nb = b2; break; }
                            ++stage;
                        }
                        *qs = nb;
                    }
                    __syncthreads();
                    const int base = *qs; if (base < 0) break;
                    const int it = base + C.wave;
                    if (it < 4096) s5_final_item_h(a, l, it, C.lane, C.lds + C.wave * 16384);
                    else if (it < 12288) rwkv_chunk_pre(a, it - 4096, C.lane, C.lds + C.wave * 16384);
                    else c1_fold_item(a, it - 12288, C.lane);
                  } }
            } break;
            case 3: if (PON(3)) {
                int bx0 = blockIdx.x; asm volatile("" : "+s"(bx0));
                if (bx0 < 64) { const Ctx C = fresh_ctx_w(lds_raw, wave0); const AP a = fresh_args(); rwkv_seq_chain(C, a, C.bx); }
                else if (bx0 < 192) {
                    if (PON(15)) { const Ctx C = fresh_ctx_w(lds_raw, wave0); const AP a = fresh_args(); unsigned char* ws = a.ws;
                      const int au = C.bx - 64;
                      { const int qblk = au & 7, hq = (au >> 3) & 3, b = au >> 5;
                        const bf16_t* Q = (const bf16_t*)(ws + WS_QB) + ((size_t)(b * SEQ + qblk * 256)) * 512 + hq * 128;
                        const bf16_t* Kp = (const bf16_t*)(ws + WS_QB) + (size_t)MTOK * 512 + ((size_t)b * SEQ) * 256 + (hq >> 1) * 128;
                        const bf16_t* Vp = Kp + (size_t)MTOK * 256;
                        float* O = (float*)(ws + WS_YA) + (size_t)2 * RWSZ + ((size_t)(b * SEQ + qblk * 256)) * 512 + hq * 128;
                        att::attn_dense_body<att::bf16>(Q, Kp, Vp, O, SEQ, (char*)C.lds, C.tid);
                      } }
                } else {
                    { const Ctx C = fresh_ctx_w(lds_raw, wave0); const AP a = fresh_args(); unsigned char* ws = a.ws;
                        pg8::Gemm g{(const bf16_t*)(ws + WS_YGELU), (const bf16_t*)(ws + WS_WGLUT) + (size_t)l * 512 * 512, 512};
                        pg8::Order S; S.init(32, 2, 1, 0, 0, 0, 64, C.bx - 192);
                        pg8::EpiGlu E{(const bf16_t*)(ws + WS_YGELU), (float*)(ws + WS_YA) + RWSZ};
                        pg8::gemm_phase(C.lds, g, S, E, C.tid);
                        __syncthreads(); }
                    if (PON(16)) { const Ctx C = fresh_ctx_w(lds_raw, wave0); const AP a = fresh_args(); unsigned char* ws = a.ws;
                      pg8::Gemm g{(const bf16_t*)(ws + WS_DFT), (const bf16_t*)(ws + WS_C1F), 2048};
                      pg8::Order S; S.init(8, 2, 4, 0, 2, 8, 64, C.bx - 192);
                      pg8::EpiF32 E{(float*)(ws + WS_YA), 512};
                      pg8::gemm_phase(C.lds, g, S, E, C.tid); }
                }
            } break;
            case 4: if (PON(4)) {
                const Ctx C = fresh_ctx_w(lds_raw, wave0); const AP a = fresh_args();
                for (int m = C.gw; m < MTOK; m += C.ngw) {
                    branch_norm_item(a, m * 4 + 0, C.lane); branch_norm_item(a, m * 4 + 1, C.lane); branch_norm_item(a, m * 4 + 2, C.lane); branch_d_item(a, l, m, C.lane); }
            } break;
            case 5: if (PON(5)) {
                const Ctx C = fresh_ctx_w(lds_raw, wave0); const AP a = fresh_args(); unsigned char* ws = a.ws;
                const float* xin = l == 0 ? a.in[0] : (const float*)(ws + WS_X2);
                pg8::Gemm g{(const bf16_t*)(ws + WS_HB), (const bf16_t*)(ws + WS_WOUTT) + (size_t)l * DM * DM, DM};
                pg8::Order S; S.init(32, 8, 1, 0, 0, 0, C.G, C.bx);
                pg8::EpiResid E{xin, (float*)(ws + WS_X1), DM};
                pg8::gemm_phase(C.lds, g, S, E, C.tid);
            } break;
            case 6: if (PON(6)) {
                const Ctx C = fresh_ctx_w(lds_raw, wave0); const AP a = fresh_args(); unsigned char* ws = a.ws;
                for (int m = C.gw; m < MTOK; m += C.ngw) rms_row_to_bf16((const float*)(ws + WS_X1) + (size_t)m * DM, (bf16_t*)(ws + WS_HB) + (size_t)m * DM, C.lane);
            } break;
            case 7: if (PON(7)) {
                int bx0 = blockIdx.x; asm volatile("" : "+s"(bx0));
                if (bx0 < 128) {
                    const Ctx C = fresh_ctx_w(lds_raw, wave0); const AP a = fresh_args(); unsigned char* ws = a.ws;
                    pg8::Gemm g{(const bf16_t*)(ws + WS_HB), (const bf16_t*)(ws + WS_WQT) + (size_t)l * 1024 * DM, DM};
                    pg8::Order S; S.init(32, 4, 1, 0, 0, 0, 128, C.bx);
                    pg8::EpiF32 E{(float*)(ws + WS_PROJ), 1024};
                    pg8::gemm_phase(C.lds, g, S, E, C.tid);
                } else {
                    const Ctx C = fresh_ctx_w(lds_raw, wave0); const AP a = fresh_args();
#pragma unroll 1
                    for (int it = (C.bx - 128) * 8 + C.wave; it < 16384; it += 1024) { const int r2 = it * 2; expert_row_item2(a, r2 >> 14, l, r2 & 16383, C.lane); }
                }
            } break;
            case 8: if (PON(8)) {
                const Ctx C = fresh_ctx_w(lds_raw, wave0); const AP a = fresh_args(); unsigned char* ws = a.ws;
                float* xo = l == 0 ? (float*)(ws + WS_X2) : a.out;
                for (int tile = C.bx; tile < MTOK / 32; tile += C.G) peer_tile(C, a, l, tile, (const float*)(ws + WS_X1), xo, l == 0);
            } break;
            default: break;
            }
    }
}
__global__ void __launch_bounds__(NTHR, 2) fwd_kernel(Args a0) {
    extern __shared__ __attribute__((aligned(16))) unsigned char lds_raw[];
    cg::grid_group grid = cg::this_grid();
    const int wave0 = __builtin_amdgcn_readfirstlane((int)threadIdx.x >> 6);
    volatile LAS unsigned* bst = (volatile LAS unsigned*)((LAS unsigned char*)lds_raw + LDS_BYTES - 64);
    if (threadIdx.x < 2) bst[threadIdx.x] = 0u;
    __syncthreads();
    const XcdBarrier xbar = xcd_barrier_post((unsigned*)(a0.ws + WS_CTL) + 4096, bst);
    const int lo = a0.ph_lo, hi = a0.ph_hi;
    if (lo < 0) grid.sync();
#define MK_STEP(PH) if (lo <= (PH) && (PH) < hi) { run_phase<PH>(lds_raw, wave0); \
        if ((((unsigned)PROBE_REP_MASK >> (PH)) & 1u) != 0u) { xcd_barrier(xbar); run_phase<PH>(lds_raw, wave0); } \
        if ((PH) + 1 < hi) xcd_barrier(xbar); }
    MK_STEP(0) MK_STEP(1) MK_STEP(2) MK_STEP(3) MK_STEP(4) MK_STEP(5) MK_STEP(6) MK_STEP(7) MK_STEP(8) MK_STEP(9)
    MK_STEP(10) MK_STEP(11) MK_STEP(12) MK_STEP(13) MK_STEP(14) MK_STEP(15) MK_STEP(16) MK_STEP(17) MK_STEP(18)
#undef MK_STEP
}

extern "C" void kernel_launch(void* const* d_in, const int* in_sizes, int n_in, void* d_out, int out_size, void* d_ws, size_t ws_size, hipStream_t stream) {
    static int grid = 0;
    if (grid == 0) {
        if (n_in != 36 || in_sizes[0] != MTOK * DM || out_size != MTOK * DM || ws_size < WS_END) {
            fprintf(stderr, "kernel_launch: shape mismatch: n_in %d in0 %d out %d ws %zu (need %zu)\n", n_in, n_in > 0 ? in_sizes[0] : -1, out_size, ws_size, (size_t)WS_END); grid = -1; return; }
        int dev = 0, cus = 0, per_cu = 0;
        if (hipGetDevice(&dev) != hipSuccess || hipDeviceGetAttribute(&cus, hipDeviceAttributeMultiprocessorCount, dev) != hipSuccess) { fprintf(stderr, "kernel_launch: device query failed\n"); grid = -1; return; }
        if (hipFuncSetAttribute((const void*)fwd_kernel, hipFuncAttributeMaxDynamicSharedMemorySize, LDS_BYTES) != hipSuccess) { fprintf(stderr, "kernel_launch: hipFuncSetAttribute failed\n"); grid = -1; return; }
        if (hipOccupancyMaxActiveBlocksPerMultiprocessor(&per_cu, (const void*)fwd_kernel, NTHR, LDS_BYTES) != hipSuccess || per_cu < 1) { fprintf(stderr, "kernel_launch: occupancy query gives %d\n", per_cu); grid = -1; return; }
        grid = cus * per_cu; if (grid > 256) grid = 256;
        if (grid < 128) { fprintf(stderr, "kernel_launch: grid %d too small\n", grid); grid = -1; return; }
    }
    if (grid < 0) return;
    if (hipMemsetAsync((char*)d_ws + WS_CTL, 0, 65536, stream) != hipSuccess) { fprintf(stderr, "kernel_launch: memset failed\n"); return; }
    Args a{};
    for (int i = 0; i < 36; ++i) a.in[i] = (const float*)d_in[i];
    a.out = (float*)d_out; a.ws = (unsigned char*)d_ws;
#if MK_ONE_LAUNCH
    a.ph_lo = 0; a.ph_hi = N_PHASES;
    void* args[] = {&a};
    hipError_t e = hipLaunchCooperativeKernel((const void*)fwd_kernel, dim3(grid), dim3(NTHR), args, LDS_BYTES, stream);
    if (e != hipSuccess) fprintf(stderr, "kernel_launch: cooperative launch failed: %s (grid %d)\n", hipGetErrorString(e), grid);
#else
    for (int ph = 0; ph < N_PHASES; ++ph) {
        a.ph_lo = ph; a.ph_hi = ph + 1;
        hipLaunchKernelGGL(fwd_kernel, dim3(grid), dim3(NTHR), LDS_BYTES, stream, a);
    }
    hipError_t e = hipPeekAtLastError();
    if (e != hipSuccess) fprintf(stderr, "kernel_launch: launch failed: %s\n", hipGetErrorString(e));
#endif
}
```

```cpp
#include <hip/hip_runtime.h>
#include <hip/hip_cooperative_groups.h>
#include <cstdio>
#include <cstdint>
#include <cstddef>
namespace cg = cooperative_groups;

#ifndef MK_ONE_LAUNCH
#define MK_ONE_LAUNCH 1
#endif
#ifndef PHM
#define PHM 0x3ffff
#endif
#define PON(i) (((PHM) >> (i)) & 1)
#ifndef PROBE_REP_MASK
#define PROBE_REP_MASK 0u
#endif

namespace pg8 {
#define PG8_LAS __attribute__((address_space(3)))
typedef unsigned short bf16_t;
typedef short bf16x8 __attribute__((ext_vector_type(8)));
typedef float f32x4 __attribute__((ext_vector_type(4)));
typedef unsigned u32x4 __attribute__((ext_vector_type(4)));
typedef unsigned u32x2 __attribute__((ext_vector_type(2)));
constexpr int BM = 256, BK = 64, HALF = 128, HTB = HALF * BK * 2, STAGE_BYTES = 8 * HTB, NXCD = 8, WGM = 8;

__host__ __device__ __forceinline__ int lds_byte(int r, int c) { const int st = (r >> 4) * 2 + (c >> 5), rr = r & 15, cc = c & 31, ob = rr * 64 + cc * 2; return st * 1024 + (ob ^ (((ob >> 9) & 1) << 5)); }
__host__ __device__ __forceinline__ void stage_rc(int b, int& R, int& C) { const int st = b / 1024, sb = b % 1024, swz = sb ^ (((sb >> 9) & 1) << 5); R = (st >> 1) * 16 + swz / 64; C = (st & 1) * 32 + (swz % 64) / 2; }

struct Unit { int pm, pn, pa, pb; };
struct Gemm { const bf16_t* A; const bf16_t* Bt; int K; };

struct Order {
    int nM, nN, nb, nwg, G, c, aM, bN, oM;
    __device__ __forceinline__ void init(int nM_, int nN_, int nb_, int aM_, int bN_, int oM_, int G_, int c_) { nM = nM_; nN = nN_; nb = nb_; aM = aM_; bN = bN_; oM = oM_; nwg = nM * nN * nb; G = G_; c = c_; }
    __device__ __forceinline__ bool next(int i, Unit& u) const {
        const int L = i * G + c; if (L >= nwg || c < 0) return false;
        const int per = nM * nN, b = L / per; int wgid = L - b * per;
        { const int q = per / NXCD, r = per % NXCD, xcd = wgid % NXCD, off = wgid / NXCD; wgid = (xcd < r ? xcd * (q + 1) : r * (q + 1) + (xcd - r) * q) + off; }
        const int nig = WGM * nN, gid = wgid / nig, fm = gid * WGM, gsz = (nM - fm) < WGM ? (nM - fm) : WGM;
        const int pm = fm + ((wgid % nig) % gsz), pn = (wgid % nig) / gsz;
        u.pm = pm + b * oM; u.pn = pn; u.pa = pm + b * aM; u.pb = pn + b * bN; return true;
    }
};

__device__ __forceinline__ unsigned cvt_pk_bf16(float lo, float hi) { unsigned r; asm volatile("v_cvt_pk_bf16_f32 %0, %1, %2" : "=v"(r) : "v"(lo), "v"(hi)); return r; }

#define PG8_EPI_LOOP(...) \
    _Pragma("unroll") for (int ai = 0; ai < 2; ++ai) _Pragma("unroll") for (int m = 0; m < 4; ++m) { const int row = u.pm * BM + ai * HALF + wr * 64 + m * 16 + fr; \
        _Pragma("unroll") for (int bj = 0; bj < 2; ++bj) _Pragma("unroll") for (int n = 0; n < 2; ++n) { const int col = u.pn * BM + bj * HALF + wc * 32 + n * 16 + 4 * fq; const f32x4 v = acc[ai][bj][m][n]; __VA_ARGS__ } }

struct EpiF32 {
    float* out; int ldc;
    __device__ __forceinline__ void operator()(const f32x4 (&acc)[2][2][4][2], const Unit& u, int wr, int wc, int fr, int fq) const {
        PG8_EPI_LOOP( *(f32x4*)(out + (size_t)row * ldc + col) = v; )
    }
};
struct EpiResid {
    const float* base; float* out; int ldc;
    __device__ __forceinline__ void operator()(const f32x4 (&acc)[2][2][4][2], const Unit& u, int wr, int wc, int fr, int fq) const {
        PG8_EPI_LOOP( const f32x4 b = *(const f32x4*)(base + (size_t)row * ldc + col); *(f32x4*)(out + (size_t)row * ldc + col) = b + v; )
    }
};
struct EpiInProj {
    bf16_t* pa; float* proj;
    __device__ __forceinline__ void operator()(const f32x4 (&acc)[2][2][4][2], const Unit& u, int wr, int wc, int fr, int fq) const {
        if (u.pn < 2) { PG8_EPI_LOOP( u32x2 w; w.x = cvt_pk_bf16(v[0], v[1]); w.y = cvt_pk_bf16(v[2], v[3]); *(u32x2*)(pa + (size_t)row * 512 + col) = w; ) }
        else { PG8_EPI_LOOP( *(f32x4*)(proj + (size_t)row * 4096 + col) = v; ) }
    }
};
struct EpiC1 {
    bf16_t* c1;
    __device__ __forceinline__ void operator()(const f32x4 (&acc)[2][2][4][2], const Unit& u, int wr, int wc, int fr, int fq) const {
        PG8_EPI_LOOP( const int b = col >> 11, s = col & 2047; u32x2 w; w.x = cvt_pk_bf16(v[0], v[1]); w.y = cvt_pk_bf16(v[2], v[3]);
                      *(u32x2*)(c1 + ((size_t)b * 1024 + row) * 2048 + s) = w; )
    }
};
struct EpiGlu {
    const bf16_t* y; float* out;
    __device__ __forceinline__ void operator()(const f32x4 (&acc)[2][2][4][2], const Unit& u, int wr, int wc, int fr, int fq) const {
        PG8_EPI_LOOP( const u32x2 yw = *(const u32x2*)(y + (size_t)row * 512 + col);
                      f32x4 yv; yv[0] = __uint_as_float(yw.x << 16); yv[1] = __uint_as_float(yw.x & 0xffff0000u); yv[2] = __uint_as_float(yw.y << 16); yv[3] = __uint_as_float(yw.y & 0xffff0000u);
                      f32x4 o; _Pragma("unroll") for (int e = 0; e < 4; ++e) o[e] = yv[e] / (1.f + __expf(-v[e]));
                      *(f32x4*)(out + (size_t)row * 512 + col) = o; )
    }
};

template <class Epi, class Sched>
__device__ __forceinline__ void gemm_phase(PG8_LAS unsigned char* lds, const Gemm g, const Sched& S, const Epi& E, const int tid) {
    const int wid = __builtin_amdgcn_readfirstlane(tid >> 6), lane = tid & 63, wr = wid >> 2, wc = wid & 3, fr = lane & 15, fq = lane >> 4;
    const int K = g.K, nt = K / BK;
    unsigned voffA[2];
#pragma unroll
    for (int i = 0; i < 2; ++i) { int R, C; stage_rc(tid * 16 + i * 8192, R, C); voffA[i] = (unsigned)(R * K + C) * 2u; }
    const size_t kstep = (size_t)(BK * 2);
    const size_t hstep = (size_t)HALF * K * 2;
    const size_t tstep = 2 * hstep;
    const unsigned ldsw = (unsigned)wid * 1024u;
    const int aoff = lds_byte(wr * 64 + fr, fq * 8), boff = lds_byte(wc * 32 + fr, fq * 8);
#define PG8_SA(b, h) (((b) * 2 + (h)) * HTB)
#define PG8_SB(b, h) ((4 + (b) * 2 + (h)) * HTB)
#define PG8_STAGE(bufoff, gbase, voff) do { _Pragma("unroll") for (int _i = 0; _i < 2; ++_i) \
        __builtin_amdgcn_global_load_lds((const unsigned*)((const char*)(gbase) + (voff)[_i]), (PG8_LAS unsigned*)(lds + (bufoff) + ldsw + _i * 8192), 16, 0, 0); } while (0)
#define PG8_LDA(dst, b, h) do { _Pragma("unroll") for (int m = 0; m < 4; ++m) _Pragma("unroll") for (int k = 0; k < 2; ++k) dst[m][k] = *(const PG8_LAS bf16x8*)(lds + PG8_SA(b, h) + aoff + m * 2048 + k * 1024); } while (0)
#define PG8_LDB(dst, b, h) do { _Pragma("unroll") for (int n = 0; n < 2; ++n) _Pragma("unroll") for (int k = 0; k < 2; ++k) dst[n][k] = *(const PG8_LAS bf16x8*)(lds + PG8_SB(b, h) + boff + n * 2048 + k * 1024); } while (0)
#define PG8_MMA(ai, bj, At, Bt) do { __builtin_amdgcn_s_setprio(1); _Pragma("unroll") for (int m = 0; m < 4; ++m) _Pragma("unroll") for (int n = 0; n < 2; ++n) _Pragma("unroll") for (int k = 0; k < 2; ++k) \
        acc[ai][bj][m][n] = __builtin_amdgcn_mfma_f32_16x16x32_bf16(Bt[n][k], At[m][k], acc[ai][bj][m][n], 0, 0, 0); __builtin_amdgcn_s_setprio(0); } while (0)
#define PG8_WAIT_V(n) asm volatile("s_waitcnt vmcnt(" #n ")" ::: "memory")
#define PG8_WAIT_L(n) asm volatile("s_waitcnt lgkmcnt(" #n ")" ::: "memory")
#define PG8_BAR __builtin_amdgcn_s_barrier()
#define PG8_SCHED __builtin_amdgcn_sched_barrier(0)
    Unit cur, nxt; int ui = 0;
    if (!S.next(0, cur)) return;
    f32x4 acc[2][2][4][2];
#pragma unroll
    for (int a = 0; a < 2; ++a)
#pragma unroll
        for (int b = 0; b < 2; ++b)
#pragma unroll
            for (int m = 0; m < 4; ++m)
#pragma unroll
                for (int n = 0; n < 2; ++n) acc[a][b][m][n] = (f32x4){0.f, 0.f, 0.f, 0.f};
    bf16x8 At[4][2], B0[2][2], B1[2][2];
    const char* cA = (const char*)g.A + (size_t)cur.pa * tstep; const char* cB = (const char*)g.Bt + (size_t)cur.pb * tstep;
    PG8_STAGE(PG8_SB(0, 0), cB, voffA); PG8_STAGE(PG8_SB(0, 1), cB + hstep, voffA); PG8_STAGE(PG8_SA(0, 0), cA, voffA); PG8_STAGE(PG8_SA(0, 1), cA + hstep, voffA);
    if (wr == 1) PG8_BAR;
    PG8_WAIT_V(2); PG8_BAR;
    PG8_STAGE(PG8_SB(1, 0), cB + kstep, voffA); PG8_STAGE(PG8_SA(1, 0), cA + kstep, voffA); PG8_STAGE(PG8_SB(1, 1), cB + hstep + kstep, voffA);
    PG8_WAIT_V(6); PG8_BAR;
    for (;;) {
        const bool has_next = S.next(ui + 1, nxt);
        const char* nA = has_next ? (const char*)g.A + (size_t)nxt.pa * tstep : cA; const char* nB = has_next ? (const char*)g.Bt + (size_t)nxt.pb * tstep : cB;
        for (int t = 0; t < nt; t += 2) {
            const bool last = (t == nt - 2);
            const char* a1 = cA + (size_t)(t + 1) * kstep;
            const char* a2 = last ? nA : cA + (size_t)(t + 2) * kstep; const char* b2 = last ? nB : cB + (size_t)(t + 2) * kstep;
            const char* a3 = a2 + kstep; const char* b3 = b2 + kstep;
            PG8_LDB(B0, 0, 0); PG8_LDB(B1, 0, 1); PG8_SCHED; PG8_LDA(At, 0, 0); PG8_STAGE(PG8_SA(1, 1), a1 + hstep, voffA);
            PG8_WAIT_V(8); PG8_WAIT_L(0); PG8_BAR; PG8_MMA(0, 0, At, B0); PG8_MMA(0, 1, At, B1); PG8_BAR; PG8_SCHED;
            PG8_LDA(At, 0, 1); PG8_STAGE(PG8_SB(0, 0), b2, voffA); PG8_STAGE(PG8_SB(0, 1), b2 + hstep, voffA); PG8_STAGE(PG8_SA(0, 0), a2, voffA);
            PG8_WAIT_V(8); PG8_WAIT_L(0); PG8_BAR; PG8_MMA(1, 0, At, B0); PG8_MMA(1, 1, At, B1); PG8_BAR; PG8_SCHED;
            PG8_LDB(B0, 1, 0); PG8_LDB(B1, 1, 1); PG8_SCHED; PG8_LDA(At, 1, 0); PG8_STAGE(PG8_SA(0, 1), a2 + hstep, voffA);
            PG8_WAIT_V(8); PG8_WAIT_L(0); PG8_BAR; PG8_MMA(0, 0, At, B0); PG8_MMA(0, 1, At, B1); PG8_BAR; PG8_SCHED;
            PG8_LDA(At, 1, 1); PG8_STAGE(PG8_SB(1, 0), b3, voffA); PG8_STAGE(PG8_SB(1, 1), b3 + hstep, voffA); PG8_STAGE(PG8_SA(1, 0), a3, voffA);
            PG8_WAIT_V(8); PG8_WAIT_L(0); PG8_BAR; PG8_MMA(1, 0, At, B0); PG8_MMA(1, 1, At, B1); PG8_BAR; PG8_SCHED;
        }
        if (wr == 0) PG8_BAR;
        E(acc, cur, wr, wc, fr, fq);
        if (!has_next) break;
#pragma unroll
        for (int a = 0; a < 2; ++a)
#pragma unroll
            for (int b = 0; b < 2; ++b)
#pragma unroll
                for (int m = 0; m < 4; ++m)
#pragma unroll
                    for (int n = 0; n < 2; ++n) acc[a][b][m][n] = (f32x4){0.f, 0.f, 0.f, 0.f};
        cur = nxt; cA = nA; cB = nB; ++ui;
        if (wr == 1) PG8_BAR;
    }
    PG8_WAIT_V(0);
    PG8_BAR;
#undef PG8_SA
#undef PG8_SB
#undef PG8_STAGE
#undef PG8_LDA
#undef PG8_LDB
#undef PG8_MMA
#undef PG8_WAIT_V
#undef PG8_WAIT_L
#undef PG8_BAR
#undef PG8_SCHED
}
}

namespace att {
using bf16 = unsigned short;
constexpr int   D = 128, NW = 8, QBLK = 32, KVBLK = 64;
constexpr float SCALE = 0.088388347648318440f;
constexpr float THR = 8.f;
constexpr int SDEPTH = 1;
constexpr int LDQ = 512, LDK = 256, LDO = 512;
constexpr size_t SHM_V = KVBLK * D * 2, SHM_K = KVBLK * D * 2, SHM_ATTN = 2 * SHM_V + 2 * SHM_K + NW * 64 * 4;

using bf16x8 = __attribute__((ext_vector_type(8))) short;
using s16x4  = __attribute__((ext_vector_type(4))) short;
using f32x16 = __attribute__((ext_vector_type(16))) float;
using f32x8  = __attribute__((ext_vector_type(8))) float;
using u32x4  = __attribute__((ext_vector_type(4))) unsigned;
#define KSWZ(row, colB) ((row) * 256 + ((colB) ^ (((row) & 7) << 4)))
#define SBAR() __builtin_amdgcn_sched_barrier(0)
__device__ __forceinline__ int crow(int r, int hi) { return (r & 3) + 8 * (r >> 2) + 4 * hi; }
__device__ __forceinline__ unsigned cvtpk(float lo, float hi) {
  unsigned r; asm volatile("v_cvt_pk_bf16_f32 %0, %1, %2" : "=v"(r) : "v"(lo), "v"(hi)); return r;
}
template <typename TIn> struct Stage;
template <> struct Stage<bf16>  { using T = bf16x8;
  __device__ static __forceinline__ T ld8(const bf16* p) { return *reinterpret_cast<const bf16x8*>(p); }
  __device__ static __forceinline__ bf16x8 tobf(T x) { return x; } };

__device__ __forceinline__ void partialSM(f32x16& p0, f32x16& p1, float& m_reg, float& mn, float& alpha) {
  constexpr float C = SCALE * 1.4426950408889634f;
  float pmax = p0[0]; for (int r = 1; r < 16; ++r) pmax = fmaxf(pmax, p0[r]); for (int r = 0; r < 16; ++r) pmax = fmaxf(pmax, p1[r]);
  { auto rr = __builtin_amdgcn_permlane32_swap(__float_as_uint(pmax), __float_as_uint(pmax), false, false);
    pmax = fmaxf(__uint_as_float(rr[0]), __uint_as_float(rr[1])); }
  if (__builtin_expect(__all(pmax - m_reg <= THR / SCALE), 1)) { mn = m_reg; alpha = 1.f; }
  else { mn = fmaxf(m_reg, pmax); alpha = __builtin_amdgcn_exp2f((m_reg - mn) * C); m_reg = mn; }
  float mnC = -mn * C;
  for (int r = 0; r < 16; ++r) p0[r] = fmaf(p0[r], C, mnC); for (int r = 0; r < 16; ++r) p1[r] = fmaf(p1[r], C, mnC);
  for (int r = 0; r < 16; ++r) p0[r] = __builtin_amdgcn_exp2f(p0[r]);
}
__device__ __forceinline__ void finishSM(f32x16& p0, f32x16& p1, float alpha, float& l_reg, bf16x8& pa0, bf16x8& pa1, bf16x8& pa2, bf16x8& pa3) {
  for (int r = 0; r < 16; ++r) p1[r] = __builtin_amdgcn_exp2f(p1[r]);
  float ps = 0; for (int r = 0; r < 16; ++r) ps += p0[r]; for (int r = 0; r < 16; ++r) ps += p1[r];
  { auto rr = __builtin_amdgcn_permlane32_swap(__float_as_uint(ps), __float_as_uint(ps), false, false);
    ps = __uint_as_float(rr[0]) + __uint_as_float(rr[1]); }
  l_reg = l_reg * alpha + ps;
#define PK4(P, BASE, OUT) do { unsigned a0 = cvtpk(P[BASE + 0], P[BASE + 1]), a1 = cvtpk(P[BASE + 2], P[BASE + 3]);   \
    unsigned b0 = cvtpk(P[BASE + 4], P[BASE + 5]), b1 = cvtpk(P[BASE + 6], P[BASE + 7]);                              \
    auto r0 = __builtin_amdgcn_permlane32_swap(a0, b0, false, false); auto r1 = __builtin_amdgcn_permlane32_swap(a1, b1, false, false); \
    u32x4 w = {r0[0], r1[0], r0[1], r1[1]}; OUT = *reinterpret_cast<bf16x8*>(&w); } while (0)
  PK4(p0, 0, pa0); PK4(p0, 8, pa1); PK4(p1, 0, pa2); PK4(p1, 8, pa3);
#undef PK4
}
__device__ __forceinline__ void qkt(f32x16& p0, f32x16& p1, const bf16* Ks, const bf16x8* qr, int r32, int hi) {
  p0 = f32x16{}; p1 = f32x16{};
  for (int d0 = 0; d0 < 8; ++d0) { int cb = (d0 * 16 + hi * 8) * 2;
    bf16x8 b0 = *reinterpret_cast<const bf16x8*>((const char*)Ks + KSWZ(r32, cb));
    bf16x8 b1 = *reinterpret_cast<const bf16x8*>((const char*)Ks + KSWZ(32 + r32, cb));
    p0 = __builtin_amdgcn_mfma_f32_32x32x16_bf16(b0, qr[d0], p0, 0, 0, 0);
    p1 = __builtin_amdgcn_mfma_f32_32x32x16_bf16(b1, qr[d0], p1, 0, 0, 0); }
}
__device__ __forceinline__ int v_st(int k, int c) { const int kk = (k & ~0xC) | ((k & 4) << 1) | ((k & 8) >> 1); return ((kk >> 3) * 4 + (c >> 5)) * 512 + ((kk & 7) * 32 + (c & 31)) * 2; }
__device__ __forceinline__ int v_rd_base(int lane) { return ((lane & 3) << 3) | (((lane >> 2) & 3) << 6) | (((lane >> 4) & 1) << 5) | (((lane >> 5) & 1) << 8); }
constexpr int v_rd_off(int d0, int ks, int half) { return d0 * 512 + ks * 4096 + half * 2048; }
template <int OFF> __device__ __forceinline__ s16x4 tr_read(int vb) {
  s16x4 r; asm volatile("ds_read_b64_tr_b16 %0, %1 offset:%2" : "=&v"(r) : "v"(vb), "i"(OFF) : "memory"); return r;
}
template <int D0> __device__ __forceinline__ void pv_one(f32x16& od, int vb, bf16x8 pa0, bf16x8 pa1, bf16x8 pa2, bf16x8 pa3) {
  const s16x4 l0 = tr_read<v_rd_off(D0, 0, 0)>(vb), h0 = tr_read<v_rd_off(D0, 0, 1)>(vb), l1 = tr_read<v_rd_off(D0, 1, 0)>(vb), h1 = tr_read<v_rd_off(D0, 1, 1)>(vb);
  const s16x4 l2 = tr_read<v_rd_off(D0, 2, 0)>(vb), h2 = tr_read<v_rd_off(D0, 2, 1)>(vb), l3 = tr_read<v_rd_off(D0, 3, 0)>(vb), h3 = tr_read<v_rd_off(D0, 3, 1)>(vb);
  asm volatile("s_waitcnt lgkmcnt(0)" ::: "memory"); SBAR();
#define PK(L, H) (bf16x8){L[0], L[1], L[2], L[3], H[0], H[1], H[2], H[3]}
  od = __builtin_amdgcn_mfma_f32_32x32x16_bf16(pa0, PK(l0, h0), od, 0, 0, 0);
  od = __builtin_amdgcn_mfma_f32_32x32x16_bf16(pa1, PK(l1, h1), od, 0, 0, 0);
  od = __builtin_amdgcn_mfma_f32_32x32x16_bf16(pa2, PK(l2, h2), od, 0, 0, 0);
  od = __builtin_amdgcn_mfma_f32_32x32x16_bf16(pa3, PK(l3, h3), od, 0, 0, 0);
#undef PK
}
__device__ __forceinline__ void pv_d0(f32x16* o, int vb, bf16x8 pa0, bf16x8 pa1, bf16x8 pa2, bf16x8 pa3) {
  pv_one<0>(o[0], vb, pa0, pa1, pa2, pa3); pv_one<1>(o[1], vb, pa0, pa1, pa2, pa3); pv_one<2>(o[2], vb, pa0, pa1, pa2, pa3); pv_one<3>(o[3], vb, pa0, pa1, pa2, pa3);
}
template <typename TQ>
__device__ __forceinline__ void attn_dense_body(const TQ* __restrict__ Qb, const bf16* __restrict__ Kh, const bf16* __restrict__ Vh,
                                                float* __restrict__ Ob, int seq, char* lds, const int tid_) {
  using St = Stage<bf16>; using SQ = Stage<TQ>;
  int tid = tid_; asm volatile("" : "+v"(tid));
  const int wid = tid >> 6, lane = tid & 63, r32 = lane & 31, hi = lane >> 5;
  bf16* V_lds = (bf16*)lds; bf16* K_lds = (bf16*)(lds + 2 * SHM_V);
  float* ws = (float*)(lds + 2 * SHM_V + 2 * SHM_K) + wid * 64; float* li_l = ws; float* al_l = ws + 32;
  float m_reg = -1e30f, l_reg = 0; f32x16 o[4] = {}; bf16x8 qr[8];
  const TQ* Qw = Qb + (long)(wid * QBLK + r32) * LDQ + hi * 8;
#pragma unroll
  for (int d0 = 0; d0 < 8; ++d0) qr[d0] = SQ::tobf(SQ::ld8(Qw + d0 * 16));
  const int sr = tid >> 4, sc = (tid & 15) * 8, vst0 = v_st(sr, sc), vst1 = v_st(32 + sr, sc);
  const int vb0 = (int)(uintptr_t)V_lds + v_rd_base(lane);
  struct { typename St::T vs0, vs1, ks0, ks1; } sr_[SDEPTH];
  const unsigned loff = (unsigned)(sr * LDK + sc);
#define SLOAD(i, k0) do { const bf16* Vt_ = Vh + (size_t)(k0) * LDK; const bf16* Kt_ = Kh + (size_t)(k0) * LDK; \
    sr_[i].vs0 = St::ld8(Vt_ + loff); sr_[i].vs1 = St::ld8(Vt_ + 32 * LDK + loff); \
    sr_[i].ks0 = St::ld8(Kt_ + loff); sr_[i].ks1 = St::ld8(Kt_ + 32 * LDK + loff); } while (0)
#define SWRITE(b, i) do { *(bf16x8*)((char*)V_lds + (b) * SHM_V + vst0) = St::tobf(sr_[i].vs0);          \
    *(bf16x8*)((char*)V_lds + (b) * SHM_V + vst1) = St::tobf(sr_[i].vs1); int kc = sc * 2;               \
    *(bf16x8*)((char*)K_lds + (b) * SHM_K + KSWZ(sr, kc)) = St::tobf(sr_[i].ks0);                       \
    *(bf16x8*)((char*)K_lds + (b) * SHM_K + KSWZ(32 + sr, kc)) = St::tobf(sr_[i].ks1); } while (0)
#define SWAIT() do { if constexpr (SDEPTH == 2) asm volatile("s_waitcnt vmcnt(4)" ::: "memory"); else asm volatile("s_waitcnt vmcnt(0)" ::: "memory"); } while (0)
#define RESC(a) do { if (__any((a) < 1.f)) { if (hi == 0) al_l[r32] = (a); asm volatile("s_waitcnt lgkmcnt(0)" ::: "memory"); \
    for (int d = 0; d < 4; ++d) for (int r = 0; r < 16; ++r) o[d][r] *= al_l[crow(r, hi)]; } } while (0)
  f32x16 pA0, pA1, pB0, pB1; float mnA, mnB, alA, alB; bf16x8 pa0, pa1, pa2, pa3; const int NT = seq / KVBLK;
  constexpr int SE = 0, SO = SDEPTH - 1;
  SLOAD(SE, 0); asm volatile("s_waitcnt vmcnt(0)" ::: "memory"); SWRITE(0, SE); __syncthreads();
  qkt(pA0, pA1, K_lds, qr, r32, hi); partialSM(pA0, pA1, m_reg, mnA, alA);
  SLOAD(SO, KVBLK); if constexpr (SDEPTH == 2) { if (2 < NT) SLOAD(SE, 2 * KVBLK); }
  SWAIT(); SWRITE(1, SO); __syncthreads();
  for (int j = 1; j + 1 < NT; j += 2) {
    SBAR(); qkt(pB0, pB1, (bf16*)((char*)K_lds + SHM_K), qr, r32, hi);
    finishSM(pA0, pA1, alA, l_reg, pa0, pa1, pa2, pa3); SBAR();
    SLOAD(SO, (j + SDEPTH) * KVBLK); SBAR();
    pv_d0(o, vb0, pa0, pa1, pa2, pa3); partialSM(pB0, pB1, m_reg, mnB, alB);
    __syncthreads(); SWAIT(); SWRITE(0, SE);
    RESC(alB); __syncthreads();
    SBAR(); qkt(pA0, pA1, K_lds, qr, r32, hi);
    finishSM(pB0, pB1, alB, l_reg, pa0, pa1, pa2, pa3); SBAR();
    if (SDEPTH == 1 || j + 3 < NT) SLOAD(SE, (j + 1 + SDEPTH) * KVBLK); SBAR();
    pv_d0(o, vb0 + (int)SHM_V, pa0, pa1, pa2, pa3); partialSM(pA0, pA1, m_reg, mnA, alA);
    __syncthreads(); SWAIT(); SWRITE(1, SO);
    RESC(alA); __syncthreads();
  }
  SBAR(); qkt(pB0, pB1, (bf16*)((char*)K_lds + SHM_K), qr, r32, hi);
  finishSM(pA0, pA1, alA, l_reg, pa0, pa1, pa2, pa3); SBAR();
  pv_d0(o, vb0, pa0, pa1, pa2, pa3); partialSM(pB0, pB1, m_reg, mnB, alB);
  __syncthreads(); RESC(alB);
  finishSM(pB0, pB1, alB, l_reg, pa0, pa1, pa2, pa3); SBAR();
  pv_d0(o, vb0 + (int)SHM_V, pa0, pa1, pa2, pa3);
  if (hi == 0) li_l[r32] = l_reg; asm volatile("s_waitcnt lgkmcnt(0)" ::: "memory");
  float rli[16];
#pragma unroll
  for (int r = 0; r < 16; ++r) rli[r] = __builtin_amdgcn_rcpf(li_l[crow(r, hi)]);
  int le = lane; asm volatile("" : "+v"(le));
  float* Ow = Ob + (size_t)(wid * QBLK) * LDO; const unsigned eo = (unsigned)((le >> 5) * 4 * LDO + (le & 31));
#pragma unroll
  for (int r = 0; r < 16; ++r) { const unsigned ro = eo + (unsigned)(((r & 3) + 8 * (r >> 2)) * LDO);
#pragma unroll
    for (int d0 = 0; d0 < 4; ++d0) Ow[ro + d0 * 32] = o[d0][r] * rli[r]; }
#undef SLOAD
#undef SWRITE
#undef SWAIT
#undef RESC
}
}
#define LAS __attribute__((address_space(3)))
typedef unsigned short bf16_t;
typedef float f32x4 __attribute__((ext_vector_type(4)));
typedef float f32x2 __attribute__((ext_vector_type(2)));
typedef unsigned u32x4 __attribute__((ext_vector_type(4)));
typedef unsigned u32x2 __attribute__((ext_vector_type(2)));

typedef short bf16x8_t __attribute__((ext_vector_type(8)));
__device__ __forceinline__ bf16x8_t mk8(unsigned d0, unsigned d1, unsigned d2, unsigned d3) { const u32x4 w = {d0, d1, d2, d3}; return __builtin_bit_cast(bf16x8_t, w); }
constexpr int NTHR = 512, NWAVES = 8;
constexpr int MTOK = 8192, DM = 2048, SEQ = 2048, NBATCH = 4, PROJ = 4096, GW = 512;
constexpr int LDS_BYTES = 147456;

constexpr size_t MiB = 1u << 20;
constexpr size_t WS_CTL = 0;
constexpr size_t WS_WINT = 1 * MiB;
constexpr size_t WS_WOUTT = WS_WINT + 32 * MiB;
constexpr size_t WS_WQT = WS_WOUTT + 16 * MiB;
constexpr size_t WS_WGLUT = WS_WQT + 8 * MiB;
constexpr size_t WS_WCST = WS_WGLUT + 1 * MiB;
constexpr size_t WS_DFT = WS_WCST + 2 * MiB;
constexpr size_t WS_C1F = WS_DFT + 8 * MiB;
constexpr size_t WS_UB = WS_DFT + 16 * MiB;
constexpr size_t WS_VB = WS_UB + 128 * MiB;
constexpr size_t WS_KEYST = WS_VB + 128 * MiB;
constexpr size_t WS_ROPE = WS_KEYST + 1 * MiB;
constexpr size_t WS_HB = WS_ROPE + 1 * MiB;
constexpr size_t WS_PROJ = WS_HB + 32 * MiB;
constexpr size_t WS_PA = WS_PROJ + 128 * MiB;
constexpr size_t WS_C1 = WS_PA + 8 * MiB;
constexpr size_t WS_YA = WS_C1 + 16 * MiB;
constexpr size_t WS_QB = WS_YA + 64 * MiB;
constexpr size_t WS_S5E = WS_QB + 16 * MiB;
constexpr size_t WS_YGELU = WS_S5E + 4 * MiB;
constexpr size_t WS_RW = WS_YGELU + 8 * MiB;
constexpr size_t WS_YRW = WS_RW + 176 * MiB;
constexpr size_t WS_X1 = WS_YRW + 32 * MiB;
constexpr size_t WS_X2 = WS_X1 + 64 * MiB;
constexpr size_t WS_KS = WS_X2 + 64 * MiB;
constexpr size_t WS_S5T = WS_VB + 122 * MiB;
constexpr size_t WS_END = WS_KS + 16 * MiB;
static_assert(WS_END <= 1024 * MiB, "workspace map must fit 1 GiB");
constexpr size_t WS_LORA = WS_VB + 1 * MiB;
constexpr size_t WS_RWC = WS_VB + 2 * MiB;
constexpr int RWC_REC = 15360;
constexpr size_t RWSZ = (size_t)MTOK * GW;
enum { RW_R = 0, RW_V, RW_KK, RW_W0, RW_W1, RW_KD0, RW_KD1, RW_B0, RW_B1, RW_G, RW_BONUS };

struct Args { const float* in[36]; float* out; unsigned char* ws; int ph_lo, ph_hi; };

__device__ __forceinline__ unsigned f2bf(float f) { const unsigned u = __float_as_uint(f); return (u + 0x7fffu + ((u >> 16) & 1u)) >> 16; }
__device__ __forceinline__ unsigned pk2(float lo, float hi) { return f2bf(lo) | (f2bf(hi) << 16); }
__device__ __forceinline__ float bflo(unsigned w) { return __uint_as_float(w << 16); }
__device__ __forceinline__ float bfhi(unsigned w) { return __uint_as_float(w & 0xffff0000u); }
#define DPPF(x, ctrl) __builtin_bit_cast(float, __builtin_amdgcn_update_dpp(0, __builtin_bit_cast(int, (x)), (ctrl), 0xF, 0xF, true))
#define RDL(x, l) __builtin_bit_cast(float, __builtin_amdgcn_readlane(__builtin_bit_cast(int, (x)), (l)))
__device__ __forceinline__ float wave_sum(float v) {
    v += DPPF(v, 0xB1); v += DPPF(v, 0x4E); v += DPPF(v, 0x124); v += DPPF(v, 0x128);
    return (RDL(v, 0) + RDL(v, 16)) + (RDL(v, 32) + RDL(v, 48));
}
__device__ __forceinline__ float wave_max(float v) {
    v = fmaxf(v, DPPF(v, 0xB1)); v = fmaxf(v, DPPF(v, 0x4E)); v = fmaxf(v, DPPF(v, 0x124)); v = fmaxf(v, DPPF(v, 0x128));
    return fmaxf(fmaxf(RDL(v, 0), RDL(v, 16)), fmaxf(RDL(v, 32), RDL(v, 48)));
}
__device__ __forceinline__ float sigmoidf_(float x) { return 1.f / (1.f + __expf(-x)); }
__device__ __forceinline__ float gelu_tanh(float x) { const float u = 0.7978845608028654f * (x + 0.044715f * x * x * x); return 0.5f * x * (1.f + tanhf(u)); }
__device__ __forceinline__ float gelu_erf(float x) { return 0.5f * x * (1.f + erff(x * 0.7071067811865476f)); }
#define LDS_WAIT() asm volatile("s_waitcnt lgkmcnt(0)" ::: "memory")

struct Ctx {
    LAS unsigned char* lds; int tid, lane, wave, G, gw, ngw, bx;
};
__device__ __forceinline__ Ctx fresh_ctx_w(unsigned char* lds_raw, int wave0) {
    Ctx C; int ln = __builtin_amdgcn_mbcnt_hi(~0u, __builtin_amdgcn_mbcnt_lo(~0u, 0u)); asm volatile("" : "+v"(ln));
    int wv = wave0; asm volatile("" : "+s"(wv));
    int t = wv * 64 + ln;
    int bx = blockIdx.x, G = gridDim.x; asm volatile("" : "+s"(bx), "+s"(G));
    unsigned lo_ = 0u; asm volatile("" : "+s"(lo_));
    C.lds = (LAS unsigned char*)lds_raw + lo_; C.tid = t; C.lane = ln; C.wave = wv;
    C.G = G; C.bx = bx; C.gw = bx * NWAVES + C.wave; C.ngw = G * NWAVES; return C;
}
#define AS4 __attribute__((address_space(4)))
typedef const float* const AS4* InTab;
struct AP { InTab in; float* out; unsigned char* ws; };
static_assert(offsetof(Args, out) == 288 && offsetof(Args, ws) == 296, "Args layout");
__device__ __forceinline__ AP fresh_args() {
    unsigned long long p = (unsigned long long)__builtin_amdgcn_kernarg_segment_ptr(); asm volatile("" : "+s"(p));
    AP r; r.in = (InTab)p; r.out = *(float* const AS4*)(p + 288); r.ws = *(unsigned char* const AS4*)(p + 296); return r;
}

typedef __attribute__((address_space(1))) unsigned gu32;
#define RLX_AGENT __ATOMIC_RELAXED, __HIP_MEMORY_SCOPE_AGENT
#define XB_TMO      128
#define XB_XCNT(j)  (256  + 64 * (j))
#define XB_XSUB(j)  (1280 + 64 * (j))
#define XB_XGEN(j)  (2304 + 64 * (j))
#define XB_TOP      3328
#define XB_TOPGEN   3392
#define XCD_BAR_WORDS 3456
#define XB_SPIN_CAP (1u << 18)

__device__ __forceinline__ unsigned xb_ld(unsigned* p)              { return __hip_atomic_load(p, __ATOMIC_RELAXED, __HIP_MEMORY_SCOPE_AGENT); }
__device__ __forceinline__ unsigned xb_add(unsigned* p, unsigned v) { return __hip_atomic_fetch_add(p, v, __ATOMIC_RELAXED, __HIP_MEMORY_SCOPE_AGENT); }
__device__ __forceinline__ unsigned xb_xcc_id() { return (unsigned)__builtin_amdgcn_s_getreg((3 << 11) | 20) & 0xFu; }
#define XB_SPIN(cond, bar) do { unsigned _sp = 0; while (cond) { __builtin_amdgcn_s_sleep(1); \
    if ((++_sp & 255u) == 0u) { if (xb_ld(&(bar)[XB_TMO])) break; if (_sp > XB_SPIN_CAP) { atomicAdd(&(bar)[XB_TMO], 1u); break; } } } } while (0)

struct XcdBarrier {
    unsigned* bar; unsigned x;
    volatile LAS unsigned* st;
};

__device__ __forceinline__ XcdBarrier xcd_barrier_post(unsigned* bar, volatile LAS unsigned* st) {
    XcdBarrier b; b.bar = bar; b.x = xb_xcc_id(); b.st = st;
    if (threadIdx.x == 0) (void)xb_add(&bar[XB_XCNT(b.x)], 1u);
    return b;
}
__device__ __forceinline__ void xcd_barrier_complete(unsigned* bar, unsigned x, unsigned& nloc, unsigned& nx) {
    const unsigned G = gridDim.x * gridDim.y * gridDim.z;
    unsigned sum, cnt, mine, sp = 0u;
    for (;;) {
        sum = 0u; cnt = 0u; mine = 0u;
#pragma unroll
        for (unsigned j = 0; j < 16; ++j) { const unsigned c = xb_ld(&bar[XB_XCNT(j)]); sum += c; cnt += (c > 0u) ? 1u : 0u; mine = (j == x) ? c : mine; }
        if (sum == G) break;
        __builtin_amdgcn_s_sleep(1);
        if ((++sp & 255u) == 0u) { if (xb_ld(&bar[XB_TMO])) break; if (sp > XB_SPIN_CAP) { atomicAdd(&bar[XB_TMO], 1u); break; } }
    }
    nloc = mine > 0u ? mine : 1u; nx = cnt > 0u ? cnt : 1u;
}

__device__ __forceinline__ void xcd_barrier(const XcdBarrier& b) {
    asm volatile("s_waitcnt vmcnt(0)" ::: "memory");
    __syncthreads();
    if (threadIdx.x == 0) {
        unsigned* bar = b.bar;
        __builtin_amdgcn_s_waitcnt(0);
        unsigned nloc = b.st[0], nx = b.st[1];
        if (nloc == 0u) { xcd_barrier_complete(bar, b.x, nloc, nx); b.st[0] = nloc; b.st[1] = nx; }
        const unsigned old = xb_add(&bar[XB_XSUB(b.x)], 1u);
        const unsigned gen = old / nloc;
        if (old + 1u == (gen + 1u) * nloc) {
            __builtin_amdgcn_fence(__ATOMIC_RELEASE, "agent");
            asm volatile("s_waitcnt vmcnt(0)" ::: "memory");
            const unsigned og = xb_add(&bar[XB_TOP], 1u);
            const unsigned tg = og / nx;
            if (og + 1u == (tg + 1u) * nx) xb_add(&bar[XB_TOPGEN], 1u);
            else XB_SPIN(xb_ld(&bar[XB_TOPGEN]) == tg, bar);
            __builtin_amdgcn_fence(__ATOMIC_ACQUIRE, "agent");
            xb_add(&bar[XB_XGEN(b.x)], 1u);
            asm volatile("s_waitcnt vmcnt(0)" ::: "memory");
        } else {
            XB_SPIN(xb_ld(&bar[XB_XGEN(b.x)]) == gen, bar);
            __builtin_amdgcn_fence(__ATOMIC_ACQUIRE, "agent");
            asm volatile("s_waitcnt vmcnt(0)" ::: "memory");
        }
    }
    __syncthreads();
}

__device__ __forceinline__ void transpose_item(const float* W, const float* gain, int K, int N, bf16_t* WT, LAS float* scr, int item, int lane) {
    const int nblk = N / 64, kb = item / nblk, nb = item % nblk, k0 = 64 * kb, n0 = 64 * nb;
    const int lr = lane >> 4, lc = (lane & 15) * 4;
    f32x4 v[16];
#pragma unroll
    for (int i = 0; i < 16; ++i) v[i] = *(const f32x4*)(W + (size_t)(k0 + 4 * i + lr) * N + n0 + lc);
#pragma unroll
    for (int i = 0; i < 16; ++i) { const int kk = 4 * i + lr; const float g = gain ? gain[k0 + kk] : 1.f; LAS float* d = scr + kk * 65 + lc;
        d[0] = v[i].x * g; d[1] = v[i].y * g; d[2] = v[i].z * g; d[3] = v[i].w * g; }
    LDS_WAIT(); asm volatile("" ::: "memory");
#pragma unroll
    for (int c = 0; c < 8; ++c) { const LAS float* sp = scr + (8 * c) * 65 + lane;
        u32x4 o; o.x = pk2(sp[0 * 65], sp[1 * 65]); o.y = pk2(sp[2 * 65], sp[3 * 65]); o.z = pk2(sp[4 * 65], sp[5 * 65]); o.w = pk2(sp[6 * 65], sp[7 * 65]);
        *(u32x4*)(WT + (size_t)(n0 + lane) * K + k0 + 8 * c) = o; }
    LDS_WAIT(); asm volatile("" ::: "memory");
}
__device__ __forceinline__ void rms_row_to_bf16(const float* xrow, bf16_t* orow, int lane) {
    const f32x4* xr = (const f32x4*)xrow + lane;
    f32x4 v[8]; float s = 0.f;
#pragma unroll
    for (int j = 0; j < 8; ++j) { v[j] = xr[64 * j]; s += (v[j].x * v[j].x + v[j].y * v[j].y) + (v[j].z * v[j].z + v[j].w * v[j].w); }
    const float rs = rsqrtf(wave_sum(s) * (1.f / DM) + 1e-6f);
    u32x2* o8 = (u32x2*)orow + lane;
#pragma unroll
    for (int j = 0; j < 8; ++j) { u32x2 w; w.x = pk2(v[j].x * rs, v[j].y * rs); w.y = pk2(v[j].z * rs, v[j].w * rs); o8[64 * j] = w; }
}
__device__ __forceinline__ void s5_tables(const Ctx& C, const AP& a);
typedef float v16f_t __attribute__((ext_vector_type(16)));
typedef float v32f_t __attribute__((ext_vector_type(32)));
typedef unsigned v6u_t __attribute__((ext_vector_type(6)));
constexpr int EROW = 1536; constexpr size_t ETAB = (size_t)16384 * EROW;
__device__ __forceinline__ void expert_row_pack(const AP& a, int which, int l, int e, int lane, const f32x4 (&v)[8], float mx) {
    unsigned char* ws = a.ws;
    if (which) {
        const float sc4 = mx > 0.f ? 6.f / mx : 1.f;
        unsigned wv[4];
#pragma unroll
        for (int d4 = 0; d4 < 4; ++d4) { unsigned w_ = 0u;
            w_ = __builtin_amdgcn_cvt_scalef32_pk_fp4_f32(w_, v[2 * d4].x * sc4, v[2 * d4].y * sc4, 1.0f, 0); w_ = __builtin_amdgcn_cvt_scalef32_pk_fp4_f32(w_, v[2 * d4].z * sc4, v[2 * d4].w * sc4, 1.0f, 1);
            w_ = __builtin_amdgcn_cvt_scalef32_pk_fp4_f32(w_, v[2 * d4 + 1].x * sc4, v[2 * d4 + 1].y * sc4, 1.0f, 2); w_ = __builtin_amdgcn_cvt_scalef32_pk_fp4_f32(w_, v[2 * d4 + 1].z * sc4, v[2 * d4 + 1].w * sc4, 1.0f, 3);
            wv[d4] = w_; }
        ((u32x4*)(ws + WS_UB + 64 * MiB + (size_t)l * 16 * MiB + (size_t)e * 1024))[lane] = (u32x4){wv[0], wv[1], wv[2], wv[3]};
        if (lane == 0) ((float*)(ws + WS_VB))[(2 + l) * 16384 + e] = mx > 0.f ? mx * (1.f / 6.f) : 1.f;
        return;
    }
    if (true) {
        const float sc4 = mx > 0.f ? 6.f / mx : 1.f;
        unsigned wv[4];
#pragma unroll
        for (int d4 = 0; d4 < 4; ++d4) { unsigned w_ = 0u;
            w_ = __builtin_amdgcn_cvt_scalef32_pk_fp4_f32(w_, v[2 * d4].x * sc4, v[2 * d4].y * sc4, 1.0f, 0); w_ = __builtin_amdgcn_cvt_scalef32_pk_fp4_f32(w_, v[2 * d4].z * sc4, v[2 * d4].w * sc4, 1.0f, 1);
            w_ = __builtin_amdgcn_cvt_scalef32_pk_fp4_f32(w_, v[2 * d4 + 1].x * sc4, v[2 * d4 + 1].y * sc4, 1.0f, 2); w_ = __builtin_amdgcn_cvt_scalef32_pk_fp4_f32(w_, v[2 * d4 + 1].z * sc4, v[2 * d4 + 1].w * sc4, 1.0f, 3);
            wv[d4] = w_; }
        ((u32x4*)(ws + WS_UB + (size_t)l * ETAB + (size_t)e * 1024))[lane] = (u32x4){wv[0], wv[1], wv[2], wv[3]};
        if (lane == 0) ((float*)(ws + WS_VB))[(0 * 2 + l) * 16384 + e] = mx > 0.f ? mx * (1.f / 6.f) : 1.f;
        return;
    }
    const float sc = mx > 0.f ? 7.f / mx : 1.f;
    typedef unsigned v16u_t __attribute__((ext_vector_type(16))); typedef __bf16 v32bf_t __attribute__((ext_vector_type(32)));
    v16u_t pw;
#pragma unroll
    for (int j = 0; j < 8; ++j) { pw[j * 2] = pk2(v[j].x * sc, v[j].y * sc); pw[j * 2 + 1] = pk2(v[j].z * sc, v[j].w * sc); }
    const v6u_t w = __builtin_amdgcn_cvt_scalef32_pk32_fp6_bf16(__builtin_bit_cast(v32bf_t, pw), 1.0f);
    unsigned char* row = ws + WS_UB + (size_t)l * ETAB + (size_t)e * EROW;
    ((u32x4*)row)[lane] = (u32x4){w[0], w[1], w[2], w[3]}; ((u32x2*)(row + 1024))[lane] = (u32x2){w[4], w[5]};
    if (lane == 0) ((float*)(ws + WS_VB))[(0 * 2 + l) * 16384 + e] = mx > 0.f ? mx * (1.f / 7.f) : 1.f;
}
__device__ __forceinline__ void expert_row_item2(const AP& a, int which, int l, int e, int lane) {
    const f32x4* src = (const f32x4*)(a.in[which ? 35 : 34] + ((size_t)l * 16384 + e) * DM) + lane;
    const f32x4* gp = (const f32x4*)(a.in[31] + l * DM) + lane;
    f32x4 v0[8], v1[8]; float m0 = 0.f, m1 = 0.f;
#pragma unroll
    for (int j = 0; j < 8; ++j) { v0[j] = src[64 * j]; v1[j] = src[512 + 64 * j]; }
#pragma unroll
    for (int j = 0; j < 8; ++j) { if (!which) { const f32x4 g = gp[64 * j]; v0[j] = v0[j] * g; v1[j] = v1[j] * g; }
        m0 = fmaxf(m0, fmaxf(fmaxf(fabsf(v0[j].x), fabsf(v0[j].y)), fmaxf(fabsf(v0[j].z), fabsf(v0[j].w))));
        m1 = fmaxf(m1, fmaxf(fmaxf(fabsf(v1[j].x), fabsf(v1[j].y)), fmaxf(fabsf(v1[j].z), fabsf(v1[j].w)))); }
    m0 = wave_max(m0); m1 = wave_max(m1);
    expert_row_pack(a, which, l, e, lane, v0, m0); expert_row_pack(a, which, l, e + 1, lane, v1, m1);
}
__device__ __forceinline__ void phase_prep(const Ctx& C, const AP& a) {
    unsigned char* ws = a.ws;
    LAS float* scr = (LAS float*)(C.lds + C.wave * 16640);
    constexpr int I_IN = 32 * 64, I_OUT = 32 * 32, I_Q = 32 * 16, I_GLU = 8 * 8, I_L = I_IN + I_OUT + I_Q + I_GLU;
    for (int it = C.gw; it < 2 * I_L; it += C.ngw) {
        const int l = it / I_L; int r = it % I_L;
        if (r < I_IN) { transpose_item(a.in[2] + (size_t)l * DM * PROJ, a.in[1] + l * DM, DM, PROJ, (bf16_t*)(ws + WS_WINT) + (size_t)l * PROJ * DM, scr, r, C.lane); continue; } r -= I_IN;
        if (r < I_OUT) { transpose_item(a.in[30] + (size_t)l * DM * DM, a.in[29] + l * DM, DM, DM, (bf16_t*)(ws + WS_WOUTT) + (size_t)l * DM * DM, scr, r, C.lane); continue; } r -= I_OUT;
        if (r < I_Q) { transpose_item(a.in[32] + (size_t)l * DM * 1024, a.in[31] + l * DM, DM, 1024, (bf16_t*)(ws + WS_WQT) + (size_t)l * 1024 * DM, scr, r, C.lane); continue; } r -= I_Q;
        transpose_item(a.in[12] + (size_t)l * 512 * 512, nullptr, 512, 512, (bf16_t*)(ws + WS_WGLUT) + (size_t)l * 512 * 512, scr, r, C.lane);
    }
    {
        LAS float* tc = (LAS float*)(C.lds + 8 * 16640); LAS float* ts = tc + 128;
        if (C.tid < 128) { tc[C.tid] = cospif((float)C.tid / 64.f); ts[C.tid] = sinpif((float)C.tid / 64.f); }
        __syncthreads();
        for (int it = C.bx * NTHR + C.tid; it < 2 * 4 * 32 * 512; it += C.G * NTHR) {
            const int cp = it & 511, ccg = (it >> 9) & 31, blk = (it >> 14) & 3, l = it >> 16;
            const float* fw = a.in[3] + (size_t)l * 512 * 512 + (size_t)blk * 128 * 512 + cp;
            float sc[4] = {0.f, 0.f, 0.f, 0.f}, ss[4] = {0.f, 0.f, 0.f, 0.f};
#pragma unroll 8
            for (int m = 0; m < 128; ++m) { const float f = fw[(size_t)m * 512];
#pragma unroll
                for (int r = 0; r < 4; ++r) { const int ix = (m * (ccg * 4 + r)) & 127; sc[r] += tc[ix] * f; ss[r] += ts[ix] * f; } }
            bf16_t* o = (bf16_t*)(ws + WS_WCST) + (size_t)l * 1024 * 512; const int c0 = blk * 128 + ccg * 4;
            u32x2 w; w.x = pk2(sc[0] * (1.f / 512.f), sc[1] * (1.f / 512.f)); w.y = pk2(sc[2] * (1.f / 512.f), sc[3] * (1.f / 512.f)); *(u32x2*)(o + (size_t)(2 * cp) * 512 + c0) = w;
            w.x = pk2(ss[0] * (1.f / 512.f), ss[1] * (1.f / 512.f)); w.y = pk2(ss[2] * (1.f / 512.f), ss[3] * (1.f / 512.f)); *(u32x2*)(o + (size_t)(2 * cp + 1) * 512 + c0) = w;
        }
    }
    for (int it = C.bx * NTHR + C.tid; it < 2048 * 256; it += C.G * NTHR) {
        const int k = it >> 8, j0 = (it & 255) * 8; float v[8];
#pragma unroll
        for (int e = 0; e < 8; ++e) { const int j = j0 + e, s = j <= 1024 ? j : j - 1024; const float x = (float)((k * s) & 2047) * (1.f / 1024.f); v[e] = (j <= 1024) ? cospif(x) : -sinpif(x); }
        u32x4 w; w.x = pk2(v[0], v[1]); w.y = pk2(v[2], v[3]); w.z = pk2(v[4], v[5]); w.w = pk2(v[6], v[7]);
        *(u32x4*)((bf16_t*)(ws + WS_DFT) + (size_t)k * 2048 + j0) = w;
    }
    for (int it = C.bx * NTHR + C.tid; it < 2 * 8 * 2 * 64 * 128; it += C.G * NTHR) {
        const int key = it & 127, d = (it >> 7) & 63, lhp = it >> 13;
        ((float*)(ws + WS_KEYST))[it] = a.in[33][((size_t)lhp * 128 + key) * 64 + d];
    }
    for (int it = C.bx * NTHR + C.tid; it < 2048 * 64; it += C.G * NTHR) {
        const int pos = it >> 6, j = it & 63; const float inv = powf(10000.f, -(float)(2 * (j & 31)) / 64.f);
        const float ang = (float)(j < 32 ? (pos >> 6) : (pos & 63)) * inv;
        ((float*)(ws + WS_ROPE))[it] = cosf(ang); ((float*)(ws + WS_ROPE))[2048 * 64 + it] = sinf(ang);
    }
    {
        bf16_t* W1T = (bf16_t*)(ws + WS_LORA); bf16_t* g2T = W1T + 2 * 224 * 512; bf16_t* w2T = g2T + 2 * 512 * 96; bf16_t* a2T = w2T + 2 * 2 * 512 * 32;
        for (int it = C.bx * NTHR + C.tid; it < 2 * 224 * 512; it += C.G * NTHR) {
            const int k = it & 511, j = (it >> 9) % 224, l = it / (224 * 512); float v;
            if (j < 96) v = a.in[22][((size_t)l * 512 + k) * 96 + j];
            else if (j < 160) v = a.in[17][((size_t)(l * 2 + ((j - 96) >> 5)) * 512 + k) * 32 + ((j - 96) & 31)];
            else v = a.in[20][((size_t)(l * 2 + ((j - 160) >> 5)) * 512 + k) * 32 + ((j - 160) & 31)];
            W1T[it] = (bf16_t)f2bf(v);
        }
        for (int it = C.bx * NTHR + C.tid; it < 2 * 512 * 96; it += C.G * NTHR) {
            const int j = it % 96, ch = (it / 96) & 511, l = it / (96 * 512);
            g2T[it] = (bf16_t)f2bf(a.in[23][((size_t)l * 96 + j) * 512 + ch]);
        }
        for (int it = C.bx * NTHR + C.tid; it < 2 * 2 * 512 * 32; it += C.G * NTHR) {
            const int j = it & 31, ch = (it >> 5) & 511, ld = it >> 14;
            w2T[it] = (bf16_t)f2bf(a.in[18][((size_t)ld * 32 + j) * 512 + ch]); a2T[it] = (bf16_t)f2bf(a.in[21][((size_t)ld * 32 + j) * 512 + ch]);
        }
    }
    for (int m = C.gw; m < MTOK; m += C.ngw) rms_row_to_bf16(a.in[0] + (size_t)m * DM, (bf16_t*)(ws + WS_HB) + (size_t)m * DM, C.lane);
}

__device__ __forceinline__ void qk_prep_token(const AP& a, int l, int m, int lane) {
    unsigned char* ws = a.ws;
    const float* pr = (const float*)(ws + WS_PROJ) + (size_t)m * PROJ;
    const int pos = m & (SEQ - 1);
    const float cs = ((const float*)(ws + WS_ROPE))[pos * 64 + lane], sn = ((const float*)(ws + WS_ROPE))[2048 * 64 + pos * 64 + lane];
    bf16_t* qo = (bf16_t*)(ws + WS_QB) + (size_t)m * 512; bf16_t* ko = (bf16_t*)(ws + WS_QB) + (size_t)MTOK * 512 + (size_t)m * 256; bf16_t* vo = ko + (size_t)MTOK * 256;
#pragma unroll
    for (int hh = 0; hh < 6; ++hh) {
        const float* src = pr + 1024 + hh * 128;
        const float* gn = a.in[hh < 4 ? 13 : 14] + l * 128;
        const float x1 = src[lane], x2 = src[lane + 64];
        const float rs = rsqrtf(wave_sum(x1 * x1 + x2 * x2) * (1.f / 128.f) + 1e-6f);
        const float y1 = x1 * rs * gn[lane], y2 = x2 * rs * gn[lane + 64];
        bf16_t* dst = hh < 4 ? qo + hh * 128 : ko + (hh - 4) * 128;
        dst[lane] = (bf16_t)f2bf(y1 * cs - y2 * sn); dst[lane + 64] = (bf16_t)f2bf(y1 * sn + y2 * cs);
    }
    const f32x4 vv = *((const f32x4*)(pr + 1792) + lane);
    u32x2 w; w.x = pk2(vv.x, vv.y); w.y = pk2(vv.z, vv.w); *((u32x2*)vo + lane) = w;
}

struct S5P { float lr, li, cr, ci; };
__device__ __forceinline__ S5P s5_params(const AP& a, int l, int d, int g, int p, float mult) {
    const int ix = ((l * 2 + d) * 32 + g) * 64 + p;
    const float lre = a.in[4][ix], lim = a.in[5][ix], step = __expf(a.in[6][(l * 2 + d) * 32 + g]) * mult;
    const float er = __expf(lre * step); float sn, cs; sincosf(lim * step, &sn, &cs);
    S5P r; r.lr = er * cs; r.li = er * sn;
    const float nr = r.lr - 1.f, ni = r.li, den = 1.f / (lre * lre + lim * lim);
    r.cr = (nr * lre + ni * lim) * den; r.ci = (ni * lre - nr * lim) * den;
    return r;
}
__device__ __forceinline__ void s5_ends_item(const AP& a, int l, int item, int lane, LAS float* us) {
    unsigned char* ws = a.ws;
    const int c = item & 31, g = (item >> 5) & 31, b = item >> 10, p = lane;
    const float* ur = (const float*)(ws + WS_PROJ) + ((size_t)(b * SEQ + c * 64 + lane)) * PROJ + 512 + g * 16;
#pragma unroll
    for (int q = 0; q < 4; ++q) *((LAS f32x4*)(us + lane * 16) + q) = *((const f32x4*)ur + q);
    LDS_WAIT(); asm volatile("" ::: "memory");
#pragma unroll 1
    for (int d = 0; d < 2; ++d) {
        const S5P P = s5_params(a, l, d, g, p, 1.f);
        f32x2 bb2[16];
        const float* bre = a.in[7] + ((size_t)((l * 2 + d) * 32 + g) * 64 + p) * 16; const float* bim = a.in[8] + ((size_t)((l * 2 + d) * 32 + g) * 64 + p) * 16;
#pragma unroll
        for (int h = 0; h < 16; ++h) { const float x = bre[h], y = bim[h]; bb2[h].x = P.cr * x - P.ci * y; bb2[h].y = P.cr * y + P.ci * x; }
        const f32x2 lam2 = {P.lr, P.lr}, lami = {-P.li, P.li};
        float xr = 0.f, xi = 0.f;
#pragma unroll 4
        for (int tt = 0; tt < 64; ++tt) {
            const int t = d ? 63 - tt : tt;
            f32x2 acc2 = {0.f, 0.f};
#pragma unroll
            for (int q = 0; q < 4; ++q) { const f32x4 u4 = *((const LAS f32x4*)(us + t * 16) + q);
#pragma unroll
                for (int e = 0; e < 4; ++e) acc2 += bb2[q * 4 + e] * u4[e]; }
            const f32x2 x2 = {xr, xi}, xs = {xi, xr}; const f32x2 n2 = lam2 * x2 + lami * xs + acc2; xr = n2.x; xi = n2.y;
        }
        f32x2 o; o.x = xr; o.y = xi;
        ((f32x2*)(ws + WS_S5E))[((size_t)((b * 32 + g) * 2 + d) * 32 + c) * 64 + p] = o;
    }
    LDS_WAIT(); asm volatile("" ::: "memory");
}
__device__ __forceinline__ void s5_final_item(const AP& a, int l, int item, int lane, LAS float* us  , LAS float* yb  , LAS float* X  ) {
    unsigned char* ws = a.ws;
    const int c = item & 31, g = (item >> 5) & 31, b = item >> 10, p = lane;
    const float* ur = (const float*)(ws + WS_PROJ) + ((size_t)(b * SEQ + c * 64 + lane)) * PROJ + 512 + g * 16;
#pragma unroll
    for (int q = 0; q < 4; ++q) { *((LAS f32x4*)(us + lane * 16) + q) = *((const f32x4*)ur + q); *((LAS f32x4*)(yb + lane * 16) + q) = (f32x4){0.f, 0.f, 0.f, 0.f}; }
    LDS_WAIT(); asm volatile("" ::: "memory");
    const int oh = lane & 15, otq = lane >> 4;
#pragma unroll 1
    for (int d = 0; d < 2; ++d) {
        const S5P P = s5_params(a, l, d, g, p, 1.f);
        const S5P P64 = s5_params(a, l, d, g, p, 64.f);
        float br[16], bi[16];
        const float* bre = a.in[7] + ((size_t)((l * 2 + d) * 32 + g) * 64 + p) * 16; const float* bim = a.in[8] + ((size_t)((l * 2 + d) * 32 + g) * 64 + p) * 16;
#pragma unroll
        for (int h = 0; h < 16; ++h) { const float x = bre[h], y = bim[h]; br[h] = P.cr * x - P.ci * y; bi[h] = P.cr * y + P.ci * x; }
        const f32x2* E = (const f32x2*)(ws + WS_S5E) + ((size_t)((b * 32 + g) * 2 + d) * 32) * 64 + p;
        float xr = 0.f, xi = 0.f;
        { f32x2 nx[4];
#pragma unroll
          for (int i = 0; i < 4; ++i) nx[i] = E[(d ? 31 - i : i) * 64];
#pragma unroll 1
          for (int grp = 0; grp < 8; ++grp) {
              if (d ? (31 - grp * 4 <= c) : (grp * 4 >= c)) break;
              f32x2 cu[4];
#pragma unroll
              for (int i = 0; i < 4; ++i) cu[i] = nx[i];
              if (grp < 7) {
#pragma unroll
                  for (int i = 0; i < 4; ++i) nx[i] = E[(d ? 27 - grp * 4 - i : grp * 4 + 4 + i) * 64];
              }
#pragma unroll
              for (int i = 0; i < 4; ++i) { const int cc = d ? 31 - grp * 4 - i : grp * 4 + i;
                  if (d ? (cc > c) : (cc < c)) { const float nr = P64.lr * xr - P64.li * xi + cu[i].x, ni = P64.lr * xi + P64.li * xr + cu[i].y; xr = nr; xi = ni; } }
          } }
        const float* cre = a.in[9] + ((size_t)((l * 2 + d) * 32 + g) * 16 + oh) * 64; const float* cim = a.in[10] + ((size_t)((l * 2 + d) * 32 + g) * 16 + oh) * 64;
#pragma unroll 1
        for (int sb = 0; sb < 4; ++sb) {
            for (int tt = 0; tt < 16; ++tt) {
                const int ts = sb * 16 + tt, t = d ? 63 - ts : ts;
                float ar = 0.f, ai = 0.f;
#pragma unroll
                for (int q = 0; q < 4; ++q) { const f32x4 u4 = *((const LAS f32x4*)(us + t * 16) + q);
#pragma unroll
                    for (int e = 0; e < 4; ++e) { ar += br[q * 4 + e] * u4[e]; ai += bi[q * 4 + e] * u4[e]; } }
                const float nr = P.lr * xr - P.li * xi + ar, ni = P.lr * xi + P.li * xr + ai; xr = nr; xi = ni;
                f32x2 o; o.x = xr; o.y = xi; *((LAS f32x2*)X + tt * 64 + p) = o;
            }
            LDS_WAIT(); asm volatile("" ::: "memory");
            float acc[4] = {0.f, 0.f, 0.f, 0.f};
            for (int pq = 0; pq < 16; ++pq) {
                const f32x4 c4r = *((const f32x4*)cre + pq), c4i = *((const f32x4*)cim + pq);
#pragma unroll
                for (int i = 0; i < 4; ++i) {
                    const LAS f32x4* xp = (const LAS f32x4*)(X + ((otq * 4 + i) * 64 + pq * 4) * 2);
                    const f32x4 xa = xp[0], xb = xp[1];
                    acc[i] += c4r[0] * xa[0] - c4i[0] * xa[1] + c4r[1] * xa[2] - c4i[1] * xa[3] + c4r[2] * xb[0] - c4i[2] * xb[1] + c4r[3] * xb[2] - c4i[3] * xb[3];
                }
            }
#pragma unroll
            for (int i = 0; i < 4; ++i) { const int ts = sb * 16 + otq * 4 + i, t = d ? 63 - ts : ts; yb[t * 16 + oh] += acc[i]; }
            LDS_WAIT(); asm volatile("" ::: "memory");
        }
    }
    const float* dsk = a.in[11] + (l * 32 + g) * 16;
    unsigned w[8];
#pragma unroll
    for (int h = 0; h < 16; h += 2) {
        const float y0 = gelu_tanh(yb[lane * 16 + h] + dsk[h] * us[lane * 16 + h]), y1 = gelu_tanh(yb[lane * 16 + h + 1] + dsk[h + 1] * us[lane * 16 + h + 1]);
        w[h >> 1] = pk2(y0, y1);
    }
    u32x4* dst = (u32x4*)((bf16_t*)(ws + WS_YGELU) + (size_t)(b * SEQ + c * 64 + lane) * 512 + g * 16);
    dst[0] = (u32x4){w[0], w[1], w[2], w[3]}; dst[1] = (u32x4){w[4], w[5], w[6], w[7]};
    LDS_WAIT(); asm volatile("" ::: "memory");
}

__device__ __forceinline__ void s5_tables(const Ctx& C, const AP& a) {
    unsigned char* ws = a.ws;
    f32x4* LAMT = (f32x4*)(ws + WS_S5T); bf16_t* BBop = (bf16_t*)(ws + WS_S5T + 131072); bf16_t* CBop = (bf16_t*)(ws + WS_S5T + 131072 + 1048576);
    for (int it = C.bx * NTHR + C.tid; it < 128 * 64; it += C.G * NTHR) {
        const int p = it & 63, ldg = it >> 6, g = ldg & 31, d = (ldg >> 5) & 1, l = ldg >> 6;
        const S5P P = s5_params(a, l, d, g, p, 1.f), P64 = s5_params(a, l, d, g, p, 64.f);
        LAMT[it] = (f32x4){P.lr, P.li, P64.lr, P64.li};
    }
    for (int it = C.bx * NTHR + C.tid; it < 128 * 8 * 64; it += C.G * NTHR) {
        const int lane = it & 63, nt = (it >> 6) & 7, ldg = it >> 9, g = ldg & 31, d = (ldg >> 5) & 1, l = ldg >> 6, fr = lane & 15, fq = lane >> 4;
        const int col = nt * 16 + fr, p = col >> 1, ri = col & 1;
        unsigned w[4] = {0u, 0u, 0u, 0u};
        if (fq < 2) {
            const S5P P = s5_params(a, l, d, g, p, 1.f);
            const float* bre = a.in[7] + ((size_t)ldg * 64 + p) * 16 + fq * 8; const float* bim = a.in[8] + ((size_t)ldg * 64 + p) * 16 + fq * 8;
            float v[8];
#pragma unroll
            for (int jj = 0; jj < 8; ++jj) v[jj] = ri ? (P.cr * bim[jj] + P.ci * bre[jj]) : (P.cr * bre[jj] - P.ci * bim[jj]);
            w[0] = pk2(v[0], v[1]); w[1] = pk2(v[2], v[3]); w[2] = pk2(v[4], v[5]); w[3] = pk2(v[6], v[7]);
        }
        *(u32x4*)(BBop + (size_t)it * 8) = (u32x4){w[0], w[1], w[2], w[3]};
    }
    for (int it = C.bx * NTHR + C.tid; it < 128 * 4 * 64; it += C.G * NTHR) {
        const int lane = it & 63, s2 = (it >> 6) & 3, ldg = it >> 8, fr = lane & 15, fq = lane >> 4;
        const float* cre = a.in[9] + ((size_t)ldg * 16 + fr) * 64 + 16 * s2 + fq * 4; const float* cim = a.in[10] + ((size_t)ldg * 16 + fr) * 64 + 16 * s2 + fq * 4;
        *(u32x4*)(CBop + (size_t)it * 8) = (u32x4){pk2(cre[0], -cim[0]), pk2(cre[1], -cim[1]), pk2(cre[2], -cim[2]), pk2(cre[3], -cim[3])};
    }
}
__device__ __forceinline__ void s5_load_u(const float* ur, LAS unsigned char* wl, int lane) {
    const f32x4 u0 = *((const f32x4*)ur + 0), u1 = *((const f32x4*)ur + 1), u2 = *((const f32x4*)ur + 2), u3 = *((const f32x4*)ur + 3);
    LAS u32x4* dst = (LAS u32x4*)(wl + lane * 32);
    dst[0] = (u32x4){pk2(u0.x, u0.y), pk2(u0.z, u0.w), pk2(u1.x, u1.y), pk2(u1.z, u1.w)}; dst[1] = (u32x4){pk2(u2.x, u2.y), pk2(u2.z, u2.w), pk2(u3.x, u3.y), pk2(u3.z, u3.w)};
}
__device__ __forceinline__ void s5_build_bb(const AP& a, int ldg, float cr, float ci, int lane, LAS unsigned char* wl, bf16x8_t (&bb)[8]) {
    const int fr = lane & 15, fq = lane >> 4;
    LAS f32x2* cf = (LAS f32x2*)(wl + 14848);
    f32x2 me; me.x = cr; me.y = ci; cf[lane] = me;
    LDS_WAIT(); asm volatile("" ::: "memory");
#pragma unroll
    for (int nt = 0; nt < 8; ++nt) {
        const int col = nt * 16 + fr, p = col >> 1, ri = col & 1;
        unsigned w_[4] = {0u, 0u, 0u, 0u};
        if (fq < 2) {
            const f32x2 c2 = cf[p];
            const f32x4* bre = (const f32x4*)(a.in[7] + ((size_t)ldg * 64 + p) * 16 + fq * 8); const f32x4* bim = (const f32x4*)(a.in[8] + ((size_t)ldg * 64 + p) * 16 + fq * 8);
            const f32x4 r0 = bre[0], r1 = bre[1], i0 = bim[0], i1 = bim[1];
            float v[8];
#pragma unroll
            for (int jj = 0; jj < 4; ++jj) { v[jj] = ri ? (c2.x * i0[jj] + c2.y * r0[jj]) : (c2.x * r0[jj] - c2.y * i0[jj]); v[4 + jj] = ri ? (c2.x * i1[jj] + c2.y * r1[jj]) : (c2.x * r1[jj] - c2.y * i1[jj]); }
            w_[0] = pk2(v[0], v[1]); w_[1] = pk2(v[2], v[3]); w_[2] = pk2(v[4], v[5]); w_[3] = pk2(v[6], v[7]);
        }
        bb[nt] = mk8(w_[0], w_[1], w_[2], w_[3]);
        asm volatile("" ::: "memory");
    }
}
template <bool FINAL>
__device__ __forceinline__ void s5_subblock(LAS unsigned char* wl, const bf16x8_t (&bb)[8], int d, int sb, int lane, float lr, float li, float& xr, float& xi) {
    const int fr = lane & 15, fq = lane >> 4;
    LAS float* BUs = (LAS float*)(wl + 2048); LAS bf16_t* Xb = (LAS bf16_t*)(wl + 10496);
    const int trow = d ? 63 - (sb * 16 + fr) : sb * 16 + fr;
    bf16x8_t aU = mk8(0u, 0u, 0u, 0u);
    if (fq < 2) aU = *(const LAS bf16x8_t*)(wl + trow * 32 + fq * 16);
    const f32x4 z4 = {0.f, 0.f, 0.f, 0.f};
#pragma unroll
    for (int nt = 0; nt < 8; ++nt) { const f32x4 bu = __builtin_amdgcn_mfma_f32_16x16x32_bf16(aU, bb[nt], z4, 0, 0, 0);
#pragma unroll
        for (int r = 0; r < 4; ++r) BUs[(fq * 4 + r) * 132 + nt * 16 + fr] = bu[r]; }
    LDS_WAIT(); asm volatile("" ::: "memory");
#pragma unroll
    for (int tt = 0; tt < 16; ++tt) {
        const f32x2 bq = *(const LAS f32x2*)(BUs + tt * 132 + 2 * lane);
        const float nr = lr * xr - li * xi + bq.x, ni = lr * xi + li * xr + bq.y; xr = nr; xi = ni;
        if (FINAL) *(LAS unsigned*)(Xb + (d ? 15 - tt : tt) * 136 + 2 * lane) = pk2(xr, xi);
    }
    LDS_WAIT(); asm volatile("" ::: "memory");
}
__device__ __forceinline__ void s5_ends_item_m(const AP& a, int l, int item, int lane, LAS unsigned char* wl) {
    unsigned char* ws = a.ws;
    const int c = item & 31, g = (item >> 5) & 31, b = item >> 10;
    s5_load_u((const float*)(ws + WS_PROJ) + ((size_t)(b * SEQ + c * 64 + lane)) * PROJ + 512 + g * 16, wl, lane);
    LDS_WAIT(); asm volatile("" ::: "memory");
#pragma unroll 1
    for (int d = 0; d < 2; ++d) {
        const int ldg = (l * 2 + d) * 32 + g;
        const S5P Pq = s5_params(a, l, d, g, lane, 1.f);
        const f32x4 lam = {Pq.lr, Pq.li, 0.f, 0.f};
        bf16x8_t bb[8]; s5_build_bb(a, ldg, Pq.cr, Pq.ci, lane, wl, bb);
        float xr = 0.f, xi = 0.f;
#pragma unroll 1
        for (int sb = 0; sb < 4; ++sb) s5_subblock<false>(wl, bb, d, sb, lane, lam[0], lam[1], xr, xi);
        f32x2 o; o.x = xr; o.y = xi;
        ((f32x2*)(ws + WS_S5E))[((size_t)((b * 32 + g) * 2 + d) * 32 + c) * 64 + lane] = o;
    }
}
__device__ __forceinline__ void s5_final_item_m(const AP& a, int l, int item, int lane, LAS unsigned char* wl) {
    unsigned char* ws = a.ws;
    const int c = item & 31, g = (item >> 5) & 31, b = item >> 10, fr = lane & 15, fq = lane >> 4;
    const float* ubase = (const float*)(ws + WS_PROJ) + ((size_t)(b * SEQ + c * 64)) * PROJ + 512 + g * 16;
    s5_load_u(ubase + (size_t)lane * PROJ, wl, lane);
    LDS_WAIT(); asm volatile("" ::: "memory");
    LAS bf16_t* Xb = (LAS bf16_t*)(wl + 10496);
    f32x4 yacc[4];
#pragma unroll
    for (int q = 0; q < 4; ++q) yacc[q] = (f32x4){0.f, 0.f, 0.f, 0.f};
#pragma unroll 1
    for (int d = 0; d < 2; ++d) {
        const int ldg = (l * 2 + d) * 32 + g;
        const S5P Pq = s5_params(a, l, d, g, lane, 1.f), P64 = s5_params(a, l, d, g, lane, 64.f);
        const f32x4 lam = {Pq.lr, Pq.li, P64.lr, P64.li};
        bf16x8_t bb[8], cb[4]; s5_build_bb(a, ldg, Pq.cr, Pq.ci, lane, wl, bb);
#pragma unroll
        for (int s2 = 0; s2 < 4; ++s2) {
            const f32x4 cr4 = *(const f32x4*)(a.in[9] + ((size_t)ldg * 16 + fr) * 64 + 16 * s2 + fq * 4), ci4 = *(const f32x4*)(a.in[10] + ((size_t)ldg * 16 + fr) * 64 + 16 * s2 + fq * 4);
            cb[s2] = mk8(pk2(cr4[0], -ci4[0]), pk2(cr4[1], -ci4[1]), pk2(cr4[2], -ci4[2]), pk2(cr4[3], -ci4[3])); }
        const f32x2* E = (const f32x2*)(ws + WS_S5E) + ((size_t)((b * 32 + g) * 2 + d) * 32) * 64 + lane;
        float xr = 0.f, xi = 0.f;
        { f32x2 nx[4];
#pragma unroll
          for (int i = 0; i < 4; ++i) nx[i] = E[(d ? 31 - i : i) * 64];
#pragma unroll 1
          for (int grp = 0; grp < 8; ++grp) {
              if (d ? (31 - grp * 4 <= c) : (grp * 4 >= c)) break;
              f32x2 cu[4];
#pragma unroll
              for (int i = 0; i < 4; ++i) cu[i] = nx[i];
              if (grp < 7) {
#pragma unroll
                  for (int i = 0; i < 4; ++i) nx[i] = E[(d ? 27 - grp * 4 - i : grp * 4 + 4 + i) * 64];
              }
#pragma unroll
              for (int i = 0; i < 4; ++i) { const int cc = d ? 31 - grp * 4 - i : grp * 4 + i;
                  if (d ? (cc > c) : (cc < c)) { const float nr = lam[2] * xr - lam[3] * xi + cu[i].x, ni = lam[2] * xi + lam[3] * xr + cu[i].y; xr = nr; xi = ni; } }
          } }
#pragma unroll
        for (int sb = 0; sb < 4; ++sb) {
            s5_subblock<true>(wl, bb, d, sb, lane, lam[0], lam[1], xr, xi);
            f32x4 acc = d ? yacc[3 - sb] : yacc[sb];
#pragma unroll
            for (int s2 = 0; s2 < 4; ++s2) acc = __builtin_amdgcn_mfma_f32_16x16x32_bf16(*(const LAS bf16x8_t*)(Xb + fr * 136 + s2 * 32 + fq * 8), cb[s2], acc, 0, 0, 0);
            if (d) yacc[3 - sb] = acc; else yacc[sb] = acc;
            LDS_WAIT(); asm volatile("" ::: "memory");
        }
    }
    const float dsk = a.in[11][(l * 32 + g) * 16 + fr];
#pragma unroll
    for (int q = 0; q < 4; ++q)
#pragma unroll
        for (int r = 0; r < 4; ++r) { const int t = q * 16 + fq * 4 + r;
            const float y = gelu_tanh(yacc[q][r] + dsk * ubase[(size_t)t * PROJ + fr]);
            ((bf16_t*)(ws + WS_YGELU))[(size_t)(b * SEQ + c * 64 + t) * 512 + g * 16 + fr] = (bf16_t)f2bf(y); }
}
__device__ __forceinline__ float gelu_tanh_fast(float x) { const float u2 = 1.5957691216057308f * (x + 0.044715f * x * x * x); return x / (1.f + __expf(-u2)); }
__device__ __forceinline__ void s5_final_item_h(const AP& a, int l, int item, int lane, LAS unsigned char* wl) {
    unsigned char* ws = a.ws;
    const int c = item & 31, g = (item >> 5) & 31, b = item >> 10, p = lane, fr = lane & 15, fq = lane >> 4;
    LAS float* us = (LAS float*)wl; LAS bf16_t* Xb = (LAS bf16_t*)(wl + 4096);
    const float* ur = (const float*)(ws + WS_PROJ) + ((size_t)(b * SEQ + c * 64 + lane)) * PROJ + 512 + g * 16;
#pragma unroll
    for (int q = 0; q < 4; ++q) *((LAS f32x4*)(us + lane * 16) + q) = *((const f32x4*)ur + q);
    LDS_WAIT(); asm volatile("" ::: "memory");
    f32x4 yacc[4];
#pragma unroll
    for (int q = 0; q < 4; ++q) yacc[q] = (f32x4){0.f, 0.f, 0.f, 0.f};
#pragma unroll 1
    for (int d = 0; d < 2; ++d) {
        const int ldg = (l * 2 + d) * 32 + g;
        const S5P P = s5_params(a, l, d, g, p, 1.f), P64 = s5_params(a, l, d, g, p, 64.f);
        f32x2 bb2[16];
        const float* bre = a.in[7] + ((size_t)ldg * 64 + p) * 16; const float* bim = a.in[8] + ((size_t)ldg * 64 + p) * 16;
#pragma unroll
        for (int h = 0; h < 16; ++h) { const float x = bre[h], y = bim[h]; bb2[h].x = P.cr * x - P.ci * y; bb2[h].y = P.cr * y + P.ci * x; }
        const f32x2 lam2 = {P.lr, P.lr}, lami = {-P.li, P.li};
        bf16x8_t cb[4];
#pragma unroll
        for (int s2 = 0; s2 < 4; ++s2) {
            const f32x4 cr4 = *(const f32x4*)(a.in[9] + ((size_t)ldg * 16 + fr) * 64 + 16 * s2 + fq * 4), ci4 = *(const f32x4*)(a.in[10] + ((size_t)ldg * 16 + fr) * 64 + 16 * s2 + fq * 4);
            cb[s2] = mk8(pk2(cr4[0], -ci4[0]), pk2(cr4[1], -ci4[1]), pk2(cr4[2], -ci4[2]), pk2(cr4[3], -ci4[3])); }
        const f32x2* E = (const f32x2*)(ws + WS_S5E) + ((size_t)((b * 32 + g) * 2 + d) * 32) * 64 + p;
        float xr = 0.f, xi = 0.f;
        { f32x2 nx[4];
#pragma unroll
          for (int i = 0; i < 4; ++i) nx[i] = E[(d ? 31 - i : i) * 64];
#pragma unroll 1
          for (int grp = 0; grp < 8; ++grp) {
              if (d ? (31 - grp * 4 <= c) : (grp * 4 >= c)) break;
              f32x2 cu[4];
#pragma unroll
              for (int i = 0; i < 4; ++i) cu[i] = nx[i];
              if (grp < 7) {
#pragma unroll
                  for (int i = 0; i < 4; ++i) nx[i] = E[(d ? 27 - grp * 4 - i : grp * 4 + 4 + i) * 64];
              }
#pragma unroll
              for (int i = 0; i < 4; ++i) { const int cc = d ? 31 - grp * 4 - i : grp * 4 + i;
                  if (d ? (cc > c) : (cc < c)) { const float nr = P64.lr * xr - P64.li * xi + cu[i].x, ni = P64.lr * xi + P64.li * xr + cu[i].y; xr = nr; xi = ni; } }
          } }
#pragma unroll
        for (int sb = 0; sb < 4; ++sb) {
#pragma unroll 4
            for (int tt = 0; tt < 16; ++tt) {
                const int ts = sb * 16 + tt, t = d ? 63 - ts : ts;
                f32x2 acc2 = {0.f, 0.f};
#pragma unroll
                for (int q = 0; q < 4; ++q) { const f32x4 u4 = *((const LAS f32x4*)(us + t * 16) + q);
#pragma unroll
                    for (int e = 0; e < 4; ++e) acc2 += bb2[q * 4 + e] * u4[e]; }
                { const f32x2 x2 = {xr, xi}, xs = {xi, xr}; const f32x2 n2 = lam2 * x2 + lami * xs + acc2; xr = n2.x; xi = n2.y; }
                *(LAS unsigned*)(Xb + (d ? 15 - tt : tt) * 136 + 2 * p) = pg8::cvt_pk_bf16(xr, xi);
            }
            LDS_WAIT(); asm volatile("" ::: "memory");
            f32x4 acc = d ? yacc[3 - sb] : yacc[sb];
#pragma unroll
            for (int s2 = 0; s2 < 4; ++s2) acc = __builtin_amdgcn_mfma_f32_16x16x32_bf16(*(const LAS bf16x8_t*)(Xb + fr * 136 + s2 * 32 + fq * 8), cb[s2], acc, 0, 0, 0);
            if (d) yacc[3 - sb] = acc; else yacc[sb] = acc;
            LDS_WAIT(); asm volatile("" ::: "memory");
        }
    }
    const float dsk = a.in[11][(l * 32 + g) * 16 + fr];
#pragma unroll
    for (int q = 0; q < 4; ++q)
#pragma unroll
        for (int r = 0; r < 4; ++r) { const int t = q * 16 + fq * 4 + r;
            const float y = gelu_tanh_fast(yacc[q][r] + dsk * us[t * 16 + fr]);
            ((bf16_t*)(ws + WS_YGELU))[(size_t)(b * SEQ + c * 64 + t) * 512 + g * 16 + fr] = (bf16_t)f2bf(y); }
    LDS_WAIT(); asm volatile("" ::: "memory");
}
__device__ __forceinline__ float shift3(float p, float c, float n, float m0, float m1) { return c + (p - c) * m0 + (n - c) * m1; }
__device__ __forceinline__ float dpp_ror4(float x) { return __builtin_bit_cast(float, __builtin_amdgcn_update_dpp(0, __builtin_bit_cast(int, x), 0x124, 0xF, 0xF, true)); }
__device__ __forceinline__ float dpp_ror8(float x) { return __builtin_bit_cast(float, __builtin_amdgcn_update_dpp(0, __builtin_bit_cast(int, x), 0x128, 0xF, 0xF, true)); }
__device__ __forceinline__ float dpp_q1(float x) { return __builtin_bit_cast(float, __builtin_amdgcn_update_dpp(0, __builtin_bit_cast(int, x), 0xB1, 0xF, 0xF, true)); }
__device__ __forceinline__ float dpp_q2(float x) { return __builtin_bit_cast(float, __builtin_amdgcn_update_dpp(0, __builtin_bit_cast(int, x), 0x4E, 0xF, 0xF, true)); }
__device__ __forceinline__ float row_sum16(float x) { x += dpp_q1(x); x += dpp_q2(x); x += dpp_ror4(x); x += dpp_ror8(x); return x; }
__device__ __forceinline__ void rwkv_prep_item(const Ctx& C, const AP& a, int l, int ti) {
    unsigned char* ws = a.ws;
    LAS bf16_t* zsb = (LAS bf16_t*)C.lds;
    LAS bf16_t* hidb = (LAS bf16_t*)(C.lds + 33280);
    const float* proj = (const float*)(ws + WS_PROJ);
    const int m0 = ti * 32, s0 = m0 & (SEQ - 1), tid = C.tid, lane = C.lane, w = C.wave;
    const float* mu = a.in[15] + (size_t)l * 4 * 2 * 512;
    float* RW = (float*)(ws + WS_RW); float* KS = (float*)(ws + WS_KS);
    {
        const int c = tid;
        const float mr0 = mu[0 * 512 + c], mr1 = mu[1 * 512 + c], mk0 = mu[2 * 512 + c], mk1 = mu[3 * 512 + c], mv0 = mu[4 * 512 + c], mv1 = mu[5 * 512 + c], mz0 = mu[6 * 512 + c], mz1 = mu[7 * 512 + c];
        const float kk_c = a.in[24][l * 512 + c];
#pragma unroll 1
        for (int hf = 0; hf < 2; ++hf) {
            const int tb0 = hf * 16;
            const float* rp = proj + (size_t)(m0 + tb0) * PROJ + 2048 + c;
            float rr[18], kr[18], vr[18], zr[18];
#pragma unroll
            for (int i = 0; i < 18; ++i) {
                const int sq = s0 + tb0 - 1 + i; const bool ok = (sq >= 0) && (sq < SEQ); const float* q = rp + (long)(i - 1) * PROJ;
                rr[i] = ok ? q[0] : 0.f; kr[i] = ok ? q[512] : 0.f; vr[i] = ok ? q[1024] : 0.f; zr[i] = ok ? q[1536] : 0.f;
            }
#pragma unroll
            for (int t = 0; t < 16; ++t) {
                const float rs = shift3(rr[t], rr[t + 1], rr[t + 2], mr0, mr1), ks = shift3(kr[t], kr[t + 1], kr[t + 2], mk0, mk1);
                const float vs = shift3(vr[t], vr[t + 1], vr[t + 2], mv0, mv1), zs = shift3(zr[t], zr[t + 1], zr[t + 2], mz0, mz1);
                const float kkr = ks * kk_c; const float kkn = kkr * rsqrtf(wave_sum(kkr * kkr) + 1e-12f);
                const size_t o = (size_t)(m0 + tb0 + t) * 512 + c;
                RW[(size_t)RW_R * RWSZ + o] = rs; RW[(size_t)RW_V * RWSZ + o] = vs; RW[(size_t)RW_KK * RWSZ + o] = kkn; KS[o] = ks;
                zsb[(tb0 + t) * 520 + c] = (bf16_t)f2bf(zs);
            }
        }
    }
    __syncthreads();
    const int fr = lane & 15, fq = lane >> 4;
    const bf16_t* W1T = (const bf16_t*)(ws + WS_LORA) + (size_t)l * 224 * 512; const bf16_t* g2T = (const bf16_t*)(ws + WS_LORA) + 2 * 224 * 512 + (size_t)l * 512 * 96;
    const bf16_t* w2T = (const bf16_t*)(ws + WS_LORA) + 2 * 224 * 512 + 2 * 512 * 96 + (size_t)l * 2 * 512 * 32; const bf16_t* a2T = w2T + 2 * 2 * 512 * 32;
    for (int tile = w; tile < 28; tile += 8) {
        const int mt = tile / 14, nt = tile % 14;
        f32x4 acc = {0.f, 0.f, 0.f, 0.f};
        const LAS bf16_t* ap = zsb + (mt * 16 + fr) * 520 + fq * 8; const bf16_t* bp = W1T + (size_t)(nt * 16 + fr) * 512 + fq * 8;
#pragma unroll
        for (int kk = 0; kk < 16; ++kk) acc = __builtin_amdgcn_mfma_f32_16x16x32_bf16(*(const LAS bf16x8_t*)(ap + kk * 32), *(const bf16x8_t*)(bp + kk * 32), acc, 0, 0, 0);
        const int hj = nt * 16 + fr;
#pragma unroll
        for (int j = 0; j < 4; ++j) { float v = acc[j]; if (hj < 96) v = sigmoidf_(v); else if (hj < 160) v = tanhf(v); hidb[(mt * 16 + fq * 4 + j) * 240 + hj] = (bf16_t)f2bf(v); }
    }
    __syncthreads();
#pragma unroll 1
    for (int mt = 0; mt < 2; ++mt) {
        bf16x8_t a7[7];
#pragma unroll
        for (int kk = 0; kk < 7; ++kk) a7[kk] = *(const LAS bf16x8_t*)(hidb + (mt * 16 + fr) * 240 + kk * 32 + fq * 8);
        float pb0[4] = {0.f, 0.f, 0.f, 0.f}, pb1[4] = {0.f, 0.f, 0.f, 0.f}, vsr[4][4];
        float cks[4], ckk[4], crs[4], nks[4], nkk[4], nrs[4];
#pragma unroll
        for (int j = 0; j < 4; ++j) { const size_t o = (size_t)(m0 + mt * 16 + fq * 4 + j) * 512 + w * 64 + fr;
            cks[j] = KS[o]; ckk[j] = RW[(size_t)RW_KK * RWSZ + o]; crs[j] = RW[(size_t)RW_R * RWSZ + o]; vsr[0][j] = RW[(size_t)RW_V * RWSZ + o]; }
#pragma unroll
        for (int nt = 0; nt < 4; ++nt) {
            if (nt < 3) {
#pragma unroll
                for (int j = 0; j < 4; ++j) { const size_t o = (size_t)(m0 + mt * 16 + fq * 4 + j) * 512 + w * 64 + (nt + 1) * 16 + fr;
                    nks[j] = KS[o]; nkk[j] = RW[(size_t)RW_KK * RWSZ + o]; nrs[j] = RW[(size_t)RW_R * RWSZ + o]; vsr[nt + 1][j] = RW[(size_t)RW_V * RWSZ + o]; }
            }
            const int ch = w * 64 + nt * 16 + fr;
            f32x4 ag = {0.f, 0.f, 0.f, 0.f}, aw0 = ag, aw1 = ag, aa0 = ag, aa1 = ag;
#pragma unroll
            for (int kk = 0; kk < 3; ++kk) ag = __builtin_amdgcn_mfma_f32_16x16x32_bf16(a7[kk], *(const bf16x8_t*)(g2T + (size_t)ch * 96 + kk * 32 + fq * 8), ag, 0, 0, 0);
            aw0 = __builtin_amdgcn_mfma_f32_16x16x32_bf16(a7[3], *(const bf16x8_t*)(w2T + (size_t)(0 * 512 + ch) * 32 + fq * 8), aw0, 0, 0, 0);
            aw1 = __builtin_amdgcn_mfma_f32_16x16x32_bf16(a7[4], *(const bf16x8_t*)(w2T + (size_t)(1 * 512 + ch) * 32 + fq * 8), aw1, 0, 0, 0);
            aa0 = __builtin_amdgcn_mfma_f32_16x16x32_bf16(a7[5], *(const bf16x8_t*)(a2T + (size_t)(0 * 512 + ch) * 32 + fq * 8), aa0, 0, 0, 0);
            aa1 = __builtin_amdgcn_mfma_f32_16x16x32_bf16(a7[6], *(const bf16x8_t*)(a2T + (size_t)(1 * 512 + ch) * 32 + fq * 8), aa1, 0, 0, 0);
            const float w00 = a.in[16][(l * 2 + 0) * 512 + ch], w01 = a.in[16][(l * 2 + 1) * 512 + ch], a00 = a.in[19][(l * 2 + 0) * 512 + ch], a01 = a.in[19][(l * 2 + 1) * 512 + ch];
            const float ka_c = a.in[25][l * 512 + ch], rk_c = a.in[26][l * 512 + ch];
#pragma unroll
            for (int j = 0; j < 4; ++j) {
                const size_t o = (size_t)(m0 + mt * 16 + fq * 4 + j) * 512 + ch;
                const float ks = cks[j], kkn = ckk[j], rs = crs[j];
#pragma unroll
                for (int d = 0; d < 2; ++d) {
                    const float wl = (d ? w01 : w00) + (d ? aw1[j] : aw0[j]);
                    const float nx = -wl, sp = fmaxf(nx, 0.f) + log1pf(__expf(-fabsf(nx)));
                    const float decay = __expf(-__expf(-sp - 0.5f));
                    const float av = sigmoidf_((d ? a01 : a00) + (d ? aa1[j] : aa0[j]));
                    const float kd = ks * (1.f + (av - 1.f) * ka_c), bb = kkn * av;
                    if (d) pb1[j] += rs * kd * rk_c; else pb0[j] += rs * kd * rk_c;
                    RW[(size_t)(RW_W0 + d) * RWSZ + o] = decay; RW[(size_t)(RW_KD0 + d) * RWSZ + o] = kd; RW[(size_t)(RW_B0 + d) * RWSZ + o] = bb;
                }
                RW[(size_t)RW_G * RWSZ + o] = ag[j];
            }
#pragma unroll
            for (int j = 0; j < 4; ++j) { cks[j] = nks[j]; ckk[j] = nkk[j]; crs[j] = nrs[j]; }
        }
#pragma unroll
        for (int j = 0; j < 4; ++j) { const float tb = row_sum16(pb0[j]) + row_sum16(pb1[j]);
#pragma unroll
            for (int nt = 0; nt < 4; ++nt) RW[(size_t)RW_BONUS * RWSZ + (size_t)(m0 + mt * 16 + fq * 4 + j) * 512 + w * 64 + nt * 16 + fr] = tb * vsr[nt][j]; }
    }
    __syncthreads();
}

__device__ __forceinline__ void rwkv_chunk_pre(const AP& a, int cid, int lane, LAS unsigned char* wl) {
    unsigned char* ws = a.ws;
    const int c = cid & 127, ci = cid >> 7, d = ci & 1, h = (ci >> 1) & 7, b = ci >> 4, fr = lane & 15, fq = lane >> 4;
    const float* RW = (const float*)(ws + WS_RW);
    unsigned char* rec = ws + WS_RWC + (size_t)cid * RWC_REC;
    LAS bf16_t* KH = (LAS bf16_t*)wl; LAS bf16_t* BC = KH + 1152; LAS bf16_t* KC = BC + 1152; LAS bf16_t* RH = KC + 1152;
    LAS bf16_t* KHT = RH + 1152;
    LAS float* Am = (LAS float*)(wl + 11264); LAS float* Bmm = Am + 256; LAS float* Abm = Bmm + 256; LAS float* Akm = Abm + 256; LAS float* Tm = Akm + 256;
    const size_t tok0 = (size_t)b * SEQ; const int colk = h * 64 + lane;
#define TOKI(i) (tok0 + (size_t)(d ? (SEQ - 1 - (c * 16 + (i))) : (c * 16 + (i))))
    {
        float W[16];
#pragma unroll
        for (int i = 0; i < 16; ++i) W[i] = RW[(size_t)(RW_W0 + d) * RWSZ + TOKI(i) * 512 + colk];
#pragma unroll
        for (int i = 1; i < 16; ++i) W[i] *= W[i - 1];
        const float W15 = W[15];
        unsigned zt[16];
#pragma unroll
        for (int i = 0; i < 16; ++i) {
            const size_t o = TOKI(i) * 512 + colk;
            const float kap = RW[(size_t)RW_KK * RWSZ + o], bv = RW[(size_t)(RW_B0 + d) * RWSZ + o], kdv = RW[(size_t)(RW_KD0 + d) * RWSZ + o], rv = RW[(size_t)RW_R * RWSZ + o];
            const float wm1 = i ? W[i - 1] : 1.f, iw = 1.f / W[i], wr = W15 * iw;
            const unsigned kh = f2bf(kap * wm1);
            KH[i * 72 + lane] = (bf16_t)kh; KHT[lane * 16 + i] = (bf16_t)kh;
            BC[i * 72 + lane] = (bf16_t)f2bf(bv * iw); KC[i * 72 + lane] = (bf16_t)f2bf(kdv * iw); RH[i * 72 + lane] = (bf16_t)f2bf(rv * W[i]);
            const unsigned bb = f2bf(bv * wr), kb = f2bf(kdv * wr);
            const int sb = (i >> 2) * 8 + (i & 3), sk = sb + 4;
            if (sb & 1) zt[sb >> 1] |= bb << 16; else zt[sb >> 1] = bb;
            if (sk & 1) zt[sk >> 1] |= kb << 16; else zt[sk >> 1] = kb;
        }
        u32x4* zp = (u32x4*)(rec + 4096 + lane * 64);
#pragma unroll
        for (int q = 0; q < 4; ++q) zp[q] = (u32x4){zt[q * 4], zt[q * 4 + 1], zt[q * 4 + 2], zt[q * 4 + 3]};
        ((float*)(rec + 8192))[lane] = W15;
    }
    float Vq[4][4];
#pragma unroll
    for (int nt = 0; nt < 4; ++nt) {
#pragma unroll
        for (int r = 0; r < 4; ++r) Vq[nt][r] = RW[(size_t)RW_V * RWSZ + TOKI(fq * 4 + r) * 512 + h * 64 + nt * 16 + fr];
        u32x2 pv; pv.x = pk2(Vq[nt][0], Vq[nt][1]); pv.y = pk2(Vq[nt][2], Vq[nt][3]);
        *(u32x2*)(rec + 12800 + (nt * 64 + lane) * 8) = pv;
    }
    LDS_WAIT(); asm volatile("" ::: "memory");
    {
        f32x4 cA = {0.f, 0.f, 0.f, 0.f}, cB = cA, cAb = cA, cAk = cA;
#pragma unroll
        for (int s2 = 0; s2 < 2; ++s2) {
            const int off = fr * 72 + s2 * 32 + fq * 8;
            const bf16x8_t fkh = *(const LAS bf16x8_t*)(KH + off), fbc = *(const LAS bf16x8_t*)(BC + off), fkc = *(const LAS bf16x8_t*)(KC + off), frh = *(const LAS bf16x8_t*)(RH + off);
            cA = __builtin_amdgcn_mfma_f32_16x16x32_bf16(fkh, fbc, cA, 0, 0, 0); cB = __builtin_amdgcn_mfma_f32_16x16x32_bf16(fkh, fkc, cB, 0, 0, 0);
            cAb = __builtin_amdgcn_mfma_f32_16x16x32_bf16(frh, fbc, cAb, 0, 0, 0); cAk = __builtin_amdgcn_mfma_f32_16x16x32_bf16(frh, fkc, cAk, 0, 0, 0);
        }
#pragma unroll
        for (int r = 0; r < 4; ++r) { const int i = fq * 4 + r, j = fr;
            Am[i * 16 + j] = j < i ? cA[r] : 0.f; Bmm[i * 16 + j] = j < i ? cB[r] : 0.f; Abm[i * 16 + j] = j <= i ? cAb[r] : 0.f; Akm[i * 16 + j] = j <= i ? cAk[r] : 0.f; }
    }
    LDS_WAIT(); asm volatile("" ::: "memory");
    {
        float x[16];
#pragma unroll
        for (int i = 0; i < 16; ++i) {
            float sacc = (i == fr) ? 1.f : 0.f;
#pragma unroll
            for (int jq = 0; jq < (i + 3) / 4; ++jq) { const f32x4 q = *(const LAS f32x4*)(Am + i * 16 + jq * 4);
#pragma unroll
                for (int e = 0; e < 4; ++e) if (jq * 4 + e < i) sacc -= q[e] * x[jq * 4 + e]; }
            x[i] = sacc;
        }
        if (fq == 0) {
#pragma unroll
            for (int i = 0; i < 16; ++i) Tm[i * 16 + fr] = x[i];
        }
    }
    LDS_WAIT(); asm volatile("" ::: "memory");
    {
        const f32x4 qT = *(const LAS f32x4*)(Tm + fr * 16 + fq * 4), qB = *(const LAS f32x4*)(Bmm + fr * 16 + fq * 4), qAb = *(const LAS f32x4*)(Abm + fr * 16 + fq * 4), qAk = *(const LAS f32x4*)(Akm + fr * 16 + fq * 4);
        const unsigned ab0 = pk2(qAb[0], qAb[1]), ab1 = pk2(qAb[2], qAb[3]);
        const bf16x8_t aT = mk8(pk2(qT[0], qT[1]), pk2(qT[2], qT[3]), 0u, 0u), aBm = mk8(pk2(qB[0], qB[1]), pk2(qB[2], qB[3]), 0u, 0u);
        const bf16x8_t aAb = mk8(ab0, ab1, 0u, 0u), aAbAk = mk8(ab0, ab1, pk2(qAk[0], qAk[1]), pk2(qAk[2], qAk[3]));
        const f32x4 z4 = {0.f, 0.f, 0.f, 0.f};
#pragma unroll
        for (int nt = 0; nt < 4; ++nt) {
            const u32x2 kq = *(const LAS u32x2*)(KHT + (nt * 16 + fr) * 16 + fq * 4);
            f32x4 ut = __builtin_amdgcn_mfma_f32_16x16x32_bf16(aT, mk8(kq.x, kq.y, 0u, 0u), z4, 0, 0, 0); ut = -ut;
            const unsigned v0 = pk2(Vq[nt][0], Vq[nt][1]), v1 = pk2(Vq[nt][2], Vq[nt][3]);
            const f32x4 bmv = __builtin_amdgcn_mfma_f32_16x16x32_bf16(aBm, mk8(v0, v1, 0u, 0u), z4, 0, 0, 0);
            f32x4 ul = __builtin_amdgcn_mfma_f32_16x16x32_bf16(aT, mk8(pk2(bmv[0], bmv[1]), pk2(bmv[2], bmv[3]), 0u, 0u), z4, 0, 0, 0); ul = -ul;
            const unsigned u0 = pk2(ut[0], ut[1]), u1 = pk2(ut[2], ut[3]);
            f32x4 yh = __builtin_amdgcn_mfma_f32_16x16x32_bf16(aAb, mk8(u0, u1, 0u, 0u), z4, 0, 0, 0);
#pragma unroll
            for (int r = 0; r < 4; ++r) yh[r] += bflo((unsigned)RH[(fq * 4 + r) * 72 + nt * 16 + fr]);
            const unsigned l0 = pk2(ul[0], ul[1]), l1 = pk2(ul[2], ul[3]);
            const f32x4 yl = __builtin_amdgcn_mfma_f32_16x16x32_bf16(aAbAk, mk8(l0, l1, v0, v1), z4, 0, 0, 0);
            const int s2 = nt >> 1, slot = (fr >> 2) * 8 + (fr & 3) + ((nt & 1) ? 4 : 0);
            bf16_t* m0p = (bf16_t*)rec + ((0 * 2 + s2) * 16) * 32 + slot; bf16_t* m1p = (bf16_t*)rec + ((1 * 2 + s2) * 16) * 32 + slot;
#pragma unroll
            for (int r = 0; r < 4; ++r) { m0p[(fq * 4 + r) * 32] = (bf16_t)((r & 1) ? (((r >> 1) ? u1 : u0) >> 16) : (((r >> 1) ? u1 : u0) & 0xffffu)); m1p[(fq * 4 + r) * 32] = (bf16_t)f2bf(yh[r]); }
            u32x2 pl; pl.x = l0; pl.y = l1; *(u32x2*)(rec + 8704 + (nt * 64 + lane) * 8) = pl;
            u32x2 py; py.x = pk2(yl[0], yl[1]); py.y = pk2(yl[2], yl[3]); *(u32x2*)(rec + 10752 + (nt * 64 + lane) * 8) = py;
        }
    }
    LDS_WAIT(); asm volatile("" ::: "memory");
#undef TOKI
}
__device__ __forceinline__ void vm_wait_chunks(int n) {
    switch (n) { case 0: asm volatile("s_waitcnt vmcnt(0)" ::: "memory"); break; case 1: asm volatile("s_waitcnt vmcnt(4)" ::: "memory"); break;
                 case 2: asm volatile("s_waitcnt vmcnt(8)" ::: "memory"); break; case 3: asm volatile("s_waitcnt vmcnt(12)" ::: "memory"); break;
                 case 4: asm volatile("s_waitcnt vmcnt(16)" ::: "memory"); break; case 5: asm volatile("s_waitcnt vmcnt(20)" ::: "memory"); break;
                 default: asm volatile("s_waitcnt vmcnt(24)" ::: "memory"); break; }
}
__device__ __forceinline__ void rwkv_seq_chain(const Ctx& C, const AP& a, int ci) {
    unsigned char* ws = a.ws;
    const int w = C.wave, lane = C.lane, fr = lane & 15, fq = lane >> 4, d = ci & 1, h = (ci >> 1) & 7, b = ci >> 4;
    const unsigned char* recs = ws + WS_RWC + (size_t)ci * 128 * RWC_REC;
    LAS unsigned char* ring = C.lds;
    const bool loader = w >= 4; const int lw = w - 4;
#define RWC_ISSUE(cc) do { _Pragma("unroll") for (int p_ = 0; p_ < 4; ++p_) { const int pc_ = (lw * 4 + p_) < 15 ? (lw * 4 + p_) : 14; \
        __builtin_amdgcn_global_load_lds((const unsigned*)(recs + (size_t)(cc) * RWC_REC + pc_ * 1024 + lane * 16), (LAS unsigned*)(ring + ((cc) & 7) * RWC_REC + pc_ * 1024), 16, 0, 0); } } while (0)
    if (loader) {
#pragma unroll 1
        for (int cc = 0; cc < 8; ++cc) RWC_ISSUE(cc);
        asm volatile("s_waitcnt vmcnt(28)" ::: "memory");
    }
    __builtin_amdgcn_s_barrier(); asm volatile("" ::: "memory");
    f32x4 ST[4];
#pragma unroll
    for (int kt = 0; kt < 4; ++kt) ST[kt] = (f32x4){0.f, 0.f, 0.f, 0.f};
    float* Y = (float*)(ws + WS_YRW) + (size_t)d * RWSZ + (size_t)b * SEQ * 512 + h * 64 + w * 16 + fr;
#pragma unroll 1
    for (int c = 0; c < 128; ++c) {
        if (!loader) {
            const LAS unsigned char* sl = ring + (c & 7) * RWC_REC;
            const bf16x8_t a00 = *(const LAS bf16x8_t*)(sl + (0 * 16 + fr) * 64 + fq * 16), a01 = *(const LAS bf16x8_t*)(sl + (1 * 16 + fr) * 64 + fq * 16);
            const bf16x8_t a10 = *(const LAS bf16x8_t*)(sl + (2 * 16 + fr) * 64 + fq * 16), a11 = *(const LAS bf16x8_t*)(sl + (3 * 16 + fr) * 64 + fq * 16);
            const u32x2 ulw = *(const LAS u32x2*)(sl + 8704 + (w * 64 + lane) * 8), ylw = *(const LAS u32x2*)(sl + 10752 + (w * 64 + lane) * 8), vpw = *(const LAS u32x2*)(sl + 12800 + (w * 64 + lane) * 8);
            const bf16x8_t bs0 = mk8(pk2(ST[0][0], ST[0][1]), pk2(ST[0][2], ST[0][3]), pk2(ST[1][0], ST[1][1]), pk2(ST[1][2], ST[1][3]));
            const bf16x8_t bs1 = mk8(pk2(ST[2][0], ST[2][1]), pk2(ST[2][2], ST[2][3]), pk2(ST[3][0], ST[3][1]), pk2(ST[3][2], ST[3][3]));
            const f32x4 z4 = {0.f, 0.f, 0.f, 0.f};
            f32x4 g0 = __builtin_amdgcn_mfma_f32_16x16x32_bf16(a00, bs0, z4, 0, 0, 0); g0 = __builtin_amdgcn_mfma_f32_16x16x32_bf16(a01, bs1, g0, 0, 0, 0);
            f32x4 g1 = __builtin_amdgcn_mfma_f32_16x16x32_bf16(a10, bs0, z4, 0, 0, 0); g1 = __builtin_amdgcn_mfma_f32_16x16x32_bf16(a11, bs1, g1, 0, 0, 0);
            const float uf0 = g0[0] + bflo(ulw.x), uf1 = g0[1] + bfhi(ulw.x), uf2 = g0[2] + bflo(ulw.y), uf3 = g0[3] + bfhi(ulw.y);
            const bf16x8_t xb = mk8(pk2(uf0, uf1), pk2(uf2, uf3), vpw.x, vpw.y);
#pragma unroll
            for (int kt = 0; kt < 4; ++kt) {
                const f32x4 dq = *(const LAS f32x4*)(sl + 8192 + (kt * 16 + fq * 4) * 4);
                const bf16x8_t az = *(const LAS bf16x8_t*)(sl + 4096 + (kt * 16 + fr) * 64 + fq * 16);
                ST[kt] = __builtin_amdgcn_mfma_f32_16x16x32_bf16(az, xb, ST[kt] * dq, 0, 0, 0);
            }
            const float y0 = g1[0] + bflo(ylw.x), y1 = g1[1] + bfhi(ylw.x), y2 = g1[2] + bflo(ylw.y), y3 = g1[3] + bfhi(ylw.y);
            const int sbase = c * 16 + fq * 4;
            Y[(size_t)(d ? SEQ - 1 - (sbase + 0) : sbase + 0) * 512] = y0; Y[(size_t)(d ? SEQ - 1 - (sbase + 1) : sbase + 1) * 512] = y1;
            Y[(size_t)(d ? SEQ - 1 - (sbase + 2) : sbase + 2) * 512] = y2; Y[(size_t)(d ? SEQ - 1 - (sbase + 3) : sbase + 3) * 512] = y3;
            asm volatile("s_waitcnt lgkmcnt(0)" ::: "memory");
        } else if (c + 1 < 128) {
            const int lastc = (c + 7 < 127) ? c + 7 : 127;
            vm_wait_chunks(lastc - (c + 1));
        }
        __builtin_amdgcn_s_barrier(); asm volatile("" ::: "memory");
        if (loader && c + 8 < 128) RWC_ISSUE(c + 8);
    }
    asm volatile("s_waitcnt vmcnt(0)" ::: "memory");
    __builtin_amdgcn_s_barrier(); asm volatile("" ::: "memory");
#undef RWC_ISSUE
}

__device__ __forceinline__ float dpp_sum8(float x) {
    x += __builtin_bit_cast(float, __builtin_amdgcn_update_dpp(0, __builtin_bit_cast(int, x), 0xB1, 0xF, 0xF, true));
    x += __builtin_bit_cast(float, __builtin_amdgcn_update_dpp(0, __builtin_bit_cast(int, x), 0x4E, 0xF, 0xF, true));
    x += __builtin_bit_cast(float, __builtin_amdgcn_update_dpp(0, __builtin_bit_cast(int, x), 0x141, 0xF, 0xF, true));
    return x;
}
__device__ __forceinline__ void rwkv_scan_item(const Ctx& C, const AP& a, int item) {
    unsigned char* ws = a.ws;
    const int d = item & 1, h = (item >> 1) & 7, b = item >> 4, tid = C.tid, v = tid >> 3, kq = tid & 7;
    const float* RW = (const float*)(ws + WS_RW);
    const float* arr[6] = { RW + (size_t)RW_KK * RWSZ, RW + (size_t)(RW_W0 + d) * RWSZ, RW + (size_t)(RW_B0 + d) * RWSZ, RW + (size_t)(RW_KD0 + d) * RWSZ, RW + (size_t)RW_R * RWSZ, RW + (size_t)RW_V * RWSZ };
    float* Y = (float*)(ws + WS_YRW) + (size_t)d * RWSZ;
    LAS float* buf = (LAS float*)C.lds;
    const int ls = tid >> 4, lq = tid & 15;
    f32x4 stg[6];
    const size_t colbase = (size_t)h * 64;
#define RW_LOAD(ch) do { const int s_ = (ch) * 32 + ls, t_ = d ? (SEQ - 1 - s_) : s_; const size_t o_ = ((size_t)(b * SEQ + t_)) * 512 + colbase + lq * 4; \
        _Pragma("unroll") for (int q_ = 0; q_ < 6; ++q_) stg[q_] = *(const f32x4*)(arr[q_] + o_); } while (0)
#define RW_WRITE(bi) do { _Pragma("unroll") for (int q_ = 0; q_ < 6; ++q_) *(LAS f32x4*)(buf + (((bi) * 6 + q_) * 32 + ls) * 64 + lq * 4) = stg[q_]; } while (0)
    float S[8];
#pragma unroll
    for (int j = 0; j < 8; ++j) S[j] = 0.f;
    RW_LOAD(0); RW_WRITE(0); __syncthreads();
    for (int ch = 0; ch < SEQ / 32; ++ch) {
        const int bi = ch & 1;
        if (ch + 1 < SEQ / 32) RW_LOAD(ch + 1);
        const LAS float* B0 = buf + (bi * 6) * 32 * 64;
        for (int st = 0; st < 32; ++st) {
            const LAS float* bp = B0 + st * 64 + kq * 8;
            const f32x4 k0 = *(const LAS f32x4*)(bp), k1 = *(const LAS f32x4*)(bp + 4);
            const f32x4 w0 = *(const LAS f32x4*)(bp + 2048), w1 = *(const LAS f32x4*)(bp + 2048 + 4);
            const f32x4 b0 = *(const LAS f32x4*)(bp + 4096), b1 = *(const LAS f32x4*)(bp + 4096 + 4);
            const f32x4 d0 = *(const LAS f32x4*)(bp + 6144), d1 = *(const LAS f32x4*)(bp + 6144 + 4);
            const f32x4 r0 = *(const LAS f32x4*)(bp + 8192), r1 = *(const LAS f32x4*)(bp + 8192 + 4);
            const float vv = B0[10240 + st * 64 + v];
            float sa = S[0] * k0[0] + S[1] * k0[1] + S[2] * k0[2] + S[3] * k0[3] + S[4] * k1[0] + S[5] * k1[1] + S[6] * k1[2] + S[7] * k1[3];
            sa = -dpp_sum8(sa);
            float y = 0.f;
#pragma unroll
            for (int j = 0; j < 4; ++j) { S[j] = S[j] * w0[j] + (sa * b0[j] + vv * d0[j]); y += S[j] * r0[j]; S[4 + j] = S[4 + j] * w1[j] + (sa * b1[j] + vv * d1[j]); y += S[4 + j] * r1[j]; }
            y = dpp_sum8(y);
            if (kq == 0) { const int s_ = ch * 32 + st, t_ = d ? (SEQ - 1 - s_) : s_; Y[((size_t)(b * SEQ + t_)) * 512 + colbase + v] = y; }
        }
        if (ch + 1 < SEQ / 32) RW_WRITE(bi ^ 1);
        __syncthreads();
    }
#undef RW_LOAD
#undef RW_WRITE
}
__device__ __forceinline__ void rwkv_post_item(const AP& a, int l, int item, int lane) {
    unsigned char* ws = a.ws;
    const int hh = item & 7, m = item >> 3, c = hh * 64 + lane; const size_t o = (size_t)m * 512 + c;
    const float* Y = (const float*)(ws + WS_YRW); const float* RW = (const float*)(ws + WS_RW);
    const float y = Y[o] + Y[RWSZ + o];
    const float mean = wave_sum(y) * (1.f / 64.f), dv = y - mean, var = wave_sum(dv * dv) * (1.f / 64.f);
    const float yn = dv * rsqrtf(var + 64e-5f) * a.in[27][l * 512 + c] + a.in[28][l * 512 + c];
    ((float*)(ws + WS_YA))[(size_t)3 * RWSZ + o] = (yn + RW[(size_t)RW_BONUS * RWSZ + o]) * RW[(size_t)RW_G * RWSZ + o];
}
__device__ __forceinline__ void c1_fold_item(const AP& a, int row, int lane) {
    const unsigned short* src = (const unsigned short*)(a.ws + WS_C1) + (size_t)row * 4096;
    unsigned short* dst = (unsigned short*)(a.ws + WS_C1F) + (size_t)row * 2048;
#pragma unroll 8
    for (int i = 0; i < 32; ++i) {
        const int j = i * 64 + lane; float v;
        if (j <= 1024) { const float x0 = __uint_as_float((unsigned)src[j] << 16); const int jm = (j >= 1 && j <= 1023) ? 2048 - j : j;
            const float x1 = __uint_as_float((unsigned)src[jm] << 16); v = (j >= 1 && j <= 1023) ? x0 + x1 : x0; }
        else { const int sidx = j - 1024; v = __uint_as_float((unsigned)src[2048 + sidx] << 16) - __uint_as_float((unsigned)src[2048 + 2048 - sidx] << 16); }
        dst[j] = (unsigned short)f2bf(v);
    }
}
__device__ __forceinline__ void branch_d_item(const AP& a, int l, int m, int lane) {
    unsigned char* ws = a.ws;
    const float* Y = (const float*)(ws + WS_YRW); const float* RW = (const float*)(ws + WS_RW);
    float o[8]; float ss = 0.f;
#pragma unroll
    for (int hh = 0; hh < 8; ++hh) {
        const int c = hh * 64 + lane; const size_t ix = (size_t)m * 512 + c;
        const float y = Y[ix] + Y[RWSZ + ix];
        const float mean = wave_sum(y) * (1.f / 64.f), dv = y - mean, var = wave_sum(dv * dv) * (1.f / 64.f);
        const float yn = dv * rsqrtf(var + 64e-5f) * a.in[27][l * 512 + c] + a.in[28][l * 512 + c];
        o[hh] = (yn + RW[(size_t)RW_BONUS * RWSZ + ix]) * RW[(size_t)RW_G * RWSZ + ix]; ss += o[hh] * o[hh];
    }
    const float rs = rsqrtf(wave_sum(ss) * (1.f / 512.f) + 1e-6f);
    bf16_t* dst = (bf16_t*)(ws + WS_HB) + (size_t)m * DM + 1536 + lane;
#pragma unroll
    for (int hh = 0; hh < 8; ++hh) dst[hh * 64] = (bf16_t)f2bf(o[hh] * rs);
}
__device__ __forceinline__ void branch_norm_item(const AP& a, int item, int lane) {
    unsigned char* ws = a.ws;
    const int br = item & 3, m = item >> 2;
    const f32x4* src = (const f32x4*)((const float*)(ws + WS_YA) + (size_t)br * RWSZ + (size_t)m * 512) + lane;
    const f32x4 v0 = src[0], v1 = src[64];
    const float ss = wave_sum(v0.x * v0.x + v0.y * v0.y + v0.z * v0.z + v0.w * v0.w + v1.x * v1.x + v1.y * v1.y + v1.z * v1.z + v1.w * v1.w);
    const float rs = rsqrtf(ss * (1.f / 512.f) + 1e-6f);
    u32x2* dst = (u32x2*)((bf16_t*)(ws + WS_HB) + (size_t)m * DM + br * 512) + lane;
    u32x2 w; w.x = pk2(v0.x * rs, v0.y * rs); w.y = pk2(v0.z * rs, v0.w * rs); dst[0] = w;
    w.x = pk2(v1.x * rs, v1.y * rs); w.y = pk2(v1.z * rs, v1.w * rs); dst[64] = w;
}

__device__ __forceinline__ unsigned fkey(float f) { const unsigned u = __float_as_uint(f); return (u & 0x80000000u) ? ~u : (u | 0x80000000u); }
__device__ __forceinline__ int lane_rank(unsigned long long m) { return __builtin_amdgcn_mbcnt_hi((unsigned)(m >> 32), __builtin_amdgcn_mbcnt_lo((unsigned)m, 0)); }
template <int N>
__device__ __forceinline__ void top16_select(const float (&val)[N], const int (&idx)[N], LAS float* lv, LAS int* li) {
    unsigned k[N];
#pragma unroll
    for (int e = 0; e < N; ++e) k[e] = fkey(val[e]);
    unsigned T = 0;
    for (int bit = 31; bit >= 0; --bit) {
        const unsigned cand = T | (1u << bit); int cnt = 0;
#pragma unroll
        for (int e = 0; e < N; ++e) cnt += __popcll(__ballot(k[e] >= cand));
        if (cnt >= 16) T = cand;
        if (cnt == 16) break;
    }
    int ngt = 0;
#pragma unroll
    for (int e = 0; e < N; ++e) ngt += __popcll(__ballot(k[e] > T));
    const int need = 16 - ngt; int eqbase = 0, posbase = 0;
#pragma unroll
    for (int e = 0; e < N; ++e) {
        const unsigned long long meq = __ballot(k[e] == T);
        const int eqrank = eqbase + lane_rank(meq);
        const bool sel = (k[e] > T) || (k[e] == T && eqrank < need);
        const unsigned long long msel = __ballot(sel);
        const int pos = posbase + lane_rank(msel);
        if (sel) { lv[pos] = val[e]; li[pos] = idx[e]; }
        eqbase += __popcll(meq); posbase += __popcll(msel);
    }
    LDS_WAIT(); asm volatile("" ::: "memory");
}
__device__ __forceinline__ float dpp_xor1(float x) { return __builtin_bit_cast(float, __builtin_amdgcn_update_dpp(0, __builtin_bit_cast(int, x), 0xB1, 0xF, 0xF, true)); }
__device__ __forceinline__ float dpp_xor2(float x) { return __builtin_bit_cast(float, __builtin_amdgcn_update_dpp(0, __builtin_bit_cast(int, x), 0x4E, 0xF, 0xF, true)); }
__device__ __forceinline__ float reduce8(const float (&v)[8], int lane) {
    const bool b0 = lane & 1, b1 = lane & 2, b2 = lane & 4;
    float w4[4], w2[2];
#pragma unroll
    for (int k = 0; k < 4; ++k) { const float keep = b0 ? v[4 + k] : v[k], send = b0 ? v[k] : v[4 + k]; w4[k] = keep + dpp_xor1(send); }
#pragma unroll
    for (int k = 0; k < 2; ++k) { const float keep = b1 ? w4[2 + k] : w4[k], send = b1 ? w4[k] : w4[2 + k]; w2[k] = keep + dpp_xor2(send); }
    const float keep = b2 ? w2[1] : w2[0], send = b2 ? w2[0] : w2[1];
    float r = keep + __shfl_xor(send, 4);
    r += __shfl_xor(r, 8); r += __shfl_xor(r, 16); r += __shfl_xor(r, 32);
    return r;
}
typedef float f32x2v __attribute__((ext_vector_type(2)));
__device__ __forceinline__ void split8(const f32x4 a0, const f32x4 a1, bf16x8_t& hi, bf16x8_t& lo) {
    unsigned h[4], l_[4];
#pragma unroll
    for (int i = 0; i < 4; ++i) { const float x0 = i < 2 ? a0[2 * i] : a1[2 * i - 4], x1 = i < 2 ? a0[2 * i + 1] : a1[2 * i - 3];
        const unsigned h0 = f2bf(x0), h1 = f2bf(x1); h[i] = h0 | (h1 << 16);
        l_[i] = pk2(x0 - __uint_as_float(h0 << 16), x1 - __uint_as_float(h1 << 16)); }
    hi = mk8(h[0], h[1], h[2], h[3]); lo = mk8(l_[0], l_[1], l_[2], l_[3]);
}
__device__ __forceinline__ void peer_select_head(const f32x2 s0, const f32x2 s1, int lane, LAS float* wl, LAS int* fe, LAS float* fg, int ci_i, int ci_j, bool cand_on) {
    { const float v0[2] = {s0.x, s0.y}; const int i0[2] = {2 * lane, 2 * lane + 1}; top16_select<2>(v0, i0, wl, (LAS int*)(wl + 16)); }
    { const float v1[2] = {s1.x, s1.y}; const int i1[2] = {2 * lane, 2 * lane + 1}; top16_select<2>(v1, i1, wl + 32, (LAS int*)(wl + 48)); }
    if (lane < 32) { const int lst = lane >> 4, ii = lane & 15; const LAS float* lv = wl + lst * 32;
      const float v = lv[ii]; const int ix = ((const LAS int*)lv)[16 + ii]; int rank = 0;
#pragma unroll
      for (int jq = 0; jq < 4; ++jq) { const f32x4 q = *(const LAS f32x4*)(lv + jq * 4);
#pragma unroll
          for (int e = 0; e < 4; ++e) rank += (q[e] > v || (q[e] == v && (jq * 4 + e) < ii)) ? 1 : 0; }
      wl[64 + lst * 32 + rank] = v; ((LAS int*)wl)[64 + lst * 32 + 16 + rank] = ix; }
    LDS_WAIT(); asm volatile("" ::: "memory");
    { const float cvv = cand_on ? wl[64 + ci_i] + wl[96 + ci_j] : -INFINITY;
      const float cv[1] = {cvv}; const int ci[1] = {ci_i * 16 + ci_j};
      top16_select<1>(cv, ci, wl + 128, (LAS int*)(wl + 144)); }
    { const bool act = lane < 16; const float sc = act ? wl[128 + lane] : -3.0e38f; const int fi = act ? ((LAS int*)wl)[144 + lane] : 0;
      const int e = ((LAS int*)wl)[80 + (fi >> 4)] * 128 + ((LAS int*)wl)[112 + (fi & 15)];
      const float mx = wave_max(sc), ex = act ? __expf(sc - mx) : 0.f, sm = wave_sum(ex);
      if (act) { fe[lane] = e; fg[lane] = ex / sm; } }
    LDS_WAIT(); asm volatile("" ::: "memory");
}
__device__ __forceinline__ void peer_tile(const Ctx& C, const AP& a, int l, int tile, const float* x1, float* xout, bool write_hb) {
    unsigned char* ws = a.ws;
    const int tid = C.tid, lane = C.lane, w = C.wave, tb = tile * 32;
    LAS float* keys = (LAS float*)C.lds;
    LAS int* rt_idx = (LAS int*)(C.lds + 65536);
    LAS float* rt_gate = (LAS float*)(C.lds + 81920);
    LAS float* wl = (LAS float*)(C.lds + 98304) + w * 256;
    LAS float* ssp = (LAS float*)(C.lds + 98304 + 8 * 1024);
    const float* qry = (const float*)(ws + WS_PROJ);
    int ci_i, ci_j; const bool cand_on = lane < 50;
    if (lane < 16) { ci_i = 0; ci_j = lane; } else if (lane < 24) { ci_i = 1; ci_j = lane - 16; } else if (lane < 29) { ci_i = 2; ci_j = lane - 24; }
    else if (lane < 33) { ci_i = 3; ci_j = lane - 29; } else if (lane < 36) { ci_i = 4; ci_j = lane - 33; } else if (lane < 38) { ci_i = 5; ci_j = lane - 36; }
    else if (lane < 40) { ci_i = 6; ci_j = lane - 38; } else if (lane < 42) { ci_i = 7; ci_j = lane - 40; } else if (lane < 50) { ci_i = lane - 34; ci_j = 0; } else { ci_i = 0; ci_j = 0; }
    float* Ssc = (float*)(ws + WS_RW) + (size_t)tile * 65536;
    { const int fr = lane & 15, fq = lane >> 4;
      LAS bf16_t* qbuf = (LAS bf16_t*)C.lds;
      const int prow = tid >> 4, pcol = (tid & 15) * 8;
#define PEER_QSTAGE(h_) do { const float* qp_ = qry + (size_t)(tb + prow) * 1024 + (h_) * 128 + pcol; bf16x8_t qh_, ql_; split8(*(const f32x4*)qp_, *(const f32x4*)(qp_ + 4), qh_, ql_); \
          LAS bf16_t* d_ = qbuf + ((h_) & 1) * 8704 + prow * 136 + pcol; *(LAS bf16x8_t*)d_ = qh_; *(LAS bf16x8_t*)(d_ + 4352) = ql_; } while (0)
      PEER_QSTAGE(0);
      f32x4 kraw[2][2][2];
#define PEER_KLOAD(h_) _Pragma("unroll") for (int pp = 0; pp < 2; ++pp) _Pragma("unroll") for (int ks = 0; ks < 2; ++ks) { \
          const float* kp = a.in[33] + ((size_t)(((l * 8 + (h_)) * 2 + pp) * 128 + 16 * w + fr)) * 64 + ks * 32 + fq * 8; kraw[pp][ks][0] = *(const f32x4*)kp; kraw[pp][ks][1] = *(const f32x4*)(kp + 4); }
      PEER_KLOAD(0)
      __syncthreads();
#pragma unroll 1
      for (int h = 0; h < 8; ++h) {
        if (h + 1 < 8) PEER_QSTAGE(h + 1);
        const LAS bf16_t* qh = qbuf + (h & 1) * 8704; const LAS bf16_t* ql = qh + 4352;
        bf16x8_t bhh[2][2], bll[2][2];
#pragma unroll
        for (int pp = 0; pp < 2; ++pp)
#pragma unroll
            for (int ks = 0; ks < 2; ++ks) split8(kraw[pp][ks][0], kraw[pp][ks][1], bhh[pp][ks], bll[pp][ks]);
        if (h + 1 < 8) { PEER_KLOAD(h + 1) }
#pragma unroll
        for (int pp = 0; pp < 2; ++pp) {
            const int hp = h * 2 + pp;
            bf16x8_t bh[2], bl[2];
#pragma unroll
            for (int ks = 0; ks < 2; ++ks) { bh[ks] = bhh[pp][ks]; bl[ks] = bll[pp][ks]; }
#pragma unroll
            for (int mt = 0; mt < 2; ++mt) { f32x4 acc = {0.f, 0.f, 0.f, 0.f};
#pragma unroll
                for (int ks = 0; ks < 2; ++ks) { const int qo = (mt * 16 + fr) * 136 + pp * 64 + ks * 32 + fq * 8;
                    const bf16x8_t ah = *(const LAS bf16x8_t*)(qh + qo), al = *(const LAS bf16x8_t*)(ql + qo);
                    acc = __builtin_amdgcn_mfma_f32_16x16x32_bf16(al, bh[ks], acc, 0, 0, 0); acc = __builtin_amdgcn_mfma_f32_16x16x32_bf16(ah, bl[ks], acc, 0, 0, 0);
                    acc = __builtin_amdgcn_mfma_f32_16x16x32_bf16(ah, bh[ks], acc, 0, 0, 0); }
#pragma unroll
                for (int r = 0; r < 4; ++r) Ssc[(size_t)(hp * 32 + mt * 16 + fq * 4 + r) * 128 + 16 * w + fr] = acc[r]; }
        }
        __syncthreads();
      }
#undef PEER_QSTAGE
#undef PEER_KLOAD
    }
    __syncthreads();
    const unsigned char* U6 = ws + WS_UB + (size_t)l * ETAB; const unsigned char* V4 = ws + WS_UB + 64 * MiB + (size_t)l * 16 * MiB;
    const float* Us = (const float*)(ws + WS_VB) + (0 * 2 + l) * 16384; const float* Vs = (const float*)(ws + WS_VB) + (1 * 2 + l) * 16384;
    bf16_t* hb = (bf16_t*)(ws + WS_HB);
    u32x4 ua[8]; u32x4 va[8]; float sul, svl, gl; float xf[32], acc[32];
#define PEER_IDS(mye_, ei_) _Pragma("unroll") for (int e = 0; e < 8; ++e) ei_[e] = __builtin_amdgcn_readlane(mye_, ((e >> 2) & 1) | (((e >> 1) & 1) << 1) | ((e & 1) << 2));
#define PEER_ISSUE_U(ei_, ln_) _Pragma("unroll") for (int e = 0; e < 8; ++e) ua[e] = ((const u32x4*)(U6 + (size_t)ei_[e] * 1024))[ln_];
#define PEER_ISSUE_V(ei_, ln_) _Pragma("unroll") for (int e = 0; e < 8; ++e) va[e] = ((const u32x4*)(V4 + (size_t)ei_[e] * 1024))[ln_];
#define PEER_DOTS(dot_) _Pragma("unroll") for (int e = 0; e < 8; ++e) { f32x2v s2 = {0.f, 0.f}; \
        _Pragma("unroll") for (int d4 = 0; d4 < 4; ++d4) { const unsigned wd = ua[e][d4]; \
            s2 = __builtin_elementwise_fma((f32x2v){xf[8 * d4 + 0], xf[8 * d4 + 1]}, __builtin_amdgcn_cvt_scalef32_pk_f32_fp4(wd, 1.0f, 0), s2); \
            s2 = __builtin_elementwise_fma((f32x2v){xf[8 * d4 + 2], xf[8 * d4 + 3]}, __builtin_amdgcn_cvt_scalef32_pk_f32_fp4(wd, 1.0f, 1), s2); \
            s2 = __builtin_elementwise_fma((f32x2v){xf[8 * d4 + 4], xf[8 * d4 + 5]}, __builtin_amdgcn_cvt_scalef32_pk_f32_fp4(wd, 1.0f, 2), s2); \
            s2 = __builtin_elementwise_fma((f32x2v){xf[8 * d4 + 6], xf[8 * d4 + 7]}, __builtin_amdgcn_cvt_scalef32_pk_f32_fp4(wd, 1.0f, 3), s2); } \
        dot_[e] = s2.x + s2.y; }
#define PEER_ACCUM(cfl_) _Pragma("unroll") for (int e = 0; e < 8; ++e) { \
        const int src = ((e >> 2) & 1) | (((e >> 1) & 1) << 1) | ((e & 1) << 2); \
        const float cf = __builtin_bit_cast(float, __builtin_amdgcn_readlane(__builtin_bit_cast(int, cfl_), src)); \
        _Pragma("unroll") for (int d4 = 0; d4 < 4; ++d4) { const unsigned wd = va[e][d4]; \
            const f32x2v p0 = __builtin_amdgcn_cvt_scalef32_pk_f32_fp4(wd, 1.0f, 0), p1 = __builtin_amdgcn_cvt_scalef32_pk_f32_fp4(wd, 1.0f, 1); \
            const f32x2v p2 = __builtin_amdgcn_cvt_scalef32_pk_f32_fp4(wd, 1.0f, 2), p3 = __builtin_amdgcn_cvt_scalef32_pk_f32_fp4(wd, 1.0f, 3); \
            acc[8 * d4 + 0] += cf * p0.x; acc[8 * d4 + 1] += cf * p0.y; acc[8 * d4 + 2] += cf * p1.x; acc[8 * d4 + 3] += cf * p1.y; \
            acc[8 * d4 + 4] += cf * p2.x; acc[8 * d4 + 5] += cf * p2.y; acc[8 * d4 + 6] += cf * p3.x; acc[8 * d4 + 7] += cf * p3.y; } \
        if (e < 7) {   \
            asm volatile("" : "+v"(va[e + 1][0]), "+v"(va[e + 1][1]) : "v"(acc[0]), "v"(acc[1]), "v"(acc[2]), "v"(acc[3]), "v"(acc[4]), "v"(acc[5]), "v"(acc[6]), "v"(acc[7]), \
                         "v"(acc[8]), "v"(acc[9]), "v"(acc[10]), "v"(acc[11]), "v"(acc[12]), "v"(acc[13]), "v"(acc[14]), "v"(acc[15])); \
            asm volatile("" : "+v"(va[e + 1][2]), "+v"(va[e + 1][3]) : "v"(acc[16]), "v"(acc[17]), "v"(acc[18]), "v"(acc[19]), "v"(acc[20]), "v"(acc[21]), "v"(acc[22]), "v"(acc[23]), \
                         "v"(acc[24]), "v"(acc[25]), "v"(acc[26]), "v"(acc[27]), "v"(acc[28]), "v"(acc[29]), "v"(acc[30]), "v"(acc[31])); } }
    {
        const int tokl = w * 4;
        peer_select_head(*(const f32x2*)(Ssc + (size_t)(0 * 32 + tokl) * 128 + 2 * lane), *(const f32x2*)(Ssc + (size_t)(1 * 32 + tokl) * 128 + 2 * lane), lane, wl, (LAS int*)(wl + 160), wl + 176, ci_i, ci_j, cand_on);
        int ln = lane; asm volatile("" : "+v"(ln)); const int el1 = ((ln >> 2) & 1) | (((ln >> 1) & 1) << 1) | ((ln & 1) << 2);
        const int mye = ((LAS int*)(wl + 160))[el1]; int ei[8]; PEER_IDS(mye, ei) PEER_ISSUE_U(ei, ln) PEER_ISSUE_V(ei, ln)
        sul = Us[mye]; svl = Vs[mye]; gl = (wl + 176)[el1];
    }
#pragma unroll 1
    for (int hh = 0; hh < 32; ++hh) {
        const int h = hh & 7, tokl = w * 4 + (hh >> 3), tok = tb + tokl;
        LAS int* fe = (LAS int*)(wl + 160 + (hh & 1) * 32); LAS float* fg = wl + 176 + (hh & 1) * 32;
        if (h == 0) {
            const u32x2* xp = (const u32x2*)(hb + (size_t)tok * DM) + lane;
#pragma unroll
            for (int j = 0; j < 8; ++j) { const u32x2 xw = xp[64 * j]; xf[j * 4 + 0] = bflo(xw.x); xf[j * 4 + 1] = bfhi(xw.x); xf[j * 4 + 2] = bflo(xw.y); xf[j * 4 + 3] = bfhi(xw.y); }
#pragma unroll
            for (int i = 0; i < 32; ++i) acc[i] = 0.f;
        }
        {
            float dot[8]; PEER_DOTS(dot)
            int ln = lane; asm volatile("" : "+v"(ln)); const int el1 = ((ln >> 2) & 1) | (((ln >> 1) & 1) << 1) | ((ln & 1) << 2);
            const int mye = fe[8 + el1]; int ei[8]; PEER_IDS(mye, ei) PEER_ISSUE_U(ei, ln)
            const float cfl = gl * gelu_erf(reduce8(dot, lane) * sul) * svl;
            PEER_ACCUM(cfl)
            f32x2 ns0 = {0.f, 0.f}, ns1 = {0.f, 0.f};
            if (hh < 31) { const int tk2 = w * 4 + ((hh + 1) >> 3), h2 = (hh + 1) & 7;
                ns0 = *(const f32x2*)(Ssc + (size_t)((h2 * 2 + 0) * 32 + tk2) * 128 + 2 * ln); ns1 = *(const f32x2*)(Ssc + (size_t)((h2 * 2 + 1) * 32 + tk2) * 128 + 2 * ln); }
            PEER_ISSUE_V(ei, ln)
            sul = Us[mye]; svl = Vs[mye]; gl = fg[8 + el1];
            if (hh < 31) peer_select_head(ns0, ns1, lane, wl, (LAS int*)(wl + 160 + ((hh + 1) & 1) * 32), wl + 176 + ((hh + 1) & 1) * 32, ci_i, ci_j, cand_on);
        }
        {
            float dot[8]; PEER_DOTS(dot)
            int ln = lane; asm volatile("" : "+v"(ln)); const int el1 = ((ln >> 2) & 1) | (((ln >> 1) & 1) << 1) | ((ln & 1) << 2);
            const int nofs = hh < 31 ? ((hh + 1) & 1) * 32 : (hh & 1) * 32 + 8;
            const int mye = ((LAS int*)(wl + 160 + nofs))[el1]; int ei[8]; PEER_IDS(mye, ei) PEER_ISSUE_U(ei, ln)
            const float cfl = gl * gelu_erf(reduce8(dot, lane) * sul) * svl;
            PEER_ACCUM(cfl)
            PEER_ISSUE_V(ei, ln)
            sul = Us[mye]; svl = Vs[mye]; gl = (wl + 176 + nofs)[el1];
        }
        if (h == 7) {
        f32x4 o[8]; float ssq = 0.f;
#pragma unroll
        for (int j = 0; j < 8; ++j) { o[j] = *((const f32x4*)(x1 + (size_t)tok * DM) + 64 * j + lane) + (f32x4){acc[j * 4 + 0], acc[j * 4 + 1], acc[j * 4 + 2], acc[j * 4 + 3]};
            *((f32x4*)(xout + (size_t)tok * DM) + 64 * j + lane) = o[j]; ssq += o[j].x * o[j].x + o[j].y * o[j].y + o[j].z * o[j].z + o[j].w * o[j].w; }
        if (write_hb) {
            const float rs = rsqrtf(wave_sum(ssq) * (1.f / DM) + 1e-6f);
#pragma unroll
            for (int j = 0; j < 8; ++j) { u32x2 pw; pw.x = pk2(o[j].x * rs, o[j].y * rs); pw.y = pk2(o[j].z * rs, o[j].w * rs); *((u32x2*)(hb + (size_t)tok * DM) + 64 * j + lane) = pw; }
        }
        }
    }
#undef PEER_IDS
#undef PEER_ISSUE_U
#undef PEER_ISSUE_V
#undef PEER_DOTS
#undef PEER_ACCUM
    __syncthreads();
}

constexpr int N_PHASES = 19;
template <int PH>
__device__ __forceinline__ void run_phase(unsigned char* lds_raw, const int wave0) {
    if constexpr (PH == 0) { if (PON(9)) { const Ctx C = fresh_ctx_w(lds_raw, wave0); const AP a = fresh_args(); phase_prep(C, a); } }
    else {
            constexpr int l = (PH - 1) / 9, k = (PH - 1) % 9;
            switch (k) {
            case 0: if (PON(0)) {
                const Ctx C = fresh_ctx_w(lds_raw, wave0); const AP a = fresh_args(); unsigned char* ws = a.ws;
                pg8::Gemm g{(const bf16_t*)(ws + WS_HB), (const bf16_t*)(ws + WS_WINT) + (size_t)l * PROJ * DM, DM};
                pg8::Order S; S.init(32, 16, 1, 0, 0, 0, C.G, C.bx);
                pg8::EpiInProj E{(bf16_t*)(ws + WS_PA), (float*)(ws + WS_PROJ)};
                pg8::gemm_phase(C.lds, g, S, E, C.tid);
            } break;
            case 1: if (PON(1)) {
                int bxo = blockIdx.x; asm volatile("" : "+s"(bxo));
                if (bxo < 128) { const Ctx C = fresh_ctx_w(lds_raw, wave0); const AP a = fresh_args();
                  for (int ti = C.bx; ti < MTOK / 32; ti += C.G) rwkv_prep_item(C, a, l, ti); }
                if (PON(11)) { const Ctx C = fresh_ctx_w(lds_raw, wave0); const AP a = fresh_args(); unsigned char* ws = a.ws;
                  pg8::Gemm g{(const bf16_t*)(ws + WS_WCST) + (size_t)l * 1024 * 512, (const bf16_t*)(ws + WS_PA), 512};
                  pg8::Order S; S.init(4, 32, 1, 0, 0, 0, C.G, C.bx);
                  pg8::EpiC1 E{(bf16_t*)(ws + WS_C1)};
                  pg8::gemm_phase(C.lds, g, S, E, C.tid); }
                __syncthreads();
                if (PON(12)) { const Ctx C = fresh_ctx_w(lds_raw, wave0); const AP a = fresh_args();
                  const int m0 = C.bx < 128 ? C.gw : 2048 + C.gw, m1 = C.bx < 128 ? 3072 : MTOK;
                  for (int m = m0; m < m1; m += 1024) qk_prep_token(a, l, m, C.lane); }
                if (PON(13)) { const Ctx C = fresh_ctx_w(lds_raw, wave0); const AP a = fresh_args();
                  const int i1 = C.bx < 128 ? 1024 : 4096;
                  for (int it = C.gw; it < i1; it += 1024) s5_ends_item(a, l, it, C.lane, (LAS float*)(C.lds + C.wave * 4096)); }
                if (bxo >= 128) { __syncthreads(); const Ctx C = fresh_ctx_w(lds_raw, wave0); const AP a = fresh_args();
                  for (int ti = C.bx; ti < MTOK / 32; ti += C.G) rwkv_prep_item(C, a, l, ti); }
            } break;
            case 2: if (PON(2)) {
                if (PON(17)) { const Ctx C = fresh_ctx_w(lds_raw, wave0); const AP a = fresh_args();
                  volatile LAS int* qs = (volatile LAS int*)(C.lds + LDS_BYTES - 128);
                  unsigned* q0 = (unsigned*)(a.ws + WS_CTL) + 64 + l * 64; unsigned* q1 = q0 + 2;
                  const int order = (C.bx >> 3) & 1; int stage = 0;
#pragma unroll 1
                  for (;;) {
                    __syncthreads();
                    if (C.tid == 0) {
                        int nb = -1;
                        while (stage < 2) {
                            const int q = stage ^ order;
                            const int t = (int)__hip_atomic_fetch_add(q ? q1 : q0, 8u, __ATOMIC_RELAXED, __HIP_MEMORY_SCOPE_AGENT);
                            const int b2 = q ? 4096 + t : t;
                            if (b2 < (q ? 14336 : 4096)) { nb = b2; break; }
                            ++stage;
                        }
                        *qs = nb;
                    }
                    __syncthreads();
                    const int base = *qs; if (base < 0) break;
                    const int it = base + C.wave;
                    if (it < 4096) s5_final_item_h(a, l, it, C.lane, C.lds + C.wave * 16384);
                    else if (it < 12288) rwkv_chunk_pre(a, it - 4096, C.lane, C.lds + C.wave * 16384);
                    else c1_fold_item(a, it - 12288, C.lane);
                  } }
            } break;
            case 3: if (PON(3)) {
                int bx0 = blockIdx.x; asm volatile("" : "+s"(bx0));
                if (bx0 < 64) { const Ctx C = fresh_ctx_w(lds_raw, wave0); const AP a = fresh_args(); rwkv_seq_chain(C, a, C.bx); }
                else if (bx0 < 192) {
                    if (PON(15)) { const Ctx C = fresh_ctx_w(lds_raw, wave0); const AP a = fresh_args(); unsigned char* ws = a.ws;
                      const int au = C.bx - 64;
                      { const int qblk = au & 7, hq = (au >> 3) & 3, b = au >> 5;
                        const bf16_t* Q = (const bf16_t*)(ws + WS_QB) + ((size_t)(b * SEQ + qblk * 256)) * 512 + hq * 128;
                        const bf16_t* Kp = (const bf16_t*)(ws + WS_QB) + (size_t)MTOK * 512 + ((size_t)b * SEQ) * 256 + (hq >> 1) * 128;
                        const bf16_t* Vp = Kp + (size_t)MTOK * 256;
                        float* O = (float*)(ws + WS_YA) + (size_t)2 * RWSZ + ((size_t)(b * SEQ + qblk * 256)) * 512 + hq * 128;
                        att::attn_dense_body<att::bf16>(Q, Kp, Vp, O, SEQ, (char*)C.lds, C.tid);
                      } }
                } else {
                    { const Ctx C = fresh_ctx_w(lds_raw, wave0); const AP a = fresh_args(); unsigned char* ws = a.ws;
                        pg8::Gemm g{(const bf16_t*)(ws + WS_YGELU), (const bf16_t*)(ws + WS_WGLUT) + (size_t)l * 512 * 512, 512};
                        pg8::Order S; S.init(32, 2, 1, 0, 0, 0, 64, C.bx - 192);
                        pg8::EpiGlu E{(const bf16_t*)(ws + WS_YGELU), (float*)(ws + WS_YA) + RWSZ};
                        pg8::gemm_phase(C.lds, g, S, E, C.tid);
                        __syncthreads(); }
                    if (PON(16)) { const Ctx C = fresh_ctx_w(lds_raw, wave0); const AP a = fresh_args(); unsigned char* ws = a.ws;
                      pg8::Gemm g{(const bf16_t*)(ws + WS_DFT), (const bf16_t*)(ws + WS_C1F), 2048};
                      pg8::Order S; S.init(8, 2, 4, 0, 2, 8, 64, C.bx - 192);
                      pg8::EpiF32 E{(float*)(ws + WS_YA), 512};
                      pg8::gemm_phase(C.lds, g, S, E, C.tid); }
                }
            } break;
            case 4: if (PON(4)) {
                const Ctx C = fresh_ctx_w(lds_raw, wave0); const AP a = fresh_args();
                for (int m = C.gw; m < MTOK; m += C.ngw) {
                    branch_norm_item(a, m * 4 + 0, C.lane); branch_norm_item(a, m * 4 + 1, C.lane); branch_norm_item(a, m * 4 + 2, C.lane); branch_d_item(a, l, m, C.lane); }
            } break;
            case 5: if (PON(5)) {
                const Ctx C = fresh_ctx_w(lds_raw, wave0); const AP a = fresh_args(); unsigned char* ws = a.ws;
                const float* xin = l == 0 ? a.in[0] : (const float*)(ws + WS_X2);
                pg8::Gemm g{(const bf16_t*)(ws + WS_HB), (const bf16_t*)(ws + WS_WOUTT) + (size_t)l * DM * DM, DM};
                pg8::Order S; S.init(32, 8, 1, 0, 0, 0, C.G, C.bx);
                pg8::EpiResid E{xin, (float*)(ws + WS_X1), DM};
                pg8::gemm_phase(C.lds, g, S, E, C.tid);
            } break;
            case 6: if (PON(6)) {
                const Ctx C = fresh_ctx_w(lds_raw, wave0); const AP a = fresh_args(); unsigned char* ws = a.ws;
                for (int m = C.gw; m < MTOK; m += C.ngw) rms_row_to_bf16((const float*)(ws + WS_X1) + (size_t)m * DM, (bf16_t*)(ws + WS_HB) + (size_t)m * DM, C.lane);
            } break;
            case 7: if (PON(7)) {
                int bx0 = blockIdx.x; asm volatile("" : "+s"(bx0));
                if (bx0 < 128) {
                    const Ctx C = fresh_ctx_w(lds_raw, wave0); const AP a = fresh_args(); unsigned char* ws = a.ws;
                    pg8::Gemm g{(const bf16_t*)(ws + WS_HB), (const bf16_t*)(ws + WS_WQT) + (size_t)l * 1024 * DM, DM};
                    pg8::Order S; S.init(32, 4, 1, 0, 0, 0, 128, C.bx);
                    pg8::EpiF32 E{(float*)(ws + WS_PROJ), 1024};
                    pg8::gemm_phase(C.lds, g, S, E, C.tid);
                } else {
                    const Ctx C = fresh_ctx_w(lds_raw, wave0); const AP a = fresh_args();
#pragma unroll 1
                    for (int it = (C.bx - 128) * 8 + C.wave; it < 16384; it += 1024) { const int r2 = it * 2; expert_row_item2(a, r2 >> 14, l, r2 & 16383, C.lane); }
                }
            } break;
            case 8: if (PON(8)) {
                const Ctx C = fresh_ctx_w(lds_raw, wave0); const AP a = fresh_args(); unsigned char* ws = a.ws;
                float* xo = l == 0 ? (float*)(ws + WS_X2) : a.out;
                for (int tile = C.bx; tile < MTOK / 32; tile += C.G) peer_tile(C, a, l, tile, (const float*)(ws + WS_X1), xo, l == 0);
            } break;
            default: break;
            }
    }
}
__global__ void __launch_bounds__(NTHR, 2) fwd_kernel(Args a0) {
    extern __shared__ __attribute__((aligned(16))) unsigned char lds_raw[];
    cg::grid_group grid = cg::this_grid();
    const int wave0 = __builtin_amdgcn_readfirstlane((int)threadIdx.x >> 6);
    volatile LAS unsigned* bst = (volatile LAS unsigned*)((LAS unsigned char*)lds_raw + LDS_BYTES - 64);
    if (threadIdx.x < 2) bst[threadIdx.x] = 0u;
    __syncthreads();
    const XcdBarrier xbar = xcd_barrier_post((unsigned*)(a0.ws + WS_CTL) + 4096, bst);
    const int lo = a0.ph_lo, hi = a0.ph_hi;
    if (lo < 0) grid.sync();
#define MK_STEP(PH) if (lo <= (PH) && (PH) < hi) { run_phase<PH>(lds_raw, wave0); \
        if ((((unsigned)PROBE_REP_MASK >> (PH)) & 1u) != 0u) { xcd_barrier(xbar); run_phase<PH>(lds_raw, wave0); } \
        if ((PH) + 1 < hi) xcd_barrier(xbar); }
    MK_STEP(0) MK_STEP(1) MK_STEP(2) MK_STEP(3) MK_STEP(4) MK_STEP(5) MK_STEP(6) MK_STEP(7) MK_STEP(8) MK_STEP(9)
    MK_STEP(10) MK_STEP(11) MK_STEP(12) MK_STEP(13) MK_STEP(14) MK_STEP(15) MK_STEP(16) MK_STEP(17) MK_STEP(18)
#undef MK_STEP
}

extern "C" void kernel_launch(void* const* d_in, const int* in_sizes, int n_in, void* d_out, int out_size, void* d_ws, size_t ws_size, hipStream_t stream) {
    static int grid = 0;
    if (grid == 0) {
        if (n_in != 36 || in_sizes[0] != MTOK * DM || out_size != MTOK * DM || ws_size < WS_END) {
            fprintf(stderr, "kernel_launch: shape mismatch: n_in %d in0 %d out %d ws %zu (need %zu)\n", n_in, n_in > 0 ? in_sizes[0] : -1, out_size, ws_size, (size_t)WS_END); grid = -1; return; }
        int dev = 0, cus = 0, per_cu = 0;
        if (hipGetDevice(&dev) != hipSuccess || hipDeviceGetAttribute(&cus, hipDeviceAttributeMultiprocessorCount, dev) != hipSuccess) { fprintf(stderr, "kernel_launch: device query failed\n"); grid = -1; return; }
        if (hipFuncSetAttribute((const void*)fwd_kernel, hipFuncAttributeMaxDynamicSharedMemorySize, LDS_BYTES) != hipSuccess) { fprintf(stderr, "kernel_launch: hipFuncSetAttribute failed\n"); grid = -1; return; }
        if (hipOccupancyMaxActiveBlocksPerMultiprocessor(&per_cu, (const void*)fwd_kernel, NTHR, LDS_BYTES) != hipSuccess || per_cu < 1) { fprintf(stderr, "kernel_launch: occupancy query gives %d\n", per_cu); grid = -1; return; }
        grid = cus * per_cu; if (grid > 256) grid = 256;
        if (grid < 128) { fprintf(stderr, "kernel_launch: grid %d too small\n", grid); grid = -1; return; }
    }
    if (grid < 0) return;
    if (hipMemsetAsync((char*)d_ws + WS_CTL, 0, 65536, stream) != hipSuccess) { fprintf(stderr, "kernel_launch: memset failed\n"); return; }
    Args a{};
    for (int i = 0; i < 36; ++i) a.in[i] = (const float*)d_in[i];
    a.out = (float*)d_out; a.ws = (unsigned char*)d_ws;
#if MK_ONE_LAUNCH
    a.ph_lo = 0; a.ph_hi = N_PHASES;
    void* args[] = {&a};
    hipError_t e = hipLaunchCooperativeKernel((const void*)fwd_kernel, dim3(grid), dim3(NTHR), args, LDS_BYTES, stream);
    if (e != hipSuccess) fprintf(stderr, "kernel_launch: cooperative launch failed: %s (grid %d)\n", hipGetErrorString(e), grid);
#else
    for (int ph = 0; ph < N_PHASES; ++ph) {
        a.ph_lo = ph; a.ph_hi = ph + 1;
        hipLaunchKernelGGL(fwd_kernel, dim3(grid), dim3(NTHR), LDS_BYTES, stream, a);
    }
    hipError_t e = hipPeekAtLastError();
    if (e != hipSuccess) fprintf(stderr, "kernel_launch: launch failed: %s\n", hipGetErrorString(e));
#endif
}
```

```cpp
#include <hip/hip_runtime.h>
#include <hip/hip_cooperative_groups.h>
#include <cstdio>
#include <cstdint>
#include <cstddef>
namespace cg = cooperative_groups;

#ifndef MK_ONE_LAUNCH
#define MK_ONE_LAUNCH 1
#endif
#ifndef PHM
#define PHM 0x3ffff
#endif
#define PON(i) (((PHM) >> (i)) & 1)
#ifndef PROBE_REP_MASK
#define PROBE_REP_MASK 0u
#endif

namespace pg8 {
#define PG8_LAS __attribute__((address_space(3)))
typedef unsigned short bf16_t;
typedef short bf16x8 __attribute__((ext_vector_type(8)));
typedef float f32x4 __attribute__((ext_vector_type(4)));
typedef unsigned u32x4 __attribute__((ext_vector_type(4)));
typedef unsigned u32x2 __attribute__((ext_vector_type(2)));
constexpr int BM = 256, BK = 64, HALF = 128, HTB = HALF * BK * 2, STAGE_BYTES = 8 * HTB, NXCD = 8, WGM = 8;

__host__ __device__ __forceinline__ int lds_byte(int r, int c) { const int st = (r >> 4) * 2 + (c >> 5), rr = r & 15, cc = c & 31, ob = rr * 64 + cc * 2; return st * 1024 + (ob ^ (((ob >> 9) & 1) << 5)); }
__host__ __device__ __forceinline__ void stage_rc(int b, int& R, int& C) { const int st = b / 1024, sb = b % 1024, swz = sb ^ (((sb >> 9) & 1) << 5); R = (st >> 1) * 16 + swz / 64; C = (st & 1) * 32 + (swz % 64) / 2; }

struct Unit { int pm, pn, pa, pb; };
struct Gemm { const bf16_t* A; const bf16_t* Bt; int K; };

struct Order {
    int nM, nN, nb, nwg, G, c, aM, bN, oM;
    __device__ __forceinline__ void init(int nM_, int nN_, int nb_, int aM_, int bN_, int oM_, int G_, int c_) { nM = nM_; nN = nN_; nb = nb_; aM = aM_; bN = bN_; oM = oM_; nwg = nM * nN * nb; G = G_; c = c_; }
    __device__ __forceinline__ bool next(int i, Unit& u) const {
        const int L = i * G + c; if (L >= nwg || c < 0) return false;
        const int per = nM * nN, b = L / per; int wgid = L - b * per;
        { const int q = per / NXCD, r = per % NXCD, xcd = wgid % NXCD, off = wgid / NXCD; wgid = (xcd < r ? xcd * (q + 1) : r * (q + 1) + (xcd - r) * q) + off; }
        const int nig = WGM * nN, gid = wgid / nig, fm = gid * WGM, gsz = (nM - fm) < WGM ? (nM - fm) : WGM;
        const int pm = fm + ((wgid % nig) % gsz), pn = (wgid % nig) / gsz;
        u.pm = pm + b * oM; u.pn = pn; u.pa = pm + b * aM; u.pb = pn + b * bN; return true;
    }
};

__device__ __forceinline__ unsigned cvt_pk_bf16(float lo, float hi) { unsigned r; asm volatile("v_cvt_pk_bf16_f32 %0, %1, %2" : "=v"(r) : "v"(lo), "v"(hi)); return r; }

#define PG8_EPI_LOOP(...) \
    _Pragma("unroll") for (int ai = 0; ai < 2; ++ai) _Pragma("unroll") for (int m = 0; m < 4; ++m) { const int row = u.pm * BM + ai * HALF + wr * 64 + m * 16 + fr; \
        _Pragma("unroll") for (int bj = 0; bj < 2; ++bj) _Pragma("unroll") for (int n = 0; n < 2; ++n) { const int col = u.pn * BM + bj * HALF + wc * 32 + n * 16 + 4 * fq; const f32x4 v = acc[ai][bj][m][n]; __VA_ARGS__ } }

struct EpiF32 {
    float* out; int ldc;
    __device__ __forceinline__ void operator()(const f32x4 (&acc)[2][2][4][2], const Unit& u, int wr, int wc, int fr, int fq) const {
        PG8_EPI_LOOP( *(f32x4*)(out + (size_t)row * ldc + col) = v; )
    }
};
struct EpiResid {
    const float* base; float* out; int ldc;
    __device__ __forceinline__ void operator()(const f32x4 (&acc)[2][2][4][2], const Unit& u, int wr, int wc, int fr, int fq) const {
        PG8_EPI_LOOP( const f32x4 b = *(const f32x4*)(base + (size_t)row * ldc + col); *(f32x4*)(out + (size_t)row * ldc + col) = b + v; )
    }
};
struct EpiInProj {
    bf16_t* pa; float* proj;
    __device__ __forceinline__ void operator()(const f32x4 (&acc)[2][2][4][2], const Unit& u, int wr, int wc, int fr, int fq) const {
        if (u.pn < 2) { PG8_EPI_LOOP( u32x2 w; w.x = cvt_pk_bf16(v[0], v[1]); w.y = cvt_pk_bf16(v[2], v[3]); *(u32x2*)(pa + (size_t)row * 512 + col) = w; ) }
        else { PG8_EPI_LOOP( *(f32x4*)(proj + (size_t)row * 4096 + col) = v; ) }
    }
};
struct EpiC1 {
    bf16_t* c1;
    __device__ __forceinline__ void operator()(const f32x4 (&acc)[2][2][4][2], const Unit& u, int wr, int wc, int fr, int fq) const {
        PG8_EPI_LOOP( const int b = col >> 11, s = col & 2047; u32x2 w; w.x = cvt_pk_bf16(v[0], v[1]); w.y = cvt_pk_bf16(v[2], v[3]);
                      *(u32x2*)(c1 + ((size_t)b * 1024 + row) * 2048 + s) = w; )
    }
};
struct EpiGlu {
    const bf16_t* y; float* out;
    __device__ __forceinline__ void operator()(const f32x4 (&acc)[2][2][4][2], const Unit& u, int wr, int wc, int fr, int fq) const {
        PG8_EPI_LOOP( const u32x2 yw = *(const u32x2*)(y + (size_t)row * 512 + col);
                      f32x4 yv; yv[0] = __uint_as_float(yw.x << 16); yv[1] = __uint_as_float(yw.x & 0xffff0000u); yv[2] = __uint_as_float(yw.y << 16); yv[3] = __uint_as_float(yw.y & 0xffff0000u);
                      f32x4 o; _Pragma("unroll") for (int e = 0; e < 4; ++e) o[e] = yv[e] / (1.f + __expf(-v[e]));
                      *(f32x4*)(out + (size_t)row * 512 + col) = o; )
    }
};

template <class Epi, class Sched>
__device__ __forceinline__ void gemm_phase(PG8_LAS unsigned char* lds, const Gemm g, const Sched& S, const Epi& E, const int tid) {
    const int wid = __builtin_amdgcn_readfirstlane(tid >> 6), lane = tid & 63, wr = wid >> 2, wc = wid & 3, fr = lane & 15, fq = lane >> 4;
    const int K = g.K, nt = K / BK;
    unsigned voffA[2];
#pragma unroll
    for (int i = 0; i < 2; ++i) { int R, C; stage_rc(tid * 16 + i * 8192, R, C); voffA[i] = (unsigned)(R * K + C) * 2u; }
    const size_t kstep = (size_t)(BK * 2);
    const size_t hstep = (size_t)HALF * K * 2;
    const size_t tstep = 2 * hstep;
    const unsigned ldsw = (unsigned)wid * 1024u;
    const int aoff = lds_byte(wr * 64 + fr, fq * 8), boff = lds_byte(wc * 32 + fr, fq * 8);
#define PG8_SA(b, h) (((b) * 2 + (h)) * HTB)
#define PG8_SB(b, h) ((4 + (b) * 2 + (h)) * HTB)
#define PG8_STAGE(bufoff, gbase, voff) do { _Pragma("unroll") for (int _i = 0; _i < 2; ++_i) \
        __builtin_amdgcn_global_load_lds((const unsigned*)((const char*)(gbase) + (voff)[_i]), (PG8_LAS unsigned*)(lds + (bufoff) + ldsw + _i * 8192), 16, 0, 0); } while (0)
#define PG8_LDA(dst, b, h) do { _Pragma("unroll") for (int m = 0; m < 4; ++m) _Pragma("unroll") for (int k = 0; k < 2; ++k) dst[m][k] = *(const PG8_LAS bf16x8*)(lds + PG8_SA(b, h) + aoff + m * 2048 + k * 1024); } while (0)
#define PG8_LDB(dst, b, h) do { _Pragma("unroll") for (int n = 0; n < 2; ++n) _Pragma("unroll") for (int k = 0; k < 2; ++k) dst[n][k] = *(const PG8_LAS bf16x8*)(lds + PG8_SB(b, h) + boff + n * 2048 + k * 1024); } while (0)
#define PG8_MMA(ai, bj, At, Bt) do { __builtin_amdgcn_s_setprio(1); _Pragma("unroll") for (int m = 0; m < 4; ++m) _Pragma("unroll") for (int n = 0; n < 2; ++n) _Pragma("unroll") for (int k = 0; k < 2; ++k) \
        acc[ai][bj][m][n] = __builtin_amdgcn_mfma_f32_16x16x32_bf16(Bt[n][k], At[m][k], acc[ai][bj][m][n], 0, 0, 0); __builtin_amdgcn_s_setprio(0); } while (0)
#define PG8_WAIT_V(n) asm volatile("s_waitcnt vmcnt(" #n ")" ::: "memory")
#define PG8_WAIT_L(n) asm volatile("s_waitcnt lgkmcnt(" #n ")" ::: "memory")
#define PG8_BAR __builtin_amdgcn_s_barrier()
#define PG8_SCHED __builtin_amdgcn_sched_barrier(0)
    Unit cur, nxt; int ui = 0;
    if (!S.next(0, cur)) return;
    f32x4 acc[2][2][4][2];
#pragma unroll
    for (int a = 0; a < 2; ++a)
#pragma unroll
        for (int b = 0; b < 2; ++b)
#pragma unroll
            for (int m = 0; m < 4; ++m)
#pragma unroll
                for (int n = 0; n < 2; ++n) acc[a][b][m][n] = (f32x4){0.f, 0.f, 0.f, 0.f};
    bf16x8 At[4][2], B0[2][2], B1[2][2];
    const char* cA = (const char*)g.A + (size_t)cur.pa * tstep; const char* cB = (const char*)g.Bt + (size_t)cur.pb * tstep;
    PG8_STAGE(PG8_SB(0, 0), cB, voffA); PG8_STAGE(PG8_SB(0, 1), cB + hstep, voffA); PG8_STAGE(PG8_SA(0, 0), cA, voffA); PG8_STAGE(PG8_SA(0, 1), cA + hstep, voffA);
    if (wr == 1) PG8_BAR;
    PG8_WAIT_V(2); PG8_BAR;
    PG8_STAGE(PG8_SB(1, 0), cB + kstep, voffA); PG8_STAGE(PG8_SA(1, 0), cA + kstep, voffA); PG8_STAGE(PG8_SB(1, 1), cB + hstep + kstep, voffA);
    PG8_WAIT_V(6); PG8_BAR;
    for (;;) {
        const bool has_next = S.next(ui + 1, nxt);
        const char* nA = has_next ? (const char*)g.A + (size_t)nxt.pa * tstep : cA; const char* nB = has_next ? (const char*)g.Bt + (size_t)nxt.pb * tstep : cB;
        for (int t = 0; t < nt; t += 2) {
            const bool last = (t == nt - 2);
            const char* a1 = cA + (size_t)(t + 1) * kstep;
            const char* a2 = last ? nA : cA + (size_t)(t + 2) * kstep; const char* b2 = last ? nB : cB + (size_t)(t + 2) * kstep;
            const char* a3 = a2 + kstep; const char* b3 = b2 + kstep;
            PG8_LDB(B0, 0, 0); PG8_LDB(B1, 0, 1); PG8_SCHED; PG8_LDA(At, 0, 0); PG8_STAGE(PG8_SA(1, 1), a1 + hstep, voffA);
            PG8_WAIT_V(8); PG8_WAIT_L(0); PG8_BAR; PG8_MMA(0, 0, At, B0); PG8_MMA(0, 1, At, B1); PG8_BAR; PG8_SCHED;
            PG8_LDA(At, 0, 1); PG8_STAGE(PG8_SB(0, 0), b2, voffA); PG8_STAGE(PG8_SB(0, 1), b2 + hstep, voffA); PG8_STAGE(PG8_SA(0, 0), a2, voffA);
            PG8_WAIT_V(8); PG8_WAIT_L(0); PG8_BAR; PG8_MMA(1, 0, At, B0); PG8_MMA(1, 1, At, B1); PG8_BAR; PG8_SCHED;
            PG8_LDB(B0, 1, 0); PG8_LDB(B1, 1, 1); PG8_SCHED; PG8_LDA(At, 1, 0); PG8_STAGE(PG8_SA(0, 1), a2 + hstep, voffA);
            PG8_WAIT_V(8); PG8_WAIT_L(0); PG8_BAR; PG8_MMA(0, 0, At, B0); PG8_MMA(0, 1, At, B1); PG8_BAR; PG8_SCHED;
            PG8_LDA(At, 1, 1); PG8_STAGE(PG8_SB(1, 0), b3, voffA); PG8_STAGE(PG8_SB(1, 1), b3 + hstep, voffA); PG8_STAGE(PG8_SA(1, 0), a3, voffA);
            PG8_WAIT_V(8); PG8_WAIT_L(0); PG8_BAR; PG8_MMA(1, 0, At, B0); PG8_MMA(1, 1, At, B1); PG8_BAR; PG8_SCHED;
        }
        if (wr == 0) PG8_BAR;
        E(acc, cur, wr, wc, fr, fq);
        if (!has_next) break;
#pragma unroll
        for (int a = 0; a < 2; ++a)
#pragma unroll
            for (int b = 0; b < 2; ++b)
#pragma unroll
                for (int m = 0; m < 4; ++m)
#pragma unroll
                    for (int n = 0; n < 2; ++n) acc[a][b][m][n] = (f32x4){0.f, 0.f, 0.f, 0.f};
        cur = nxt; cA = nA; cB = nB; ++ui;
        if (wr == 1) PG8_BAR;
    }
    PG8_WAIT_V(0);
    PG8_BAR;
#undef PG8_SA
#undef PG8_SB
#undef PG8_STAGE
#undef PG8_LDA
#undef PG8_LDB
#undef PG8_MMA
#undef PG8_WAIT_V
#undef PG8_WAIT_L
#undef PG8_BAR
#undef PG8_SCHED
}
}

namespace att {
using bf16 = unsigned short;
constexpr int   D = 128, NW = 8, QBLK = 32, KVBLK = 64;
constexpr float SCALE = 0.088388347648318440f;
constexpr float THR = 8.f;
constexpr int SDEPTH = 1;
constexpr int LDQ = 512, LDK = 256, LDO = 512;
constexpr size_t SHM_V = KVBLK * D * 2, SHM_K = KVBLK * D * 2, SHM_ATTN = 2 * SHM_V + 2 * SHM_K + NW * 64 * 4;

using bf16x8 = __attribute__((ext_vector_type(8))) short;
using s16x4  = __attribute__((ext_vector_type(4))) short;
using f32x16 = __attribute__((ext_vector_type(16))) float;
using f32x8  = __attribute__((ext_vector_type(8))) float;
using u32x4  = __attribute__((ext_vector_type(4))) unsigned;
#define KSWZ(row, colB) ((row) * 256 + ((colB) ^ (((row) & 7) << 4)))
#define SBAR() __builtin_amdgcn_sched_barrier(0)
__device__ __forceinline__ int crow(int r, int hi) { return (r & 3) + 8 * (r >> 2) + 4 * hi; }
__device__ __forceinline__ unsigned cvtpk(float lo, float hi) {
  unsigned r; asm volatile("v_cvt_pk_bf16_f32 %0, %1, %2" : "=v"(r) : "v"(lo), "v"(hi)); return r;
}
template <typename TIn> struct Stage;
template <> struct Stage<bf16>  { using T = bf16x8;
  __device__ static __forceinline__ T ld8(const bf16* p) { return *reinterpret_cast<const bf16x8*>(p); }
  __device__ static __forceinline__ bf16x8 tobf(T x) { return x; } };

__device__ __forceinline__ void partialSM(f32x16& p0, f32x16& p1, float& m_reg, float& mn, float& alpha) {
  constexpr float C = SCALE * 1.4426950408889634f;
  float pmax = p0[0]; for (int r = 1; r < 16; ++r) pmax = fmaxf(pmax, p0[r]); for (int r = 0; r < 16; ++r) pmax = fmaxf(pmax, p1[r]);
  { auto rr = __builtin_amdgcn_permlane32_swap(__float_as_uint(pmax), __float_as_uint(pmax), false, false);
    pmax = fmaxf(__uint_as_float(rr[0]), __uint_as_float(rr[1])); }
  if (__builtin_expect(__all(pmax - m_reg <= THR / SCALE), 1)) { mn = m_reg; alpha = 1.f; }
  else { mn = fmaxf(m_reg, pmax); alpha = __builtin_amdgcn_exp2f((m_reg - mn) * C); m_reg = mn; }
  float mnC = -mn * C;
  for (int r = 0; r < 16; ++r) p0[r] = fmaf(p0[r], C, mnC); for (int r = 0; r < 16; ++r) p1[r] = fmaf(p1[r], C, mnC);
  for (int r = 0; r < 16; ++r) p0[r] = __builtin_amdgcn_exp2f(p0[r]);
}
__device__ __forceinline__ void finishSM(f32x16& p0, f32x16& p1, float alpha, float& l_reg, bf16x8& pa0, bf16x8& pa1, bf16x8& pa2, bf16x8& pa3) {
  for (int r = 0; r < 16; ++r) p1[r] = __builtin_amdgcn_exp2f(p1[r]);
  float ps = 0; for (int r = 0; r < 16; ++r) ps += p0[r]; for (int r = 0; r < 16; ++r) ps += p1[r];
  { auto rr = __builtin_amdgcn_permlane32_swap(__float_as_uint(ps), __float_as_uint(ps), false, false);
    ps = __uint_as_float(rr[0]) + __uint_as_float(rr[1]); }
  l_reg = l_reg * alpha + ps;
#define PK4(P, BASE, OUT) do { unsigned a0 = cvtpk(P[BASE + 0], P[BASE + 1]), a1 = cvtpk(P[BASE + 2], P[BASE + 3]);   \
    unsigned b0 = cvtpk(P[BASE + 4], P[BASE + 5]), b1 = cvtpk(P[BASE + 6], P[BASE + 7]);                              \
    auto r0 = __builtin_amdgcn_permlane32_swap(a0, b0, false, false); auto r1 = __builtin_amdgcn_permlane32_swap(a1, b1, false, false); \
    u32x4 w = {r0[0], r1[0], r0[1], r1[1]}; OUT = *reinterpret_cast<bf16x8*>(&w); } while (0)
  PK4(p0, 0, pa0); PK4(p0, 8, pa1); PK4(p1, 0, pa2); PK4(p1, 8, pa3);
#undef PK4
}
__device__ __forceinline__ void qkt(f32x16& p0, f32x16& p1, const bf16* Ks, const bf16x8* qr, int r32, int hi) {
  p0 = f32x16{}; p1 = f32x16{};
  for (int d0 = 0; d0 < 8; ++d0) { int cb = (d0 * 16 + hi * 8) * 2;
    bf16x8 b0 = *reinterpret_cast<const bf16x8*>((const char*)Ks + KSWZ(r32, cb));
    bf16x8 b1 = *reinterpret_cast<const bf16x8*>((const char*)Ks + KSWZ(32 + r32, cb));
    p0 = __builtin_amdgcn_mfma_f32_32x32x16_bf16(b0, qr[d0], p0, 0, 0, 0);
    p1 = __builtin_amdgcn_mfma_f32_32x32x16_bf16(b1, qr[d0], p1, 0, 0, 0); }
}
__device__ __forceinline__ int v_st(int k, int c) { const int kk = (k & ~0xC) | ((k & 4) << 1) | ((k & 8) >> 1); return ((kk >> 3) * 4 + (c >> 5)) * 512 + ((kk & 7) * 32 + (c & 31)) * 2; }
__device__ __forceinline__ int v_rd_base(int lane) { return ((lane & 3) << 3) | (((lane >> 2) & 3) << 6) | (((lane >> 4) & 1) << 5) | (((lane >> 5) & 1) << 8); }
constexpr int v_rd_off(int d0, int ks, int half) { return d0 * 512 + ks * 4096 + half * 2048; }
template <int OFF> __device__ __forceinline__ s16x4 tr_read(int vb) {
  s16x4 r; asm volatile("ds_read_b64_tr_b16 %0, %1 offset:%2" : "=&v"(r) : "v"(vb), "i"(OFF) : "memory"); return r;
}
template <int D0> __device__ __forceinline__ void pv_one(f32x16& od, int vb, bf16x8 pa0, bf16x8 pa1, bf16x8 pa2, bf16x8 pa3) {
  const s16x4 l0 = tr_read<v_rd_off(D0, 0, 0)>(vb), h0 = tr_read<v_rd_off(D0, 0, 1)>(vb), l1 = tr_read<v_rd_off(D0, 1, 0)>(vb), h1 = tr_read<v_rd_off(D0, 1, 1)>(vb);
  const s16x4 l2 = tr_read<v_rd_off(D0, 2, 0)>(vb), h2 = tr_read<v_rd_off(D0, 2, 1)>(vb), l3 = tr_read<v_rd_off(D0, 3, 0)>(vb), h3 = tr_read<v_rd_off(D0, 3, 1)>(vb);
  asm volatile("s_waitcnt lgkmcnt(0)" ::: "memory"); SBAR();
#define PK(L, H) (bf16x8){L[0], L[1], L[2], L[3], H[0], H[1], H[2], H[3]}
  od = __builtin_amdgcn_mfma_f32_32x32x16_bf16(pa0, PK(l0, h0), od, 0, 0, 0);
  od = __builtin_amdgcn_mfma_f32_32x32x16_bf16(pa1, PK(l1, h1), od, 0, 0, 0);
  od = __builtin_amdgcn_mfma_f32_32x32x16_bf16(pa2, PK(l2, h2), od, 0, 0, 0);
  od = __builtin_amdgcn_mfma_f32_32x32x16_bf16(pa3, PK(l3, h3), od, 0, 0, 0);
#undef PK
}
__device__ __forceinline__ void pv_d0(f32x16* o, int vb, bf16x8 pa0, bf16x8 pa1, bf16x8 pa2, bf16x8 pa3) {
  pv_one<0>(o[0], vb, pa0, pa1, pa2, pa3); pv_one<1>(o[1], vb, pa0, pa1, pa2, pa3); pv_one<2>(o[2], vb, pa0, pa1, pa2, pa3); pv_one<3>(o[3], vb, pa0, pa1, pa2, pa3);
}
template <typename TQ>
__device__ __forceinline__ void attn_dense_body(const TQ* __restrict__ Qb, const bf16* __restrict__ Kh, const bf16* __restrict__ Vh,
                                                float* __restrict__ Ob, int seq, char* lds, const int tid_) {
  using St = Stage<bf16>; using SQ = Stage<TQ>;
  int tid = tid_; asm volatile("" : "+v"(tid));
  const int wid = tid >> 6, lane = tid & 63, r32 = lane & 31, hi = lane >> 5;
  bf16* V_lds = (bf16*)lds; bf16* K_lds = (bf16*)(lds + 2 * SHM_V);
  float* ws = (float*)(lds + 2 * SHM_V + 2 * SHM_K) + wid * 64; float* li_l = ws; float* al_l = ws + 32;
  float m_reg = -1e30f, l_reg = 0; f32x16 o[4] = {}; bf16x8 qr[8];
  const TQ* Qw = Qb + (long)(wid * QBLK + r32) * LDQ + hi * 8;
#pragma unroll
  for (int d0 = 0; d0 < 8; ++d0) qr[d0] = SQ::tobf(SQ::ld8(Qw + d0 * 16));
  const int sr = tid >> 4, sc = (tid & 15) * 8, vst0 = v_st(sr, sc), vst1 = v_st(32 + sr, sc);
  const int vb0 = (int)(uintptr_t)V_lds + v_rd_base(lane);
  struct { typename St::T vs0, vs1, ks0, ks1; } sr_[SDEPTH];
  const unsigned loff = (unsigned)(sr * LDK + sc);
#define SLOAD(i, k0) do { const bf16* Vt_ = Vh + (size_t)(k0) * LDK; const bf16* Kt_ = Kh + (size_t)(k0) * LDK; \
    sr_[i].vs0 = St::ld8(Vt_ + loff); sr_[i].vs1 = St::ld8(Vt_ + 32 * LDK + loff); \
    sr_[i].ks0 = St::ld8(Kt_ + loff); sr_[i].ks1 = St::ld8(Kt_ + 32 * LDK + loff); } while (0)
#define SWRITE(b, i) do { *(bf16x8*)((char*)V_lds + (b) * SHM_V + vst0) = St::tobf(sr_[i].vs0);          \
    *(bf16x8*)((char*)V_lds + (b) * SHM_V + vst1) = St::tobf(sr_[i].vs1); int kc = sc * 2;               \
    *(bf16x8*)((char*)K_lds + (b) * SHM_K + KSWZ(sr, kc)) = St::tobf(sr_[i].ks0);                       \
    *(bf16x8*)((char*)K_lds + (b) * SHM_K + KSWZ(32 + sr, kc)) = St::tobf(sr_[i].ks1); } while (0)
#define SWAIT() do { if constexpr (SDEPTH == 2) asm volatile("s_waitcnt vmcnt(4)" ::: "memory"); else asm volatile("s_waitcnt vmcnt(0)" ::: "memory"); } while (0)
#define RESC(a) do { if (__any((a) < 1.f)) { if (hi == 0) al_l[r32] = (a); asm volatile("s_waitcnt lgkmcnt(0)" ::: "memory"); \
    for (int d = 0; d < 4; ++d) for (int r = 0; r < 16; ++r) o[d][r] *= al_l[crow(r, hi)]; } } while (0)
  f32x16 pA0, pA1, pB0, pB1; float mnA, mnB, alA, alB; bf16x8 pa0, pa1, pa2, pa3; const int NT = seq / KVBLK;
  constexpr int SE = 0, SO = SDEPTH - 1;
  SLOAD(SE, 0); asm volatile("s_waitcnt vmcnt(0)" ::: "memory"); SWRITE(0, SE); __syncthreads();
  qkt(pA0, pA1, K_lds, qr, r32, hi); partialSM(pA0, pA1, m_reg, mnA, alA);
  SLOAD(SO, KVBLK); if constexpr (SDEPTH == 2) { if (2 < NT) SLOAD(SE, 2 * KVBLK); }
  SWAIT(); SWRITE(1, SO); __syncthreads();
  for (int j = 1; j + 1 < NT; j += 2) {
    SBAR(); qkt(pB0, pB1, (bf16*)((char*)K_lds + SHM_K), qr, r32, hi);
    finishSM(pA0, pA1, alA, l_reg, pa0, pa1, pa2, pa3); SBAR();
    SLOAD(SO, (j + SDEPTH) * KVBLK); SBAR();
    pv_d0(o, vb0, pa0, pa1, pa2, pa3); partialSM(pB0, pB1, m_reg, mnB, alB);
    __syncthreads(); SWAIT(); SWRITE(0, SE);
    RESC(alB); __syncthreads();
    SBAR(); qkt(pA0, pA1, K_lds, qr, r32, hi);
    finishSM(pB0, pB1, alB, l_reg, pa0, pa1, pa2, pa3); SBAR();
    if (SDEPTH == 1 || j + 3 < NT) SLOAD(SE, (j + 1 + SDEPTH) * KVBLK); SBAR();
    pv_d0(o, vb0 + (int)SHM_V, pa0, pa1, pa2, pa3); partialSM(pA0, pA1, m_reg, mnA, alA);
    __syncthreads(); SWAIT(); SWRITE(1, SO);
    RESC(alA); __syncthreads();
  }
  SBAR(); qkt(pB0, pB1, (bf16*)((char*)K_lds + SHM_K), qr, r32, hi);
  finishSM(pA0, pA1, alA, l_reg, pa0, pa1, pa2, pa3); SBAR();
  pv_d0(o, vb0, pa0, pa1, pa2, pa3); partialSM(pB0, pB1, m_reg, mnB, alB);
  __syncthreads(); RESC(alB);
  finishSM(pB0, pB1, alB, l_reg, pa0, pa1, pa2, pa3); SBAR();
  pv_d0(o, vb0 + (int)SHM_V, pa0, pa1, pa2, pa3);
  if (hi == 0) li_l[r32] = l_reg; asm volatile("s_waitcnt lgkmcnt(0)" ::: "memory");
  float rli[16];
#pragma unroll
  for (int r = 0; r < 16; ++r) rli[r] = __builtin_amdgcn_rcpf(li_l[crow(r, hi)]);
  int le = lane; asm volatile("" : "+v"(le));
  float* Ow = Ob + (size_t)(wid * QBLK) * LDO; const unsigned eo = (unsigned)((le >> 5) * 4 * LDO + (le & 31));
#pragma unroll
  for (int r = 0; r < 16; ++r) { const unsigned ro = eo + (unsigned)(((r & 3) + 8 * (r >> 2)) * LDO);
#pragma unroll
    for (int d0 = 0; d0 < 4; ++d0) Ow[ro + d0 * 32] = o[d0][r] * rli[r]; }
#undef SLOAD
#undef SWRITE
#undef SWAIT
#undef RESC
}
}
#define LAS __attribute__((address_space(3)))
typedef unsigned short bf16_t;
typedef float f32x4 __attribute__((ext_vector_type(4)));
typedef float f32x2 __attribute__((ext_vector_type(2)));
typedef unsigned u32x4 __attribute__((ext_vector_type(4)));
typedef unsigned u32x2 __attribute__((ext_vector_type(2)));

typedef short bf16x8_t __attribute__((ext_vector_type(8)));
__device__ __forceinline__ bf16x8_t mk8(unsigned d0, unsigned d1, unsigned d2, unsigned d3) { const u32x4 w = {d0, d1, d2, d3}; return __builtin_bit_cast(bf16x8_t, w); }
constexpr int NTHR = 512, NWAVES = 8;
constexpr int MTOK = 8192, DM = 2048, SEQ = 2048, NBATCH = 4, PROJ = 4096, GW = 512;
constexpr int LDS_BYTES = 147456;

constexpr size_t MiB = 1u << 20;
constexpr size_t WS_CTL = 0;
constexpr size_t WS_WINT = 1 * MiB;
constexpr size_t WS_WOUTT = WS_WINT + 32 * MiB;
constexpr size_t WS_WQT = WS_WOUTT + 16 * MiB;
constexpr size_t WS_WGLUT = WS_WQT + 8 * MiB;
constexpr size_t WS_WCST = WS_WGLUT + 1 * MiB;
constexpr size_t WS_DFT = WS_WCST + 2 * MiB;
constexpr size_t WS_C1F = WS_DFT + 8 * MiB;
constexpr size_t WS_UB = WS_DFT + 16 * MiB;
constexpr size_t WS_VB = WS_UB + 128 * MiB;
constexpr size_t WS_KEYST = WS_VB + 128 * MiB;
constexpr size_t WS_ROPE = WS_KEYST + 1 * MiB;
constexpr size_t WS_HB = WS_ROPE + 1 * MiB;
constexpr size_t WS_PROJ = WS_HB + 32 * MiB;
constexpr size_t WS_PA = WS_PROJ + 128 * MiB;
constexpr size_t WS_C1 = WS_PA + 8 * MiB;
constexpr size_t WS_YA = WS_C1 + 16 * MiB;
constexpr size_t WS_QB = WS_YA + 64 * MiB;
constexpr size_t WS_S5E = WS_QB + 16 * MiB;
constexpr size_t WS_YGELU = WS_S5E + 4 * MiB;
constexpr size_t WS_RW = WS_YGELU + 8 * MiB;
constexpr size_t WS_YRW = WS_RW + 176 * MiB;
constexpr size_t WS_X1 = WS_YRW + 32 * MiB;
constexpr size_t WS_X2 = WS_X1 + 64 * MiB;
constexpr size_t WS_KS = WS_X2 + 64 * MiB;
constexpr size_t WS_S5T = WS_VB + 122 * MiB;
constexpr size_t WS_END = WS_KS + 16 * MiB;
static_assert(WS_END <= 1024 * MiB, "workspace map must fit 1 GiB");
constexpr size_t WS_LORA = WS_VB + 1 * MiB;
constexpr size_t WS_RWC = WS_VB + 2 * MiB;
constexpr int RWC_REC = 15360;
constexpr size_t RWSZ = (size_t)MTOK * GW;
enum { RW_R = 0, RW_V, RW_KK, RW_W0, RW_W1, RW_KD0, RW_KD1, RW_B0, RW_B1, RW_G, RW_BONUS };

struct Args { const float* in[36]; float* out; unsigned char* ws; int ph_lo, ph_hi; };

__device__ __forceinline__ unsigned f2bf(float f) { const unsigned u = __float_as_uint(f); return (u + 0x7fffu + ((u >> 16) & 1u)) >> 16; }
__device__ __forceinline__ unsigned pk2(float lo, float hi) { return f2bf(lo) | (f2bf(hi) << 16); }
__device__ __forceinline__ float bflo(unsigned w) { return __uint_as_float(w << 16); }
__device__ __forceinline__ float bfhi(unsigned w) { return __uint_as_float(w & 0xffff0000u); }
#define DPPF(x, ctrl) __builtin_bit_cast(float, __builtin_amdgcn_update_dpp(0, __builtin_bit_cast(int, (x)), (ctrl), 0xF, 0xF, true))
#define RDL(x, l) __builtin_bit_cast(float, __builtin_amdgcn_readlane(__builtin_bit_cast(int, (x)), (l)))
__device__ __forceinline__ float wave_sum(float v) {
    v += DPPF(v, 0xB1); v += DPPF(v, 0x4E); v += DPPF(v, 0x124); v += DPPF(v, 0x128);
    return (RDL(v, 0) + RDL(v, 16)) + (RDL(v, 32) + RDL(v, 48));
}
__device__ __forceinline__ float wave_max(float v) {
    v = fmaxf(v, DPPF(v, 0xB1)); v = fmaxf(v, DPPF(v, 0x4E)); v = fmaxf(v, DPPF(v, 0x124)); v = fmaxf(v, DPPF(v, 0x128));
    return fmaxf(fmaxf(RDL(v, 0), RDL(v, 16)), fmaxf(RDL(v, 32), RDL(v, 48)));
}
__device__ __forceinline__ float sigmoidf_(float x) { return 1.f / (1.f + __expf(-x)); }
__device__ __forceinline__ float gelu_tanh(float x) { const float u = 0.7978845608028654f * (x + 0.044715f * x * x * x); return 0.5f * x * (1.f + tanhf(u)); }
__device__ __forceinline__ float gelu_erf(float x) { return 0.5f * x * (1.f + erff(x * 0.7071067811865476f)); }
#define LDS_WAIT() asm volatile("s_waitcnt lgkmcnt(0)" ::: "memory")

struct Ctx {
    LAS unsigned char* lds; int tid, lane, wave, G, gw, ngw, bx;
};
__device__ __forceinline__ Ctx fresh_ctx_w(unsigned char* lds_raw, int wave0) {
    Ctx C; int ln = __builtin_amdgcn_mbcnt_hi(~0u, __builtin_amdgcn_mbcnt_lo(~0u, 0u)); asm volatile("" : "+v"(ln));
    int wv = wave0; asm volatile("" : "+s"(wv));
    int t = wv * 64 + ln;
    int bx = blockIdx.x, G = gridDim.x; asm volatile("" : "+s"(bx), "+s"(G));
    unsigned lo_ = 0u; asm volatile("" : "+s"(lo_));
    C.lds = (LAS unsigned char*)lds_raw + lo_; C.tid = t; C.lane = ln; C.wave = wv;
    C.G = G; C.bx = bx; C.gw = bx * NWAVES + C.wave; C.ngw = G * NWAVES; return C;
}
#define AS4 __attribute__((address_space(4)))
typedef const float* const AS4* InTab;
struct AP { InTab in; float* out; unsigned char* ws; };
static_assert(offsetof(Args, out) == 288 && offsetof(Args, ws) == 296, "Args layout");
__device__ __forceinline__ AP fresh_args() {
    unsigned long long p = (unsigned long long)__builtin_amdgcn_kernarg_segment_ptr(); asm volatile("" : "+s"(p));
    AP r; r.in = (InTab)p; r.out = *(float* const AS4*)(p + 288); r.ws = *(unsigned char* const AS4*)(p + 296); return r;
}

typedef __attribute__((address_space(1))) unsigned gu32;
#define RLX_AGENT __ATOMIC_RELAXED, __HIP_MEMORY_SCOPE_AGENT
#define XB_TMO      128
#define XB_XCNT(j)  (256  + 64 * (j))
#define XB_XSUB(j)  (1280 + 64 * (j))
#define XB_XGEN(j)  (2304 + 64 * (j))
#define XB_TOP      3328
#define XB_TOPGEN   3392
#define XCD_BAR_WORDS 3456
#define XB_SPIN_CAP (1u << 18)

__device__ __forceinline__ unsigned xb_ld(unsigned* p)              { return __hip_atomic_load(p, __ATOMIC_RELAXED, __HIP_MEMORY_SCOPE_AGENT); }
__device__ __forceinline__ unsigned xb_add(unsigned* p, unsigned v) { return __hip_atomic_fetch_add(p, v, __ATOMIC_RELAXED, __HIP_MEMORY_SCOPE_AGENT); }
__device__ __forceinline__ unsigned xb_xcc_id() { return (unsigned)__builtin_amdgcn_s_getreg((3 << 11) | 20) & 0xFu; }
#define XB_SPIN(cond, bar) do { unsigned _sp = 0; while (cond) { __builtin_amdgcn_s_sleep(1); \
    if ((++_sp & 255u) == 0u) { if (xb_ld(&(bar)[XB_TMO])) break; if (_sp > XB_SPIN_CAP) { atomicAdd(&(bar)[XB_TMO], 1u); break; } } } } while (0)

struct XcdBarrier {
    unsigned* bar; unsigned x;
    volatile LAS unsigned* st;
};

__device__ __forceinline__ XcdBarrier xcd_barrier_post(unsigned* bar, volatile LAS unsigned* st) {
    XcdBarrier b; b.bar = bar; b.x = xb_xcc_id(); b.st = st;
    if (threadIdx.x == 0) (void)xb_add(&bar[XB_XCNT(b.x)], 1u);
    return b;
}
__device__ __forceinline__ void xcd_barrier_complete(unsigned* bar, unsigned x, unsigned& nloc, unsigned& nx) {
    const unsigned G = gridDim.x * gridDim.y * gridDim.z;
    unsigned sum, cnt, mine, sp = 0u;
    for (;;) {
        sum = 0u; cnt = 0u; mine = 0u;
#pragma unroll
        for (unsigned j = 0; j < 16; ++j) { const unsigned c = xb_ld(&bar[XB_XCNT(j)]); sum += c; cnt += (c > 0u) ? 1u : 0u; mine = (j == x) ? c : mine; }
        if (sum == G) break;
        __builtin_amdgcn_s_sleep(1);
        if ((++sp & 255u) == 0u) { if (xb_ld(&bar[XB_TMO])) break; if (sp > XB_SPIN_CAP) { atomicAdd(&bar[XB_TMO], 1u); break; } }
    }
    nloc = mine > 0u ? mine : 1u; nx = cnt > 0u ? cnt : 1u;
}

__device__ __forceinline__ void xcd_barrier(const XcdBarrier& b) {
    asm volatile("s_waitcnt vmcnt(0)" ::: "memory");
    __syncthreads();
    if (threadIdx.x == 0) {
        unsigned* bar = b.bar;
        __builtin_amdgcn_s_waitcnt(0);
        unsigned nloc = b.st[0], nx = b.st[1];
        if (nloc == 0u) { xcd_barrier_complete(bar, b.x, nloc, nx); b.st[0] = nloc; b.st[1] = nx; }
        const unsigned old = xb_add(&bar[XB_XSUB(b.x)], 1u);
        const unsigned gen = old / nloc;
        if (old + 1u == (gen + 1u) * nloc) {
            __builtin_amdgcn_fence(__ATOMIC_RELEASE, "agent");
            asm volatile("s_waitcnt vmcnt(0)" ::: "memory");
            const unsigned og = xb_add(&bar[XB_TOP], 1u);
            const unsigned tg = og / nx;
            if (og + 1u == (tg + 1u) * nx) xb_add(&bar[XB_TOPGEN], 1u);
            else XB_SPIN(xb_ld(&bar[XB_TOPGEN]) == tg, bar);
            __builtin_amdgcn_fence(__ATOMIC_ACQUIRE, "agent");
            xb_add(&bar[XB_XGEN(b.x)], 1u);
            asm volatile("s_waitcnt vmcnt(0)" ::: "memory");
        } else {
            XB_SPIN(xb_ld(&bar[XB_XGEN(b.x)]) == gen, bar);
            __builtin_amdgcn_fence(__ATOMIC_ACQUIRE, "agent");
            asm volatile("s_waitcnt vmcnt(0)" ::: "memory");
        }
    }
    __syncthreads();
}

__device__ __forceinline__ void transpose_item(const float* W, const float* gain, int K, int N, bf16_t* WT, LAS float* scr, int item, int lane) {
    const int nblk = N / 64, kb = item / nblk, nb = item % nblk, k0 = 64 * kb, n0 = 64 * nb;
    const int lr = lane >> 4, lc = (lane & 15) * 4;
    f32x4 v[16];
#pragma unroll
    for (int i = 0; i < 16; ++i) v[i] = *(const f32x4*)(W + (size_t)(k0 + 4 * i + lr) * N + n0 + lc);
#pragma unroll
    for (int i = 0; i < 16; ++i) { const int kk = 4 * i + lr; const float g = gain ? gain[k0 + kk] : 1.f; LAS float* d = scr + kk * 65 + lc;
        d[0] = v[i].x * g; d[1] = v[i].y * g; d[2] = v[i].z * g; d[3] = v[i].w * g; }
    LDS_WAIT(); asm volatile("" ::: "memory");
#pragma unroll
    for (int c = 0; c < 8; ++c) { const LAS float* sp = scr + (8 * c) * 65 + lane;
        u32x4 o; o.x = pk2(sp[0 * 65], sp[1 * 65]); o.y = pk2(sp[2 * 65], sp[3 * 65]); o.z = pk2(sp[4 * 65], sp[5 * 65]); o.w = pk2(sp[6 * 65], sp[7 * 65]);
        *(u32x4*)(WT + (size_t)(n0 + lane) * K + k0 + 8 * c) = o; }
    LDS_WAIT(); asm volatile("" ::: "memory");
}
__device__ __forceinline__ void rms_row_to_bf16(const float* xrow, bf16_t* orow, int lane) {
    const f32x4* xr = (const f32x4*)xrow + lane;
    f32x4 v[8]; float s = 0.f;
#pragma unroll
    for (int j = 0; j < 8; ++j) { v[j] = xr[64 * j]; s += (v[j].x * v[j].x + v[j].y * v[j].y) + (v[j].z * v[j].z + v[j].w * v[j].w); }
    const float rs = rsqrtf(wave_sum(s) * (1.f / DM) + 1e-6f);
    u32x2* o8 = (u32x2*)orow + lane;
#pragma unroll
    for (int j = 0; j < 8; ++j) { u32x2 w; w.x = pk2(v[j].x * rs, v[j].y * rs); w.y = pk2(v[j].z * rs, v[j].w * rs); o8[64 * j] = w; }
}
__device__ __forceinline__ void s5_tables(const Ctx& C, const AP& a);
typedef float v16f_t __attribute__((ext_vector_type(16)));
typedef float v32f_t __attribute__((ext_vector_type(32)));
typedef unsigned v6u_t __attribute__((ext_vector_type(6)));
constexpr int EROW = 1536; constexpr size_t ETAB = (size_t)16384 * EROW;
__device__ __forceinline__ void expert_row_pack(const AP& a, int which, int l, int e, int lane, const f32x4 (&v)[8], float mx) {
    unsigned char* ws = a.ws;
    if (which) {
        const float sc4 = mx > 0.f ? 6.f / mx : 1.f;
        unsigned wv[4];
#pragma unroll
        for (int d4 = 0; d4 < 4; ++d4) { unsigned w_ = 0u;
            w_ = __builtin_amdgcn_cvt_scalef32_pk_fp4_f32(w_, v[2 * d4].x * sc4, v[2 * d4].y * sc4, 1.0f, 0); w_ = __builtin_amdgcn_cvt_scalef32_pk_fp4_f32(w_, v[2 * d4].z * sc4, v[2 * d4].w * sc4, 1.0f, 1);
            w_ = __builtin_amdgcn_cvt_scalef32_pk_fp4_f32(w_, v[2 * d4 + 1].x * sc4, v[2 * d4 + 1].y * sc4, 1.0f, 2); w_ = __builtin_amdgcn_cvt_scalef32_pk_fp4_f32(w_, v[2 * d4 + 1].z * sc4, v[2 * d4 + 1].w * sc4, 1.0f, 3);
            wv[d4] = w_; }
        ((u32x4*)(ws + WS_UB + 64 * MiB + (size_t)l * 16 * MiB + (size_t)e * 1024))[lane] = (u32x4){wv[0], wv[1], wv[2], wv[3]};
        if (lane == 0) ((float*)(ws + WS_VB))[(2 + l) * 16384 + e] = mx > 0.f ? mx * (1.f / 6.f) : 1.f;
        return;
    }
    if (true) {
        const float sc4 = mx > 0.f ? 6.f / mx : 1.f;
        unsigned wv[4];
#pragma unroll
        for (int d4 = 0; d4 < 4; ++d4) { unsigned w_ = 0u;
            w_ = __builtin_amdgcn_cvt_scalef32_pk_fp4_f32(w_, v[2 * d4].x * sc4, v[2 * d4].y * sc4, 1.0f, 0); w_ = __builtin_amdgcn_cvt_scalef32_pk_fp4_f32(w_, v[2 * d4].z * sc4, v[2 * d4].w * sc4, 1.0f, 1);
            w_ = __builtin_amdgcn_cvt_scalef32_pk_fp4_f32(w_, v[2 * d4 + 1].x * sc4, v[2 * d4 + 1].y * sc4, 1.0f, 2); w_ = __builtin_amdgcn_cvt_scalef32_pk_fp4_f32(w_, v[2 * d4 + 1].z * sc4, v[2 * d4 + 1].w * sc4, 1.0f, 3);
            wv[d4] = w_; }
        ((u32x4*)(ws + WS_UB + (size_t)l * ETAB + (size_t)e * 1024))[lane] = (u32x4){wv[0], wv[1], wv[2], wv[3]};
        if (lane == 0) ((float*)(ws + WS_VB))[(0 * 2 + l) * 16384 + e] = mx > 0.f ? mx * (1.f / 6.f) : 1.f;
        return;
    }
    const float sc = mx > 0.f ? 7.f / mx : 1.f;
    typedef unsigned v16u_t __attribute__((ext_vector_type(16))); typedef __bf16 v32bf_t __attribute__((ext_vector_type(32)));
    v16u_t pw;
#pragma unroll
    for (int j = 0; j < 8; ++j) { pw[j * 2] = pk2(v[j].x * sc, v[j].y * sc); pw[j * 2 + 1] = pk2(v[j].z * sc, v[j].w * sc); }
    const v6u_t w = __builtin_amdgcn_cvt_scalef32_pk32_fp6_bf16(__builtin_bit_cast(v32bf_t, pw), 1.0f);
    unsigned char* row = ws + WS_UB + (size_t)l * ETAB + (size_t)e * EROW;
    ((u32x4*)row)[lane] = (u32x4){w[0], w[1], w[2], w[3]}; ((u32x2*)(row + 1024))[lane] = (u32x2){w[4], w[5]};
    if (lane == 0) ((float*)(ws + WS_VB))[(0 * 2 + l) * 16384 + e] = mx > 0.f ? mx * (1.f / 7.f) : 1.f;
}
__device__ __forceinline__ void expert_row_item2(const AP& a, int which, int l, int e, int lane) {
    const f32x4* src = (const f32x4*)(a.in[which ? 35 : 34] + ((size_t)l * 16384 + e) * DM) + lane;
    const f32x4* gp = (const f32x4*)(a.in[31] + l * DM) + lane;
    f32x4 v0[8], v1[8]; float m0 = 0.f, m1 = 0.f;
#pragma unroll
    for (int j = 0; j < 8; ++j) { v0[j] = src[64 * j]; v1[j] = src[512 + 64 * j]; }
#pragma unroll
    for (int j = 0; j < 8; ++j) { if (!which) { const f32x4 g = gp[64 * j]; v0[j] = v0[j] * g; v1[j] = v1[j] * g; }
        m0 = fmaxf(m0, fmaxf(fmaxf(fabsf(v0[j].x), fabsf(v0[j].y)), fmaxf(fabsf(v0[j].z), fabsf(v0[j].w))));
        m1 = fmaxf(m1, fmaxf(fmaxf(fabsf(v1[j].x), fabsf(v1[j].y)), fmaxf(fabsf(v1[j].z), fabsf(v1[j].w)))); }
    m0 = wave_max(m0); m1 = wave_max(m1);
    expert_row_pack(a, which, l, e, lane, v0, m0); expert_row_pack(a, which, l, e + 1, lane, v1, m1);
}
__device__ __forceinline__ void split8(const f32x4 a0, const f32x4 a1, bf16x8_t& hi, bf16x8_t& lo) {
    unsigned h[4], l_[4];
#pragma unroll
    for (int i = 0; i < 4; ++i) { const float x0 = i < 2 ? a0[2 * i] : a1[2 * i - 4], x1 = i < 2 ? a0[2 * i + 1] : a1[2 * i - 3];
        const unsigned h0 = f2bf(x0), h1 = f2bf(x1); h[i] = h0 | (h1 << 16);
        l_[i] = pk2(x0 - __uint_as_float(h0 << 16), x1 - __uint_as_float(h1 << 16)); }
    hi = mk8(h[0], h[1], h[2], h[3]); lo = mk8(l_[0], l_[1], l_[2], l_[3]);
}
__device__ __forceinline__ void phase_prep(const Ctx& C, const AP& a) {
    unsigned char* ws = a.ws;
    LAS float* scr = (LAS float*)(C.lds + C.wave * 16640);
    constexpr int I_IN = 32 * 64, I_OUT = 32 * 32, I_Q = 32 * 16, I_GLU = 8 * 8, I_L = I_IN + I_OUT + I_Q + I_GLU;
    for (int it = C.gw; it < 2 * I_L; it += C.ngw) {
        const int l = it / I_L; int r = it % I_L;
        if (r < I_IN) { transpose_item(a.in[2] + (size_t)l * DM * PROJ, a.in[1] + l * DM, DM, PROJ, (bf16_t*)(ws + WS_WINT) + (size_t)l * PROJ * DM, scr, r, C.lane); continue; } r -= I_IN;
        if (r < I_OUT) { transpose_item(a.in[30] + (size_t)l * DM * DM, a.in[29] + l * DM, DM, DM, (bf16_t*)(ws + WS_WOUTT) + (size_t)l * DM * DM, scr, r, C.lane); continue; } r -= I_OUT;
        if (r < I_Q) { transpose_item(a.in[32] + (size_t)l * DM * 1024, a.in[31] + l * DM, DM, 1024, (bf16_t*)(ws + WS_WQT) + (size_t)l * 1024 * DM, scr, r, C.lane); continue; } r -= I_Q;
        transpose_item(a.in[12] + (size_t)l * 512 * 512, nullptr, 512, 512, (bf16_t*)(ws + WS_WGLUT) + (size_t)l * 512 * 512, scr, r, C.lane);
    }
    {
        LAS float* tc = (LAS float*)(C.lds + 8 * 16640); LAS float* ts = tc + 128;
        if (C.tid < 128) { tc[C.tid] = cospif((float)C.tid / 64.f); ts[C.tid] = sinpif((float)C.tid / 64.f); }
        __syncthreads();
        for (int it = C.bx * NTHR + C.tid; it < 2 * 4 * 32 * 512; it += C.G * NTHR) {
            const int cp = it & 511, ccg = (it >> 9) & 31, blk = (it >> 14) & 3, l = it >> 16;
            const float* fw = a.in[3] + (size_t)l * 512 * 512 + (size_t)blk * 128 * 512 + cp;
            float sc[4] = {0.f, 0.f, 0.f, 0.f}, ss[4] = {0.f, 0.f, 0.f, 0.f};
#pragma unroll 8
            for (int m = 0; m < 128; ++m) { const float f = fw[(size_t)m * 512];
#pragma unroll
                for (int r = 0; r < 4; ++r) { const int ix = (m * (ccg * 4 + r)) & 127; sc[r] += tc[ix] * f; ss[r] += ts[ix] * f; } }
            bf16_t* o = (bf16_t*)(ws + WS_WCST) + (size_t)l * 1024 * 512; const int c0 = blk * 128 + ccg * 4;
            u32x2 w; w.x = pk2(sc[0] * (1.f / 512.f), sc[1] * (1.f / 512.f)); w.y = pk2(sc[2] * (1.f / 512.f), sc[3] * (1.f / 512.f)); *(u32x2*)(o + (size_t)(2 * cp) * 512 + c0) = w;
            w.x = pk2(ss[0] * (1.f / 512.f), ss[1] * (1.f / 512.f)); w.y = pk2(ss[2] * (1.f / 512.f), ss[3] * (1.f / 512.f)); *(u32x2*)(o + (size_t)(2 * cp + 1) * 512 + c0) = w;
        }
    }
    for (int it = C.bx * NTHR + C.tid; it < 2048 * 256; it += C.G * NTHR) {
        const int k = it >> 8, j0 = (it & 255) * 8; float v[8];
#pragma unroll
        for (int e = 0; e < 8; ++e) { const int j = j0 + e, s = j <= 1024 ? j : j - 1024; const float x = (float)((k * s) & 2047) * (1.f / 1024.f); v[e] = (j <= 1024) ? cospif(x) : -sinpif(x); }
        u32x4 w; w.x = pk2(v[0], v[1]); w.y = pk2(v[2], v[3]); w.z = pk2(v[4], v[5]); w.w = pk2(v[6], v[7]);
        *(u32x4*)((bf16_t*)(ws + WS_DFT) + (size_t)k * 2048 + j0) = w;
    }
    for (int it = C.bx * NTHR + C.tid; it < 2 * 8 * 2 * 128 * 64 / 8; it += C.G * NTHR) {
        const float* kp = a.in[33] + (size_t)it * 8; bf16x8_t kh_, kl_; split8(*(const f32x4*)kp, *(const f32x4*)(kp + 4), kh_, kl_);
        *(bf16x8_t*)((bf16_t*)(ws + WS_KEYST) + (size_t)it * 8) = kh_; *(bf16x8_t*)((bf16_t*)(ws + WS_KEYST) + 262144 + (size_t)it * 8) = kl_;
    }
    for (int it = C.bx * NTHR + C.tid; it < 2048 * 64; it += C.G * NTHR) {
        const int pos = it >> 6, j = it & 63; const float inv = powf(10000.f, -(float)(2 * (j & 31)) / 64.f);
        const float ang = (float)(j < 32 ? (pos >> 6) : (pos & 63)) * inv;
        ((float*)(ws + WS_ROPE))[it] = cosf(ang); ((float*)(ws + WS_ROPE))[2048 * 64 + it] = sinf(ang);
    }
    {
        bf16_t* W1T = (bf16_t*)(ws + WS_LORA); bf16_t* g2T = W1T + 2 * 224 * 512; bf16_t* w2T = g2T + 2 * 512 * 96; bf16_t* a2T = w2T + 2 * 2 * 512 * 32;
        for (int it = C.bx * NTHR + C.tid; it < 2 * 224 * 512; it += C.G * NTHR) {
            const int k = it & 511, j = (it >> 9) % 224, l = it / (224 * 512); float v;
            if (j < 96) v = a.in[22][((size_t)l * 512 + k) * 96 + j];
            else if (j < 160) v = a.in[17][((size_t)(l * 2 + ((j - 96) >> 5)) * 512 + k) * 32 + ((j - 96) & 31)];
            else v = a.in[20][((size_t)(l * 2 + ((j - 160) >> 5)) * 512 + k) * 32 + ((j - 160) & 31)];
            W1T[it] = (bf16_t)f2bf(v);
        }
        for (int it = C.bx * NTHR + C.tid; it < 2 * 512 * 96; it += C.G * NTHR) {
            const int j = it % 96, ch = (it / 96) & 511, l = it / (96 * 512);
            g2T[it] = (bf16_t)f2bf(a.in[23][((size_t)l * 96 + j) * 512 + ch]);
        }
        for (int it = C.bx * NTHR + C.tid; it < 2 * 2 * 512 * 32; it += C.G * NTHR) {
            const int j = it & 31, ch = (it >> 5) & 511, ld = it >> 14;
            w2T[it] = (bf16_t)f2bf(a.in[18][((size_t)ld * 32 + j) * 512 + ch]); a2T[it] = (bf16_t)f2bf(a.in[21][((size_t)ld * 32 + j) * 512 + ch]);
        }
    }
    for (int m = C.gw; m < MTOK; m += C.ngw) rms_row_to_bf16(a.in[0] + (size_t)m * DM, (bf16_t*)(ws + WS_HB) + (size_t)m * DM, C.lane);
}

__device__ __forceinline__ void qk_prep_token(const AP& a, int l, int m, int lane) {
    unsigned char* ws = a.ws;
    const float* pr = (const float*)(ws + WS_PROJ) + (size_t)m * PROJ;
    const int pos = m & (SEQ - 1);
    const float cs = ((const float*)(ws + WS_ROPE))[pos * 64 + lane], sn = ((const float*)(ws + WS_ROPE))[2048 * 64 + pos * 64 + lane];
    bf16_t* qo = (bf16_t*)(ws + WS_QB) + (size_t)m * 512; bf16_t* ko = (bf16_t*)(ws + WS_QB) + (size_t)MTOK * 512 + (size_t)m * 256; bf16_t* vo = ko + (size_t)MTOK * 256;
#pragma unroll
    for (int hh = 0; hh < 6; ++hh) {
        const float* src = pr + 1024 + hh * 128;
        const float* gn = a.in[hh < 4 ? 13 : 14] + l * 128;
        const float x1 = src[lane], x2 = src[lane + 64];
        const float rs = rsqrtf(wave_sum(x1 * x1 + x2 * x2) * (1.f / 128.f) + 1e-6f);
        const float y1 = x1 * rs * gn[lane], y2 = x2 * rs * gn[lane + 64];
        bf16_t* dst = hh < 4 ? qo + hh * 128 : ko + (hh - 4) * 128;
        dst[lane] = (bf16_t)f2bf(y1 * cs - y2 * sn); dst[lane + 64] = (bf16_t)f2bf(y1 * sn + y2 * cs);
    }
    const f32x4 vv = *((const f32x4*)(pr + 1792) + lane);
    u32x2 w; w.x = pk2(vv.x, vv.y); w.y = pk2(vv.z, vv.w); *((u32x2*)vo + lane) = w;
}

struct S5P { float lr, li, cr, ci; };
__device__ __forceinline__ S5P s5_params(const AP& a, int l, int d, int g, int p, float mult) {
    const int ix = ((l * 2 + d) * 32 + g) * 64 + p;
    const float lre = a.in[4][ix], lim = a.in[5][ix], step = __expf(a.in[6][(l * 2 + d) * 32 + g]) * mult;
    const float er = __expf(lre * step); float sn, cs; sincosf(lim * step, &sn, &cs);
    S5P r; r.lr = er * cs; r.li = er * sn;
    const float nr = r.lr - 1.f, ni = r.li, den = 1.f / (lre * lre + lim * lim);
    r.cr = (nr * lre + ni * lim) * den; r.ci = (ni * lre - nr * lim) * den;
    return r;
}
__device__ __forceinline__ void s5_ends_item(const AP& a, int l, int item, int lane, LAS float* us) {
    unsigned char* ws = a.ws;
    const int c = item & 31, g = (item >> 5) & 31, b = item >> 10, p = lane;
    const float* ur = (const float*)(ws + WS_PROJ) + ((size_t)(b * SEQ + c * 64 + lane)) * PROJ + 512 + g * 16;
#pragma unroll
    for (int q = 0; q < 4; ++q) *((LAS f32x4*)(us + lane * 16) + q) = *((const f32x4*)ur + q);
    LDS_WAIT(); asm volatile("" ::: "memory");
#pragma unroll 1
    for (int d = 0; d < 2; ++d) {
        const S5P P = s5_params(a, l, d, g, p, 1.f);
        f32x2 bb2[16];
        const float* bre = a.in[7] + ((size_t)((l * 2 + d) * 32 + g) * 64 + p) * 16; const float* bim = a.in[8] + ((size_t)((l * 2 + d) * 32 + g) * 64 + p) * 16;
#pragma unroll
        for (int h = 0; h < 16; ++h) { const float x = bre[h], y = bim[h]; bb2[h].x = P.cr * x - P.ci * y; bb2[h].y = P.cr * y + P.ci * x; }
        const f32x2 lam2 = {P.lr, P.lr}, lami = {-P.li, P.li};
        float xr = 0.f, xi = 0.f;
#pragma unroll 4
        for (int tt = 0; tt < 64; ++tt) {
            const int t = d ? 63 - tt : tt;
            f32x2 acc2 = {0.f, 0.f};
#pragma unroll
            for (int q = 0; q < 4; ++q) { const f32x4 u4 = *((const LAS f32x4*)(us + t * 16) + q);
#pragma unroll
                for (int e = 0; e < 4; ++e) acc2 += bb2[q * 4 + e] * u4[e]; }
            const f32x2 x2 = {xr, xi}, xs = {xi, xr}; const f32x2 n2 = lam2 * x2 + lami * xs + acc2; xr = n2.x; xi = n2.y;
        }
        f32x2 o; o.x = xr; o.y = xi;
        ((f32x2*)(ws + WS_S5E))[((size_t)((b * 32 + g) * 2 + d) * 32 + c) * 64 + p] = o;
    }
    LDS_WAIT(); asm volatile("" ::: "memory");
}
__device__ __forceinline__ void s5_final_item(const AP& a, int l, int item, int lane, LAS float* us  , LAS float* yb  , LAS float* X  ) {
    unsigned char* ws = a.ws;
    const int c = item & 31, g = (item >> 5) & 31, b = item >> 10, p = lane;
    const float* ur = (const float*)(ws + WS_PROJ) + ((size_t)(b * SEQ + c * 64 + lane)) * PROJ + 512 + g * 16;
#pragma unroll
    for (int q = 0; q < 4; ++q) { *((LAS f32x4*)(us + lane * 16) + q) = *((const f32x4*)ur + q); *((LAS f32x4*)(yb + lane * 16) + q) = (f32x4){0.f, 0.f, 0.f, 0.f}; }
    LDS_WAIT(); asm volatile("" ::: "memory");
    const int oh = lane & 15, otq = lane >> 4;
#pragma unroll 1
    for (int d = 0; d < 2; ++d) {
        const S5P P = s5_params(a, l, d, g, p, 1.f);
        const S5P P64 = s5_params(a, l, d, g, p, 64.f);
        float br[16], bi[16];
        const float* bre = a.in[7] + ((size_t)((l * 2 + d) * 32 + g) * 64 + p) * 16; const float* bim = a.in[8] + ((size_t)((l * 2 + d) * 32 + g) * 64 + p) * 16;
#pragma unroll
        for (int h = 0; h < 16; ++h) { const float x = bre[h], y = bim[h]; br[h] = P.cr * x - P.ci * y; bi[h] = P.cr * y + P.ci * x; }
        const f32x2* E = (const f32x2*)(ws + WS_S5E) + ((size_t)((b * 32 + g) * 2 + d) * 32) * 64 + p;
        float xr = 0.f, xi = 0.f;
        { f32x2 nx[4];
#pragma unroll
          for (int i = 0; i < 4; ++i) nx[i] = E[(d ? 31 - i : i) * 64];
#pragma unroll 1
          for (int grp = 0; grp < 8; ++grp) {
              if (d ? (31 - grp * 4 <= c) : (grp * 4 >= c)) break;
              f32x2 cu[4];
#pragma unroll
              for (int i = 0; i < 4; ++i) cu[i] = nx[i];
              if (grp < 7) {
#pragma unroll
                  for (int i = 0; i < 4; ++i) nx[i] = E[(d ? 27 - grp * 4 - i : grp * 4 + 4 + i) * 64];
              }
#pragma unroll
              for (int i = 0; i < 4; ++i) { const int cc = d ? 31 - grp * 4 - i : grp * 4 + i;
                  if (d ? (cc > c) : (cc < c)) { const float nr = P64.lr * xr - P64.li * xi + cu[i].x, ni = P64.lr * xi + P64.li * xr + cu[i].y; xr = nr; xi = ni; } }
          } }
        const float* cre = a.in[9] + ((size_t)((l * 2 + d) * 32 + g) * 16 + oh) * 64; const float* cim = a.in[10] + ((size_t)((l * 2 + d) * 32 + g) * 16 + oh) * 64;
#pragma unroll 1
        for (int sb = 0; sb < 4; ++sb) {
            for (int tt = 0; tt < 16; ++tt) {
                const int ts = sb * 16 + tt, t = d ? 63 - ts : ts;
                float ar = 0.f, ai = 0.f;
#pragma unroll
                for (int q = 0; q < 4; ++q) { const f32x4 u4 = *((const LAS f32x4*)(us + t * 16) + q);
#pragma unroll
                    for (int e = 0; e < 4; ++e) { ar += br[q * 4 + e] * u4[e]; ai += bi[q * 4 + e] * u4[e]; } }
                const float nr = P.lr * xr - P.li * xi + ar, ni = P.lr * xi + P.li * xr + ai; xr = nr; xi = ni;
                f32x2 o; o.x = xr; o.y = xi; *((LAS f32x2*)X + tt * 64 + p) = o;
            }
            LDS_WAIT(); asm volatile("" ::: "memory");
            float acc[4] = {0.f, 0.f, 0.f, 0.f};
            for (int pq = 0; pq < 16; ++pq) {
                const f32x4 c4r = *((const f32x4*)cre + pq), c4i = *((const f32x4*)cim + pq);
#pragma unroll
                for (int i = 0; i < 4; ++i) {
                    const LAS f32x4* xp = (const LAS f32x4*)(X + ((otq * 4 + i) * 64 + pq * 4) * 2);
                    const f32x4 xa = xp[0], xb = xp[1];
                    acc[i] += c4r[0] * xa[0] - c4i[0] * xa[1] + c4r[1] * xa[2] - c4i[1] * xa[3] + c4r[2] * xb[0] - c4i[2] * xb[1] + c4r[3] * xb[2] - c4i[3] * xb[3];
                }
            }
#pragma unroll
            for (int i = 0; i < 4; ++i) { const int ts = sb * 16 + otq * 4 + i, t = d ? 63 - ts : ts; yb[t * 16 + oh] += acc[i]; }
            LDS_WAIT(); asm volatile("" ::: "memory");
        }
    }
    const float* dsk = a.in[11] + (l * 32 + g) * 16;
    unsigned w[8];
#pragma unroll
    for (int h = 0; h < 16; h += 2) {
        const float y0 = gelu_tanh(yb[lane * 16 + h] + dsk[h] * us[lane * 16 + h]), y1 = gelu_tanh(yb[lane * 16 + h + 1] + dsk[h + 1] * us[lane * 16 + h + 1]);
        w[h >> 1] = pk2(y0, y1);
    }
    u32x4* dst = (u32x4*)((bf16_t*)(ws + WS_YGELU) + (size_t)(b * SEQ + c * 64 + lane) * 512 + g * 16);
    dst[0] = (u32x4){w[0], w[1], w[2], w[3]}; dst[1] = (u32x4){w[4], w[5], w[6], w[7]};
    LDS_WAIT(); asm volatile("" ::: "memory");
}

__device__ __forceinline__ void s5_tables(const Ctx& C, const AP& a) {
    unsigned char* ws = a.ws;
    f32x4* LAMT = (f32x4*)(ws + WS_S5T); bf16_t* BBop = (bf16_t*)(ws + WS_S5T + 131072); bf16_t* CBop = (bf16_t*)(ws + WS_S5T + 131072 + 1048576);
    for (int it = C.bx * NTHR + C.tid; it < 128 * 64; it += C.G * NTHR) {
        const int p = it & 63, ldg = it >> 6, g = ldg & 31, d = (ldg >> 5) & 1, l = ldg >> 6;
        const S5P P = s5_params(a, l, d, g, p, 1.f), P64 = s5_params(a, l, d, g, p, 64.f);
        LAMT[it] = (f32x4){P.lr, P.li, P64.lr, P64.li};
    }
    for (int it = C.bx * NTHR + C.tid; it < 128 * 8 * 64; it += C.G * NTHR) {
        const int lane = it & 63, nt = (it >> 6) & 7, ldg = it >> 9, g = ldg & 31, d = (ldg >> 5) & 1, l = ldg >> 6, fr = lane & 15, fq = lane >> 4;
        const int col = nt * 16 + fr, p = col >> 1, ri = col & 1;
        unsigned w[4] = {0u, 0u, 0u, 0u};
        if (fq < 2) {
            const S5P P = s5_params(a, l, d, g, p, 1.f);
            const float* bre = a.in[7] + ((size_t)ldg * 64 + p) * 16 + fq * 8; const float* bim = a.in[8] + ((size_t)ldg * 64 + p) * 16 + fq * 8;
            float v[8];
#pragma unroll
            for (int jj = 0; jj < 8; ++jj) v[jj] = ri ? (P.cr * bim[jj] + P.ci * bre[jj]) : (P.cr * bre[jj] - P.ci * bim[jj]);
            w[0] = pk2(v[0], v[1]); w[1] = pk2(v[2], v[3]); w[2] = pk2(v[4], v[5]); w[3] = pk2(v[6], v[7]);
        }
        *(u32x4*)(BBop + (size_t)it * 8) = (u32x4){w[0], w[1], w[2], w[3]};
    }
    for (int it = C.bx * NTHR + C.tid; it < 128 * 4 * 64; it += C.G * NTHR) {
        const int lane = it & 63, s2 = (it >> 6) & 3, ldg = it >> 8, fr = lane & 15, fq = lane >> 4;
        const float* cre = a.in[9] + ((size_t)ldg * 16 + fr) * 64 + 16 * s2 + fq * 4; const float* cim = a.in[10] + ((size_t)ldg * 16 + fr) * 64 + 16 * s2 + fq * 4;
        *(u32x4*)(CBop + (size_t)it * 8) = (u32x4){pk2(cre[0], -cim[0]), pk2(cre[1], -cim[1]), pk2(cre[2], -cim[2]), pk2(cre[3], -cim[3])};
    }
}
__device__ __forceinline__ void s5_load_u(const float* ur, LAS unsigned char* wl, int lane) {
    const f32x4 u0 = *((const f32x4*)ur + 0), u1 = *((const f32x4*)ur + 1), u2 = *((const f32x4*)ur + 2), u3 = *((const f32x4*)ur + 3);
    LAS u32x4* dst = (LAS u32x4*)(wl + lane * 32);
    dst[0] = (u32x4){pk2(u0.x, u0.y), pk2(u0.z, u0.w), pk2(u1.x, u1.y), pk2(u1.z, u1.w)}; dst[1] = (u32x4){pk2(u2.x, u2.y), pk2(u2.z, u2.w), pk2(u3.x, u3.y), pk2(u3.z, u3.w)};
}
__device__ __forceinline__ void s5_build_bb(const AP& a, int ldg, float cr, float ci, int lane, LAS unsigned char* wl, bf16x8_t (&bb)[8]) {
    const int fr = lane & 15, fq = lane >> 4;
    LAS f32x2* cf = (LAS f32x2*)(wl + 14848);
    f32x2 me; me.x = cr; me.y = ci; cf[lane] = me;
    LDS_WAIT(); asm volatile("" ::: "memory");
#pragma unroll
    for (int nt = 0; nt < 8; ++nt) {
        const int col = nt * 16 + fr, p = col >> 1, ri = col & 1;
        unsigned w_[4] = {0u, 0u, 0u, 0u};
        if (fq < 2) {
            const f32x2 c2 = cf[p];
            const f32x4* bre = (const f32x4*)(a.in[7] + ((size_t)ldg * 64 + p) * 16 + fq * 8); const f32x4* bim = (const f32x4*)(a.in[8] + ((size_t)ldg * 64 + p) * 16 + fq * 8);
            const f32x4 r0 = bre[0], r1 = bre[1], i0 = bim[0], i1 = bim[1];
            float v[8];
#pragma unroll
            for (int jj = 0; jj < 4; ++jj) { v[jj] = ri ? (c2.x * i0[jj] + c2.y * r0[jj]) : (c2.x * r0[jj] - c2.y * i0[jj]); v[4 + jj] = ri ? (c2.x * i1[jj] + c2.y * r1[jj]) : (c2.x * r1[jj] - c2.y * i1[jj]); }
            w_[0] = pk2(v[0], v[1]); w_[1] = pk2(v[2], v[3]); w_[2] = pk2(v[4], v[5]); w_[3] = pk2(v[6], v[7]);
        }
        bb[nt] = mk8(w_[0], w_[1], w_[2], w_[3]);
        asm volatile("" ::: "memory");
    }
}
template <bool FINAL>
__device__ __forceinline__ void s5_subblock(LAS unsigned char* wl, const bf16x8_t (&bb)[8], int d, int sb, int lane, float lr, float li, float& xr, float& xi) {
    const int fr = lane & 15, fq = lane >> 4;
    LAS float* BUs = (LAS float*)(wl + 2048); LAS bf16_t* Xb = (LAS bf16_t*)(wl + 10496);
    const int trow = d ? 63 - (sb * 16 + fr) : sb * 16 + fr;
    bf16x8_t aU = mk8(0u, 0u, 0u, 0u);
    if (fq < 2) aU = *(const LAS bf16x8_t*)(wl + trow * 32 + fq * 16);
    const f32x4 z4 = {0.f, 0.f, 0.f, 0.f};
#pragma unroll
    for (int nt = 0; nt < 8; ++nt) { const f32x4 bu = __builtin_amdgcn_mfma_f32_16x16x32_bf16(aU, bb[nt], z4, 0, 0, 0);
#pragma unroll
        for (int r = 0; r < 4; ++r) BUs[(fq * 4 + r) * 132 + nt * 16 + fr] = bu[r]; }
    LDS_WAIT(); asm volatile("" ::: "memory");
#pragma unroll
    for (int tt = 0; tt < 16; ++tt) {
        const f32x2 bq = *(const LAS f32x2*)(BUs + tt * 132 + 2 * lane);
        const float nr = lr * xr - li * xi + bq.x, ni = lr * xi + li * xr + bq.y; xr = nr; xi = ni;
        if (FINAL) *(LAS unsigned*)(Xb + (d ? 15 - tt : tt) * 136 + 2 * lane) = pk2(xr, xi);
    }
    LDS_WAIT(); asm volatile("" ::: "memory");
}
__device__ __forceinline__ void s5_ends_item_m(const AP& a, int l, int item, int lane, LAS unsigned char* wl) {
    unsigned char* ws = a.ws;
    const int c = item & 31, g = (item >> 5) & 31, b = item >> 10;
    s5_load_u((const float*)(ws + WS_PROJ) + ((size_t)(b * SEQ + c * 64 + lane)) * PROJ + 512 + g * 16, wl, lane);
    LDS_WAIT(); asm volatile("" ::: "memory");
#pragma unroll 1
    for (int d = 0; d < 2; ++d) {
        const int ldg = (l * 2 + d) * 32 + g;
        const S5P Pq = s5_params(a, l, d, g, lane, 1.f);
        const f32x4 lam = {Pq.lr, Pq.li, 0.f, 0.f};
        bf16x8_t bb[8]; s5_build_bb(a, ldg, Pq.cr, Pq.ci, lane, wl, bb);
        float xr = 0.f, xi = 0.f;
#pragma unroll 1
        for (int sb = 0; sb < 4; ++sb) s5_subblock<false>(wl, bb, d, sb, lane, lam[0], lam[1], xr, xi);
        f32x2 o; o.x = xr; o.y = xi;
        ((f32x2*)(ws + WS_S5E))[((size_t)((b * 32 + g) * 2 + d) * 32 + c) * 64 + lane] = o;
    }
}
__device__ __forceinline__ void s5_final_item_m(const AP& a, int l, int item, int lane, LAS unsigned char* wl) {
    unsigned char* ws = a.ws;
    const int c = item & 31, g = (item >> 5) & 31, b = item >> 10, fr = lane & 15, fq = lane >> 4;
    const float* ubase = (const float*)(ws + WS_PROJ) + ((size_t)(b * SEQ + c * 64)) * PROJ + 512 + g * 16;
    s5_load_u(ubase + (size_t)lane * PROJ, wl, lane);
    LDS_WAIT(); asm volatile("" ::: "memory");
    LAS bf16_t* Xb = (LAS bf16_t*)(wl + 10496);
    f32x4 yacc[4];
#pragma unroll
    for (int q = 0; q < 4; ++q) yacc[q] = (f32x4){0.f, 0.f, 0.f, 0.f};
#pragma unroll 1
    for (int d = 0; d < 2; ++d) {
        const int ldg = (l * 2 + d) * 32 + g;
        const S5P Pq = s5_params(a, l, d, g, lane, 1.f), P64 = s5_params(a, l, d, g, lane, 64.f);
        const f32x4 lam = {Pq.lr, Pq.li, P64.lr, P64.li};
        bf16x8_t bb[8], cb[4]; s5_build_bb(a, ldg, Pq.cr, Pq.ci, lane, wl, bb);
#pragma unroll
        for (int s2 = 0; s2 < 4; ++s2) {
            const f32x4 cr4 = *(const f32x4*)(a.in[9] + ((size_t)ldg * 16 + fr) * 64 + 16 * s2 + fq * 4), ci4 = *(const f32x4*)(a.in[10] + ((size_t)ldg * 16 + fr) * 64 + 16 * s2 + fq * 4);
            cb[s2] = mk8(pk2(cr4[0], -ci4[0]), pk2(cr4[1], -ci4[1]), pk2(cr4[2], -ci4[2]), pk2(cr4[3], -ci4[3])); }
        const f32x2* E = (const f32x2*)(ws + WS_S5E) + ((size_t)((b * 32 + g) * 2 + d) * 32) * 64 + lane;
        float xr = 0.f, xi = 0.f;
        { f32x2 nx[4];
#pragma unroll
          for (int i = 0; i < 4; ++i) nx[i] = E[(d ? 31 - i : i) * 64];
#pragma unroll 1
          for (int grp = 0; grp < 8; ++grp) {
              if (d ? (31 - grp * 4 <= c) : (grp * 4 >= c)) break;
              f32x2 cu[4];
#pragma unroll
              for (int i = 0; i < 4; ++i) cu[i] = nx[i];
              if (grp < 7) {
#pragma unroll
                  for (int i = 0; i < 4; ++i) nx[i] = E[(d ? 27 - grp * 4 - i : grp * 4 + 4 + i) * 64];
              }
#pragma unroll
              for (int i = 0; i < 4; ++i) { const int cc = d ? 31 - grp * 4 - i : grp * 4 + i;
                  if (d ? (cc > c) : (cc < c)) { const float nr = lam[2] * xr - lam[3] * xi + cu[i].x, ni = lam[2] * xi + lam[3] * xr + cu[i].y; xr = nr; xi = ni; } }
          } }
#pragma unroll
        for (int sb = 0; sb < 4; ++sb) {
            s5_subblock<true>(wl, bb, d, sb, lane, lam[0], lam[1], xr, xi);
            f32x4 acc = d ? yacc[3 - sb] : yacc[sb];
#pragma unroll
            for (int s2 = 0; s2 < 4; ++s2) acc = __builtin_amdgcn_mfma_f32_16x16x32_bf16(*(const LAS bf16x8_t*)(Xb + fr * 136 + s2 * 32 + fq * 8), cb[s2], acc, 0, 0, 0);
            if (d) yacc[3 - sb] = acc; else yacc[sb] = acc;
            LDS_WAIT(); asm volatile("" ::: "memory");
        }
    }
    const float dsk = a.in[11][(l * 32 + g) * 16 + fr];
#pragma unroll
    for (int q = 0; q < 4; ++q)
#pragma unroll
        for (int r = 0; r < 4; ++r) { const int t = q * 16 + fq * 4 + r;
            const float y = gelu_tanh(yacc[q][r] + dsk * ubase[(size_t)t * PROJ + fr]);
            ((bf16_t*)(ws + WS_YGELU))[(size_t)(b * SEQ + c * 64 + t) * 512 + g * 16 + fr] = (bf16_t)f2bf(y); }
}
__device__ __forceinline__ float gelu_tanh_fast(float x) { const float u2 = 1.5957691216057308f * (x + 0.044715f * x * x * x); return x / (1.f + __expf(-u2)); }
__device__ __forceinline__ void s5_final_item_h(const AP& a, int l, int item, int lane, LAS unsigned char* wl) {
    unsigned char* ws = a.ws;
    const int c = item & 31, g = (item >> 5) & 31, b = item >> 10, p = lane, fr = lane & 15, fq = lane >> 4;
    LAS float* us = (LAS float*)wl; LAS bf16_t* Xb = (LAS bf16_t*)(wl + 4096);
    const float* ur = (const float*)(ws + WS_PROJ) + ((size_t)(b * SEQ + c * 64 + lane)) * PROJ + 512 + g * 16;
#pragma unroll
    for (int q = 0; q < 4; ++q) *((LAS f32x4*)(us + lane * 16) + q) = *((const f32x4*)ur + q);
    LDS_WAIT(); asm volatile("" ::: "memory");
    f32x4 yacc[4];
#pragma unroll
    for (int q = 0; q < 4; ++q) yacc[q] = (f32x4){0.f, 0.f, 0.f, 0.f};
#pragma unroll 1
    for (int d = 0; d < 2; ++d) {
        const int ldg = (l * 2 + d) * 32 + g;
        const S5P P = s5_params(a, l, d, g, p, 1.f), P64 = s5_params(a, l, d, g, p, 64.f);
        f32x2 bb2[16];
        const float* bre = a.in[7] + ((size_t)ldg * 64 + p) * 16; const float* bim = a.in[8] + ((size_t)ldg * 64 + p) * 16;
#pragma unroll
        for (int h = 0; h < 16; ++h) { const float x = bre[h], y = bim[h]; bb2[h].x = P.cr * x - P.ci * y; bb2[h].y = P.cr * y + P.ci * x; }
        const f32x2 lam2 = {P.lr, P.lr}, lami = {-P.li, P.li};
        bf16x8_t cb[4];
#pragma unroll
        for (int s2 = 0; s2 < 4; ++s2) {
            const f32x4 cr4 = *(const f32x4*)(a.in[9] + ((size_t)ldg * 16 + fr) * 64 + 16 * s2 + fq * 4), ci4 = *(const f32x4*)(a.in[10] + ((size_t)ldg * 16 + fr) * 64 + 16 * s2 + fq * 4);
            cb[s2] = mk8(pk2(cr4[0], -ci4[0]), pk2(cr4[1], -ci4[1]), pk2(cr4[2], -ci4[2]), pk2(cr4[3], -ci4[3])); }
        const f32x2* E = (const f32x2*)(ws + WS_S5E) + ((size_t)((b * 32 + g) * 2 + d) * 32) * 64 + p;
        float xr = 0.f, xi = 0.f;
        { f32x2 nx[4];
#pragma unroll
          for (int i = 0; i < 4; ++i) nx[i] = E[(d ? 31 - i : i) * 64];
#pragma unroll 1
          for (int grp = 0; grp < 8; ++grp) {
              if (d ? (31 - grp * 4 <= c) : (grp * 4 >= c)) break;
              f32x2 cu[4];
#pragma unroll
              for (int i = 0; i < 4; ++i) cu[i] = nx[i];
              if (grp < 7) {
#pragma unroll
                  for (int i = 0; i < 4; ++i) nx[i] = E[(d ? 27 - grp * 4 - i : grp * 4 + 4 + i) * 64];
              }
#pragma unroll
              for (int i = 0; i < 4; ++i) { const int cc = d ? 31 - grp * 4 - i : grp * 4 + i;
                  if (d ? (cc > c) : (cc < c)) { const float nr = P64.lr * xr - P64.li * xi + cu[i].x, ni = P64.lr * xi + P64.li * xr + cu[i].y; xr = nr; xi = ni; } }
          } }
#pragma unroll
        for (int sb = 0; sb < 4; ++sb) {
#pragma unroll 4
            for (int tt = 0; tt < 16; ++tt) {
                const int ts = sb * 16 + tt, t = d ? 63 - ts : ts;
                f32x2 acc2 = {0.f, 0.f};
#pragma unroll
                for (int q = 0; q < 4; ++q) { const f32x4 u4 = *((const LAS f32x4*)(us + t * 16) + q);
#pragma unroll
                    for (int e = 0; e < 4; ++e) acc2 += bb2[q * 4 + e] * u4[e]; }
                { const f32x2 x2 = {xr, xi}, xs = {xi, xr}; const f32x2 n2 = lam2 * x2 + lami * xs + acc2; xr = n2.x; xi = n2.y; }
                *(LAS unsigned*)(Xb + (d ? 15 - tt : tt) * 136 + 2 * p) = pg8::cvt_pk_bf16(xr, xi);
            }
            LDS_WAIT(); asm volatile("" ::: "memory");
            f32x4 acc = d ? yacc[3 - sb] : yacc[sb];
#pragma unroll
            for (int s2 = 0; s2 < 4; ++s2) acc = __builtin_amdgcn_mfma_f32_16x16x32_bf16(*(const LAS bf16x8_t*)(Xb + fr * 136 + s2 * 32 + fq * 8), cb[s2], acc, 0, 0, 0);
            if (d) yacc[3 - sb] = acc; else yacc[sb] = acc;
            LDS_WAIT(); asm volatile("" ::: "memory");
        }
    }
    const float dsk = a.in[11][(l * 32 + g) * 16 + fr];
#pragma unroll
    for (int q = 0; q < 4; ++q)
#pragma unroll
        for (int r = 0; r < 4; ++r) { const int t = q * 16 + fq * 4 + r;
            const float y = gelu_tanh_fast(yacc[q][r] + dsk * us[t * 16 + fr]);
            ((bf16_t*)(ws + WS_YGELU))[(size_t)(b * SEQ + c * 64 + t) * 512 + g * 16 + fr] = (bf16_t)f2bf(y); }
    LDS_WAIT(); asm volatile("" ::: "memory");
}
__device__ __forceinline__ float shift3(float p, float c, float n, float m0, float m1) { return c + (p - c) * m0 + (n - c) * m1; }
__device__ __forceinline__ float dpp_ror4(float x) { return __builtin_bit_cast(float, __builtin_amdgcn_update_dpp(0, __builtin_bit_cast(int, x), 0x124, 0xF, 0xF, true)); }
__device__ __forceinline__ float dpp_ror8(float x) { return __builtin_bit_cast(float, __builtin_amdgcn_update_dpp(0, __builtin_bit_cast(int, x), 0x128, 0xF, 0xF, true)); }
__device__ __forceinline__ float dpp_q1(float x) { return __builtin_bit_cast(float, __builtin_amdgcn_update_dpp(0, __builtin_bit_cast(int, x), 0xB1, 0xF, 0xF, true)); }
__device__ __forceinline__ float dpp_q2(float x) { return __builtin_bit_cast(float, __builtin_amdgcn_update_dpp(0, __builtin_bit_cast(int, x), 0x4E, 0xF, 0xF, true)); }
__device__ __forceinline__ float row_sum16(float x) { x += dpp_q1(x); x += dpp_q2(x); x += dpp_ror4(x); x += dpp_ror8(x); return x; }
__device__ __forceinline__ void rwkv_prep_item(const Ctx& C, const AP& a, int l, int ti) {
    unsigned char* ws = a.ws;
    LAS bf16_t* zsb = (LAS bf16_t*)C.lds;
    LAS bf16_t* hidb = (LAS bf16_t*)(C.lds + 33280);
    const float* proj = (const float*)(ws + WS_PROJ);
    const int m0 = ti * 32, s0 = m0 & (SEQ - 1), tid = C.tid, lane = C.lane, w = C.wave;
    const float* mu = a.in[15] + (size_t)l * 4 * 2 * 512;
    float* RW = (float*)(ws + WS_RW); float* KS = (float*)(ws + WS_KS);
    {
        const int c = tid;
        const float mr0 = mu[0 * 512 + c], mr1 = mu[1 * 512 + c], mk0 = mu[2 * 512 + c], mk1 = mu[3 * 512 + c], mv0 = mu[4 * 512 + c], mv1 = mu[5 * 512 + c], mz0 = mu[6 * 512 + c], mz1 = mu[7 * 512 + c];
        const float kk_c = a.in[24][l * 512 + c];
#pragma unroll 1
        for (int hf = 0; hf < 2; ++hf) {
            const int tb0 = hf * 16;
            const float* rp = proj + (size_t)(m0 + tb0) * PROJ + 2048 + c;
            float rr[18], kr[18], vr[18], zr[18];
#pragma unroll
            for (int i = 0; i < 18; ++i) {
                const int sq = s0 + tb0 - 1 + i; const bool ok = (sq >= 0) && (sq < SEQ); const float* q = rp + (long)(i - 1) * PROJ;
                rr[i] = ok ? q[0] : 0.f; kr[i] = ok ? q[512] : 0.f; vr[i] = ok ? q[1024] : 0.f; zr[i] = ok ? q[1536] : 0.f;
            }
#pragma unroll
            for (int t = 0; t < 16; ++t) {
                const float rs = shift3(rr[t], rr[t + 1], rr[t + 2], mr0, mr1), ks = shift3(kr[t], kr[t + 1], kr[t + 2], mk0, mk1);
                const float vs = shift3(vr[t], vr[t + 1], vr[t + 2], mv0, mv1), zs = shift3(zr[t], zr[t + 1], zr[t + 2], mz0, mz1);
                const float kkr = ks * kk_c; const float kkn = kkr * rsqrtf(wave_sum(kkr * kkr) + 1e-12f);
                const size_t o = (size_t)(m0 + tb0 + t) * 512 + c;
                RW[(size_t)RW_R * RWSZ + o] = rs; RW[(size_t)RW_V * RWSZ + o] = vs; RW[(size_t)RW_KK * RWSZ + o] = kkn; KS[o] = ks;
                zsb[(tb0 + t) * 520 + c] = (bf16_t)f2bf(zs);
            }
        }
    }
    __syncthreads();
    const int fr = lane & 15, fq = lane >> 4;
    const bf16_t* W1T = (const bf16_t*)(ws + WS_LORA) + (size_t)l * 224 * 512; const bf16_t* g2T = (const bf16_t*)(ws + WS_LORA) + 2 * 224 * 512 + (size_t)l * 512 * 96;
    const bf16_t* w2T = (const bf16_t*)(ws + WS_LORA) + 2 * 224 * 512 + 2 * 512 * 96 + (size_t)l * 2 * 512 * 32; const bf16_t* a2T = w2T + 2 * 2 * 512 * 32;
    for (int tile = w; tile < 28; tile += 8) {
        const int mt = tile / 14, nt = tile % 14;
        f32x4 acc = {0.f, 0.f, 0.f, 0.f};
        const LAS bf16_t* ap = zsb + (mt * 16 + fr) * 520 + fq * 8; const bf16_t* bp = W1T + (size_t)(nt * 16 + fr) * 512 + fq * 8;
#pragma unroll
        for (int kk = 0; kk < 16; ++kk) acc = __builtin_amdgcn_mfma_f32_16x16x32_bf16(*(const LAS bf16x8_t*)(ap + kk * 32), *(const bf16x8_t*)(bp + kk * 32), acc, 0, 0, 0);
        const int hj = nt * 16 + fr;
#pragma unroll
        for (int j = 0; j < 4; ++j) { float v = acc[j]; if (hj < 96) v = sigmoidf_(v); else if (hj < 160) v = tanhf(v); hidb[(mt * 16 + fq * 4 + j) * 240 + hj] = (bf16_t)f2bf(v); }
    }
    __syncthreads();
#pragma unroll 1
    for (int mt = 0; mt < 2; ++mt) {
        bf16x8_t a7[7];
#pragma unroll
        for (int kk = 0; kk < 7; ++kk) a7[kk] = *(const LAS bf16x8_t*)(hidb + (mt * 16 + fr) * 240 + kk * 32 + fq * 8);
        float pb0[4] = {0.f, 0.f, 0.f, 0.f}, pb1[4] = {0.f, 0.f, 0.f, 0.f}, vsr[4][4];
        float cks[4], ckk[4], crs[4], nks[4], nkk[4], nrs[4];
#pragma unroll
        for (int j = 0; j < 4; ++j) { const size_t o = (size_t)(m0 + mt * 16 + fq * 4 + j) * 512 + w * 64 + fr;
            cks[j] = KS[o]; ckk[j] = RW[(size_t)RW_KK * RWSZ + o]; crs[j] = RW[(size_t)RW_R * RWSZ + o]; vsr[0][j] = RW[(size_t)RW_V * RWSZ + o]; }
#pragma unroll
        for (int nt = 0; nt < 4; ++nt) {
            if (nt < 3) {
#pragma unroll
                for (int j = 0; j < 4; ++j) { const size_t o = (size_t)(m0 + mt * 16 + fq * 4 + j) * 512 + w * 64 + (nt + 1) * 16 + fr;
                    nks[j] = KS[o]; nkk[j] = RW[(size_t)RW_KK * RWSZ + o]; nrs[j] = RW[(size_t)RW_R * RWSZ + o]; vsr[nt + 1][j] = RW[(size_t)RW_V * RWSZ + o]; }
            }
            const int ch = w * 64 + nt * 16 + fr;
            f32x4 ag = {0.f, 0.f, 0.f, 0.f}, aw0 = ag, aw1 = ag, aa0 = ag, aa1 = ag;
#pragma unroll
            for (int kk = 0; kk < 3; ++kk) ag = __builtin_amdgcn_mfma_f32_16x16x32_bf16(a7[kk], *(const bf16x8_t*)(g2T + (size_t)ch * 96 + kk * 32 + fq * 8), ag, 0, 0, 0);
            aw0 = __builtin_amdgcn_mfma_f32_16x16x32_bf16(a7[3], *(const bf16x8_t*)(w2T + (size_t)(0 * 512 + ch) * 32 + fq * 8), aw0, 0, 0, 0);
            aw1 = __builtin_amdgcn_mfma_f32_16x16x32_bf16(a7[4], *(const bf16x8_t*)(w2T + (size_t)(1 * 512 + ch) * 32 + fq * 8), aw1, 0, 0, 0);
            aa0 = __builtin_amdgcn_mfma_f32_16x16x32_bf16(a7[5], *(const bf16x8_t*)(a2T + (size_t)(0 * 512 + ch) * 32 + fq * 8), aa0, 0, 0, 0);
            aa1 = __builtin_amdgcn_mfma_f32_16x16x32_bf16(a7[6], *(const bf16x8_t*)(a2T + (size_t)(1 * 512 + ch) * 32 + fq * 8), aa1, 0, 0, 0);
            const float w00 = a.in[16][(l * 2 + 0) * 512 + ch], w01 = a.in[16][(l * 2 + 1) * 512 + ch], a00 = a.in[19][(l * 2 + 0) * 512 + ch], a01 = a.in[19][(l * 2 + 1) * 512 + ch];
            const float ka_c = a.in[25][l * 512 + ch], rk_c = a.in[26][l * 512 + ch];
#pragma unroll
            for (int j = 0; j < 4; ++j) {
                const size_t o = (size_t)(m0 + mt * 16 + fq * 4 + j) * 512 + ch;
                const float ks = cks[j], kkn = ckk[j], rs = crs[j];
#pragma unroll
                for (int d = 0; d < 2; ++d) {
                    const float wl = (d ? w01 : w00) + (d ? aw1[j] : aw0[j]);
                    const float nx = -wl, sp = fmaxf(nx, 0.f) + log1pf(__expf(-fabsf(nx)));
                    const float decay = __expf(-__expf(-sp - 0.5f));
                    const float av = sigmoidf_((d ? a01 : a00) + (d ? aa1[j] : aa0[j]));
                    const float kd = ks * (1.f + (av - 1.f) * ka_c), bb = kkn * av;
                    if (d) pb1[j] += rs * kd * rk_c; else pb0[j] += rs * kd * rk_c;
                    RW[(size_t)(RW_W0 + d) * RWSZ + o] = decay; RW[(size_t)(RW_KD0 + d) * RWSZ + o] = kd; RW[(size_t)(RW_B0 + d) * RWSZ + o] = bb;
                }
                RW[(size_t)RW_G * RWSZ + o] = ag[j];
            }
#pragma unroll
            for (int j = 0; j < 4; ++j) { cks[j] = nks[j]; ckk[j] = nkk[j]; crs[j] = nrs[j]; }
        }
#pragma unroll
        for (int j = 0; j < 4; ++j) { const float tb = row_sum16(pb0[j]) + row_sum16(pb1[j]);
#pragma unroll
            for (int nt = 0; nt < 4; ++nt) RW[(size_t)RW_BONUS * RWSZ + (size_t)(m0 + mt * 16 + fq * 4 + j) * 512 + w * 64 + nt * 16 + fr] = tb * vsr[nt][j]; }
    }
    __syncthreads();
}

__device__ __forceinline__ void rwkv_chunk_pre(const AP& a, int cid, int lane, LAS unsigned char* wl) {
    unsigned char* ws = a.ws;
    const int c = cid & 127, ci = cid >> 7, d = ci & 1, h = (ci >> 1) & 7, b = ci >> 4, fr = lane & 15, fq = lane >> 4;
    const float* RW = (const float*)(ws + WS_RW);
    unsigned char* rec = ws + WS_RWC + (size_t)cid * RWC_REC;
    LAS bf16_t* KH = (LAS bf16_t*)wl; LAS bf16_t* BC = KH + 1152; LAS bf16_t* KC = BC + 1152; LAS bf16_t* RH = KC + 1152;
    LAS bf16_t* KHT = RH + 1152;
    LAS float* Am = (LAS float*)(wl + 11264); LAS float* Bmm = Am + 256; LAS float* Abm = Bmm + 256; LAS float* Akm = Abm + 256; LAS float* Tm = Akm + 256;
    const size_t tok0 = (size_t)b * SEQ; const int colk = h * 64 + lane;
#define TOKI(i) (tok0 + (size_t)(d ? (SEQ - 1 - (c * 16 + (i))) : (c * 16 + (i))))
    {
        float W[16];
#pragma unroll
        for (int i = 0; i < 16; ++i) W[i] = RW[(size_t)(RW_W0 + d) * RWSZ + TOKI(i) * 512 + colk];
#pragma unroll
        for (int i = 1; i < 16; ++i) W[i] *= W[i - 1];
        const float W15 = W[15];
        unsigned zt[16];
#pragma unroll
        for (int i = 0; i < 16; ++i) {
            const size_t o = TOKI(i) * 512 + colk;
            const float kap = RW[(size_t)RW_KK * RWSZ + o], bv = RW[(size_t)(RW_B0 + d) * RWSZ + o], kdv = RW[(size_t)(RW_KD0 + d) * RWSZ + o], rv = RW[(size_t)RW_R * RWSZ + o];
            const float wm1 = i ? W[i - 1] : 1.f, iw = 1.f / W[i], wr = W15 * iw;
            const unsigned kh = f2bf(kap * wm1);
            KH[i * 72 + lane] = (bf16_t)kh; KHT[lane * 16 + i] = (bf16_t)kh;
            BC[i * 72 + lane] = (bf16_t)f2bf(bv * iw); KC[i * 72 + lane] = (bf16_t)f2bf(kdv * iw); RH[i * 72 + lane] = (bf16_t)f2bf(rv * W[i]);
            const unsigned bb = f2bf(bv * wr), kb = f2bf(kdv * wr);
            const int sb = (i >> 2) * 8 + (i & 3), sk = sb + 4;
            if (sb & 1) zt[sb >> 1] |= bb << 16; else zt[sb >> 1] = bb;
            if (sk & 1) zt[sk >> 1] |= kb << 16; else zt[sk >> 1] = kb;
        }
        u32x4* zp = (u32x4*)(rec + 4096 + lane * 64);
#pragma unroll
        for (int q = 0; q < 4; ++q) zp[q] = (u32x4){zt[q * 4], zt[q * 4 + 1], zt[q * 4 + 2], zt[q * 4 + 3]};
        ((float*)(rec + 8192))[lane] = W15;
    }
    float Vq[4][4];
#pragma unroll
    for (int nt = 0; nt < 4; ++nt) {
#pragma unroll
        for (int r = 0; r < 4; ++r) Vq[nt][r] = RW[(size_t)RW_V * RWSZ + TOKI(fq * 4 + r) * 512 + h * 64 + nt * 16 + fr];
        u32x2 pv; pv.x = pk2(Vq[nt][0], Vq[nt][1]); pv.y = pk2(Vq[nt][2], Vq[nt][3]);
        *(u32x2*)(rec + 12800 + (nt * 64 + lane) * 8) = pv;
    }
    LDS_WAIT(); asm volatile("" ::: "memory");
    {
        f32x4 cA = {0.f, 0.f, 0.f, 0.f}, cB = cA, cAb = cA, cAk = cA;
#pragma unroll
        for (int s2 = 0; s2 < 2; ++s2) {
            const int off = fr * 72 + s2 * 32 + fq * 8;
            const bf16x8_t fkh = *(const LAS bf16x8_t*)(KH + off), fbc = *(const LAS bf16x8_t*)(BC + off), fkc = *(const LAS bf16x8_t*)(KC + off), frh = *(const LAS bf16x8_t*)(RH + off);
            cA = __builtin_amdgcn_mfma_f32_16x16x32_bf16(fkh, fbc, cA, 0, 0, 0); cB = __builtin_amdgcn_mfma_f32_16x16x32_bf16(fkh, fkc, cB, 0, 0, 0);
            cAb = __builtin_amdgcn_mfma_f32_16x16x32_bf16(frh, fbc, cAb, 0, 0, 0); cAk = __builtin_amdgcn_mfma_f32_16x16x32_bf16(frh, fkc, cAk, 0, 0, 0);
        }
#pragma unroll
        for (int r = 0; r < 4; ++r) { const int i = fq * 4 + r, j = fr;
            Am[i * 16 + j] = j < i ? cA[r] : 0.f; Bmm[i * 16 + j] = j < i ? cB[r] : 0.f; Abm[i * 16 + j] = j <= i ? cAb[r] : 0.f; Akm[i * 16 + j] = j <= i ? cAk[r] : 0.f; }
    }
    LDS_WAIT(); asm volatile("" ::: "memory");
    {
        float x[16];
#pragma unroll
        for (int i = 0; i < 16; ++i) {
            float sacc = (i == fr) ? 1.f : 0.f;
#pragma unroll
            for (int jq = 0; jq < (i + 3) / 4; ++jq) { const f32x4 q = *(const LAS f32x4*)(Am + i * 16 + jq * 4);
#pragma unroll
                for (int e = 0; e < 4; ++e) if (jq * 4 + e < i) sacc -= q[e] * x[jq * 4 + e]; }
            x[i] = sacc;
        }
        if (fq == 0) {
#pragma unroll
            for (int i = 0; i < 16; ++i) Tm[i * 16 + fr] = x[i];
        }
    }
    LDS_WAIT(); asm volatile("" ::: "memory");
    {
        const f32x4 qT = *(const LAS f32x4*)(Tm + fr * 16 + fq * 4), qB = *(const LAS f32x4*)(Bmm + fr * 16 + fq * 4), qAb = *(const LAS f32x4*)(Abm + fr * 16 + fq * 4), qAk = *(const LAS f32x4*)(Akm + fr * 16 + fq * 4);
        const unsigned ab0 = pk2(qAb[0], qAb[1]), ab1 = pk2(qAb[2], qAb[3]);
        const bf16x8_t aT = mk8(pk2(qT[0], qT[1]), pk2(qT[2], qT[3]), 0u, 0u), aBm = mk8(pk2(qB[0], qB[1]), pk2(qB[2], qB[3]), 0u, 0u);
        const bf16x8_t aAb = mk8(ab0, ab1, 0u, 0u), aAbAk = mk8(ab0, ab1, pk2(qAk[0], qAk[1]), pk2(qAk[2], qAk[3]));
        const f32x4 z4 = {0.f, 0.f, 0.f, 0.f};
#pragma unroll
        for (int nt = 0; nt < 4; ++nt) {
            const u32x2 kq = *(const LAS u32x2*)(KHT + (nt * 16 + fr) * 16 + fq * 4);
            f32x4 ut = __builtin_amdgcn_mfma_f32_16x16x32_bf16(aT, mk8(kq.x, kq.y, 0u, 0u), z4, 0, 0, 0); ut = -ut;
            const unsigned v0 = pk2(Vq[nt][0], Vq[nt][1]), v1 = pk2(Vq[nt][2], Vq[nt][3]);
            const f32x4 bmv = __builtin_amdgcn_mfma_f32_16x16x32_bf16(aBm, mk8(v0, v1, 0u, 0u), z4, 0, 0, 0);
            f32x4 ul = __builtin_amdgcn_mfma_f32_16x16x32_bf16(aT, mk8(pk2(bmv[0], bmv[1]), pk2(bmv[2], bmv[3]), 0u, 0u), z4, 0, 0, 0); ul = -ul;
            const unsigned u0 = pk2(ut[0], ut[1]), u1 = pk2(ut[2], ut[3]);
            f32x4 yh = __builtin_amdgcn_mfma_f32_16x16x32_bf16(aAb, mk8(u0, u1, 0u, 0u), z4, 0, 0, 0);
#pragma unroll
            for (int r = 0; r < 4; ++r) yh[r] += bflo((unsigned)RH[(fq * 4 + r) * 72 + nt * 16 + fr]);
            const unsigned l0 = pk2(ul[0], ul[1]), l1 = pk2(ul[2], ul[3]);
            const f32x4 yl = __builtin_amdgcn_mfma_f32_16x16x32_bf16(aAbAk, mk8(l0, l1, v0, v1), z4, 0, 0, 0);
            const int s2 = nt >> 1, slot = (fr >> 2) * 8 + (fr & 3) + ((nt & 1) ? 4 : 0);
            bf16_t* m0p = (bf16_t*)rec + ((0 * 2 + s2) * 16) * 32 + slot; bf16_t* m1p = (bf16_t*)rec + ((1 * 2 + s2) * 16) * 32 + slot;
#pragma unroll
            for (int r = 0; r < 4; ++r) { m0p[(fq * 4 + r) * 32] = (bf16_t)((r & 1) ? (((r >> 1) ? u1 : u0) >> 16) : (((r >> 1) ? u1 : u0) & 0xffffu)); m1p[(fq * 4 + r) * 32] = (bf16_t)f2bf(yh[r]); }
            u32x2 pl; pl.x = l0; pl.y = l1; *(u32x2*)(rec + 8704 + (nt * 64 + lane) * 8) = pl;
            u32x2 py; py.x = pk2(yl[0], yl[1]); py.y = pk2(yl[2], yl[3]); *(u32x2*)(rec + 10752 + (nt * 64 + lane) * 8) = py;
        }
    }
    LDS_WAIT(); asm volatile("" ::: "memory");
#undef TOKI
}
__device__ __forceinline__ void vm_wait_chunks(int n) {
    switch (n) { case 0: asm volatile("s_waitcnt vmcnt(0)" ::: "memory"); break; case 1: asm volatile("s_waitcnt vmcnt(4)" ::: "memory"); break;
                 case 2: asm volatile("s_waitcnt vmcnt(8)" ::: "memory"); break; case 3: asm volatile("s_waitcnt vmcnt(12)" ::: "memory"); break;
                 case 4: asm volatile("s_waitcnt vmcnt(16)" ::: "memory"); break; case 5: asm volatile("s_waitcnt vmcnt(20)" ::: "memory"); break;
                 default: asm volatile("s_waitcnt vmcnt(24)" ::: "memory"); break; }
}
__device__ __forceinline__ void rwkv_seq_chain(const Ctx& C, const AP& a, int ci) {
    unsigned char* ws = a.ws;
    const int w = C.wave, lane = C.lane, fr = lane & 15, fq = lane >> 4, d = ci & 1, h = (ci >> 1) & 7, b = ci >> 4;
    const unsigned char* recs = ws + WS_RWC + (size_t)ci * 128 * RWC_REC;
    LAS unsigned char* ring = C.lds;
    const bool loader = w >= 4; const int lw = w - 4;
#define RWC_ISSUE(cc) do { _Pragma("unroll") for (int p_ = 0; p_ < 4; ++p_) { const int pc_ = (lw * 4 + p_) < 15 ? (lw * 4 + p_) : 14; \
        __builtin_amdgcn_global_load_lds((const unsigned*)(recs + (size_t)(cc) * RWC_REC + pc_ * 1024 + lane * 16), (LAS unsigned*)(ring + ((cc) & 7) * RWC_REC + pc_ * 1024), 16, 0, 0); } } while (0)
    if (loader) {
#pragma unroll 1
        for (int cc = 0; cc < 8; ++cc) RWC_ISSUE(cc);
        asm volatile("s_waitcnt vmcnt(28)" ::: "memory");
    }
    __builtin_amdgcn_s_barrier(); asm volatile("" ::: "memory");
    f32x4 ST[4];
#pragma unroll
    for (int kt = 0; kt < 4; ++kt) ST[kt] = (f32x4){0.f, 0.f, 0.f, 0.f};
    float* Y = (float*)(ws + WS_YRW) + (size_t)d * RWSZ + (size_t)b * SEQ * 512 + h * 64 + w * 16 + fr;
#pragma unroll 1
    for (int c = 0; c < 128; ++c) {
        if (!loader) {
            const LAS unsigned char* sl = ring + (c & 7) * RWC_REC;
            const bf16x8_t a00 = *(const LAS bf16x8_t*)(sl + (0 * 16 + fr) * 64 + fq * 16), a01 = *(const LAS bf16x8_t*)(sl + (1 * 16 + fr) * 64 + fq * 16);
            const bf16x8_t a10 = *(const LAS bf16x8_t*)(sl + (2 * 16 + fr) * 64 + fq * 16), a11 = *(const LAS bf16x8_t*)(sl + (3 * 16 + fr) * 64 + fq * 16);
            const u32x2 ulw = *(const LAS u32x2*)(sl + 8704 + (w * 64 + lane) * 8), ylw = *(const LAS u32x2*)(sl + 10752 + (w * 64 + lane) * 8), vpw = *(const LAS u32x2*)(sl + 12800 + (w * 64 + lane) * 8);
            const bf16x8_t bs0 = mk8(pk2(ST[0][0], ST[0][1]), pk2(ST[0][2], ST[0][3]), pk2(ST[1][0], ST[1][1]), pk2(ST[1][2], ST[1][3]));
            const bf16x8_t bs1 = mk8(pk2(ST[2][0], ST[2][1]), pk2(ST[2][2], ST[2][3]), pk2(ST[3][0], ST[3][1]), pk2(ST[3][2], ST[3][3]));
            const f32x4 z4 = {0.f, 0.f, 0.f, 0.f};
            f32x4 g0 = __builtin_amdgcn_mfma_f32_16x16x32_bf16(a00, bs0, z4, 0, 0, 0); g0 = __builtin_amdgcn_mfma_f32_16x16x32_bf16(a01, bs1, g0, 0, 0, 0);
            f32x4 g1 = __builtin_amdgcn_mfma_f32_16x16x32_bf16(a10, bs0, z4, 0, 0, 0); g1 = __builtin_amdgcn_mfma_f32_16x16x32_bf16(a11, bs1, g1, 0, 0, 0);
            const float uf0 = g0[0] + bflo(ulw.x), uf1 = g0[1] + bfhi(ulw.x), uf2 = g0[2] + bflo(ulw.y), uf3 = g0[3] + bfhi(ulw.y);
            const bf16x8_t xb = mk8(pk2(uf0, uf1), pk2(uf2, uf3), vpw.x, vpw.y);
#pragma unroll
            for (int kt = 0; kt < 4; ++kt) {
                const f32x4 dq = *(const LAS f32x4*)(sl + 8192 + (kt * 16 + fq * 4) * 4);
                const bf16x8_t az = *(const LAS bf16x8_t*)(sl + 4096 + (kt * 16 + fr) * 64 + fq * 16);
                ST[kt] = __builtin_amdgcn_mfma_f32_16x16x32_bf16(az, xb, ST[kt] * dq, 0, 0, 0);
            }
            const float y0 = g1[0] + bflo(ylw.x), y1 = g1[1] + bfhi(ylw.x), y2 = g1[2] + bflo(ylw.y), y3 = g1[3] + bfhi(ylw.y);
            const int sbase = c * 16 + fq * 4;
            Y[(size_t)(d ? SEQ - 1 - (sbase + 0) : sbase + 0) * 512] = y0; Y[(size_t)(d ? SEQ - 1 - (sbase + 1) : sbase + 1) * 512] = y1;
            Y[(size_t)(d ? SEQ - 1 - (sbase + 2) : sbase + 2) * 512] = y2; Y[(size_t)(d ? SEQ - 1 - (sbase + 3) : sbase + 3) * 512] = y3;
            asm volatile("s_waitcnt lgkmcnt(0)" ::: "memory");
        } else if (c + 1 < 128) {
            const int lastc = (c + 7 < 127) ? c + 7 : 127;
            vm_wait_chunks(lastc - (c + 1));
        }
        __builtin_amdgcn_s_barrier(); asm volatile("" ::: "memory");
        if (loader && c + 8 < 128) RWC_ISSUE(c + 8);
    }
    asm volatile("s_waitcnt vmcnt(0)" ::: "memory");
    __builtin_amdgcn_s_barrier(); asm volatile("" ::: "memory");
#undef RWC_ISSUE
}

__device__ __forceinline__ float dpp_sum8(float x) {
    x += __builtin_bit_cast(float, __builtin_amdgcn_update_dpp(0, __builtin_bit_cast(int, x), 0xB1, 0xF, 0xF, true));
    x += __builtin_bit_cast(float, __builtin_amdgcn_update_dpp(0, __builtin_bit_cast(int, x), 0x4E, 0xF, 0xF, true));
    x += __builtin_bit_cast(float, __builtin_amdgcn_update_dpp(0, __builtin_bit_cast(int, x), 0x141, 0xF, 0xF, true));
    return x;
}
__device__ __forceinline__ void rwkv_scan_item(const Ctx& C, const AP& a, int item) {
    unsigned char* ws = a.ws;
    const int d = item & 1, h = (item >> 1) & 7, b = item >> 4, tid = C.tid, v = tid >> 3, kq = tid & 7;
    const float* RW = (const float*)(ws + WS_RW);
    const float* arr[6] = { RW + (size_t)RW_KK * RWSZ, RW + (size_t)(RW_W0 + d) * RWSZ, RW + (size_t)(RW_B0 + d) * RWSZ, RW + (size_t)(RW_KD0 + d) * RWSZ, RW + (size_t)RW_R * RWSZ, RW + (size_t)RW_V * RWSZ };
    float* Y = (float*)(ws + WS_YRW) + (size_t)d * RWSZ;
    LAS float* buf = (LAS float*)C.lds;
    const int ls = tid >> 4, lq = tid & 15;
    f32x4 stg[6];
    const size_t colbase = (size_t)h * 64;
#define RW_LOAD(ch) do { const int s_ = (ch) * 32 + ls, t_ = d ? (SEQ - 1 - s_) : s_; const size_t o_ = ((size_t)(b * SEQ + t_)) * 512 + colbase + lq * 4; \
        _Pragma("unroll") for (int q_ = 0; q_ < 6; ++q_) stg[q_] = *(const f32x4*)(arr[q_] + o_); } while (0)
#define RW_WRITE(bi) do { _Pragma("unroll") for (int q_ = 0; q_ < 6; ++q_) *(LAS f32x4*)(buf + (((bi) * 6 + q_) * 32 + ls) * 64 + lq * 4) = stg[q_]; } while (0)
    float S[8];
#pragma unroll
    for (int j = 0; j < 8; ++j) S[j] = 0.f;
    RW_LOAD(0); RW_WRITE(0); __syncthreads();
    for (int ch = 0; ch < SEQ / 32; ++ch) {
        const int bi = ch & 1;
        if (ch + 1 < SEQ / 32) RW_LOAD(ch + 1);
        const LAS float* B0 = buf + (bi * 6) * 32 * 64;
        for (int st = 0; st < 32; ++st) {
            const LAS float* bp = B0 + st * 64 + kq * 8;
            const f32x4 k0 = *(const LAS f32x4*)(bp), k1 = *(const LAS f32x4*)(bp + 4);
            const f32x4 w0 = *(const LAS f32x4*)(bp + 2048), w1 = *(const LAS f32x4*)(bp + 2048 + 4);
            const f32x4 b0 = *(const LAS f32x4*)(bp + 4096), b1 = *(const LAS f32x4*)(bp + 4096 + 4);
            const f32x4 d0 = *(const LAS f32x4*)(bp + 6144), d1 = *(const LAS f32x4*)(bp + 6144 + 4);
            const f32x4 r0 = *(const LAS f32x4*)(bp + 8192), r1 = *(const LAS f32x4*)(bp + 8192 + 4);
            const float vv = B0[10240 + st * 64 + v];
            float sa = S[0] * k0[0] + S[1] * k0[1] + S[2] * k0[2] + S[3] * k0[3] + S[4] * k1[0] + S[5] * k1[1] + S[6] * k1[2] + S[7] * k1[3];
            sa = -dpp_sum8(sa);
            float y = 0.f;
#pragma unroll
            for (int j = 0; j < 4; ++j) { S[j] = S[j] * w0[j] + (sa * b0[j] + vv * d0[j]); y += S[j] * r0[j]; S[4 + j] = S[4 + j] * w1[j] + (sa * b1[j] + vv * d1[j]); y += S[4 + j] * r1[j]; }
            y = dpp_sum8(y);
            if (kq == 0) { const int s_ = ch * 32 + st, t_ = d ? (SEQ - 1 - s_) : s_; Y[((size_t)(b * SEQ + t_)) * 512 + colbase + v] = y; }
        }
        if (ch + 1 < SEQ / 32) RW_WRITE(bi ^ 1);
        __syncthreads();
    }
#undef RW_LOAD
#undef RW_WRITE
}
__device__ __forceinline__ void rwkv_post_item(const AP& a, int l, int item, int lane) {
    unsigned char* ws = a.ws;
    const int hh = item & 7, m = item >> 3, c = hh * 64 + lane; const size_t o = (size_t)m * 512 + c;
    const float* Y = (const float*)(ws + WS_YRW); const float* RW = (const float*)(ws + WS_RW);
    const float y = Y[o] + Y[RWSZ + o];
    const float mean = wave_sum(y) * (1.f / 64.f), dv = y - mean, var = wave_sum(dv * dv) * (1.f / 64.f);
    const float yn = dv * rsqrtf(var + 64e-5f) * a.in[27][l * 512 + c] + a.in[28][l * 512 + c];
    ((float*)(ws + WS_YA))[(size_t)3 * RWSZ + o] = (yn + RW[(size_t)RW_BONUS * RWSZ + o]) * RW[(size_t)RW_G * RWSZ + o];
}
__device__ __forceinline__ void c1_fold_item(const AP& a, int row, int lane) {
    const unsigned short* src = (const unsigned short*)(a.ws + WS_C1) + (size_t)row * 4096;
    unsigned short* dst = (unsigned short*)(a.ws + WS_C1F) + (size_t)row * 2048;
#pragma unroll 8
    for (int i = 0; i < 32; ++i) {
        const int j = i * 64 + lane; float v;
        if (j <= 1024) { const float x0 = __uint_as_float((unsigned)src[j] << 16); const int jm = (j >= 1 && j <= 1023) ? 2048 - j : j;
            const float x1 = __uint_as_float((unsigned)src[jm] << 16); v = (j >= 1 && j <= 1023) ? x0 + x1 : x0; }
        else { const int sidx = j - 1024; v = __uint_as_float((unsigned)src[2048 + sidx] << 16) - __uint_as_float((unsigned)src[2048 + 2048 - sidx] << 16); }
        dst[j] = (unsigned short)f2bf(v);
    }
}
__device__ __forceinline__ void branch_d_item(const AP& a, int l, int m, int lane) {
    unsigned char* ws = a.ws;
    const float* Y = (const float*)(ws + WS_YRW); const float* RW = (const float*)(ws + WS_RW);
    float o[8]; float ss = 0.f;
#pragma unroll
    for (int hh = 0; hh < 8; ++hh) {
        const int c = hh * 64 + lane; const size_t ix = (size_t)m * 512 + c;
        const float y = Y[ix] + Y[RWSZ + ix];
        const float mean = wave_sum(y) * (1.f / 64.f), dv = y - mean, var = wave_sum(dv * dv) * (1.f / 64.f);
        const float yn = dv * rsqrtf(var + 64e-5f) * a.in[27][l * 512 + c] + a.in[28][l * 512 + c];
        o[hh] = (yn + RW[(size_t)RW_BONUS * RWSZ + ix]) * RW[(size_t)RW_G * RWSZ + ix]; ss += o[hh] * o[hh];
    }
    const float rs = rsqrtf(wave_sum(ss) * (1.f / 512.f) + 1e-6f);
    bf16_t* dst = (bf16_t*)(ws + WS_HB) + (size_t)m * DM + 1536 + lane;
#pragma unroll
    for (int hh = 0; hh < 8; ++hh) dst[hh * 64] = (bf16_t)f2bf(o[hh] * rs);
}
__device__ __forceinline__ void branch_norm_item(const AP& a, int item, int lane) {
    unsigned char* ws = a.ws;
    const int br = item & 3, m = item >> 2;
    const f32x4* src = (const f32x4*)((const float*)(ws + WS_YA) + (size_t)br * RWSZ + (size_t)m * 512) + lane;
    const f32x4 v0 = src[0], v1 = src[64];
    const float ss = wave_sum(v0.x * v0.x + v0.y * v0.y + v0.z * v0.z + v0.w * v0.w + v1.x * v1.x + v1.y * v1.y + v1.z * v1.z + v1.w * v1.w);
    const float rs = rsqrtf(ss * (1.f / 512.f) + 1e-6f);
    u32x2* dst = (u32x2*)((bf16_t*)(ws + WS_HB) + (size_t)m * DM + br * 512) + lane;
    u32x2 w; w.x = pk2(v0.x * rs, v0.y * rs); w.y = pk2(v0.z * rs, v0.w * rs); dst[0] = w;
    w.x = pk2(v1.x * rs, v1.y * rs); w.y = pk2(v1.z * rs, v1.w * rs); dst[64] = w;
}

__device__ __forceinline__ unsigned fkey(float f) { const unsigned u = __float_as_uint(f); return (u & 0x80000000u) ? ~u : (u | 0x80000000u); }
__device__ __forceinline__ int lane_rank(unsigned long long m) { return __builtin_amdgcn_mbcnt_hi((unsigned)(m >> 32), __builtin_amdgcn_mbcnt_lo((unsigned)m, 0)); }
template <int N>
__device__ __forceinline__ void top16_select(const float (&val)[N], const int (&idx)[N], LAS float* lv, LAS int* li) {
    unsigned k[N];
#pragma unroll
    for (int e = 0; e < N; ++e) k[e] = fkey(val[e]);
    unsigned T = 0;
    for (int bit = 31; bit >= 0; --bit) {
        const unsigned cand = T | (1u << bit); int cnt = 0;
#pragma unroll
        for (int e = 0; e < N; ++e) cnt += __popcll(__ballot(k[e] >= cand));
        if (cnt >= 16) T = cand;
        if (cnt == 16) break;
    }
    int ngt = 0;
#pragma unroll
    for (int e = 0; e < N; ++e) ngt += __popcll(__ballot(k[e] > T));
    const int need = 16 - ngt; int eqbase = 0, posbase = 0;
#pragma unroll
    for (int e = 0; e < N; ++e) {
        const unsigned long long meq = __ballot(k[e] == T);
        const int eqrank = eqbase + lane_rank(meq);
        const bool sel = (k[e] > T) || (k[e] == T && eqrank < need);
        const unsigned long long msel = __ballot(sel);
        const int pos = posbase + lane_rank(msel);
        if (sel) { lv[pos] = val[e]; li[pos] = idx[e]; }
        eqbase += __popcll(meq); posbase += __popcll(msel);
    }
    LDS_WAIT(); asm volatile("" ::: "memory");
}
__device__ __forceinline__ float dpp_xor1(float x) { return __builtin_bit_cast(float, __builtin_amdgcn_update_dpp(0, __builtin_bit_cast(int, x), 0xB1, 0xF, 0xF, true)); }
__device__ __forceinline__ float dpp_xor2(float x) { return __builtin_bit_cast(float, __builtin_amdgcn_update_dpp(0, __builtin_bit_cast(int, x), 0x4E, 0xF, 0xF, true)); }
__device__ __forceinline__ float reduce8(const float (&v)[8], int lane) {
    const bool b0 = lane & 1, b1 = lane & 2, b2 = lane & 4;
    float w4[4], w2[2];
#pragma unroll
    for (int k = 0; k < 4; ++k) { const float keep = b0 ? v[4 + k] : v[k], send = b0 ? v[k] : v[4 + k]; w4[k] = keep + dpp_xor1(send); }
#pragma unroll
    for (int k = 0; k < 2; ++k) { const float keep = b1 ? w4[2 + k] : w4[k], send = b1 ? w4[k] : w4[2 + k]; w2[k] = keep + dpp_xor2(send); }
    const float keep = b2 ? w2[1] : w2[0], send = b2 ? w2[0] : w2[1];
    float r = keep + __shfl_xor(send, 4);
    r += __shfl_xor(r, 8); r += __shfl_xor(r, 16); r += __shfl_xor(r, 32);
    return r;
}
typedef float f32x2v __attribute__((ext_vector_type(2)));
__device__ __forceinline__ void peer_select_head(const f32x2 s0, const f32x2 s1, int lane, LAS float* wl, LAS int* fe, LAS float* fg, int ci_i, int ci_j, bool cand_on) {
    { const float v0[2] = {s0.x, s0.y}; const int i0[2] = {2 * lane, 2 * lane + 1}; top16_select<2>(v0, i0, wl, (LAS int*)(wl + 16)); }
    { const float v1[2] = {s1.x, s1.y}; const int i1[2] = {2 * lane, 2 * lane + 1}; top16_select<2>(v1, i1, wl + 32, (LAS int*)(wl + 48)); }
    if (lane < 32) { const int lst = lane >> 4, ii = lane & 15; const LAS float* lv = wl + lst * 32;
      const float v = lv[ii]; const int ix = ((const LAS int*)lv)[16 + ii]; int rank = 0;
#pragma unroll
      for (int jq = 0; jq < 4; ++jq) { const f32x4 q = *(const LAS f32x4*)(lv + jq * 4);
#pragma unroll
          for (int e = 0; e < 4; ++e) rank += (q[e] > v || (q[e] == v && (jq * 4 + e) < ii)) ? 1 : 0; }
      wl[64 + lst * 32 + rank] = v; ((LAS int*)wl)[64 + lst * 32 + 16 + rank] = ix; }
    LDS_WAIT(); asm volatile("" ::: "memory");
    { const float cvv = cand_on ? wl[64 + ci_i] + wl[96 + ci_j] : -INFINITY;
      const float cv[1] = {cvv}; const int ci[1] = {ci_i * 16 + ci_j};
      top16_select<1>(cv, ci, wl + 128, (LAS int*)(wl + 144)); }
    { const bool act = lane < 16; const float sc = act ? wl[128 + lane] : -3.0e38f; const int fi = act ? ((LAS int*)wl)[144 + lane] : 0;
      const int e = ((LAS int*)wl)[80 + (fi >> 4)] * 128 + ((LAS int*)wl)[112 + (fi & 15)];
      const float mx = wave_max(sc), ex = act ? __expf(sc - mx) : 0.f, sm = wave_sum(ex);
      if (act) { fe[lane] = e; fg[lane] = ex / sm; } }
    LDS_WAIT(); asm volatile("" ::: "memory");
}
__device__ __forceinline__ void peer_tile(const Ctx& C, const AP& a, int l, int tile, const float* x1, float* xout, bool write_hb) {
    unsigned char* ws = a.ws;
    const int tid = C.tid, lane = C.lane, w = C.wave, tb = tile * 32;
    LAS float* keys = (LAS float*)C.lds;
    LAS int* rt_idx = (LAS int*)(C.lds + 65536);
    LAS float* rt_gate = (LAS float*)(C.lds + 81920);
    LAS float* wl = (LAS float*)(C.lds + 98304) + w * 256;
    LAS float* ssp = (LAS float*)(C.lds + 98304 + 8 * 1024);
    const float* qry = (const float*)(ws + WS_PROJ);
    int ci_i, ci_j; const bool cand_on = lane < 50;
    if (lane < 16) { ci_i = 0; ci_j = lane; } else if (lane < 24) { ci_i = 1; ci_j = lane - 16; } else if (lane < 29) { ci_i = 2; ci_j = lane - 24; }
    else if (lane < 33) { ci_i = 3; ci_j = lane - 29; } else if (lane < 36) { ci_i = 4; ci_j = lane - 33; } else if (lane < 38) { ci_i = 5; ci_j = lane - 36; }
    else if (lane < 40) { ci_i = 6; ci_j = lane - 38; } else if (lane < 42) { ci_i = 7; ci_j = lane - 40; } else if (lane < 50) { ci_i = lane - 34; ci_j = 0; } else { ci_i = 0; ci_j = 0; }
    float* Ssc = (float*)(ws + WS_RW) + (size_t)tile * 65536;
    { const int fr = lane & 15, fq = lane >> 4;
      LAS bf16_t* qbuf = (LAS bf16_t*)C.lds;
      const int prow = tid >> 4, pcol = (tid & 15) * 8;
#define PEER_QSTAGE(h_) do { const float* qp_ = qry + (size_t)(tb + prow) * 1024 + (h_) * 128 + pcol; bf16x8_t qh_, ql_; split8(*(const f32x4*)qp_, *(const f32x4*)(qp_ + 4), qh_, ql_); \
          LAS bf16_t* d_ = qbuf + ((h_) & 1) * 8704 + prow * 136 + pcol; *(LAS bf16x8_t*)d_ = qh_; *(LAS bf16x8_t*)(d_ + 4352) = ql_; } while (0)
      PEER_QSTAGE(0);
      bf16x8_t kraw[2][2][2];
#define PEER_KLOAD(h_) _Pragma("unroll") for (int pp = 0; pp < 2; ++pp) _Pragma("unroll") for (int ks = 0; ks < 2; ++ks) { \
          const bf16_t* kp = (const bf16_t*)(ws + WS_KEYST) + ((size_t)(((l * 8 + (h_)) * 2 + pp) * 128 + 16 * w + fr)) * 64 + ks * 32 + fq * 8; kraw[pp][ks][0] = *(const bf16x8_t*)kp; kraw[pp][ks][1] = *(const bf16x8_t*)(kp + 262144); }
      PEER_KLOAD(0)
      __syncthreads();
#pragma unroll 1
      for (int h = 0; h < 8; ++h) {
        if (h + 1 < 8) PEER_QSTAGE(h + 1);
        const LAS bf16_t* qh = qbuf + (h & 1) * 8704; const LAS bf16_t* ql = qh + 4352;
        bf16x8_t bhh[2][2], bll[2][2];
#pragma unroll
        for (int pp = 0; pp < 2; ++pp)
#pragma unroll
            for (int ks = 0; ks < 2; ++ks) { bhh[pp][ks] = kraw[pp][ks][0]; bll[pp][ks] = kraw[pp][ks][1]; }
        if (h + 1 < 8) { PEER_KLOAD(h + 1) }
#pragma unroll
        for (int pp = 0; pp < 2; ++pp) {
            const int hp = h * 2 + pp;
            bf16x8_t bh[2], bl[2];
#pragma unroll
            for (int ks = 0; ks < 2; ++ks) { bh[ks] = bhh[pp][ks]; bl[ks] = bll[pp][ks]; }
#pragma unroll
            for (int mt = 0; mt < 2; ++mt) { f32x4 acc = {0.f, 0.f, 0.f, 0.f};
#pragma unroll
                for (int ks = 0; ks < 2; ++ks) { const int qo = (mt * 16 + fr) * 136 + pp * 64 + ks * 32 + fq * 8;
                    const bf16x8_t ah = *(const LAS bf16x8_t*)(qh + qo), al = *(const LAS bf16x8_t*)(ql + qo);
                    acc = __builtin_amdgcn_mfma_f32_16x16x32_bf16(al, bh[ks], acc, 0, 0, 0); acc = __builtin_amdgcn_mfma_f32_16x16x32_bf16(ah, bl[ks], acc, 0, 0, 0);
                    acc = __builtin_amdgcn_mfma_f32_16x16x32_bf16(ah, bh[ks], acc, 0, 0, 0); }
#pragma unroll
                for (int r = 0; r < 4; ++r) Ssc[(size_t)(hp * 32 + mt * 16 + fq * 4 + r) * 128 + 16 * w + fr] = acc[r]; }
        }
        __syncthreads();
      }
#undef PEER_QSTAGE
#undef PEER_KLOAD
    }
    __syncthreads();
    const unsigned char* U6 = ws + WS_UB + (size_t)l * ETAB; const unsigned char* V4 = ws + WS_UB + 64 * MiB + (size_t)l * 16 * MiB;
    const float* Us = (const float*)(ws + WS_VB) + (0 * 2 + l) * 16384; const float* Vs = (const float*)(ws + WS_VB) + (1 * 2 + l) * 16384;
    bf16_t* hb = (bf16_t*)(ws + WS_HB);
    u32x4 ua[8]; u32x4 va[8]; float sul, svl, gl; float xf[32], acc[32];
#define PEER_IDS(mye_, ei_) _Pragma("unroll") for (int e = 0; e < 8; ++e) ei_[e] = __builtin_amdgcn_readlane(mye_, ((e >> 2) & 1) | (((e >> 1) & 1) << 1) | ((e & 1) << 2));
#define PEER_ISSUE_U(ei_, ln_) _Pragma("unroll") for (int e = 0; e < 8; ++e) ua[e] = ((const u32x4*)(U6 + (size_t)ei_[e] * 1024))[ln_];
#define PEER_ISSUE_V(ei_, ln_) _Pragma("unroll") for (int e = 0; e < 8; ++e) va[e] = ((const u32x4*)(V4 + (size_t)ei_[e] * 1024))[ln_];
#define PEER_DOTS(dot_) _Pragma("unroll") for (int e = 0; e < 8; ++e) { f32x2v s2 = {0.f, 0.f}; \
        _Pragma("unroll") for (int d4 = 0; d4 < 4; ++d4) { const unsigned wd = ua[e][d4]; \
            s2 = __builtin_elementwise_fma((f32x2v){xf[8 * d4 + 0], xf[8 * d4 + 1]}, __builtin_amdgcn_cvt_scalef32_pk_f32_fp4(wd, 1.0f, 0), s2); \
            s2 = __builtin_elementwise_fma((f32x2v){xf[8 * d4 + 2], xf[8 * d4 + 3]}, __builtin_amdgcn_cvt_scalef32_pk_f32_fp4(wd, 1.0f, 1), s2); \
            s2 = __builtin_elementwise_fma((f32x2v){xf[8 * d4 + 4], xf[8 * d4 + 5]}, __builtin_amdgcn_cvt_scalef32_pk_f32_fp4(wd, 1.0f, 2), s2); \
            s2 = __builtin_elementwise_fma((f32x2v){xf[8 * d4 + 6], xf[8 * d4 + 7]}, __builtin_amdgcn_cvt_scalef32_pk_f32_fp4(wd, 1.0f, 3), s2); } \
        dot_[e] = s2.x + s2.y; }
#define PEER_ACCUM(cfl_) _Pragma("unroll") for (int e = 0; e < 8; ++e) { \
        const int src = ((e >> 2) & 1) | (((e >> 1) & 1) << 1) | ((e & 1) << 2); \
        const float cf = __builtin_bit_cast(float, __builtin_amdgcn_readlane(__builtin_bit_cast(int, cfl_), src)); \
        _Pragma("unroll") for (int d4 = 0; d4 < 4; ++d4) { const unsigned wd = va[e][d4]; \
            const f32x2v p0 = __builtin_amdgcn_cvt_scalef32_pk_f32_fp4(wd, 1.0f, 0), p1 = __builtin_amdgcn_cvt_scalef32_pk_f32_fp4(wd, 1.0f, 1); \
            const f32x2v p2 = __builtin_amdgcn_cvt_scalef32_pk_f32_fp4(wd, 1.0f, 2), p3 = __builtin_amdgcn_cvt_scalef32_pk_f32_fp4(wd, 1.0f, 3); \
            acc[8 * d4 + 0] += cf * p0.x; acc[8 * d4 + 1] += cf * p0.y; acc[8 * d4 + 2] += cf * p1.x; acc[8 * d4 + 3] += cf * p1.y; \
            acc[8 * d4 + 4] += cf * p2.x; acc[8 * d4 + 5] += cf * p2.y; acc[8 * d4 + 6] += cf * p3.x; acc[8 * d4 + 7] += cf * p3.y; } \
        if (e < 7) {   \
            asm volatile("" : "+v"(va[e + 1][0]), "+v"(va[e + 1][1]) : "v"(acc[0]), "v"(acc[1]), "v"(acc[2]), "v"(acc[3]), "v"(acc[4]), "v"(acc[5]), "v"(acc[6]), "v"(acc[7]), \
                         "v"(acc[8]), "v"(acc[9]), "v"(acc[10]), "v"(acc[11]), "v"(acc[12]), "v"(acc[13]), "v"(acc[14]), "v"(acc[15])); \
            asm volatile("" : "+v"(va[e + 1][2]), "+v"(va[e + 1][3]) : "v"(acc[16]), "v"(acc[17]), "v"(acc[18]), "v"(acc[19]), "v"(acc[20]), "v"(acc[21]), "v"(acc[22]), "v"(acc[23]), \
                         "v"(acc[24]), "v"(acc[25]), "v"(acc[26]), "v"(acc[27]), "v"(acc[28]), "v"(acc[29]), "v"(acc[30]), "v"(acc[31])); } }
    {
        const int tokl = w * 4;
        peer_select_head(*(const f32x2*)(Ssc + (size_t)(0 * 32 + tokl) * 128 + 2 * lane), *(const f32x2*)(Ssc + (size_t)(1 * 32 + tokl) * 128 + 2 * lane), lane, wl, (LAS int*)(wl + 160), wl + 176, ci_i, ci_j, cand_on);
        int ln = lane; asm volatile("" : "+v"(ln)); const int el1 = ((ln >> 2) & 1) | (((ln >> 1) & 1) << 1) | ((ln & 1) << 2);
        const int mye = ((LAS int*)(wl + 160))[el1]; int ei[8]; PEER_IDS(mye, ei) PEER_ISSUE_U(ei, ln) PEER_ISSUE_V(ei, ln)
        sul = Us[mye]; svl = Vs[mye]; gl = (wl + 176)[el1];
    }
#pragma unroll 1
    for (int hh = 0; hh < 32; ++hh) {
        const int h = hh & 7, tokl = w * 4 + (hh >> 3), tok = tb + tokl;
        LAS int* fe = (LAS int*)(wl + 160 + (hh & 1) * 32); LAS float* fg = wl + 176 + (hh & 1) * 32;
        if (h == 0) {
            const u32x2* xp = (const u32x2*)(hb + (size_t)tok * DM) + lane;
#pragma unroll
            for (int j = 0; j < 8; ++j) { const u32x2 xw = xp[64 * j]; xf[j * 4 + 0] = bflo(xw.x); xf[j * 4 + 1] = bfhi(xw.x); xf[j * 4 + 2] = bflo(xw.y); xf[j * 4 + 3] = bfhi(xw.y); }
#pragma unroll
            for (int i = 0; i < 32; ++i) acc[i] = 0.f;
        }
        {
            float dot[8]; PEER_DOTS(dot)
            int ln = lane; asm volatile("" : "+v"(ln)); const int el1 = ((ln >> 2) & 1) | (((ln >> 1) & 1) << 1) | ((ln & 1) << 2);
            const int mye = fe[8 + el1]; int ei[8]; PEER_IDS(mye, ei) PEER_ISSUE_U(ei, ln)
            const float cfl = gl * gelu_erf(reduce8(dot, lane) * sul) * svl;
            PEER_ACCUM(cfl)
            f32x2 ns0 = {0.f, 0.f}, ns1 = {0.f, 0.f};
            if (hh < 31) { const int tk2 = w * 4 + ((hh + 1) >> 3), h2 = (hh + 1) & 7;
                ns0 = *(const f32x2*)(Ssc + (size_t)((h2 * 2 + 0) * 32 + tk2) * 128 + 2 * ln); ns1 = *(const f32x2*)(Ssc + (size_t)((h2 * 2 + 1) * 32 + tk2) * 128 + 2 * ln); }
            PEER_ISSUE_V(ei, ln)
            sul = Us[mye]; svl = Vs[mye]; gl = fg[8 + el1];
            if (hh < 31) peer_select_head(ns0, ns1, lane, wl, (LAS int*)(wl + 160 + ((hh + 1) & 1) * 32), wl + 176 + ((hh + 1) & 1) * 32, ci_i, ci_j, cand_on);
        }
        {
            float dot[8]; PEER_DOTS(dot)
            int ln = lane; asm volatile("" : "+v"(ln)); const int el1 = ((ln >> 2) & 1) | (((ln >> 1) & 1) << 1) | ((ln & 1) << 2);
            const int nofs = hh < 31 ? ((hh + 1) & 1) * 32 : (hh & 1) * 32 + 8;
            const int mye = ((LAS int*)(wl + 160 + nofs))[el1]; int ei[8]; PEER_IDS(mye, ei) PEER_ISSUE_U(ei, ln)
            const float cfl = gl * gelu_erf(reduce8(dot, lane) * sul) * svl;
            PEER_ACCUM(cfl)
            PEER_ISSUE_V(ei, ln)
            sul = Us[mye]; svl = Vs[mye]; gl = (wl + 176 + nofs)[el1];
        }
        if (h == 7) {
        f32x4 o[8]; float ssq = 0.f;
#pragma unroll
        for (int j = 0; j < 8; ++j) { o[j] = *((const f32x4*)(x1 + (size_t)tok * DM) + 64 * j + lane) + (f32x4){acc[j * 4 + 0], acc[j * 4 + 1], acc[j * 4 + 2], acc[j * 4 + 3]};
            *((f32x4*)(xout + (size_t)tok * DM) + 64 * j + lane) = o[j]; ssq += o[j].x * o[j].x + o[j].y * o[j].y + o[j].z * o[j].z + o[j].w * o[j].w; }
        if (write_hb) {
            const float rs = rsqrtf(wave_sum(ssq) * (1.f / DM) + 1e-6f);
#pragma unroll
            for (int j = 0; j < 8; ++j) { u32x2 pw; pw.x = pk2(o[j].x * rs, o[j].y * rs); pw.y = pk2(o[j].z * rs, o[j].w * rs); *((u32x2*)(hb + (size_t)tok * DM) + 64 * j + lane) = pw; }
        }
        }
    }
#undef PEER_IDS
#undef PEER_ISSUE_U
#undef PEER_ISSUE_V
#undef PEER_DOTS
#undef PEER_ACCUM
    __syncthreads();
}

constexpr int N_PHASES = 19;
template <int PH>
__device__ __forceinline__ void run_phase(unsigned char* lds_raw, const int wave0) {
    if constexpr (PH == 0) { if (PON(9)) { const Ctx C = fresh_ctx_w(lds_raw, wave0); const AP a = fresh_args(); phase_prep(C, a); } }
    else {
            constexpr int l = (PH - 1) / 9, k = (PH - 1) % 9;
            switch (k) {
            case 0: if (PON(0)) {
                const Ctx C = fresh_ctx_w(lds_raw, wave0); const AP a = fresh_args(); unsigned char* ws = a.ws;
                pg8::Gemm g{(const bf16_t*)(ws + WS_HB), (const bf16_t*)(ws + WS_WINT) + (size_t)l * PROJ * DM, DM};
                pg8::Order S; S.init(32, 16, 1, 0, 0, 0, C.G, C.bx);
                pg8::EpiInProj E{(bf16_t*)(ws + WS_PA), (float*)(ws + WS_PROJ)};
                pg8::gemm_phase(C.lds, g, S, E, C.tid);
            } break;
            case 1: if (PON(1)) {
                int bxo = blockIdx.x; asm volatile("" : "+s"(bxo));
                if (bxo < 128) { const Ctx C = fresh_ctx_w(lds_raw, wave0); const AP a = fresh_args();
                  for (int ti = C.bx; ti < MTOK / 32; ti += C.G) rwkv_prep_item(C, a, l, ti); }
                if (PON(11)) { const Ctx C = fresh_ctx_w(lds_raw, wave0); const AP a = fresh_args(); unsigned char* ws = a.ws;
                  pg8::Gemm g{(const bf16_t*)(ws + WS_WCST) + (size_t)l * 1024 * 512, (const bf16_t*)(ws + WS_PA), 512};
                  pg8::Order S; S.init(4, 32, 1, 0, 0, 0, C.G, C.bx);
                  pg8::EpiC1 E{(bf16_t*)(ws + WS_C1)};
                  pg8::gemm_phase(C.lds, g, S, E, C.tid); }
                __syncthreads();
                if (PON(12)) { const Ctx C = fresh_ctx_w(lds_raw, wave0); const AP a = fresh_args();
                  const int m0 = C.bx < 128 ? C.gw : 2048 + C.gw, m1 = C.bx < 128 ? 3072 : MTOK;
                  for (int m = m0; m < m1; m += 1024) qk_prep_token(a, l, m, C.lane); }
                if (PON(13)) { const Ctx C = fresh_ctx_w(lds_raw, wave0); const AP a = fresh_args();
                  const int i1 = C.bx < 128 ? 1024 : 4096;
                  for (int it = C.gw; it < i1; it += 1024) s5_ends_item(a, l, it, C.lane, (LAS float*)(C.lds + C.wave * 4096)); }
                if (bxo >= 128) { __syncthreads(); const Ctx C = fresh_ctx_w(lds_raw, wave0); const AP a = fresh_args();
                  for (int ti = C.bx; ti < MTOK / 32; ti += C.G) rwkv_prep_item(C, a, l, ti); }
            } break;
            case 2: if (PON(2)) {
                if (PON(17)) { const Ctx C = fresh_ctx_w(lds_raw, wave0); const AP a = fresh_args();
                  volatile LAS int* qs = (volatile LAS int*)(C.lds + LDS_BYTES - 128);
                  unsigned* q0 = (unsigned*)(a.ws + WS_CTL) + 64 + l * 64; unsigned* q1 = q0 + 2;
                  const int order = (C.bx >> 3) & 1; int stage = 0;
#pragma unroll 1
                  for (;;) {
                    __syncthreads();
                    if (C.tid == 0) {
                        int nb = -1;
                        while (stage < 2) {
                            const int q = stage ^ order;
                            const int t = (int)__hip_atomic_fetch_add(q ? q1 : q0, 8u, __ATOMIC_RELAXED, __HIP_MEMORY_SCOPE_AGENT);
                            const int b2 = q ? 4096 + t : t;
                            if (b2 < (q ? 14336 : 4096)) { nb = b2; break; }
                            ++stage;
                        }
                        *qs = nb;
                    }
                    __syncthreads();
                    const int base = *qs; if (base < 0) break;
                    const int it = base + C.wave;
                    if (it < 4096) s5_final_item_h(a, l, it, C.lane, C.lds + C.wave * 16384);
                    else if (it < 12288) rwkv_chunk_pre(a, it - 4096, C.lane, C.lds + C.wave * 16384);
                    else c1_fold_item(a, it - 12288, C.lane);
                  } }
            } break;
            case 3: if (PON(3)) {
                int bx0 = blockIdx.x; asm volatile("" : "+s"(bx0));
                if (bx0 < 64) { const Ctx C = fresh_ctx_w(lds_raw, wave0); const AP a = fresh_args(); rwkv_seq_chain(C, a, C.bx); }
                else if (bx0 < 192) {
                    if (PON(15)) { const Ctx C = fresh_ctx_w(lds_raw, wave0); const AP a = fresh_args(); unsigned char* ws = a.ws;
                      const int au = C.bx - 64;
                      { const int qblk = au & 7, hq = (au >> 3) & 3, b = au >> 5;
                        const bf16_t* Q = (const bf16_t*)(ws + WS_QB) + ((size_t)(b * SEQ + qblk * 256)) * 512 + hq * 128;
                        const bf16_t* Kp = (const bf16_t*)(ws + WS_QB) + (size_t)MTOK * 512 + ((size_t)b * SEQ) * 256 + (hq >> 1) * 128;
                        const bf16_t* Vp = Kp + (size_t)MTOK * 256;
                        float* O = (float*)(ws + WS_YA) + (size_t)2 * RWSZ + ((size_t)(b * SEQ + qblk * 256)) * 512 + hq * 128;
                        att::attn_dense_body<att::bf16>(Q, Kp, Vp, O, SEQ, (char*)C.lds, C.tid);
                      } }
                } else {
                    { const Ctx C = fresh_ctx_w(lds_raw, wave0); const AP a = fresh_args(); unsigned char* ws = a.ws;
                        pg8::Gemm g{(const bf16_t*)(ws + WS_YGELU), (const bf16_t*)(ws + WS_WGLUT) + (size_t)l * 512 * 512, 512};
                        pg8::Order S; S.init(32, 2, 1, 0, 0, 0, 64, C.bx - 192);
                        pg8::EpiGlu E{(const bf16_t*)(ws + WS_YGELU), (float*)(ws + WS_YA) + RWSZ};
                        pg8::gemm_phase(C.lds, g, S, E, C.tid);
                        __syncthreads(); }
                    if (PON(16)) { const Ctx C = fresh_ctx_w(lds_raw, wave0); const AP a = fresh_args(); unsigned char* ws = a.ws;
                      pg8::Gemm g{(const bf16_t*)(ws + WS_DFT), (const bf16_t*)(ws + WS_C1F), 2048};
                      pg8::Order S; S.init(8, 2, 4, 0, 2, 8, 64, C.bx - 192);
                      pg8::EpiF32 E{(float*)(ws + WS_YA), 512};
                      pg8::gemm_phase(C.lds, g, S, E, C.tid); }
                }
            } break;
            case 4: if (PON(4)) {
                const Ctx C = fresh_ctx_w(lds_raw, wave0); const AP a = fresh_args();
                for (int m = C.gw; m < MTOK; m += C.ngw) {
                    branch_norm_item(a, m * 4 + 0, C.lane); branch_norm_item(a, m * 4 + 1, C.lane); branch_norm_item(a, m * 4 + 2, C.lane); branch_d_item(a, l, m, C.lane); }
            } break;
            case 5: if (PON(5)) {
                const Ctx C = fresh_ctx_w(lds_raw, wave0); const AP a = fresh_args(); unsigned char* ws = a.ws;
                const float* xin = l == 0 ? a.in[0] : (const float*)(ws + WS_X2);
                pg8::Gemm g{(const bf16_t*)(ws + WS_HB), (const bf16_t*)(ws + WS_WOUTT) + (size_t)l * DM * DM, DM};
                pg8::Order S; S.init(32, 8, 1, 0, 0, 0, C.G, C.bx);
                pg8::EpiResid E{xin, (float*)(ws + WS_X1), DM};
                pg8::gemm_phase(C.lds, g, S, E, C.tid);
            } break;
            case 6: if (PON(6)) {
                const Ctx C = fresh_ctx_w(lds_raw, wave0); const AP a = fresh_args(); unsigned char* ws = a.ws;
                for (int m = C.gw; m < MTOK; m += C.ngw) rms_row_to_bf16((const float*)(ws + WS_X1) + (size_t)m * DM, (bf16_t*)(ws + WS_HB) + (size_t)m * DM, C.lane);
            } break;
            case 7: if (PON(7)) {
                int bx0 = blockIdx.x; asm volatile("" : "+s"(bx0));
                if (bx0 < 128) {
                    const Ctx C = fresh_ctx_w(lds_raw, wave0); const AP a = fresh_args(); unsigned char* ws = a.ws;
                    pg8::Gemm g{(const bf16_t*)(ws + WS_HB), (const bf16_t*)(ws + WS_WQT) + (size_t)l * 1024 * DM, DM};
                    pg8::Order S; S.init(32, 4, 1, 0, 0, 0, 128, C.bx);
                    pg8::EpiF32 E{(float*)(ws + WS_PROJ), 1024};
                    pg8::gemm_phase(C.lds, g, S, E, C.tid);
                } else {
                    const Ctx C = fresh_ctx_w(lds_raw, wave0); const AP a = fresh_args();
#pragma unroll 1
                    for (int it = (C.bx - 128) * 8 + C.wave; it < 16384; it += 1024) { const int r2 = it * 2; expert_row_item2(a, r2 >> 14, l, r2 & 16383, C.lane); }
                }
            } break;
            case 8: if (PON(8)) {
                const Ctx C = fresh_ctx_w(lds_raw, wave0); const AP a = fresh_args(); unsigned char* ws = a.ws;
                float* xo = l == 0 ? (float*)(ws + WS_X2) : a.out;
                for (int tile = C.bx; tile < MTOK / 32; tile += C.G) peer_tile(C, a, l, tile, (const float*)(ws + WS_X1), xo, l == 0);
            } break;
            default: break;
            }
    }
}
__global__ void __launch_bounds__(NTHR, 2) fwd_kernel(Args a0) {
    extern __shared__ __attribute__((aligned(16))) unsigned char lds_raw[];
    cg::grid_group grid = cg::this_grid();
    const int wave0 = __builtin_amdgcn_readfirstlane((int)threadIdx.x >> 6);
    volatile LAS unsigned* bst = (volatile LAS unsigned*)((LAS unsigned char*)lds_raw + LDS_BYTES - 64);
    if (threadIdx.x < 2) bst[threadIdx.x] = 0u;
    __syncthreads();
    const XcdBarrier xbar = xcd_barrier_post((unsigned*)(a0.ws + WS_CTL) + 4096, bst);
    const int lo = a0.ph_lo, hi = a0.ph_hi;
    if (lo < 0) grid.sync();
#define MK_STEP(PH) if (lo <= (PH) && (PH) < hi) { run_phase<PH>(lds_raw, wave0); \
        if ((((unsigned)PROBE_REP_MASK >> (PH)) & 1u) != 0u) { xcd_barrier(xbar); run_phase<PH>(lds_raw, wave0); } \
        if ((PH) + 1 < hi) xcd_barrier(xbar); }
    MK_STEP(0) MK_STEP(1) MK_STEP(2) MK_STEP(3) MK_STEP(4) MK_STEP(5) MK_STEP(6) MK_STEP(7) MK_STEP(8) MK_STEP(9)
    MK_STEP(10) MK_STEP(11) MK_STEP(12) MK_STEP(13) MK_STEP(14) MK_STEP(15) MK_STEP(16) MK_STEP(17) MK_STEP(18)
#undef MK_STEP
}

extern "C" void kernel_launch(void* const* d_in, const int* in_sizes, int n_in, void* d_out, int out_size, void* d_ws, size_t ws_size, hipStream_t stream) {
    static int grid = 0;
    if (grid == 0) {
        if (n_in != 36 || in_sizes[0] != MTOK * DM || out_size != MTOK * DM || ws_size < WS_END) {
            fprintf(stderr, "kernel_launch: shape mismatch: n_in %d in0 %d out %d ws %zu (need %zu)\n", n_in, n_in > 0 ? in_sizes[0] : -1, out_size, ws_size, (size_t)WS_END); grid = -1; return; }
        int dev = 0, cus = 0, per_cu = 0;
        if (hipGetDevice(&dev) != hipSuccess || hipDeviceGetAttribute(&cus, hipDeviceAttributeMultiprocessorCount, dev) != hipSuccess) { fprintf(stderr, "kernel_launch: device query failed\n"); grid = -1; return; }
        if (hipFuncSetAttribute((const void*)fwd_kernel, hipFuncAttributeMaxDynamicSharedMemorySize, LDS_BYTES) != hipSuccess) { fprintf(stderr, "kernel_launch: hipFuncSetAttribute failed\n"); grid = -1; return; }
        if (hipOccupancyMaxActiveBlocksPerMultiprocessor(&per_cu, (const void*)fwd_kernel, NTHR, LDS_BYTES) != hipSuccess || per_cu < 1) { fprintf(stderr, "kernel_launch: occupancy query gives %d\n", per_cu); grid = -1; return; }
        grid = cus * per_cu; if (grid > 256) grid = 256;
        if (grid < 128) { fprintf(stderr, "kernel_launch: grid %d too small\n", grid); grid = -1; return; }
    }
    if (grid < 0) return;
    if (hipMemsetAsync((char*)d_ws + WS_CTL, 0, 65536, stream) != hipSuccess) { fprintf(stderr, "kernel_launch: memset failed\n"); return; }
    Args a{};
    for (int i = 0; i < 36; ++i) a.in[i] = (const float*)d_in[i];
    a.out = (float*)d_out; a.ws = (unsigned char*)d_ws;
#if MK_ONE_LAUNCH
    a.ph_lo = 0; a.ph_hi = N_PHASES;
    void* args[] = {&a};
    hipError_t e = hipLaunchCooperativeKernel((const void*)fwd_kernel, dim3(grid), dim3(NTHR), args, LDS_BYTES, stream);
    if (e != hipSuccess) fprintf(stderr, "kernel_launch: cooperative launch failed: %s (grid %d)\n", hipGetErrorString(e), grid);
#else
    for (int ph = 0; ph < N_PHASES; ++ph) {
        a.ph_lo = ph; a.ph_hi = ph + 1;
        hipLaunchKernelGGL(fwd_kernel, dim3(grid), dim3(NTHR), LDS_BYTES, stream, a);
    }
    hipError_t e = hipPeekAtLastError();
    if (e != hipSuccess) fprintf(stderr, "kernel_launch: launch failed: %s\n", hipGetErrorString(e));
#endif
}
```

```cpp
#include <hip/hip_runtime.h>
#include <hip/hip_cooperative_groups.h>
#include <cstdio>
#include <cstdint>
#include <cstddef>
namespace cg = cooperative_groups;

#ifndef MK_ONE_LAUNCH
#define MK_ONE_LAUNCH 1
#endif
#ifndef PHM
#define PHM 0x3ffff
#endif
#define PON(i) (((PHM) >> (i)) & 1)
#ifndef PROBE_REP_MASK
#define PROBE_REP_MASK 0u
#endif

namespace pg8 {
#define PG8_LAS __attribute__((address_space(3)))
typedef unsigned short bf16_t;
typedef short bf16x8 __attribute__((ext_vector_type(8)));
typedef float f32x4 __attribute__((ext_vector_type(4)));
typedef unsigned u32x4 __attribute__((ext_vector_type(4)));
typedef unsigned u32x2 __attribute__((ext_vector_type(2)));
constexpr int BM = 256, BK = 64, HALF = 128, HTB = HALF * BK * 2, STAGE_BYTES = 8 * HTB, NXCD = 8, WGM = 8;

__host__ __device__ __forceinline__ int lds_byte(int r, int c) { const int st = (r >> 4) * 2 + (c >> 5), rr = r & 15, cc = c & 31, ob = rr * 64 + cc * 2; return st * 1024 + (ob ^ (((ob >> 9) & 1) << 5)); }
__host__ __device__ __forceinline__ void stage_rc(int b, int& R, int& C) { const int st = b / 1024, sb = b % 1024, swz = sb ^ (((sb >> 9) & 1) << 5); R = (st >> 1) * 16 + swz / 64; C = (st & 1) * 32 + (swz % 64) / 2; }

struct Unit { int pm, pn, pa, pb; };
struct Gemm { const bf16_t* A; const bf16_t* Bt; int K; };

struct Order {
    int nM, nN, nb, nwg, G, c, aM, bN, oM;
    __device__ __forceinline__ void init(int nM_, int nN_, int nb_, int aM_, int bN_, int oM_, int G_, int c_) { nM = nM_; nN = nN_; nb = nb_; aM = aM_; bN = bN_; oM = oM_; nwg = nM * nN * nb; G = G_; c = c_; }
    __device__ __forceinline__ bool next(int i, Unit& u) const {
        const int L = i * G + c; if (L >= nwg || c < 0) return false;
        const int per = nM * nN, b = L / per; int wgid = L - b * per;
        { const int q = per / NXCD, r = per % NXCD, xcd = wgid % NXCD, off = wgid / NXCD; wgid = (xcd < r ? xcd * (q + 1) : r * (q + 1) + (xcd - r) * q) + off; }
        const int nig = WGM * nN, gid = wgid / nig, fm = gid * WGM, gsz = (nM - fm) < WGM ? (nM - fm) : WGM;
        const int pm = fm + ((wgid % nig) % gsz), pn = (wgid % nig) / gsz;
        u.pm = pm + b * oM; u.pn = pn; u.pa = pm + b * aM; u.pb = pn + b * bN; return true;
    }
};

__device__ __forceinline__ unsigned cvt_pk_bf16(float lo, float hi) { unsigned r; asm volatile("v_cvt_pk_bf16_f32 %0, %1, %2" : "=v"(r) : "v"(lo), "v"(hi)); return r; }

#define PG8_EPI_LOOP(...) \
    _Pragma("unroll") for (int ai = 0; ai < 2; ++ai) _Pragma("unroll") for (int m = 0; m < 4; ++m) { const int row = u.pm * BM + ai * HALF + wr * 64 + m * 16 + fr; \
        _Pragma("unroll") for (int bj = 0; bj < 2; ++bj) _Pragma("unroll") for (int n = 0; n < 2; ++n) { const int col = u.pn * BM + bj * HALF + wc * 32 + n * 16 + 4 * fq; const f32x4 v = acc[ai][bj][m][n]; __VA_ARGS__ } }

struct EpiF32 {
    float* out; int ldc;
    __device__ __forceinline__ void operator()(const f32x4 (&acc)[2][2][4][2], const Unit& u, int wr, int wc, int fr, int fq) const {
        PG8_EPI_LOOP( *(f32x4*)(out + (size_t)row * ldc + col) = v; )
    }
};
struct EpiResid {
    const float* base; float* out; int ldc;
    __device__ __forceinline__ void operator()(const f32x4 (&acc)[2][2][4][2], const Unit& u, int wr, int wc, int fr, int fq) const {
        PG8_EPI_LOOP( const f32x4 b = *(const f32x4*)(base + (size_t)row * ldc + col); *(f32x4*)(out + (size_t)row * ldc + col) = b + v; )
    }
};
struct EpiInProj {
    bf16_t* pa; float* proj; bf16_t* prb;
    __device__ __forceinline__ void operator()(const f32x4 (&acc)[2][2][4][2], const Unit& u, int wr, int wc, int fr, int fq) const {
        if (u.pn < 2) { PG8_EPI_LOOP( u32x2 w; w.x = cvt_pk_bf16(v[0], v[1]); w.y = cvt_pk_bf16(v[2], v[3]); *(u32x2*)(pa + (size_t)row * 512 + col) = w; ) }
        else if (u.pn >= 8) { PG8_EPI_LOOP( u32x2 w; w.x = cvt_pk_bf16(v[0], v[1]); w.y = cvt_pk_bf16(v[2], v[3]); *(u32x2*)(prb + (size_t)row * 2048 + (col - 2048)) = w; ) }
        else { PG8_EPI_LOOP( u32x2 w; w.x = cvt_pk_bf16(v[0], v[1]); w.y = cvt_pk_bf16(v[2], v[3]); *(u32x2*)((bf16_t*)proj + (size_t)row * 1536 + (col - 512)) = w; ) }
    }
};
struct EpiC1 {
    bf16_t* c1;
    __device__ __forceinline__ void operator()(const f32x4 (&acc)[2][2][4][2], const Unit& u, int wr, int wc, int fr, int fq) const {
        PG8_EPI_LOOP( const int b = col >> 11, s = col & 2047; u32x2 w; w.x = cvt_pk_bf16(v[0], v[1]); w.y = cvt_pk_bf16(v[2], v[3]);
                      *(u32x2*)(c1 + ((size_t)b * 1024 + row) * 2048 + s) = w; )
    }
};
struct EpiGlu {
    const bf16_t* y; float* out;
    __device__ __forceinline__ void operator()(const f32x4 (&acc)[2][2][4][2], const Unit& u, int wr, int wc, int fr, int fq) const {
        PG8_EPI_LOOP( const u32x2 yw = *(const u32x2*)(y + (size_t)row * 512 + col);
                      f32x4 yv; yv[0] = __uint_as_float(yw.x << 16); yv[1] = __uint_as_float(yw.x & 0xffff0000u); yv[2] = __uint_as_float(yw.y << 16); yv[3] = __uint_as_float(yw.y & 0xffff0000u);
                      f32x4 o; _Pragma("unroll") for (int e = 0; e < 4; ++e) o[e] = yv[e] / (1.f + __expf(-v[e]));
                      *(f32x4*)(out + (size_t)row * 512 + col) = o; )
    }
};

template <class Epi, class Sched>
__device__ __forceinline__ void gemm_phase(PG8_LAS unsigned char* lds, const Gemm g, const Sched& S, const Epi& E, const int tid) {
    const int wid = __builtin_amdgcn_readfirstlane(tid >> 6), lane = tid & 63, wr = wid >> 2, wc = wid & 3, fr = lane & 15, fq = lane >> 4;
    const int K = g.K, nt = K / BK;
    unsigned voffA[2];
#pragma unroll
    for (int i = 0; i < 2; ++i) { int R, C; stage_rc(tid * 16 + i * 8192, R, C); voffA[i] = (unsigned)(R * K + C) * 2u; }
    const size_t kstep = (size_t)(BK * 2);
    const size_t hstep = (size_t)HALF * K * 2;
    const size_t tstep = 2 * hstep;
    const unsigned ldsw = (unsigned)wid * 1024u;
    const int aoff = lds_byte(wr * 64 + fr, fq * 8), boff = lds_byte(wc * 32 + fr, fq * 8);
#define PG8_SA(b, h) (((b) * 2 + (h)) * HTB)
#define PG8_SB(b, h) ((4 + (b) * 2 + (h)) * HTB)
#define PG8_STAGE(bufoff, gbase, voff) do { _Pragma("unroll") for (int _i = 0; _i < 2; ++_i) \
        __builtin_amdgcn_global_load_lds((const unsigned*)((const char*)(gbase) + (voff)[_i]), (PG8_LAS unsigned*)(lds + (bufoff) + ldsw + _i * 8192), 16, 0, 0); } while (0)
#define PG8_LDA(dst, b, h) do { _Pragma("unroll") for (int m = 0; m < 4; ++m) _Pragma("unroll") for (int k = 0; k < 2; ++k) dst[m][k] = *(const PG8_LAS bf16x8*)(lds + PG8_SA(b, h) + aoff + m * 2048 + k * 1024); } while (0)
#define PG8_LDB(dst, b, h) do { _Pragma("unroll") for (int n = 0; n < 2; ++n) _Pragma("unroll") for (int k = 0; k < 2; ++k) dst[n][k] = *(const PG8_LAS bf16x8*)(lds + PG8_SB(b, h) + boff + n * 2048 + k * 1024); } while (0)
#define PG8_MMA(ai, bj, At, Bt) do { __builtin_amdgcn_s_setprio(1); _Pragma("unroll") for (int m = 0; m < 4; ++m) _Pragma("unroll") for (int n = 0; n < 2; ++n) _Pragma("unroll") for (int k = 0; k < 2; ++k) \
        acc[ai][bj][m][n] = __builtin_amdgcn_mfma_f32_16x16x32_bf16(Bt[n][k], At[m][k], acc[ai][bj][m][n], 0, 0, 0); __builtin_amdgcn_s_setprio(0); } while (0)
#define PG8_WAIT_V(n) asm volatile("s_waitcnt vmcnt(" #n ")" ::: "memory")
#define PG8_WAIT_L(n) asm volatile("s_waitcnt lgkmcnt(" #n ")" ::: "memory")
#define PG8_BAR __builtin_amdgcn_s_barrier()
#define PG8_SCHED __builtin_amdgcn_sched_barrier(0)
    Unit cur, nxt; int ui = 0;
    if (!S.next(0, cur)) return;
    f32x4 acc[2][2][4][2];
#pragma unroll
    for (int a = 0; a < 2; ++a)
#pragma unroll
        for (int b = 0; b < 2; ++b)
#pragma unroll
            for (int m = 0; m < 4; ++m)
#pragma unroll
                for (int n = 0; n < 2; ++n) acc[a][b][m][n] = (f32x4){0.f, 0.f, 0.f, 0.f};
    bf16x8 At[4][2], B0[2][2], B1[2][2];
    const char* cA = (const char*)g.A + (size_t)cur.pa * tstep; const char* cB = (const char*)g.Bt + (size_t)cur.pb * tstep;
    PG8_STAGE(PG8_SB(0, 0), cB, voffA); PG8_STAGE(PG8_SB(0, 1), cB + hstep, voffA); PG8_STAGE(PG8_SA(0, 0), cA, voffA); PG8_STAGE(PG8_SA(0, 1), cA + hstep, voffA);
    if (wr == 1) PG8_BAR;
    PG8_WAIT_V(2); PG8_BAR;
    PG8_STAGE(PG8_SB(1, 0), cB + kstep, voffA); PG8_STAGE(PG8_SA(1, 0), cA + kstep, voffA); PG8_STAGE(PG8_SB(1, 1), cB + hstep + kstep, voffA);
    PG8_WAIT_V(6); PG8_BAR;
    for (;;) {
        const bool has_next = S.next(ui + 1, nxt);
        const char* nA = has_next ? (const char*)g.A + (size_t)nxt.pa * tstep : cA; const char* nB = has_next ? (const char*)g.Bt + (size_t)nxt.pb * tstep : cB;
        for (int t = 0; t < nt; t += 2) {
            const bool last = (t == nt - 2);
            const char* a1 = cA + (size_t)(t + 1) * kstep;
            const char* a2 = last ? nA : cA + (size_t)(t + 2) * kstep; const char* b2 = last ? nB : cB + (size_t)(t + 2) * kstep;
            const char* a3 = a2 + kstep; const char* b3 = b2 + kstep;
            PG8_LDB(B0, 0, 0); PG8_LDB(B1, 0, 1); PG8_SCHED; PG8_LDA(At, 0, 0); PG8_STAGE(PG8_SA(1, 1), a1 + hstep, voffA);
            PG8_WAIT_V(8); PG8_WAIT_L(0); PG8_BAR; PG8_MMA(0, 0, At, B0); PG8_MMA(0, 1, At, B1); PG8_BAR; PG8_SCHED;
            PG8_LDA(At, 0, 1); PG8_STAGE(PG8_SB(0, 0), b2, voffA); PG8_STAGE(PG8_SB(0, 1), b2 + hstep, voffA); PG8_STAGE(PG8_SA(0, 0), a2, voffA);
            PG8_WAIT_V(8); PG8_WAIT_L(0); PG8_BAR; PG8_MMA(1, 0, At, B0); PG8_MMA(1, 1, At, B1); PG8_BAR; PG8_SCHED;
            PG8_LDB(B0, 1, 0); PG8_LDB(B1, 1, 1); PG8_SCHED; PG8_LDA(At, 1, 0); PG8_STAGE(PG8_SA(0, 1), a2 + hstep, voffA);
            PG8_WAIT_V(8); PG8_WAIT_L(0); PG8_BAR; PG8_MMA(0, 0, At, B0); PG8_MMA(0, 1, At, B1); PG8_BAR; PG8_SCHED;
            PG8_LDA(At, 1, 1); PG8_STAGE(PG8_SB(1, 0), b3, voffA); PG8_STAGE(PG8_SB(1, 1), b3 + hstep, voffA); PG8_STAGE(PG8_SA(1, 0), a3, voffA);
            PG8_WAIT_V(8); PG8_WAIT_L(0); PG8_BAR; PG8_MMA(1, 0, At, B0); PG8_MMA(1, 1, At, B1); PG8_BAR; PG8_SCHED;
        }
        if (wr == 0) PG8_BAR;
        E(acc, cur, wr, wc, fr, fq);
        if (!has_next) break;
#pragma unroll
        for (int a = 0; a < 2; ++a)
#pragma unroll
            for (int b = 0; b < 2; ++b)
#pragma unroll
                for (int m = 0; m < 4; ++m)
#pragma unroll
                    for (int n = 0; n < 2; ++n) acc[a][b][m][n] = (f32x4){0.f, 0.f, 0.f, 0.f};
        cur = nxt; cA = nA; cB = nB; ++ui;
        if (wr == 1) PG8_BAR;
    }
    PG8_WAIT_V(0);
    PG8_BAR;
#undef PG8_SA
#undef PG8_SB
#undef PG8_STAGE
#undef PG8_LDA
#undef PG8_LDB
#undef PG8_MMA
#undef PG8_WAIT_V
#undef PG8_WAIT_L
#undef PG8_BAR
#undef PG8_SCHED
}
}

namespace att {
using bf16 = unsigned short;
constexpr int   D = 128, NW = 8, QBLK = 32, KVBLK = 64;
constexpr float SCALE = 0.088388347648318440f;
constexpr float THR = 8.f;
constexpr int SDEPTH = 1;
constexpr int LDQ = 512, LDK = 256, LDO = 512;
constexpr size_t SHM_V = KVBLK * D * 2, SHM_K = KVBLK * D * 2, SHM_ATTN = 2 * SHM_V + 2 * SHM_K + NW * 64 * 4;

using bf16x8 = __attribute__((ext_vector_type(8))) short;
using s16x4  = __attribute__((ext_vector_type(4))) short;
using f32x16 = __attribute__((ext_vector_type(16))) float;
using f32x8  = __attribute__((ext_vector_type(8))) float;
using u32x4  = __attribute__((ext_vector_type(4))) unsigned;
#define KSWZ(row, colB) ((row) * 256 + ((colB) ^ (((row) & 7) << 4)))
#define SBAR() __builtin_amdgcn_sched_barrier(0)
__device__ __forceinline__ int crow(int r, int hi) { return (r & 3) + 8 * (r >> 2) + 4 * hi; }
__device__ __forceinline__ unsigned cvtpk(float lo, float hi) {
  unsigned r; asm volatile("v_cvt_pk_bf16_f32 %0, %1, %2" : "=v"(r) : "v"(lo), "v"(hi)); return r;
}
template <typename TIn> struct Stage;
template <> struct Stage<bf16>  { using T = bf16x8;
  __device__ static __forceinline__ T ld8(const bf16* p) { return *reinterpret_cast<const bf16x8*>(p); }
  __device__ static __forceinline__ bf16x8 tobf(T x) { return x; } };

__device__ __forceinline__ void partialSM(f32x16& p0, f32x16& p1, float& m_reg, float& mn, float& alpha) {
  constexpr float C = SCALE * 1.4426950408889634f;
  float pmax = p0[0]; for (int r = 1; r < 16; ++r) pmax = fmaxf(pmax, p0[r]); for (int r = 0; r < 16; ++r) pmax = fmaxf(pmax, p1[r]);
  { auto rr = __builtin_amdgcn_permlane32_swap(__float_as_uint(pmax), __float_as_uint(pmax), false, false);
    pmax = fmaxf(__uint_as_float(rr[0]), __uint_as_float(rr[1])); }
  if (__builtin_expect(__all(pmax - m_reg <= THR / SCALE), 1)) { mn = m_reg; alpha = 1.f; }
  else { mn = fmaxf(m_reg, pmax); alpha = __builtin_amdgcn_exp2f((m_reg - mn) * C); m_reg = mn; }
  float mnC = -mn * C;
  for (int r = 0; r < 16; ++r) p0[r] = fmaf(p0[r], C, mnC); for (int r = 0; r < 16; ++r) p1[r] = fmaf(p1[r], C, mnC);
  for (int r = 0; r < 16; ++r) p0[r] = __builtin_amdgcn_exp2f(p0[r]);
}
__device__ __forceinline__ void finishSM(f32x16& p0, f32x16& p1, float alpha, float& l_reg, bf16x8& pa0, bf16x8& pa1, bf16x8& pa2, bf16x8& pa3) {
  for (int r = 0; r < 16; ++r) p1[r] = __builtin_amdgcn_exp2f(p1[r]);
  float ps = 0; for (int r = 0; r < 16; ++r) ps += p0[r]; for (int r = 0; r < 16; ++r) ps += p1[r];
  { auto rr = __builtin_amdgcn_permlane32_swap(__float_as_uint(ps), __float_as_uint(ps), false, false);
    ps = __uint_as_float(rr[0]) + __uint_as_float(rr[1]); }
  l_reg = l_reg * alpha + ps;
#define PK4(P, BASE, OUT) do { unsigned a0 = cvtpk(P[BASE + 0], P[BASE + 1]), a1 = cvtpk(P[BASE + 2], P[BASE + 3]);   \
    unsigned b0 = cvtpk(P[BASE + 4], P[BASE + 5]), b1 = cvtpk(P[BASE + 6], P[BASE + 7]);                              \
    auto r0 = __builtin_amdgcn_permlane32_swap(a0, b0, false, false); auto r1 = __builtin_amdgcn_permlane32_swap(a1, b1, false, false); \
    u32x4 w = {r0[0], r1[0], r0[1], r1[1]}; OUT = *reinterpret_cast<bf16x8*>(&w); } while (0)
  PK4(p0, 0, pa0); PK4(p0, 8, pa1); PK4(p1, 0, pa2); PK4(p1, 8, pa3);
#undef PK4
}
__device__ __forceinline__ void qkt(f32x16& p0, f32x16& p1, const bf16* Ks, const bf16x8* qr, int r32, int hi) {
  p0 = f32x16{}; p1 = f32x16{};
  for (int d0 = 0; d0 < 8; ++d0) { int cb = (d0 * 16 + hi * 8) * 2;
    bf16x8 b0 = *reinterpret_cast<const bf16x8*>((const char*)Ks + KSWZ(r32, cb));
    bf16x8 b1 = *reinterpret_cast<const bf16x8*>((const char*)Ks + KSWZ(32 + r32, cb));
    p0 = __builtin_amdgcn_mfma_f32_32x32x16_bf16(b0, qr[d0], p0, 0, 0, 0);
    p1 = __builtin_amdgcn_mfma_f32_32x32x16_bf16(b1, qr[d0], p1, 0, 0, 0); }
}
__device__ __forceinline__ int v_st(int k, int c) { const int kk = (k & ~0xC) | ((k & 4) << 1) | ((k & 8) >> 1); return ((kk >> 3) * 4 + (c >> 5)) * 512 + ((kk & 7) * 32 + (c & 31)) * 2; }
__device__ __forceinline__ int v_rd_base(int lane) { return ((lane & 3) << 3) | (((lane >> 2) & 3) << 6) | (((lane >> 4) & 1) << 5) | (((lane >> 5) & 1) << 8); }
constexpr int v_rd_off(int d0, int ks, int half) { return d0 * 512 + ks * 4096 + half * 2048; }
template <int OFF> __device__ __forceinline__ s16x4 tr_read(int vb) {
  s16x4 r; asm volatile("ds_read_b64_tr_b16 %0, %1 offset:%2" : "=&v"(r) : "v"(vb), "i"(OFF) : "memory"); return r;
}
template <int D0> __device__ __forceinline__ void pv_one(f32x16& od, int vb, bf16x8 pa0, bf16x8 pa1, bf16x8 pa2, bf16x8 pa3) {
  const s16x4 l0 = tr_read<v_rd_off(D0, 0, 0)>(vb), h0 = tr_read<v_rd_off(D0, 0, 1)>(vb), l1 = tr_read<v_rd_off(D0, 1, 0)>(vb), h1 = tr_read<v_rd_off(D0, 1, 1)>(vb);
  const s16x4 l2 = tr_read<v_rd_off(D0, 2, 0)>(vb), h2 = tr_read<v_rd_off(D0, 2, 1)>(vb), l3 = tr_read<v_rd_off(D0, 3, 0)>(vb), h3 = tr_read<v_rd_off(D0, 3, 1)>(vb);
  asm volatile("s_waitcnt lgkmcnt(0)" ::: "memory"); SBAR();
#define PK(L, H) (bf16x8){L[0], L[1], L[2], L[3], H[0], H[1], H[2], H[3]}
  od = __builtin_amdgcn_mfma_f32_32x32x16_bf16(pa0, PK(l0, h0), od, 0, 0, 0);
  od = __builtin_amdgcn_mfma_f32_32x32x16_bf16(pa1, PK(l1, h1), od, 0, 0, 0);
  od = __builtin_amdgcn_mfma_f32_32x32x16_bf16(pa2, PK(l2, h2), od, 0, 0, 0);
  od = __builtin_amdgcn_mfma_f32_32x32x16_bf16(pa3, PK(l3, h3), od, 0, 0, 0);
#undef PK
}
__device__ __forceinline__ void pv_d0(f32x16* o, int vb, bf16x8 pa0, bf16x8 pa1, bf16x8 pa2, bf16x8 pa3) {
  pv_one<0>(o[0], vb, pa0, pa1, pa2, pa3); pv_one<1>(o[1], vb, pa0, pa1, pa2, pa3); pv_one<2>(o[2], vb, pa0, pa1, pa2, pa3); pv_one<3>(o[3], vb, pa0, pa1, pa2, pa3);
}
template <typename TQ>
__device__ __forceinline__ void attn_dense_body(const TQ* __restrict__ Qb, const bf16* __restrict__ Kh, const bf16* __restrict__ Vh,
                                                float* __restrict__ Ob, int seq, char* lds, const int tid_) {
  using St = Stage<bf16>; using SQ = Stage<TQ>;
  int tid = tid_; asm volatile("" : "+v"(tid));
  const int wid = tid >> 6, lane = tid & 63, r32 = lane & 31, hi = lane >> 5;
  bf16* V_lds = (bf16*)lds; bf16* K_lds = (bf16*)(lds + 2 * SHM_V);
  float* ws = (float*)(lds + 2 * SHM_V + 2 * SHM_K) + wid * 64; float* li_l = ws; float* al_l = ws + 32;
  float m_reg = -1e30f, l_reg = 0; f32x16 o[4] = {}; bf16x8 qr[8];
  const TQ* Qw = Qb + (long)(wid * QBLK + r32) * LDQ + hi * 8;
#pragma unroll
  for (int d0 = 0; d0 < 8; ++d0) qr[d0] = SQ::tobf(SQ::ld8(Qw + d0 * 16));
  const int sr = tid >> 4, sc = (tid & 15) * 8, vst0 = v_st(sr, sc), vst1 = v_st(32 + sr, sc);
  const int vb0 = (int)(uintptr_t)V_lds + v_rd_base(lane);
  struct { typename St::T vs0, vs1, ks0, ks1; } sr_[SDEPTH];
  const unsigned loff = (unsigned)(sr * LDK + sc);
#define SLOAD(i, k0) do { const bf16* Vt_ = Vh + (size_t)(k0) * LDK; const bf16* Kt_ = Kh + (size_t)(k0) * LDK; \
    sr_[i].vs0 = St::ld8(Vt_ + loff); sr_[i].vs1 = St::ld8(Vt_ + 32 * LDK + loff); \
    sr_[i].ks0 = St::ld8(Kt_ + loff); sr_[i].ks1 = St::ld8(Kt_ + 32 * LDK + loff); } while (0)
#define SWRITE(b, i) do { *(bf16x8*)((char*)V_lds + (b) * SHM_V + vst0) = St::tobf(sr_[i].vs0);          \
    *(bf16x8*)((char*)V_lds + (b) * SHM_V + vst1) = St::tobf(sr_[i].vs1); int kc = sc * 2;               \
    *(bf16x8*)((char*)K_lds + (b) * SHM_K + KSWZ(sr, kc)) = St::tobf(sr_[i].ks0);                       \
    *(bf16x8*)((char*)K_lds + (b) * SHM_K + KSWZ(32 + sr, kc)) = St::tobf(sr_[i].ks1); } while (0)
#define SWAIT() do { if constexpr (SDEPTH == 2) asm volatile("s_waitcnt vmcnt(4)" ::: "memory"); else asm volatile("s_waitcnt vmcnt(0)" ::: "memory"); } while (0)
#define RESC(a) do { if (__any((a) < 1.f)) { if (hi == 0) al_l[r32] = (a); asm volatile("s_waitcnt lgkmcnt(0)" ::: "memory"); \
    for (int d = 0; d < 4; ++d) for (int r = 0; r < 16; ++r) o[d][r] *= al_l[crow(r, hi)]; } } while (0)
  f32x16 pA0, pA1, pB0, pB1; float mnA, mnB, alA, alB; bf16x8 pa0, pa1, pa2, pa3; const int NT = seq / KVBLK;
  constexpr int SE = 0, SO = SDEPTH - 1;
  SLOAD(SE, 0); asm volatile("s_waitcnt vmcnt(0)" ::: "memory"); SWRITE(0, SE); __syncthreads();
  qkt(pA0, pA1, K_lds, qr, r32, hi); partialSM(pA0, pA1, m_reg, mnA, alA);
  SLOAD(SO, KVBLK); if constexpr (SDEPTH == 2) { if (2 < NT) SLOAD(SE, 2 * KVBLK); }
  SWAIT(); SWRITE(1, SO); __syncthreads();
  for (int j = 1; j + 1 < NT; j += 2) {
    SBAR(); qkt(pB0, pB1, (bf16*)((char*)K_lds + SHM_K), qr, r32, hi);
    finishSM(pA0, pA1, alA, l_reg, pa0, pa1, pa2, pa3); SBAR();
    SLOAD(SO, (j + SDEPTH) * KVBLK); SBAR();
    pv_d0(o, vb0, pa0, pa1, pa2, pa3); partialSM(pB0, pB1, m_reg, mnB, alB);
    __syncthreads(); SWAIT(); SWRITE(0, SE);
    RESC(alB); __syncthreads();
    SBAR(); qkt(pA0, pA1, K_lds, qr, r32, hi);
    finishSM(pB0, pB1, alB, l_reg, pa0, pa1, pa2, pa3); SBAR();
    if (SDEPTH == 1 || j + 3 < NT) SLOAD(SE, (j + 1 + SDEPTH) * KVBLK); SBAR();
    pv_d0(o, vb0 + (int)SHM_V, pa0, pa1, pa2, pa3); partialSM(pA0, pA1, m_reg, mnA, alA);
    __syncthreads(); SWAIT(); SWRITE(1, SO);
    RESC(alA); __syncthreads();
  }
  SBAR(); qkt(pB0, pB1, (bf16*)((char*)K_lds + SHM_K), qr, r32, hi);
  finishSM(pA0, pA1, alA, l_reg, pa0, pa1, pa2, pa3); SBAR();
  pv_d0(o, vb0, pa0, pa1, pa2, pa3); partialSM(pB0, pB1, m_reg, mnB, alB);
  __syncthreads(); RESC(alB);
  finishSM(pB0, pB1, alB, l_reg, pa0, pa1, pa2, pa3); SBAR();
  pv_d0(o, vb0 + (int)SHM_V, pa0, pa1, pa2, pa3);
  if (hi == 0) li_l[r32] = l_reg; asm volatile("s_waitcnt lgkmcnt(0)" ::: "memory");
  float rli[16];
#pragma unroll
  for (int r = 0; r < 16; ++r) rli[r] = __builtin_amdgcn_rcpf(li_l[crow(r, hi)]);
  int le = lane; asm volatile("" : "+v"(le));
  float* Ow = Ob + (size_t)(wid * QBLK) * LDO; const unsigned eo = (unsigned)((le >> 5) * 4 * LDO + (le & 31));
#pragma unroll
  for (int r = 0; r < 16; ++r) { const unsigned ro = eo + (unsigned)(((r & 3) + 8 * (r >> 2)) * LDO);
#pragma unroll
    for (int d0 = 0; d0 < 4; ++d0) Ow[ro + d0 * 32] = o[d0][r] * rli[r]; }
#undef SLOAD
#undef SWRITE
#undef SWAIT
#undef RESC
}
}
#define LAS __attribute__((address_space(3)))
typedef unsigned short bf16_t;
typedef float f32x4 __attribute__((ext_vector_type(4)));
typedef float f32x2 __attribute__((ext_vector_type(2)));
typedef unsigned u32x4 __attribute__((ext_vector_type(4)));
typedef unsigned u32x2 __attribute__((ext_vector_type(2)));

typedef short bf16x8_t __attribute__((ext_vector_type(8)));
__device__ __forceinline__ bf16x8_t mk8(unsigned d0, unsigned d1, unsigned d2, unsigned d3) { const u32x4 w = {d0, d1, d2, d3}; return __builtin_bit_cast(bf16x8_t, w); }
constexpr int NTHR = 512, NWAVES = 8;
constexpr int MTOK = 8192, DM = 2048, SEQ = 2048, NBATCH = 4, PROJ = 4096, GW = 512;
constexpr int LDS_BYTES = 147456;

constexpr size_t MiB = 1u << 20;
constexpr size_t WS_CTL = 0;
constexpr size_t WS_WINT = 1 * MiB;
constexpr size_t WS_WOUTT = WS_WINT + 32 * MiB;
constexpr size_t WS_WQT = WS_WOUTT + 16 * MiB;
constexpr size_t WS_WGLUT = WS_WQT + 8 * MiB;
constexpr size_t WS_WCST = WS_WGLUT + 1 * MiB;
constexpr size_t WS_DFT = WS_WCST + 2 * MiB;
constexpr size_t WS_C1F = WS_DFT + 8 * MiB;
constexpr size_t WS_UB = WS_DFT + 16 * MiB;
constexpr size_t WS_VB = WS_UB + 128 * MiB;
constexpr size_t WS_KEYST = WS_VB + 128 * MiB;
constexpr size_t WS_ROPE = WS_KEYST + 1 * MiB;
constexpr size_t WS_HB = WS_ROPE + 1 * MiB;
constexpr size_t WS_PROJ = WS_HB + 32 * MiB;
constexpr size_t WS_PA = WS_PROJ + 128 * MiB;
constexpr size_t WS_PRB = WS_UB + 96 * MiB;
constexpr size_t WS_C1 = WS_PA + 8 * MiB;
constexpr size_t WS_YA = WS_C1 + 16 * MiB;
constexpr size_t WS_QB = WS_YA + 64 * MiB;
constexpr size_t WS_S5E = WS_QB + 16 * MiB;
constexpr size_t WS_YGELU = WS_S5E + 4 * MiB;
constexpr size_t WS_RW = WS_YGELU + 8 * MiB;
constexpr size_t WS_YRW = WS_RW + 176 * MiB;
constexpr size_t WS_X1 = WS_YRW + 32 * MiB;
constexpr size_t WS_X2 = WS_X1 + 64 * MiB;
constexpr size_t WS_KS = WS_X2 + 64 * MiB;
constexpr size_t WS_S5T = WS_VB + 122 * MiB;
constexpr size_t WS_END = WS_KS + 16 * MiB;
static_assert(WS_END <= 1024 * MiB, "workspace map must fit 1 GiB");
constexpr size_t WS_LORA = WS_VB + 1 * MiB;
constexpr size_t WS_RWC = WS_VB + 2 * MiB;
constexpr int RWC_REC = 15360;
constexpr size_t RWSZ = (size_t)MTOK * GW;
enum { RW_R = 0, RW_V, RW_KK, RW_W0, RW_W1, RW_KD0, RW_KD1, RW_B0, RW_B1, RW_G, RW_BONUS };

struct Args { const float* in[36]; float* out; unsigned char* ws; int ph_lo, ph_hi; };

__device__ __forceinline__ unsigned f2bf(float f) { return (unsigned)__builtin_bit_cast(unsigned short, (__bf16)f); }
typedef __bf16 bf16x2n_t __attribute__((ext_vector_type(2)));
typedef float f32x2n_t __attribute__((ext_vector_type(2)));
__device__ __forceinline__ unsigned pk2(float lo, float hi) { const f32x2n_t v = {lo, hi}; return __builtin_bit_cast(unsigned, __builtin_convertvector(v, bf16x2n_t)); }
__device__ __forceinline__ float bflo(unsigned w) { return __uint_as_float(w << 16); }
__device__ __forceinline__ float bfhi(unsigned w) { return __uint_as_float(w & 0xffff0000u); }
#define DPPF(x, ctrl) __builtin_bit_cast(float, __builtin_amdgcn_update_dpp(0, __builtin_bit_cast(int, (x)), (ctrl), 0xF, 0xF, true))
#define RDL(x, l) __builtin_bit_cast(float, __builtin_amdgcn_readlane(__builtin_bit_cast(int, (x)), (l)))
__device__ __forceinline__ float wave_sum(float v) {
    v += DPPF(v, 0xB1); v += DPPF(v, 0x4E); v += DPPF(v, 0x124); v += DPPF(v, 0x128);
    return (RDL(v, 0) + RDL(v, 16)) + (RDL(v, 32) + RDL(v, 48));
}
__device__ __forceinline__ float wave_max(float v) {
    v = fmaxf(v, DPPF(v, 0xB1)); v = fmaxf(v, DPPF(v, 0x4E)); v = fmaxf(v, DPPF(v, 0x124)); v = fmaxf(v, DPPF(v, 0x128));
    return fmaxf(fmaxf(RDL(v, 0), RDL(v, 16)), fmaxf(RDL(v, 32), RDL(v, 48)));
}
__device__ __forceinline__ float sigmoidf_(float x) { return __builtin_amdgcn_rcpf(1.f + __expf(-x)); }
__device__ __forceinline__ float tanh_fast(float x) { return 1.f - 2.f * __builtin_amdgcn_rcpf(__expf(2.f * x) + 1.f); }
__device__ __forceinline__ float gelu_tanh(float x) { const float u = 0.7978845608028654f * (x + 0.044715f * x * x * x); return 0.5f * x * (1.f + tanhf(u)); }
__device__ __forceinline__ float gelu_erf(float x) { return 0.5f * x * (1.f + erff(x * 0.7071067811865476f)); }
#define LDS_WAIT() asm volatile("s_waitcnt lgkmcnt(0)" ::: "memory")

struct Ctx {
    LAS unsigned char* lds; int tid, lane, wave, G, gw, ngw, bx;
};
__device__ __forceinline__ Ctx fresh_ctx_w(unsigned char* lds_raw, int wave0) {
    Ctx C; int ln = __builtin_amdgcn_mbcnt_hi(~0u, __builtin_amdgcn_mbcnt_lo(~0u, 0u)); asm volatile("" : "+v"(ln));
    int wv = wave0; asm volatile("" : "+s"(wv));
    int t = wv * 64 + ln;
    int bx = blockIdx.x, G = gridDim.x; asm volatile("" : "+s"(bx), "+s"(G));
    unsigned lo_ = 0u; asm volatile("" : "+s"(lo_));
    C.lds = (LAS unsigned char*)lds_raw + lo_; C.tid = t; C.lane = ln; C.wave = wv;
    C.G = G; C.bx = bx; C.gw = bx * NWAVES + C.wave; C.ngw = G * NWAVES; return C;
}
#define AS4 __attribute__((address_space(4)))
typedef const float* const AS4* InTab;
struct AP { InTab in; float* out; unsigned char* ws; };
static_assert(offsetof(Args, out) == 288 && offsetof(Args, ws) == 296, "Args layout");
__device__ __forceinline__ AP fresh_args() {
    unsigned long long p = (unsigned long long)__builtin_amdgcn_kernarg_segment_ptr(); asm volatile("" : "+s"(p));
    AP r; r.in = (InTab)p; r.out = *(float* const AS4*)(p + 288); r.ws = *(unsigned char* const AS4*)(p + 296); return r;
}

typedef __attribute__((address_space(1))) unsigned gu32;
#define RLX_AGENT __ATOMIC_RELAXED, __HIP_MEMORY_SCOPE_AGENT
#define XB_TMO      128
#define XB_XCNT(j)  (256  + 64 * (j))
#define XB_XSUB(j)  (1280 + 64 * (j))
#define XB_XGEN(j)  (2304 + 64 * (j))
#define XB_TOP      3328
#define XB_TOPGEN   3392
#define XCD_BAR_WORDS 3456
#define XB_SPIN_CAP (1u << 18)

__device__ __forceinline__ unsigned xb_ld(unsigned* p)              { return __hip_atomic_load(p, __ATOMIC_RELAXED, __HIP_MEMORY_SCOPE_AGENT); }
__device__ __forceinline__ unsigned xb_add(unsigned* p, unsigned v) { return __hip_atomic_fetch_add(p, v, __ATOMIC_RELAXED, __HIP_MEMORY_SCOPE_AGENT); }
__device__ __forceinline__ unsigned xb_xcc_id() { return (unsigned)__builtin_amdgcn_s_getreg((3 << 11) | 20) & 0xFu; }
#define XB_SPIN(cond, bar) do { unsigned _sp = 0; while (cond) { __builtin_amdgcn_s_sleep(1); \
    if ((++_sp & 255u) == 0u) { if (xb_ld(&(bar)[XB_TMO])) break; if (_sp > XB_SPIN_CAP) { atomicAdd(&(bar)[XB_TMO], 1u); break; } } } } while (0)

struct XcdBarrier {
    unsigned* bar; unsigned x;
    volatile LAS unsigned* st;
};

__device__ __forceinline__ XcdBarrier xcd_barrier_post(unsigned* bar, volatile LAS unsigned* st) {
    XcdBarrier b; b.bar = bar; b.x = xb_xcc_id(); b.st = st;
    if (threadIdx.x == 0) (void)xb_add(&bar[XB_XCNT(b.x)], 1u);
    return b;
}
__device__ __forceinline__ void xcd_barrier_complete(unsigned* bar, unsigned x, unsigned& nloc, unsigned& nx) {
    const unsigned G = gridDim.x * gridDim.y * gridDim.z;
    unsigned sum, cnt, mine, sp = 0u;
    for (;;) {
        sum = 0u; cnt = 0u; mine = 0u;
#pragma unroll
        for (unsigned j = 0; j < 16; ++j) { const unsigned c = xb_ld(&bar[XB_XCNT(j)]); sum += c; cnt += (c > 0u) ? 1u : 0u; mine = (j == x) ? c : mine; }
        if (sum == G) break;
        __builtin_amdgcn_s_sleep(1);
        if ((++sp & 255u) == 0u) { if (xb_ld(&bar[XB_TMO])) break; if (sp > XB_SPIN_CAP) { atomicAdd(&bar[XB_TMO], 1u); break; } }
    }
    nloc = mine > 0u ? mine : 1u; nx = cnt > 0u ? cnt : 1u;
}

__device__ __forceinline__ void xcd_barrier(const XcdBarrier& b) {
    asm volatile("s_waitcnt vmcnt(0)" ::: "memory");
    __syncthreads();
    if (threadIdx.x == 0) {
        unsigned* bar = b.bar;
        __builtin_amdgcn_s_waitcnt(0);
        unsigned nloc = b.st[0], nx = b.st[1];
        if (nloc == 0u) { xcd_barrier_complete(bar, b.x, nloc, nx); b.st[0] = nloc; b.st[1] = nx; }
        const unsigned old = xb_add(&bar[XB_XSUB(b.x)], 1u);
        const unsigned gen = old / nloc;
        if (old + 1u == (gen + 1u) * nloc) {
            __builtin_amdgcn_fence(__ATOMIC_RELEASE, "agent");
            asm volatile("s_waitcnt vmcnt(0)" ::: "memory");
            const unsigned og = xb_add(&bar[XB_TOP], 1u);
            const unsigned tg = og / nx;
            if (og + 1u == (tg + 1u) * nx) xb_add(&bar[XB_TOPGEN], 1u);
            else XB_SPIN(xb_ld(&bar[XB_TOPGEN]) == tg, bar);
            __builtin_amdgcn_fence(__ATOMIC_ACQUIRE, "agent");
            xb_add(&bar[XB_XGEN(b.x)], 1u);
            asm volatile("s_waitcnt vmcnt(0)" ::: "memory");
        } else {
            XB_SPIN(xb_ld(&bar[XB_XGEN(b.x)]) == gen, bar);
            __builtin_amdgcn_fence(__ATOMIC_ACQUIRE, "agent");
            asm volatile("s_waitcnt vmcnt(0)" ::: "memory");
        }
    }
    __syncthreads();
}

__device__ __forceinline__ void transpose_item(const float* W, const float* gain, int K, int N, bf16_t* WT, LAS float* scr, int item, int lane) {
    const int nblk = N / 64, kb = item / nblk, nb = item % nblk, k0 = 64 * kb, n0 = 64 * nb;
    const int lr = lane >> 4, lc = (lane & 15) * 4;
    f32x4 v[16];
#pragma unroll
    for (int i = 0; i < 16; ++i) v[i] = *(const f32x4*)(W + (size_t)(k0 + 4 * i + lr) * N + n0 + lc);
#pragma unroll
    for (int i = 0; i < 16; ++i) { const int kk = 4 * i + lr; const float g = gain ? gain[k0 + kk] : 1.f; LAS float* d = scr + kk * 65 + lc;
        d[0] = v[i].x * g; d[1] = v[i].y * g; d[2] = v[i].z * g; d[3] = v[i].w * g; }
    LDS_WAIT(); asm volatile("" ::: "memory");
#pragma unroll
    for (int c = 0; c < 8; ++c) { const LAS float* sp = scr + (8 * c) * 65 + lane;
        u32x4 o; o.x = pk2(sp[0 * 65], sp[1 * 65]); o.y = pk2(sp[2 * 65], sp[3 * 65]); o.z = pk2(sp[4 * 65], sp[5 * 65]); o.w = pk2(sp[6 * 65], sp[7 * 65]);
        *(u32x4*)(WT + (size_t)(n0 + lane) * K + k0 + 8 * c) = o; }
    LDS_WAIT(); asm volatile("" ::: "memory");
}
__device__ __forceinline__ void rms_row_to_bf16(const float* xrow, bf16_t* orow, int lane) {
    const f32x4* xr = (const f32x4*)xrow + lane;
    f32x4 v[8]; float s = 0.f;
#pragma unroll
    for (int j = 0; j < 8; ++j) { v[j] = xr[64 * j]; s += (v[j].x * v[j].x + v[j].y * v[j].y) + (v[j].z * v[j].z + v[j].w * v[j].w); }
    const float rs = rsqrtf(wave_sum(s) * (1.f / DM) + 1e-6f);
    u32x2* o8 = (u32x2*)orow + lane;
#pragma unroll
    for (int j = 0; j < 8; ++j) { u32x2 w; w.x = pk2(v[j].x * rs, v[j].y * rs); w.y = pk2(v[j].z * rs, v[j].w * rs); o8[64 * j] = w; }
}
__device__ __forceinline__ void s5_tables(const Ctx& C, const AP& a);
typedef float v16f_t __attribute__((ext_vector_type(16)));
typedef float v32f_t __attribute__((ext_vector_type(32)));
typedef unsigned v6u_t __attribute__((ext_vector_type(6)));
constexpr int EROW = 1536; constexpr size_t ETAB = (size_t)16384 * EROW;
__device__ __forceinline__ void expert_row_pack(const AP& a, int which, int l, int e, int lane, const f32x4 (&v)[8], float mx) {
    unsigned char* ws = a.ws;
    if (which) {
        const float sc4 = mx > 0.f ? 6.f / mx : 1.f;
        unsigned wv[4];
#pragma unroll
        for (int d4 = 0; d4 < 4; ++d4) { unsigned w_ = 0u;
            w_ = __builtin_amdgcn_cvt_scalef32_pk_fp4_f32(w_, v[2 * d4].x * sc4, v[2 * d4].y * sc4, 1.0f, 0); w_ = __builtin_amdgcn_cvt_scalef32_pk_fp4_f32(w_, v[2 * d4].z * sc4, v[2 * d4].w * sc4, 1.0f, 1);
            w_ = __builtin_amdgcn_cvt_scalef32_pk_fp4_f32(w_, v[2 * d4 + 1].x * sc4, v[2 * d4 + 1].y * sc4, 1.0f, 2); w_ = __builtin_amdgcn_cvt_scalef32_pk_fp4_f32(w_, v[2 * d4 + 1].z * sc4, v[2 * d4 + 1].w * sc4, 1.0f, 3);
            wv[d4] = w_; }
        ((u32x4*)(ws + WS_UB + 64 * MiB + (size_t)l * 16 * MiB + (size_t)e * 1024))[lane] = (u32x4){wv[0], wv[1], wv[2], wv[3]};
        if (lane == 0) ((float*)(ws + WS_VB))[(2 + l) * 16384 + e] = mx > 0.f ? mx * (1.f / 6.f) : 1.f;
        return;
    }
    if (true) {
        const float sc4 = mx > 0.f ? 6.f / mx : 1.f;
        unsigned wv[4];
#pragma unroll
        for (int d4 = 0; d4 < 4; ++d4) { unsigned w_ = 0u;
            w_ = __builtin_amdgcn_cvt_scalef32_pk_fp4_f32(w_, v[2 * d4].x * sc4, v[2 * d4].y * sc4, 1.0f, 0); w_ = __builtin_amdgcn_cvt_scalef32_pk_fp4_f32(w_, v[2 * d4].z * sc4, v[2 * d4].w * sc4, 1.0f, 1);
            w_ = __builtin_amdgcn_cvt_scalef32_pk_fp4_f32(w_, v[2 * d4 + 1].x * sc4, v[2 * d4 + 1].y * sc4, 1.0f, 2); w_ = __builtin_amdgcn_cvt_scalef32_pk_fp4_f32(w_, v[2 * d4 + 1].z * sc4, v[2 * d4 + 1].w * sc4, 1.0f, 3);
            wv[d4] = w_; }
        ((u32x4*)(ws + WS_UB + (size_t)l * ETAB + (size_t)e * 1024))[lane] = (u32x4){wv[0], wv[1], wv[2], wv[3]};
        if (lane == 0) ((float*)(ws + WS_VB))[(0 * 2 + l) * 16384 + e] = mx > 0.f ? mx * (1.f / 6.f) : 1.f;
        return;
    }
    const float sc = mx > 0.f ? 7.f / mx : 1.f;
    typedef unsigned v16u_t __attribute__((ext_vector_type(16))); typedef __bf16 v32bf_t __attribute__((ext_vector_type(32)));
    v16u_t pw;
#pragma unroll
    for (int j = 0; j < 8; ++j) { pw[j * 2] = pk2(v[j].x * sc, v[j].y * sc); pw[j * 2 + 1] = pk2(v[j].z * sc, v[j].w * sc); }
    const v6u_t w = __builtin_amdgcn_cvt_scalef32_pk32_fp6_bf16(__builtin_bit_cast(v32bf_t, pw), 1.0f);
    unsigned char* row = ws + WS_UB + (size_t)l * ETAB + (size_t)e * EROW;
    ((u32x4*)row)[lane] = (u32x4){w[0], w[1], w[2], w[3]}; ((u32x2*)(row + 1024))[lane] = (u32x2){w[4], w[5]};
    if (lane == 0) ((float*)(ws + WS_VB))[(0 * 2 + l) * 16384 + e] = mx > 0.f ? mx * (1.f / 7.f) : 1.f;
}
__device__ __forceinline__ void expert_row_item2(const AP& a, int which, int l, int e, int lane) {
    const f32x4* src = (const f32x4*)(a.in[which ? 35 : 34] + ((size_t)l * 16384 + e) * DM) + lane;
    const f32x4* gp = (const f32x4*)(a.in[31] + l * DM) + lane;
    f32x4 v0[8], v1[8]; float m0 = 0.f, m1 = 0.f;
#pragma unroll
    for (int j = 0; j < 8; ++j) { v0[j] = src[64 * j]; v1[j] = src[512 + 64 * j]; }
#pragma unroll
    for (int j = 0; j < 8; ++j) { if (!which) { const f32x4 g = gp[64 * j]; v0[j] = v0[j] * g; v1[j] = v1[j] * g; }
        m0 = fmaxf(m0, fmaxf(fmaxf(fabsf(v0[j].x), fabsf(v0[j].y)), fmaxf(fabsf(v0[j].z), fabsf(v0[j].w))));
        m1 = fmaxf(m1, fmaxf(fmaxf(fabsf(v1[j].x), fabsf(v1[j].y)), fmaxf(fabsf(v1[j].z), fabsf(v1[j].w)))); }
    m0 = wave_max(m0); m1 = wave_max(m1);
    expert_row_pack(a, which, l, e, lane, v0, m0); expert_row_pack(a, which, l, e + 1, lane, v1, m1);
}
__device__ __forceinline__ void split8(const f32x4 a0, const f32x4 a1, bf16x8_t& hi, bf16x8_t& lo) {
    unsigned h[4], l_[4];
#pragma unroll
    for (int i = 0; i < 4; ++i) { const float x0 = i < 2 ? a0[2 * i] : a1[2 * i - 4], x1 = i < 2 ? a0[2 * i + 1] : a1[2 * i - 3];
        const unsigned h0 = f2bf(x0), h1 = f2bf(x1); h[i] = h0 | (h1 << 16);
        l_[i] = pk2(x0 - __uint_as_float(h0 << 16), x1 - __uint_as_float(h1 << 16)); }
    hi = mk8(h[0], h[1], h[2], h[3]); lo = mk8(l_[0], l_[1], l_[2], l_[3]);
}
__device__ __forceinline__ void phase_prep(const Ctx& C, const AP& a) {
    unsigned char* ws = a.ws;
    LAS float* scr = (LAS float*)(C.lds + C.wave * 16640);
    constexpr int I_IN = 32 * 64, I_OUT = 32 * 32, I_Q = 32 * 16, I_GLU = 8 * 8, I_L = I_IN + I_OUT + I_Q + I_GLU;
    for (int it = C.gw; it < 2 * I_L; it += C.ngw) {
        const int l = it / I_L; int r = it % I_L;
        if (r < I_IN) { transpose_item(a.in[2] + (size_t)l * DM * PROJ, a.in[1] + l * DM, DM, PROJ, (bf16_t*)(ws + WS_WINT) + (size_t)l * PROJ * DM, scr, r, C.lane); continue; } r -= I_IN;
        if (r < I_OUT) { transpose_item(a.in[30] + (size_t)l * DM * DM, a.in[29] + l * DM, DM, DM, (bf16_t*)(ws + WS_WOUTT) + (size_t)l * DM * DM, scr, r, C.lane); continue; } r -= I_OUT;
        if (r < I_Q) { transpose_item(a.in[32] + (size_t)l * DM * 1024, a.in[31] + l * DM, DM, 1024, (bf16_t*)(ws + WS_WQT) + (size_t)l * 1024 * DM, scr, r, C.lane); continue; } r -= I_Q;
        transpose_item(a.in[12] + (size_t)l * 512 * 512, nullptr, 512, 512, (bf16_t*)(ws + WS_WGLUT) + (size_t)l * 512 * 512, scr, r, C.lane);
    }
    {
        LAS float* tc = (LAS float*)(C.lds + 8 * 16640); LAS float* ts = tc + 128;
        if (C.tid < 128) { tc[C.tid] = cospif((float)C.tid / 64.f); ts[C.tid] = sinpif((float)C.tid / 64.f); }
        __syncthreads();
        for (int it = C.bx * NTHR + C.tid; it < 2 * 4 * 32 * 512; it += C.G * NTHR) {
            const int cp = it & 511, ccg = (it >> 9) & 31, blk = (it >> 14) & 3, l = it >> 16;
            const float* fw = a.in[3] + (size_t)l * 512 * 512 + (size_t)blk * 128 * 512 + cp;
            float sc[4] = {0.f, 0.f, 0.f, 0.f}, ss[4] = {0.f, 0.f, 0.f, 0.f};
#pragma unroll 8
            for (int m = 0; m < 128; ++m) { const float f = fw[(size_t)m * 512];
#pragma unroll
                for (int r = 0; r < 4; ++r) { const int ix = (m * (ccg * 4 + r)) & 127; sc[r] += tc[ix] * f; ss[r] += ts[ix] * f; } }
            bf16_t* o = (bf16_t*)(ws + WS_WCST) + (size_t)l * 1024 * 512; const int c0 = blk * 128 + ccg * 4;
            u32x2 w; w.x = pk2(sc[0] * (1.f / 512.f), sc[1] * (1.f / 512.f)); w.y = pk2(sc[2] * (1.f / 512.f), sc[3] * (1.f / 512.f)); *(u32x2*)(o + (size_t)(2 * cp) * 512 + c0) = w;
            w.x = pk2(ss[0] * (1.f / 512.f), ss[1] * (1.f / 512.f)); w.y = pk2(ss[2] * (1.f / 512.f), ss[3] * (1.f / 512.f)); *(u32x2*)(o + (size_t)(2 * cp + 1) * 512 + c0) = w;
        }
    }
    for (int it = C.bx * NTHR + C.tid; it < 2048 * 256; it += C.G * NTHR) {
        const int k = it >> 8, j0 = (it & 255) * 8; float v[8];
#pragma unroll
        for (int e = 0; e < 8; ++e) { const int j = j0 + e, s = j <= 1024 ? j : j - 1024; const float x = (float)((k * s) & 2047) * (1.f / 1024.f); v[e] = (j <= 1024) ? cospif(x) : -sinpif(x); }
        u32x4 w; w.x = pk2(v[0], v[1]); w.y = pk2(v[2], v[3]); w.z = pk2(v[4], v[5]); w.w = pk2(v[6], v[7]);
        *(u32x4*)((bf16_t*)(ws + WS_DFT) + (size_t)k * 2048 + j0) = w;
    }
    for (int it = C.bx * NTHR + C.tid; it < 2 * 8 * 2 * 128 * 64 / 8; it += C.G * NTHR) {
        const float* kp = a.in[33] + (size_t)it * 8; bf16x8_t kh_, kl_; split8(*(const f32x4*)kp, *(const f32x4*)(kp + 4), kh_, kl_);
        *(bf16x8_t*)((bf16_t*)(ws + WS_KEYST) + (size_t)it * 8) = kh_; *(bf16x8_t*)((bf16_t*)(ws + WS_KEYST) + 262144 + (size_t)it * 8) = kl_;
    }
    for (int it = C.bx * NTHR + C.tid; it < 2048 * 64; it += C.G * NTHR) {
        const int pos = it >> 6, j = it & 63; const float inv = powf(10000.f, -(float)(2 * (j & 31)) / 64.f);
        const float ang = (float)(j < 32 ? (pos >> 6) : (pos & 63)) * inv;
        ((float*)(ws + WS_ROPE))[it] = cosf(ang); ((float*)(ws + WS_ROPE))[2048 * 64 + it] = sinf(ang);
    }
    {
        bf16_t* W1T = (bf16_t*)(ws + WS_LORA); bf16_t* g2T = W1T + 2 * 224 * 512; bf16_t* w2T = g2T + 2 * 512 * 96; bf16_t* a2T = w2T + 2 * 2 * 512 * 32;
        for (int it = C.bx * NTHR + C.tid; it < 2 * 224 * 512; it += C.G * NTHR) {
            const int k = it & 511, j = (it >> 9) % 224, l = it / (224 * 512); float v;
            if (j < 96) v = a.in[22][((size_t)l * 512 + k) * 96 + j];
            else if (j < 160) v = a.in[17][((size_t)(l * 2 + ((j - 96) >> 5)) * 512 + k) * 32 + ((j - 96) & 31)];
            else v = a.in[20][((size_t)(l * 2 + ((j - 160) >> 5)) * 512 + k) * 32 + ((j - 160) & 31)];
            W1T[it] = (bf16_t)f2bf(v);
        }
        for (int it = C.bx * NTHR + C.tid; it < 2 * 512 * 96; it += C.G * NTHR) {
            const int j = it % 96, ch = (it / 96) & 511, l = it / (96 * 512);
            g2T[it] = (bf16_t)f2bf(a.in[23][((size_t)l * 96 + j) * 512 + ch]);
        }
        for (int it = C.bx * NTHR + C.tid; it < 2 * 2 * 512 * 32; it += C.G * NTHR) {
            const int j = it & 31, ch = (it >> 5) & 511, ld = it >> 14;
            w2T[it] = (bf16_t)f2bf(a.in[18][((size_t)ld * 32 + j) * 512 + ch]); a2T[it] = (bf16_t)f2bf(a.in[21][((size_t)ld * 32 + j) * 512 + ch]);
        }
    }
    for (int m = C.gw; m < MTOK; m += C.ngw) rms_row_to_bf16(a.in[0] + (size_t)m * DM, (bf16_t*)(ws + WS_HB) + (size_t)m * DM, C.lane);
}

__device__ __forceinline__ void qk_prep_token(const AP& a, int l, int m, int lane) {
    unsigned char* ws = a.ws;
    const unsigned short* pr = (const unsigned short*)(ws + WS_PROJ) + (size_t)m * 1536;
    const int pos = m & (SEQ - 1);
    const float cs = ((const float*)(ws + WS_ROPE))[pos * 64 + lane], sn = ((const float*)(ws + WS_ROPE))[2048 * 64 + pos * 64 + lane];
    bf16_t* qo = (bf16_t*)(ws + WS_QB) + (size_t)m * 512; bf16_t* ko = (bf16_t*)(ws + WS_QB) + (size_t)MTOK * 512 + (size_t)m * 256; bf16_t* vo = ko + (size_t)MTOK * 256;
#pragma unroll
    for (int hh = 0; hh < 6; ++hh) {
        const unsigned short* src = pr + 512 + hh * 128;
        const float* gn = a.in[hh < 4 ? 13 : 14] + l * 128;
        const float x1 = __uint_as_float((unsigned)src[lane] << 16), x2 = __uint_as_float((unsigned)src[lane + 64] << 16);
        const float rs = rsqrtf(wave_sum(x1 * x1 + x2 * x2) * (1.f / 128.f) + 1e-6f);
        const float y1 = x1 * rs * gn[lane], y2 = x2 * rs * gn[lane + 64];
        bf16_t* dst = hh < 4 ? qo + hh * 128 : ko + (hh - 4) * 128;
        dst[lane] = (bf16_t)f2bf(y1 * cs - y2 * sn); dst[lane + 64] = (bf16_t)f2bf(y1 * sn + y2 * cs);
    }
    *((u32x2*)vo + lane) = *((const u32x2*)(pr + 1280) + lane);
}

struct S5P { float lr, li, cr, ci; };
__device__ __forceinline__ S5P s5_params(const AP& a, int l, int d, int g, int p, float mult) {
    const int ix = ((l * 2 + d) * 32 + g) * 64 + p;
    const float lre = a.in[4][ix], lim = a.in[5][ix], step = __expf(a.in[6][(l * 2 + d) * 32 + g]) * mult;
    const float er = __expf(lre * step); float sn, cs; __sincosf(lim * step, &sn, &cs);
    S5P r; r.lr = er * cs; r.li = er * sn;
    const float nr = r.lr - 1.f, ni = r.li, den = 1.f / (lre * lre + lim * lim);
    r.cr = (nr * lre + ni * lim) * den; r.ci = (ni * lre - nr * lim) * den;
    return r;
}
__device__ __forceinline__ void s5_ends_item(const AP& a, int l, int item, int lane, LAS float* us) {
    unsigned char* ws = a.ws;
    const int c = item & 31, g = (item >> 5) & 31, b = item >> 10, p = lane;
    { const u32x4* ur = (const u32x4*)((const bf16_t*)(ws + WS_PROJ) + ((size_t)(b * SEQ + c * 64 + lane)) * 1536 + g * 16);
      const u32x4 r0 = ur[0], r1 = ur[1];
#pragma unroll
      for (int q = 0; q < 4; ++q) { const unsigned wa = q < 2 ? r0[2 * q] : r1[2 * q - 4], wb = q < 2 ? r0[2 * q + 1] : r1[2 * q - 3];
          *((LAS f32x4*)(us + lane * 16) + q) = (f32x4){bflo(wa), bfhi(wa), bflo(wb), bfhi(wb)}; } }
    LDS_WAIT(); asm volatile("" ::: "memory");
#pragma unroll 1
    for (int d = 0; d < 2; ++d) {
        const S5P P = s5_params(a, l, d, g, p, 1.f);
        f32x2 bb2[16];
        const float* bre = a.in[7] + ((size_t)((l * 2 + d) * 32 + g) * 64 + p) * 16; const float* bim = a.in[8] + ((size_t)((l * 2 + d) * 32 + g) * 64 + p) * 16;
#pragma unroll
        for (int h = 0; h < 16; ++h) { const float x = bre[h], y = bim[h]; bb2[h].x = P.cr * x - P.ci * y; bb2[h].y = P.cr * y + P.ci * x; }
        const f32x2 lam2 = {P.lr, P.lr}, lami = {-P.li, P.li};
        float xr = 0.f, xi = 0.f;
#pragma unroll 4
        for (int tt = 0; tt < 64; ++tt) {
            const int t = d ? 63 - tt : tt;
            f32x2 acc2 = {0.f, 0.f};
#pragma unroll
            for (int q = 0; q < 4; ++q) { const f32x4 u4 = *((const LAS f32x4*)(us + t * 16) + q);
#pragma unroll
                for (int e = 0; e < 4; ++e) acc2 += bb2[q * 4 + e] * u4[e]; }
            const f32x2 x2 = {xr, xi}, xs = {xi, xr}; const f32x2 n2 = lam2 * x2 + lami * xs + acc2; xr = n2.x; xi = n2.y;
        }
        f32x2 o; o.x = xr; o.y = xi;
        ((f32x2*)(ws + WS_S5E))[((size_t)((b * 32 + g) * 2 + d) * 32 + c) * 64 + p] = o;
    }
    LDS_WAIT(); asm volatile("" ::: "memory");
}
__device__ __forceinline__ void s5_final_item(const AP& a, int l, int item, int lane, LAS float* us  , LAS float* yb  , LAS float* X  ) {
    unsigned char* ws = a.ws;
    const int c = item & 31, g = (item >> 5) & 31, b = item >> 10, p = lane;
    const float* ur = (const float*)(ws + WS_PROJ) + ((size_t)(b * SEQ + c * 64 + lane)) * PROJ + 512 + g * 16;
#pragma unroll
    for (int q = 0; q < 4; ++q) { *((LAS f32x4*)(us + lane * 16) + q) = *((const f32x4*)ur + q); *((LAS f32x4*)(yb + lane * 16) + q) = (f32x4){0.f, 0.f, 0.f, 0.f}; }
    LDS_WAIT(); asm volatile("" ::: "memory");
    const int oh = lane & 15, otq = lane >> 4;
#pragma unroll 1
    for (int d = 0; d < 2; ++d) {
        const S5P P = s5_params(a, l, d, g, p, 1.f);
        const S5P P64 = s5_params(a, l, d, g, p, 64.f);
        float br[16], bi[16];
        const float* bre = a.in[7] + ((size_t)((l * 2 + d) * 32 + g) * 64 + p) * 16; const float* bim = a.in[8] + ((size_t)((l * 2 + d) * 32 + g) * 64 + p) * 16;
#pragma unroll
        for (int h = 0; h < 16; ++h) { const float x = bre[h], y = bim[h]; br[h] = P.cr * x - P.ci * y; bi[h] = P.cr * y + P.ci * x; }
        const f32x2* E = (const f32x2*)(ws + WS_S5E) + ((size_t)((b * 32 + g) * 2 + d) * 32) * 64 + p;
        float xr = 0.f, xi = 0.f;
        { f32x2 nx[4];
#pragma unroll
          for (int i = 0; i < 4; ++i) nx[i] = E[(d ? 31 - i : i) * 64];
#pragma unroll 1
          for (int grp = 0; grp < 8; ++grp) {
              if (d ? (31 - grp * 4 <= c) : (grp * 4 >= c)) break;
              f32x2 cu[4];
#pragma unroll
              for (int i = 0; i < 4; ++i) cu[i] = nx[i];
              if (grp < 7) {
#pragma unroll
                  for (int i = 0; i < 4; ++i) nx[i] = E[(d ? 27 - grp * 4 - i : grp * 4 + 4 + i) * 64];
              }
#pragma unroll
              for (int i = 0; i < 4; ++i) { const int cc = d ? 31 - grp * 4 - i : grp * 4 + i;
                  if (d ? (cc > c) : (cc < c)) { const float nr = P64.lr * xr - P64.li * xi + cu[i].x, ni = P64.lr * xi + P64.li * xr + cu[i].y; xr = nr; xi = ni; } }
          } }
        const float* cre = a.in[9] + ((size_t)((l * 2 + d) * 32 + g) * 16 + oh) * 64; const float* cim = a.in[10] + ((size_t)((l * 2 + d) * 32 + g) * 16 + oh) * 64;
#pragma unroll 1
        for (int sb = 0; sb < 4; ++sb) {
            for (int tt = 0; tt < 16; ++tt) {
                const int ts = sb * 16 + tt, t = d ? 63 - ts : ts;
                float ar = 0.f, ai = 0.f;
#pragma unroll
                for (int q = 0; q < 4; ++q) { const f32x4 u4 = *((const LAS f32x4*)(us + t * 16) + q);
#pragma unroll
                    for (int e = 0; e < 4; ++e) { ar += br[q * 4 + e] * u4[e]; ai += bi[q * 4 + e] * u4[e]; } }
                const float nr = P.lr * xr - P.li * xi + ar, ni = P.lr * xi + P.li * xr + ai; xr = nr; xi = ni;
                f32x2 o; o.x = xr; o.y = xi; *((LAS f32x2*)X + tt * 64 + p) = o;
            }
            LDS_WAIT(); asm volatile("" ::: "memory");
            float acc[4] = {0.f, 0.f, 0.f, 0.f};
            for (int pq = 0; pq < 16; ++pq) {
                const f32x4 c4r = *((const f32x4*)cre + pq), c4i = *((const f32x4*)cim + pq);
#pragma unroll
                for (int i = 0; i < 4; ++i) {
                    const LAS f32x4* xp = (const LAS f32x4*)(X + ((otq * 4 + i) * 64 + pq * 4) * 2);
                    const f32x4 xa = xp[0], xb = xp[1];
                    acc[i] += c4r[0] * xa[0] - c4i[0] * xa[1] + c4r[1] * xa[2] - c4i[1] * xa[3] + c4r[2] * xb[0] - c4i[2] * xb[1] + c4r[3] * xb[2] - c4i[3] * xb[3];
                }
            }
#pragma unroll
            for (int i = 0; i < 4; ++i) { const int ts = sb * 16 + otq * 4 + i, t = d ? 63 - ts : ts; yb[t * 16 + oh] += acc[i]; }
            LDS_WAIT(); asm volatile("" ::: "memory");
        }
    }
    const float* dsk = a.in[11] + (l * 32 + g) * 16;
    unsigned w[8];
#pragma unroll
    for (int h = 0; h < 16; h += 2) {
        const float y0 = gelu_tanh(yb[lane * 16 + h] + dsk[h] * us[lane * 16 + h]), y1 = gelu_tanh(yb[lane * 16 + h + 1] + dsk[h + 1] * us[lane * 16 + h + 1]);
        w[h >> 1] = pk2(y0, y1);
    }
    u32x4* dst = (u32x4*)((bf16_t*)(ws + WS_YGELU) + (size_t)(b * SEQ + c * 64 + lane) * 512 + g * 16);
    dst[0] = (u32x4){w[0], w[1], w[2], w[3]}; dst[1] = (u32x4){w[4], w[5], w[6], w[7]};
    LDS_WAIT(); asm volatile("" ::: "memory");
}

__device__ __forceinline__ void s5_tables(const Ctx& C, const AP& a) {
    unsigned char* ws = a.ws;
    f32x4* LAMT = (f32x4*)(ws + WS_S5T); bf16_t* BBop = (bf16_t*)(ws + WS_S5T + 131072); bf16_t* CBop = (bf16_t*)(ws + WS_S5T + 131072 + 1048576);
    for (int it = C.bx * NTHR + C.tid; it < 128 * 64; it += C.G * NTHR) {
        const int p = it & 63, ldg = it >> 6, g = ldg & 31, d = (ldg >> 5) & 1, l = ldg >> 6;
        const S5P P = s5_params(a, l, d, g, p, 1.f), P64 = s5_params(a, l, d, g, p, 64.f);
        LAMT[it] = (f32x4){P.lr, P.li, P64.lr, P64.li};
    }
    for (int it = C.bx * NTHR + C.tid; it < 128 * 8 * 64; it += C.G * NTHR) {
        const int lane = it & 63, nt = (it >> 6) & 7, ldg = it >> 9, g = ldg & 31, d = (ldg >> 5) & 1, l = ldg >> 6, fr = lane & 15, fq = lane >> 4;
        const int col = nt * 16 + fr, p = col >> 1, ri = col & 1;
        unsigned w[4] = {0u, 0u, 0u, 0u};
        if (fq < 2) {
            const S5P P = s5_params(a, l, d, g, p, 1.f);
            const float* bre = a.in[7] + ((size_t)ldg * 64 + p) * 16 + fq * 8; const float* bim = a.in[8] + ((size_t)ldg * 64 + p) * 16 + fq * 8;
            float v[8];
#pragma unroll
            for (int jj = 0; jj < 8; ++jj) v[jj] = ri ? (P.cr * bim[jj] + P.ci * bre[jj]) : (P.cr * bre[jj] - P.ci * bim[jj]);
            w[0] = pk2(v[0], v[1]); w[1] = pk2(v[2], v[3]); w[2] = pk2(v[4], v[5]); w[3] = pk2(v[6], v[7]);
        }
        *(u32x4*)(BBop + (size_t)it * 8) = (u32x4){w[0], w[1], w[2], w[3]};
    }
    for (int it = C.bx * NTHR + C.tid; it < 128 * 4 * 64; it += C.G * NTHR) {
        const int lane = it & 63, s2 = (it >> 6) & 3, ldg = it >> 8, fr = lane & 15, fq = lane >> 4;
        const float* cre = a.in[9] + ((size_t)ldg * 16 + fr) * 64 + 16 * s2 + fq * 4; const float* cim = a.in[10] + ((size_t)ldg * 16 + fr) * 64 + 16 * s2 + fq * 4;
        *(u32x4*)(CBop + (size_t)it * 8) = (u32x4){pk2(cre[0], -cim[0]), pk2(cre[1], -cim[1]), pk2(cre[2], -cim[2]), pk2(cre[3], -cim[3])};
    }
}
__device__ __forceinline__ void s5_load_u(const float* ur, LAS unsigned char* wl, int lane) {
    const f32x4 u0 = *((const f32x4*)ur + 0), u1 = *((const f32x4*)ur + 1), u2 = *((const f32x4*)ur + 2), u3 = *((const f32x4*)ur + 3);
    LAS u32x4* dst = (LAS u32x4*)(wl + lane * 32);
    dst[0] = (u32x4){pk2(u0.x, u0.y), pk2(u0.z, u0.w), pk2(u1.x, u1.y), pk2(u1.z, u1.w)}; dst[1] = (u32x4){pk2(u2.x, u2.y), pk2(u2.z, u2.w), pk2(u3.x, u3.y), pk2(u3.z, u3.w)};
}
__device__ __forceinline__ void s5_build_bb(const AP& a, int ldg, float cr, float ci, int lane, LAS unsigned char* wl, bf16x8_t (&bb)[8]) {
    const int fr = lane & 15, fq = lane >> 4;
    LAS f32x2* cf = (LAS f32x2*)(wl + 14848);
    f32x2 me; me.x = cr; me.y = ci; cf[lane] = me;
    LDS_WAIT(); asm volatile("" ::: "memory");
#pragma unroll
    for (int nt = 0; nt < 8; ++nt) {
        const int col = nt * 16 + fr, p = col >> 1, ri = col & 1;
        unsigned w_[4] = {0u, 0u, 0u, 0u};
        if (fq < 2) {
            const f32x2 c2 = cf[p];
            const f32x4* bre = (const f32x4*)(a.in[7] + ((size_t)ldg * 64 + p) * 16 + fq * 8); const f32x4* bim = (const f32x4*)(a.in[8] + ((size_t)ldg * 64 + p) * 16 + fq * 8);
            const f32x4 r0 = bre[0], r1 = bre[1], i0 = bim[0], i1 = bim[1];
            float v[8];
#pragma unroll
            for (int jj = 0; jj < 4; ++jj) { v[jj] = ri ? (c2.x * i0[jj] + c2.y * r0[jj]) : (c2.x * r0[jj] - c2.y * i0[jj]); v[4 + jj] = ri ? (c2.x * i1[jj] + c2.y * r1[jj]) : (c2.x * r1[jj] - c2.y * i1[jj]); }
            w_[0] = pk2(v[0], v[1]); w_[1] = pk2(v[2], v[3]); w_[2] = pk2(v[4], v[5]); w_[3] = pk2(v[6], v[7]);
        }
        bb[nt] = mk8(w_[0], w_[1], w_[2], w_[3]);
        asm volatile("" ::: "memory");
    }
}
template <bool FINAL>
__device__ __forceinline__ void s5_subblock(LAS unsigned char* wl, const bf16x8_t (&bb)[8], int d, int sb, int lane, float lr, float li, float& xr, float& xi) {
    const int fr = lane & 15, fq = lane >> 4;
    LAS float* BUs = (LAS float*)(wl + 2048); LAS bf16_t* Xb = (LAS bf16_t*)(wl + 10496);
    const int trow = d ? 63 - (sb * 16 + fr) : sb * 16 + fr;
    bf16x8_t aU = mk8(0u, 0u, 0u, 0u);
    if (fq < 2) aU = *(const LAS bf16x8_t*)(wl + trow * 32 + fq * 16);
    const f32x4 z4 = {0.f, 0.f, 0.f, 0.f};
#pragma unroll
    for (int nt = 0; nt < 8; ++nt) { const f32x4 bu = __builtin_amdgcn_mfma_f32_16x16x32_bf16(aU, bb[nt], z4, 0, 0, 0);
#pragma unroll
        for (int r = 0; r < 4; ++r) BUs[(fq * 4 + r) * 132 + nt * 16 + fr] = bu[r]; }
    LDS_WAIT(); asm volatile("" ::: "memory");
#pragma unroll
    for (int tt = 0; tt < 16; ++tt) {
        const f32x2 bq = *(const LAS f32x2*)(BUs + tt * 132 + 2 * lane);
        const float nr = lr * xr - li * xi + bq.x, ni = lr * xi + li * xr + bq.y; xr = nr; xi = ni;
        if (FINAL) *(LAS unsigned*)(Xb + (d ? 15 - tt : tt) * 136 + 2 * lane) = pk2(xr, xi);
    }
    LDS_WAIT(); asm volatile("" ::: "memory");
}
__device__ __forceinline__ void s5_ends_item_m(const AP& a, int l, int item, int lane, LAS unsigned char* wl) {
    unsigned char* ws = a.ws;
    const int c = item & 31, g = (item >> 5) & 31, b = item >> 10;
    s5_load_u((const float*)(ws + WS_PROJ) + ((size_t)(b * SEQ + c * 64 + lane)) * PROJ + 512 + g * 16, wl, lane);
    LDS_WAIT(); asm volatile("" ::: "memory");
#pragma unroll 1
    for (int d = 0; d < 2; ++d) {
        const int ldg = (l * 2 + d) * 32 + g;
        const S5P Pq = s5_params(a, l, d, g, lane, 1.f);
        const f32x4 lam = {Pq.lr, Pq.li, 0.f, 0.f};
        bf16x8_t bb[8]; s5_build_bb(a, ldg, Pq.cr, Pq.ci, lane, wl, bb);
        float xr = 0.f, xi = 0.f;
#pragma unroll 1
        for (int sb = 0; sb < 4; ++sb) s5_subblock<false>(wl, bb, d, sb, lane, lam[0], lam[1], xr, xi);
        f32x2 o; o.x = xr; o.y = xi;
        ((f32x2*)(ws + WS_S5E))[((size_t)((b * 32 + g) * 2 + d) * 32 + c) * 64 + lane] = o;
    }
}
__device__ __forceinline__ void s5_final_item_m(const AP& a, int l, int item, int lane, LAS unsigned char* wl) {
    unsigned char* ws = a.ws;
    const int c = item & 31, g = (item >> 5) & 31, b = item >> 10, fr = lane & 15, fq = lane >> 4;
    const float* ubase = (const float*)(ws + WS_PROJ) + ((size_t)(b * SEQ + c * 64)) * PROJ + 512 + g * 16;
    s5_load_u(ubase + (size_t)lane * PROJ, wl, lane);
    LDS_WAIT(); asm volatile("" ::: "memory");
    LAS bf16_t* Xb = (LAS bf16_t*)(wl + 10496);
    f32x4 yacc[4];
#pragma unroll
    for (int q = 0; q < 4; ++q) yacc[q] = (f32x4){0.f, 0.f, 0.f, 0.f};
#pragma unroll 1
    for (int d = 0; d < 2; ++d) {
        const int ldg = (l * 2 + d) * 32 + g;
        const S5P Pq = s5_params(a, l, d, g, lane, 1.f), P64 = s5_params(a, l, d, g, lane, 64.f);
        const f32x4 lam = {Pq.lr, Pq.li, P64.lr, P64.li};
        bf16x8_t bb[8], cb[4]; s5_build_bb(a, ldg, Pq.cr, Pq.ci, lane, wl, bb);
#pragma unroll
        for (int s2 = 0; s2 < 4; ++s2) {
            const f32x4 cr4 = *(const f32x4*)(a.in[9] + ((size_t)ldg * 16 + fr) * 64 + 16 * s2 + fq * 4), ci4 = *(const f32x4*)(a.in[10] + ((size_t)ldg * 16 + fr) * 64 + 16 * s2 + fq * 4);
            cb[s2] = mk8(pk2(cr4[0], -ci4[0]), pk2(cr4[1], -ci4[1]), pk2(cr4[2], -ci4[2]), pk2(cr4[3], -ci4[3])); }
        const f32x2* E = (const f32x2*)(ws + WS_S5E) + ((size_t)((b * 32 + g) * 2 + d) * 32) * 64 + lane;
        float xr = 0.f, xi = 0.f;
        { f32x2 nx[4];
#pragma unroll
          for (int i = 0; i < 4; ++i) nx[i] = E[(d ? 31 - i : i) * 64];
#pragma unroll 1
          for (int grp = 0; grp < 8; ++grp) {
              if (d ? (31 - grp * 4 <= c) : (grp * 4 >= c)) break;
              f32x2 cu[4];
#pragma unroll
              for (int i = 0; i < 4; ++i) cu[i] = nx[i];
              if (grp < 7) {
#pragma unroll
                  for (int i = 0; i < 4; ++i) nx[i] = E[(d ? 27 - grp * 4 - i : grp * 4 + 4 + i) * 64];
              }
#pragma unroll
              for (int i = 0; i < 4; ++i) { const int cc = d ? 31 - grp * 4 - i : grp * 4 + i;
                  if (d ? (cc > c) : (cc < c)) { const float nr = lam[2] * xr - lam[3] * xi + cu[i].x, ni = lam[2] * xi + lam[3] * xr + cu[i].y; xr = nr; xi = ni; } }
          } }
#pragma unroll
        for (int sb = 0; sb < 4; ++sb) {
            s5_subblock<true>(wl, bb, d, sb, lane, lam[0], lam[1], xr, xi);
            f32x4 acc = d ? yacc[3 - sb] : yacc[sb];
#pragma unroll
            for (int s2 = 0; s2 < 4; ++s2) acc = __builtin_amdgcn_mfma_f32_16x16x32_bf16(*(const LAS bf16x8_t*)(Xb + fr * 136 + s2 * 32 + fq * 8), cb[s2], acc, 0, 0, 0);
            if (d) yacc[3 - sb] = acc; else yacc[sb] = acc;
            LDS_WAIT(); asm volatile("" ::: "memory");
        }
    }
    const float dsk = a.in[11][(l * 32 + g) * 16 + fr];
#pragma unroll
    for (int q = 0; q < 4; ++q)
#pragma unroll
        for (int r = 0; r < 4; ++r) { const int t = q * 16 + fq * 4 + r;
            const float y = gelu_tanh(yacc[q][r] + dsk * ubase[(size_t)t * PROJ + fr]);
            ((bf16_t*)(ws + WS_YGELU))[(size_t)(b * SEQ + c * 64 + t) * 512 + g * 16 + fr] = (bf16_t)f2bf(y); }
}
__device__ __forceinline__ float gelu_tanh_fast(float x) { const float u2 = 1.5957691216057308f * (x + 0.044715f * x * x * x); return x / (1.f + __expf(-u2)); }
__device__ __forceinline__ void s5_final_item_h(const AP& a, int l, int item, int lane, LAS unsigned char* wl) {
    unsigned char* ws = a.ws;
    const int c = item & 31, g = (item >> 5) & 31, b = item >> 10, p = lane, fr = lane & 15, fq = lane >> 4;
    LAS float* us = (LAS float*)wl; LAS bf16_t* Xb = (LAS bf16_t*)(wl + 4096);
    { const u32x4* ur = (const u32x4*)((const bf16_t*)(ws + WS_PROJ) + ((size_t)(b * SEQ + c * 64 + lane)) * 1536 + g * 16);
      const u32x4 r0 = ur[0], r1 = ur[1];
#pragma unroll
      for (int q = 0; q < 4; ++q) { const unsigned wa = q < 2 ? r0[2 * q] : r1[2 * q - 4], wb = q < 2 ? r0[2 * q + 1] : r1[2 * q - 3];
          *((LAS f32x4*)(us + lane * 16) + q) = (f32x4){bflo(wa), bfhi(wa), bflo(wb), bfhi(wb)}; } }
    LDS_WAIT(); asm volatile("" ::: "memory");
    f32x4 yacc[4];
#pragma unroll
    for (int q = 0; q < 4; ++q) yacc[q] = (f32x4){0.f, 0.f, 0.f, 0.f};
#pragma unroll 1
    for (int d = 0; d < 2; ++d) {
        const int ldg = (l * 2 + d) * 32 + g;
        const S5P P = s5_params(a, l, d, g, p, 1.f), P64 = s5_params(a, l, d, g, p, 64.f);
        f32x2 bb2[16];
        const float* bre = a.in[7] + ((size_t)ldg * 64 + p) * 16; const float* bim = a.in[8] + ((size_t)ldg * 64 + p) * 16;
#pragma unroll
        for (int h = 0; h < 16; ++h) { const float x = bre[h], y = bim[h]; bb2[h].x = P.cr * x - P.ci * y; bb2[h].y = P.cr * y + P.ci * x; }
        const f32x2 lam2 = {P.lr, P.lr}, lami = {-P.li, P.li};
        bf16x8_t cb[4];
#pragma unroll
        for (int s2 = 0; s2 < 4; ++s2) {
            const f32x4 cr4 = *(const f32x4*)(a.in[9] + ((size_t)ldg * 16 + fr) * 64 + 16 * s2 + fq * 4), ci4 = *(const f32x4*)(a.in[10] + ((size_t)ldg * 16 + fr) * 64 + 16 * s2 + fq * 4);
            cb[s2] = mk8(pk2(cr4[0], -ci4[0]), pk2(cr4[1], -ci4[1]), pk2(cr4[2], -ci4[2]), pk2(cr4[3], -ci4[3])); }
        const f32x2* E = (const f32x2*)(ws + WS_S5E) + ((size_t)((b * 32 + g) * 2 + d) * 32) * 64 + p;
        float xr = 0.f, xi = 0.f;
        { f32x2 nx[4];
#pragma unroll
          for (int i = 0; i < 4; ++i) nx[i] = E[(d ? 31 - i : i) * 64];
#pragma unroll 1
          for (int grp = 0; grp < 8; ++grp) {
              if (d ? (31 - grp * 4 <= c) : (grp * 4 >= c)) break;
              f32x2 cu[4];
#pragma unroll
              for (int i = 0; i < 4; ++i) cu[i] = nx[i];
              if (grp < 7) {
#pragma unroll
                  for (int i = 0; i < 4; ++i) nx[i] = E[(d ? 27 - grp * 4 - i : grp * 4 + 4 + i) * 64];
              }
#pragma unroll
              for (int i = 0; i < 4; ++i) { const int cc = d ? 31 - grp * 4 - i : grp * 4 + i;
                  if (d ? (cc > c) : (cc < c)) { const float nr = P64.lr * xr - P64.li * xi + cu[i].x, ni = P64.lr * xi + P64.li * xr + cu[i].y; xr = nr; xi = ni; } }
          } }
#pragma unroll
        for (int sb = 0; sb < 4; ++sb) {
#pragma unroll 4
            for (int tt = 0; tt < 16; ++tt) {
                const int ts = sb * 16 + tt, t = d ? 63 - ts : ts;
                f32x2 acc2 = {0.f, 0.f};
#pragma unroll
                for (int q = 0; q < 4; ++q) { const f32x4 u4 = *((const LAS f32x4*)(us + t * 16) + q);
#pragma unroll
                    for (int e = 0; e < 4; ++e) acc2 += bb2[q * 4 + e] * u4[e]; }
                { const f32x2 x2 = {xr, xi}, xs = {xi, xr}; const f32x2 n2 = lam2 * x2 + lami * xs + acc2; xr = n2.x; xi = n2.y; }
                *(LAS unsigned*)(Xb + (d ? 15 - tt : tt) * 136 + 2 * p) = pg8::cvt_pk_bf16(xr, xi);
            }
            LDS_WAIT(); asm volatile("" ::: "memory");
            f32x4 acc = d ? yacc[3 - sb] : yacc[sb];
#pragma unroll
            for (int s2 = 0; s2 < 4; ++s2) acc = __builtin_amdgcn_mfma_f32_16x16x32_bf16(*(const LAS bf16x8_t*)(Xb + fr * 136 + s2 * 32 + fq * 8), cb[s2], acc, 0, 0, 0);
            if (d) yacc[3 - sb] = acc; else yacc[sb] = acc;
            LDS_WAIT(); asm volatile("" ::: "memory");
        }
    }
    const float dsk = a.in[11][(l * 32 + g) * 16 + fr];
#pragma unroll
    for (int q = 0; q < 4; ++q)
#pragma unroll
        for (int r = 0; r < 4; ++r) { const int t = q * 16 + fq * 4 + r;
            const float y = gelu_tanh_fast(yacc[q][r] + dsk * us[t * 16 + fr]);
            ((bf16_t*)(ws + WS_YGELU))[(size_t)(b * SEQ + c * 64 + t) * 512 + g * 16 + fr] = (bf16_t)f2bf(y); }
    LDS_WAIT(); asm volatile("" ::: "memory");
}
__device__ __forceinline__ float shift3(float p, float c, float n, float m0, float m1) { return c + (p - c) * m0 + (n - c) * m1; }
__device__ __forceinline__ float dpp_ror4(float x) { return __builtin_bit_cast(float, __builtin_amdgcn_update_dpp(0, __builtin_bit_cast(int, x), 0x124, 0xF, 0xF, true)); }
__device__ __forceinline__ float dpp_ror8(float x) { return __builtin_bit_cast(float, __builtin_amdgcn_update_dpp(0, __builtin_bit_cast(int, x), 0x128, 0xF, 0xF, true)); }
__device__ __forceinline__ float dpp_q1(float x) { return __builtin_bit_cast(float, __builtin_amdgcn_update_dpp(0, __builtin_bit_cast(int, x), 0xB1, 0xF, 0xF, true)); }
__device__ __forceinline__ float dpp_q2(float x) { return __builtin_bit_cast(float, __builtin_amdgcn_update_dpp(0, __builtin_bit_cast(int, x), 0x4E, 0xF, 0xF, true)); }
__device__ __forceinline__ float row_sum16(float x) { x += dpp_q1(x); x += dpp_q2(x); x += dpp_ror4(x); x += dpp_ror8(x); return x; }
__device__ __forceinline__ void rwkv_prep_item(const Ctx& C, const AP& a, int l, int ti) {
    unsigned char* ws = a.ws;
    LAS bf16_t* zsb = (LAS bf16_t*)C.lds;
    LAS bf16_t* hidb = (LAS bf16_t*)(C.lds + 33280);
    const float* proj = (const float*)(ws + WS_PROJ);
    const int m0 = ti * 32, s0 = m0 & (SEQ - 1), tid = C.tid, lane = C.lane, w = C.wave;
    const float* mu = a.in[15] + (size_t)l * 4 * 2 * 512;
    float* RW = (float*)(ws + WS_RW); float* KS = (float*)(ws + WS_KS);
    {
        int c = tid; asm volatile("" : "+v"(c));
        const float mr0 = mu[0 * 512 + c], mr1 = mu[1 * 512 + c], mk0 = mu[2 * 512 + c], mk1 = mu[3 * 512 + c], mv0 = mu[4 * 512 + c], mv1 = mu[5 * 512 + c], mz0 = mu[6 * 512 + c], mz1 = mu[7 * 512 + c];
        const float kk_c = a.in[24][l * 512 + c];
#pragma unroll 1
        for (int hf = 0; hf < 2; ++hf) {
            const int tb0 = hf * 16;
            const unsigned short* rp = (const unsigned short*)(ws + WS_PRB) + (size_t)(m0 + tb0) * 2048 + c;
            float rr[18], kr[18], vr[18], zr[18];
#pragma unroll
            for (int i = 0; i < 18; ++i) {
                const int sq = s0 + tb0 - 1 + i; const bool ok = (sq >= 0) && (sq < SEQ); const unsigned short* q = rp + (i - 1) * 2048;
                rr[i] = ok ? __uint_as_float((unsigned)q[0] << 16) : 0.f; kr[i] = ok ? __uint_as_float((unsigned)q[512] << 16) : 0.f;
                vr[i] = ok ? __uint_as_float((unsigned)q[1024] << 16) : 0.f; zr[i] = ok ? __uint_as_float((unsigned)q[1536] << 16) : 0.f;
            }
#pragma unroll
            for (int t = 0; t < 16; ++t) {
                const float rs = shift3(rr[t], rr[t + 1], rr[t + 2], mr0, mr1), ks = shift3(kr[t], kr[t + 1], kr[t + 2], mk0, mk1);
                const float vs = shift3(vr[t], vr[t + 1], vr[t + 2], mv0, mv1), zs = shift3(zr[t], zr[t + 1], zr[t + 2], mz0, mz1);
                const float kkr = ks * kk_c; const float kkn = kkr * rsqrtf(wave_sum(kkr * kkr) + 1e-12f);
                const size_t o = (size_t)(m0 + tb0 + t) * 512 + c;
                RW[(size_t)RW_R * RWSZ + o] = rs; RW[(size_t)RW_V * RWSZ + o] = vs; RW[(size_t)RW_KK * RWSZ + o] = kkn; KS[o] = ks;
                zsb[(tb0 + t) * 520 + c] = (bf16_t)f2bf(zs);
            }
        }
    }
    __syncthreads();
    const int fr = lane & 15, fq = lane >> 4;
    const bf16_t* W1T = (const bf16_t*)(ws + WS_LORA) + (size_t)l * 224 * 512; const bf16_t* g2T = (const bf16_t*)(ws + WS_LORA) + 2 * 224 * 512 + (size_t)l * 512 * 96;
    const bf16_t* w2T = (const bf16_t*)(ws + WS_LORA) + 2 * 224 * 512 + 2 * 512 * 96 + (size_t)l * 2 * 512 * 32; const bf16_t* a2T = w2T + 2 * 2 * 512 * 32;
    for (int tile = w; tile < 28; tile += 8) {
        const int mt = tile / 14, nt = tile % 14;
        f32x4 acc = {0.f, 0.f, 0.f, 0.f};
        const LAS bf16_t* ap = zsb + (mt * 16 + fr) * 520 + fq * 8; const bf16_t* bp = W1T + (size_t)(nt * 16 + fr) * 512 + fq * 8;
#pragma unroll
        for (int kk = 0; kk < 16; ++kk) acc = __builtin_amdgcn_mfma_f32_16x16x32_bf16(*(const LAS bf16x8_t*)(ap + kk * 32), *(const bf16x8_t*)(bp + kk * 32), acc, 0, 0, 0);
        const int hj = nt * 16 + fr;
#pragma unroll
        for (int j = 0; j < 4; ++j) { float v = acc[j]; if (hj < 96) v = sigmoidf_(v); else if (hj < 160) v = tanh_fast(v); hidb[(mt * 16 + fq * 4 + j) * 240 + hj] = (bf16_t)f2bf(v); }
    }
    __syncthreads();
#pragma unroll 1
    for (int mt = 0; mt < 2; ++mt) {
        bf16x8_t a7[7];
#pragma unroll
        for (int kk = 0; kk < 7; ++kk) a7[kk] = *(const LAS bf16x8_t*)(hidb + (mt * 16 + fr) * 240 + kk * 32 + fq * 8);
        float pb0[4] = {0.f, 0.f, 0.f, 0.f}, pb1[4] = {0.f, 0.f, 0.f, 0.f}, vsr[4][4];
        float cks[4], ckk[4], crs[4], nks[4], nkk[4], nrs[4];
#pragma unroll
        for (int j = 0; j < 4; ++j) { const size_t o = (size_t)(m0 + mt * 16 + fq * 4 + j) * 512 + w * 64 + fr;
            cks[j] = KS[o]; ckk[j] = RW[(size_t)RW_KK * RWSZ + o]; crs[j] = RW[(size_t)RW_R * RWSZ + o]; vsr[0][j] = RW[(size_t)RW_V * RWSZ + o]; }
#pragma unroll
        for (int nt = 0; nt < 4; ++nt) {
            if (nt < 3) {
#pragma unroll
                for (int j = 0; j < 4; ++j) { const size_t o = (size_t)(m0 + mt * 16 + fq * 4 + j) * 512 + w * 64 + (nt + 1) * 16 + fr;
                    nks[j] = KS[o]; nkk[j] = RW[(size_t)RW_KK * RWSZ + o]; nrs[j] = RW[(size_t)RW_R * RWSZ + o]; vsr[nt + 1][j] = RW[(size_t)RW_V * RWSZ + o]; }
            }
            const int ch = w * 64 + nt * 16 + fr;
            f32x4 ag = {0.f, 0.f, 0.f, 0.f}, aw0 = ag, aw1 = ag, aa0 = ag, aa1 = ag;
#pragma unroll
            for (int kk = 0; kk < 3; ++kk) ag = __builtin_amdgcn_mfma_f32_16x16x32_bf16(a7[kk], *(const bf16x8_t*)(g2T + (size_t)ch * 96 + kk * 32 + fq * 8), ag, 0, 0, 0);
            aw0 = __builtin_amdgcn_mfma_f32_16x16x32_bf16(a7[3], *(const bf16x8_t*)(w2T + (size_t)(0 * 512 + ch) * 32 + fq * 8), aw0, 0, 0, 0);
            aw1 = __builtin_amdgcn_mfma_f32_16x16x32_bf16(a7[4], *(const bf16x8_t*)(w2T + (size_t)(1 * 512 + ch) * 32 + fq * 8), aw1, 0, 0, 0);
            aa0 = __builtin_amdgcn_mfma_f32_16x16x32_bf16(a7[5], *(const bf16x8_t*)(a2T + (size_t)(0 * 512 + ch) * 32 + fq * 8), aa0, 0, 0, 0);
            aa1 = __builtin_amdgcn_mfma_f32_16x16x32_bf16(a7[6], *(const bf16x8_t*)(a2T + (size_t)(1 * 512 + ch) * 32 + fq * 8), aa1, 0, 0, 0);
            const float w00 = a.in[16][(l * 2 + 0) * 512 + ch], w01 = a.in[16][(l * 2 + 1) * 512 + ch], a00 = a.in[19][(l * 2 + 0) * 512 + ch], a01 = a.in[19][(l * 2 + 1) * 512 + ch];
            const float ka_c = a.in[25][l * 512 + ch], rk_c = a.in[26][l * 512 + ch];
#pragma unroll
            for (int j = 0; j < 4; ++j) {
                const size_t o = (size_t)(m0 + mt * 16 + fq * 4 + j) * 512 + ch;
                const float ks = cks[j], kkn = ckk[j], rs = crs[j];
#pragma unroll
                for (int d = 0; d < 2; ++d) {
                    const float wl = (d ? w01 : w00) + (d ? aw1[j] : aw0[j]);
                    const float decay = __expf(-0.6065306597126334f * sigmoidf_(wl));
                    const float av = sigmoidf_((d ? a01 : a00) + (d ? aa1[j] : aa0[j]));
                    const float kd = ks * (1.f + (av - 1.f) * ka_c), bb = kkn * av;
                    if (d) pb1[j] += rs * kd * rk_c; else pb0[j] += rs * kd * rk_c;
                    RW[(size_t)(RW_W0 + d) * RWSZ + o] = decay; RW[(size_t)(RW_KD0 + d) * RWSZ + o] = kd; RW[(size_t)(RW_B0 + d) * RWSZ + o] = bb;
                }
                RW[(size_t)RW_G * RWSZ + o] = ag[j];
            }
#pragma unroll
            for (int j = 0; j < 4; ++j) { cks[j] = nks[j]; ckk[j] = nkk[j]; crs[j] = nrs[j]; }
        }
#pragma unroll
        for (int j = 0; j < 4; ++j) { const float tb = row_sum16(pb0[j]) + row_sum16(pb1[j]);
#pragma unroll
            for (int nt = 0; nt < 4; ++nt) RW[(size_t)RW_BONUS * RWSZ + (size_t)(m0 + mt * 16 + fq * 4 + j) * 512 + w * 64 + nt * 16 + fr] = tb * vsr[nt][j]; }
    }
    __syncthreads();
}

__device__ __forceinline__ void rwkv_chunk_pre(const AP& a, int cid, int lane, LAS unsigned char* wl) {
    unsigned char* ws = a.ws;
    const int c = cid & 127, ci = cid >> 7, d = ci & 1, h = (ci >> 1) & 7, b = ci >> 4, fr = lane & 15, fq = lane >> 4;
    const float* RW = (const float*)(ws + WS_RW);
    unsigned char* rec = ws + WS_RWC + (size_t)cid * RWC_REC;
    LAS bf16_t* KH = (LAS bf16_t*)wl; LAS bf16_t* BC = KH + 1152; LAS bf16_t* KC = BC + 1152; LAS bf16_t* RH = KC + 1152;
    LAS bf16_t* KHT = RH + 1152;
    LAS float* Am = (LAS float*)(wl + 11264); LAS float* Bmm = Am + 256; LAS float* Abm = Bmm + 256; LAS float* Akm = Abm + 256; LAS float* Tm = Akm + 256;
    const size_t tok0 = (size_t)b * SEQ; const int colk = h * 64 + lane;
#define TOKI(i) (tok0 + (size_t)(d ? (SEQ - 1 - (c * 16 + (i))) : (c * 16 + (i))))
    {
        float W[16];
#pragma unroll
        for (int i = 0; i < 16; ++i) W[i] = RW[(size_t)(RW_W0 + d) * RWSZ + TOKI(i) * 512 + colk];
#pragma unroll
        for (int i = 1; i < 16; ++i) W[i] *= W[i - 1];
        const float W15 = W[15];
        unsigned zt[16];
#pragma unroll
        for (int i = 0; i < 16; ++i) {
            const size_t o = TOKI(i) * 512 + colk;
            const float kap = RW[(size_t)RW_KK * RWSZ + o], bv = RW[(size_t)(RW_B0 + d) * RWSZ + o], kdv = RW[(size_t)(RW_KD0 + d) * RWSZ + o], rv = RW[(size_t)RW_R * RWSZ + o];
            const float wm1 = i ? W[i - 1] : 1.f, iw = 1.f / W[i], wr = W15 * iw;
            const unsigned kh = f2bf(kap * wm1);
            KH[i * 72 + lane] = (bf16_t)kh; KHT[lane * 16 + i] = (bf16_t)kh;
            BC[i * 72 + lane] = (bf16_t)f2bf(bv * iw); KC[i * 72 + lane] = (bf16_t)f2bf(kdv * iw); RH[i * 72 + lane] = (bf16_t)f2bf(rv * W[i]);
            const unsigned bb = f2bf(bv * wr), kb = f2bf(kdv * wr);
            const int sb = (i >> 2) * 8 + (i & 3), sk = sb + 4;
            if (sb & 1) zt[sb >> 1] |= bb << 16; else zt[sb >> 1] = bb;
            if (sk & 1) zt[sk >> 1] |= kb << 16; else zt[sk >> 1] = kb;
        }
        u32x4* zp = (u32x4*)(rec + 4096 + lane * 64);
#pragma unroll
        for (int q = 0; q < 4; ++q) zp[q] = (u32x4){zt[q * 4], zt[q * 4 + 1], zt[q * 4 + 2], zt[q * 4 + 3]};
        ((float*)(rec + 8192))[lane] = W15;
    }
    float Vq[4][4];
#pragma unroll
    for (int nt = 0; nt < 4; ++nt) {
#pragma unroll
        for (int r = 0; r < 4; ++r) Vq[nt][r] = RW[(size_t)RW_V * RWSZ + TOKI(fq * 4 + r) * 512 + h * 64 + nt * 16 + fr];
        u32x2 pv; pv.x = pk2(Vq[nt][0], Vq[nt][1]); pv.y = pk2(Vq[nt][2], Vq[nt][3]);
        *(u32x2*)(rec + 12800 + (nt * 64 + lane) * 8) = pv;
    }
    LDS_WAIT(); asm volatile("" ::: "memory");
    {
        f32x4 cA = {0.f, 0.f, 0.f, 0.f}, cB = cA, cAb = cA, cAk = cA;
#pragma unroll
        for (int s2 = 0; s2 < 2; ++s2) {
            const int off = fr * 72 + s2 * 32 + fq * 8;
            const bf16x8_t fkh = *(const LAS bf16x8_t*)(KH + off), fbc = *(const LAS bf16x8_t*)(BC + off), fkc = *(const LAS bf16x8_t*)(KC + off), frh = *(const LAS bf16x8_t*)(RH + off);
            cA = __builtin_amdgcn_mfma_f32_16x16x32_bf16(fkh, fbc, cA, 0, 0, 0); cB = __builtin_amdgcn_mfma_f32_16x16x32_bf16(fkh, fkc, cB, 0, 0, 0);
            cAb = __builtin_amdgcn_mfma_f32_16x16x32_bf16(frh, fbc, cAb, 0, 0, 0); cAk = __builtin_amdgcn_mfma_f32_16x16x32_bf16(frh, fkc, cAk, 0, 0, 0);
        }
#pragma unroll
        for (int r = 0; r < 4; ++r) { const int i = fq * 4 + r, j = fr;
            Am[i * 16 + j] = j < i ? cA[r] : 0.f; Bmm[i * 16 + j] = j < i ? cB[r] : 0.f; Abm[i * 16 + j] = j <= i ? cAb[r] : 0.f; Akm[i * 16 + j] = j <= i ? cAk[r] : 0.f; }
    }
    LDS_WAIT(); asm volatile("" ::: "memory");
    {
        float x[16];
#pragma unroll
        for (int i = 0; i < 16; ++i) {
            float sacc = (i == fr) ? 1.f : 0.f;
#pragma unroll
            for (int jq = 0; jq < (i + 3) / 4; ++jq) { const f32x4 q = *(const LAS f32x4*)(Am + i * 16 + jq * 4);
#pragma unroll
                for (int e = 0; e < 4; ++e) if (jq * 4 + e < i) sacc -= q[e] * x[jq * 4 + e]; }
            x[i] = sacc;
        }
        if (fq == 0) {
#pragma unroll
            for (int i = 0; i < 16; ++i) Tm[i * 16 + fr] = x[i];
        }
    }
    LDS_WAIT(); asm volatile("" ::: "memory");
    {
        const f32x4 qT = *(const LAS f32x4*)(Tm + fr * 16 + fq * 4), qB = *(const LAS f32x4*)(Bmm + fr * 16 + fq * 4), qAb = *(const LAS f32x4*)(Abm + fr * 16 + fq * 4), qAk = *(const LAS f32x4*)(Akm + fr * 16 + fq * 4);
        const unsigned ab0 = pk2(qAb[0], qAb[1]), ab1 = pk2(qAb[2], qAb[3]);
        const bf16x8_t aT = mk8(pk2(qT[0], qT[1]), pk2(qT[2], qT[3]), 0u, 0u), aBm = mk8(pk2(qB[0], qB[1]), pk2(qB[2], qB[3]), 0u, 0u);
        const bf16x8_t aAb = mk8(ab0, ab1, 0u, 0u), aAbAk = mk8(ab0, ab1, pk2(qAk[0], qAk[1]), pk2(qAk[2], qAk[3]));
        const f32x4 z4 = {0.f, 0.f, 0.f, 0.f};
#pragma unroll
        for (int nt = 0; nt < 4; ++nt) {
            const u32x2 kq = *(const LAS u32x2*)(KHT + (nt * 16 + fr) * 16 + fq * 4);
            f32x4 ut = __builtin_amdgcn_mfma_f32_16x16x32_bf16(aT, mk8(kq.x, kq.y, 0u, 0u), z4, 0, 0, 0); ut = -ut;
            const unsigned v0 = pk2(Vq[nt][0], Vq[nt][1]), v1 = pk2(Vq[nt][2], Vq[nt][3]);
            const f32x4 bmv = __builtin_amdgcn_mfma_f32_16x16x32_bf16(aBm, mk8(v0, v1, 0u, 0u), z4, 0, 0, 0);
            f32x4 ul = __builtin_amdgcn_mfma_f32_16x16x32_bf16(aT, mk8(pk2(bmv[0], bmv[1]), pk2(bmv[2], bmv[3]), 0u, 0u), z4, 0, 0, 0); ul = -ul;
            const unsigned u0 = pk2(ut[0], ut[1]), u1 = pk2(ut[2], ut[3]);
            f32x4 yh = __builtin_amdgcn_mfma_f32_16x16x32_bf16(aAb, mk8(u0, u1, 0u, 0u), z4, 0, 0, 0);
#pragma unroll
            for (int r = 0; r < 4; ++r) yh[r] += bflo((unsigned)RH[(fq * 4 + r) * 72 + nt * 16 + fr]);
            const unsigned l0 = pk2(ul[0], ul[1]), l1 = pk2(ul[2], ul[3]);
            const f32x4 yl = __builtin_amdgcn_mfma_f32_16x16x32_bf16(aAbAk, mk8(l0, l1, v0, v1), z4, 0, 0, 0);
            const int s2 = nt >> 1, slot = (fr >> 2) * 8 + (fr & 3) + ((nt & 1) ? 4 : 0);
            bf16_t* m0p = (bf16_t*)rec + ((0 * 2 + s2) * 16) * 32 + slot; bf16_t* m1p = (bf16_t*)rec + ((1 * 2 + s2) * 16) * 32 + slot;
#pragma unroll
            for (int r = 0; r < 4; ++r) { m0p[(fq * 4 + r) * 32] = (bf16_t)((r & 1) ? (((r >> 1) ? u1 : u0) >> 16) : (((r >> 1) ? u1 : u0) & 0xffffu)); m1p[(fq * 4 + r) * 32] = (bf16_t)f2bf(yh[r]); }
            u32x2 pl; pl.x = l0; pl.y = l1; *(u32x2*)(rec + 8704 + (nt * 64 + lane) * 8) = pl;
            u32x2 py; py.x = pk2(yl[0], yl[1]); py.y = pk2(yl[2], yl[3]); *(u32x2*)(rec + 10752 + (nt * 64 + lane) * 8) = py;
        }
    }
    LDS_WAIT(); asm volatile("" ::: "memory");
#undef TOKI
}
__device__ __forceinline__ void vm_wait_chunks(int n) {
    switch (n) { case 0: asm volatile("s_waitcnt vmcnt(0)" ::: "memory"); break; case 1: asm volatile("s_waitcnt vmcnt(4)" ::: "memory"); break;
                 case 2: asm volatile("s_waitcnt vmcnt(8)" ::: "memory"); break; case 3: asm volatile("s_waitcnt vmcnt(12)" ::: "memory"); break;
                 case 4: asm volatile("s_waitcnt vmcnt(16)" ::: "memory"); break; case 5: asm volatile("s_waitcnt vmcnt(20)" ::: "memory"); break;
                 default: asm volatile("s_waitcnt vmcnt(24)" ::: "memory"); break; }
}
__device__ __forceinline__ void rwkv_seq_chain(const Ctx& C, const AP& a, int ci) {
    unsigned char* ws = a.ws;
    const int w = C.wave, lane = C.lane, fr = lane & 15, fq = lane >> 4, d = ci & 1, h = (ci >> 1) & 7, b = ci >> 4;
    const unsigned char* recs = ws + WS_RWC + (size_t)ci * 128 * RWC_REC;
    LAS unsigned char* ring = C.lds;
    const bool loader = w >= 4; const int lw = w - 4;
#define RWC_ISSUE(cc) do { _Pragma("unroll") for (int p_ = 0; p_ < 4; ++p_) { const int pc_ = (lw * 4 + p_) < 15 ? (lw * 4 + p_) : 14; \
        __builtin_amdgcn_global_load_lds((const unsigned*)(recs + (size_t)(cc) * RWC_REC + pc_ * 1024 + lane * 16), (LAS unsigned*)(ring + ((cc) & 7) * RWC_REC + pc_ * 1024), 16, 0, 0); } } while (0)
    if (loader) {
#pragma unroll 1
        for (int cc = 0; cc < 8; ++cc) RWC_ISSUE(cc);
        asm volatile("s_waitcnt vmcnt(28)" ::: "memory");
    }
    __builtin_amdgcn_s_barrier(); asm volatile("" ::: "memory");
    f32x4 ST[4];
#pragma unroll
    for (int kt = 0; kt < 4; ++kt) ST[kt] = (f32x4){0.f, 0.f, 0.f, 0.f};
    float* Y = (float*)(ws + WS_YRW) + (size_t)d * RWSZ + (size_t)b * SEQ * 512 + h * 64 + w * 16 + fr;
#pragma unroll 1
    for (int c = 0; c < 128; ++c) {
        if (!loader) {
            const LAS unsigned char* sl = ring + (c & 7) * RWC_REC;
            const bf16x8_t a00 = *(const LAS bf16x8_t*)(sl + (0 * 16 + fr) * 64 + fq * 16), a01 = *(const LAS bf16x8_t*)(sl + (1 * 16 + fr) * 64 + fq * 16);
            const bf16x8_t a10 = *(const LAS bf16x8_t*)(sl + (2 * 16 + fr) * 64 + fq * 16), a11 = *(const LAS bf16x8_t*)(sl + (3 * 16 + fr) * 64 + fq * 16);
            const u32x2 ulw = *(const LAS u32x2*)(sl + 8704 + (w * 64 + lane) * 8), ylw = *(const LAS u32x2*)(sl + 10752 + (w * 64 + lane) * 8), vpw = *(const LAS u32x2*)(sl + 12800 + (w * 64 + lane) * 8);
            const bf16x8_t bs0 = mk8(pk2(ST[0][0], ST[0][1]), pk2(ST[0][2], ST[0][3]), pk2(ST[1][0], ST[1][1]), pk2(ST[1][2], ST[1][3]));
            const bf16x8_t bs1 = mk8(pk2(ST[2][0], ST[2][1]), pk2(ST[2][2], ST[2][3]), pk2(ST[3][0], ST[3][1]), pk2(ST[3][2], ST[3][3]));
            const f32x4 z4 = {0.f, 0.f, 0.f, 0.f};
            f32x4 g0 = __builtin_amdgcn_mfma_f32_16x16x32_bf16(a00, bs0, z4, 0, 0, 0); g0 = __builtin_amdgcn_mfma_f32_16x16x32_bf16(a01, bs1, g0, 0, 0, 0);
            f32x4 g1 = __builtin_amdgcn_mfma_f32_16x16x32_bf16(a10, bs0, z4, 0, 0, 0); g1 = __builtin_amdgcn_mfma_f32_16x16x32_bf16(a11, bs1, g1, 0, 0, 0);
            const float uf0 = g0[0] + bflo(ulw.x), uf1 = g0[1] + bfhi(ulw.x), uf2 = g0[2] + bflo(ulw.y), uf3 = g0[3] + bfhi(ulw.y);
            const bf16x8_t xb = mk8(pk2(uf0, uf1), pk2(uf2, uf3), vpw.x, vpw.y);
#pragma unroll
            for (int kt = 0; kt < 4; ++kt) {
                const f32x4 dq = *(const LAS f32x4*)(sl + 8192 + (kt * 16 + fq * 4) * 4);
                const bf16x8_t az = *(const LAS bf16x8_t*)(sl + 4096 + (kt * 16 + fr) * 64 + fq * 16);
                ST[kt] = __builtin_amdgcn_mfma_f32_16x16x32_bf16(az, xb, ST[kt] * dq, 0, 0, 0);
            }
            const float y0 = g1[0] + bflo(ylw.x), y1 = g1[1] + bfhi(ylw.x), y2 = g1[2] + bflo(ylw.y), y3 = g1[3] + bfhi(ylw.y);
            const int sbase = c * 16 + fq * 4;
            Y[(size_t)(d ? SEQ - 1 - (sbase + 0) : sbase + 0) * 512] = y0; Y[(size_t)(d ? SEQ - 1 - (sbase + 1) : sbase + 1) * 512] = y1;
            Y[(size_t)(d ? SEQ - 1 - (sbase + 2) : sbase + 2) * 512] = y2; Y[(size_t)(d ? SEQ - 1 - (sbase + 3) : sbase + 3) * 512] = y3;
            asm volatile("s_waitcnt lgkmcnt(0)" ::: "memory");
        } else if (c + 1 < 128) {
            const int lastc = (c + 7 < 127) ? c + 7 : 127;
            vm_wait_chunks(lastc - (c + 1));
        }
        __builtin_amdgcn_s_barrier(); asm volatile("" ::: "memory");
        if (loader && c + 8 < 128) RWC_ISSUE(c + 8);
    }
    asm volatile("s_waitcnt vmcnt(0)" ::: "memory");
    __builtin_amdgcn_s_barrier(); asm volatile("" ::: "memory");
#undef RWC_ISSUE
}

__device__ __forceinline__ float dpp_sum8(float x) {
    x += __builtin_bit_cast(float, __builtin_amdgcn_update_dpp(0, __builtin_bit_cast(int, x), 0xB1, 0xF, 0xF, true));
    x += __builtin_bit_cast(float, __builtin_amdgcn_update_dpp(0, __builtin_bit_cast(int, x), 0x4E, 0xF, 0xF, true));
    x += __builtin_bit_cast(float, __builtin_amdgcn_update_dpp(0, __builtin_bit_cast(int, x), 0x141, 0xF, 0xF, true));
    return x;
}
__device__ __forceinline__ void rwkv_scan_item(const Ctx& C, const AP& a, int item) {
    unsigned char* ws = a.ws;
    const int d = item & 1, h = (item >> 1) & 7, b = item >> 4, tid = C.tid, v = tid >> 3, kq = tid & 7;
    const float* RW = (const float*)(ws + WS_RW);
    const float* arr[6] = { RW + (size_t)RW_KK * RWSZ, RW + (size_t)(RW_W0 + d) * RWSZ, RW + (size_t)(RW_B0 + d) * RWSZ, RW + (size_t)(RW_KD0 + d) * RWSZ, RW + (size_t)RW_R * RWSZ, RW + (size_t)RW_V * RWSZ };
    float* Y = (float*)(ws + WS_YRW) + (size_t)d * RWSZ;
    LAS float* buf = (LAS float*)C.lds;
    const int ls = tid >> 4, lq = tid & 15;
    f32x4 stg[6];
    const size_t colbase = (size_t)h * 64;
#define RW_LOAD(ch) do { const int s_ = (ch) * 32 + ls, t_ = d ? (SEQ - 1 - s_) : s_; const size_t o_ = ((size_t)(b * SEQ + t_)) * 512 + colbase + lq * 4; \
        _Pragma("unroll") for (int q_ = 0; q_ < 6; ++q_) stg[q_] = *(const f32x4*)(arr[q_] + o_); } while (0)
#define RW_WRITE(bi) do { _Pragma("unroll") for (int q_ = 0; q_ < 6; ++q_) *(LAS f32x4*)(buf + (((bi) * 6 + q_) * 32 + ls) * 64 + lq * 4) = stg[q_]; } while (0)
    float S[8];
#pragma unroll
    for (int j = 0; j < 8; ++j) S[j] = 0.f;
    RW_LOAD(0); RW_WRITE(0); __syncthreads();
    for (int ch = 0; ch < SEQ / 32; ++ch) {
        const int bi = ch & 1;
        if (ch + 1 < SEQ / 32) RW_LOAD(ch + 1);
        const LAS float* B0 = buf + (bi * 6) * 32 * 64;
        for (int st = 0; st < 32; ++st) {
            const LAS float* bp = B0 + st * 64 + kq * 8;
            const f32x4 k0 = *(const LAS f32x4*)(bp), k1 = *(const LAS f32x4*)(bp + 4);
            const f32x4 w0 = *(const LAS f32x4*)(bp + 2048), w1 = *(const LAS f32x4*)(bp + 2048 + 4);
            const f32x4 b0 = *(const LAS f32x4*)(bp + 4096), b1 = *(const LAS f32x4*)(bp + 4096 + 4);
            const f32x4 d0 = *(const LAS f32x4*)(bp + 6144), d1 = *(const LAS f32x4*)(bp + 6144 + 4);
            const f32x4 r0 = *(const LAS f32x4*)(bp + 8192), r1 = *(const LAS f32x4*)(bp + 8192 + 4);
            const float vv = B0[10240 + st * 64 + v];
            float sa = S[0] * k0[0] + S[1] * k0[1] + S[2] * k0[2] + S[3] * k0[3] + S[4] * k1[0] + S[5] * k1[1] + S[6] * k1[2] + S[7] * k1[3];
            sa = -dpp_sum8(sa);
            float y = 0.f;
#pragma unroll
            for (int j = 0; j < 4; ++j) { S[j] = S[j] * w0[j] + (sa * b0[j] + vv * d0[j]); y += S[j] * r0[j]; S[4 + j] = S[4 + j] * w1[j] + (sa * b1[j] + vv * d1[j]); y += S[4 + j] * r1[j]; }
            y = dpp_sum8(y);
            if (kq == 0) { const int s_ = ch * 32 + st, t_ = d ? (SEQ - 1 - s_) : s_; Y[((size_t)(b * SEQ + t_)) * 512 + colbase + v] = y; }
        }
        if (ch + 1 < SEQ / 32) RW_WRITE(bi ^ 1);
        __syncthreads();
    }
#undef RW_LOAD
#undef RW_WRITE
}
__device__ __forceinline__ void rwkv_post_item(const AP& a, int l, int item, int lane) {
    unsigned char* ws = a.ws;
    const int hh = item & 7, m = item >> 3, c = hh * 64 + lane; const size_t o = (size_t)m * 512 + c;
    const float* Y = (const float*)(ws + WS_YRW); const float* RW = (const float*)(ws + WS_RW);
    const float y = Y[o] + Y[RWSZ + o];
    const float mean = wave_sum(y) * (1.f / 64.f), dv = y - mean, var = wave_sum(dv * dv) * (1.f / 64.f);
    const float yn = dv * rsqrtf(var + 64e-5f) * a.in[27][l * 512 + c] + a.in[28][l * 512 + c];
    ((float*)(ws + WS_YA))[(size_t)3 * RWSZ + o] = (yn + RW[(size_t)RW_BONUS * RWSZ + o]) * RW[(size_t)RW_G * RWSZ + o];
}
__device__ __forceinline__ void c1_fold_item(const AP& a, int row, int lane) {
    const unsigned short* src = (const unsigned short*)(a.ws + WS_C1) + (size_t)row * 4096;
    unsigned short* dst = (unsigned short*)(a.ws + WS_C1F) + (size_t)row * 2048;
#pragma unroll 8
    for (int i = 0; i < 32; ++i) {
        const int j = i * 64 + lane; float v;
        if (j <= 1024) { const float x0 = __uint_as_float((unsigned)src[j] << 16); const int jm = (j >= 1 && j <= 1023) ? 2048 - j : j;
            const float x1 = __uint_as_float((unsigned)src[jm] << 16); v = (j >= 1 && j <= 1023) ? x0 + x1 : x0; }
        else { const int sidx = j - 1024; v = __uint_as_float((unsigned)src[2048 + sidx] << 16) - __uint_as_float((unsigned)src[2048 + 2048 - sidx] << 16); }
        dst[j] = (unsigned short)f2bf(v);
    }
}
__device__ __forceinline__ void branch_d_item(const AP& a, int l, int m, int lane) {
    unsigned char* ws = a.ws;
    const float* Y = (const float*)(ws + WS_YRW); const float* RW = (const float*)(ws + WS_RW);
    float o[8]; float ss = 0.f;
#pragma unroll
    for (int hh = 0; hh < 8; ++hh) {
        const int c = hh * 64 + lane; const size_t ix = (size_t)m * 512 + c;
        const float y = Y[ix] + Y[RWSZ + ix];
        const float mean = wave_sum(y) * (1.f / 64.f), dv = y - mean, var = wave_sum(dv * dv) * (1.f / 64.f);
        const float yn = dv * rsqrtf(var + 64e-5f) * a.in[27][l * 512 + c] + a.in[28][l * 512 + c];
        o[hh] = (yn + RW[(size_t)RW_BONUS * RWSZ + ix]) * RW[(size_t)RW_G * RWSZ + ix]; ss += o[hh] * o[hh];
    }
    const float rs = rsqrtf(wave_sum(ss) * (1.f / 512.f) + 1e-6f);
    bf16_t* dst = (bf16_t*)(ws + WS_HB) + (size_t)m * DM + 1536 + lane;
#pragma unroll
    for (int hh = 0; hh < 8; ++hh) dst[hh * 64] = (bf16_t)f2bf(o[hh] * rs);
}
__device__ __forceinline__ void branch_norm_item(const AP& a, int item, int lane) {
    unsigned char* ws = a.ws;
    const int br = item & 3, m = item >> 2;
    const f32x4* src = (const f32x4*)((const float*)(ws + WS_YA) + (size_t)br * RWSZ + (size_t)m * 512) + lane;
    const f32x4 v0 = src[0], v1 = src[64];
    const float ss = wave_sum(v0.x * v0.x + v0.y * v0.y + v0.z * v0.z + v0.w * v0.w + v1.x * v1.x + v1.y * v1.y + v1.z * v1.z + v1.w * v1.w);
    const float rs = rsqrtf(ss * (1.f / 512.f) + 1e-6f);
    u32x2* dst = (u32x2*)((bf16_t*)(ws + WS_HB) + (size_t)m * DM + br * 512) + lane;
    u32x2 w; w.x = pk2(v0.x * rs, v0.y * rs); w.y = pk2(v0.z * rs, v0.w * rs); dst[0] = w;
    w.x = pk2(v1.x * rs, v1.y * rs); w.y = pk2(v1.z * rs, v1.w * rs); dst[64] = w;
}

__device__ __forceinline__ unsigned fkey(float f) { const unsigned u = __float_as_uint(f); return (u & 0x80000000u) ? ~u : (u | 0x80000000u); }
__device__ __forceinline__ int lane_rank(unsigned long long m) { return __builtin_amdgcn_mbcnt_hi((unsigned)(m >> 32), __builtin_amdgcn_mbcnt_lo((unsigned)m, 0)); }
template <int N>
__device__ __forceinline__ void top16_select(const float (&val)[N], const int (&idx)[N], LAS float* lv, LAS int* li) {
    unsigned k[N];
#pragma unroll
    for (int e = 0; e < N; ++e) k[e] = fkey(val[e]);
    unsigned T = 0;
    for (int bit = 31; bit >= 0; --bit) {
        const unsigned cand = T | (1u << bit); int cnt = 0;
#pragma unroll
        for (int e = 0; e < N; ++e) cnt += __popcll(__ballot(k[e] >= cand));
        if (cnt >= 16) T = cand;
        if (cnt == 16) break;
    }
    int ngt = 0;
#pragma unroll
    for (int e = 0; e < N; ++e) ngt += __popcll(__ballot(k[e] > T));
    const int need = 16 - ngt; int eqbase = 0, posbase = 0;
#pragma unroll
    for (int e = 0; e < N; ++e) {
        const unsigned long long meq = __ballot(k[e] == T);
        const int eqrank = eqbase + lane_rank(meq);
        const bool sel = (k[e] > T) || (k[e] == T && eqrank < need);
        const unsigned long long msel = __ballot(sel);
        const int pos = posbase + lane_rank(msel);
        if (sel) { lv[pos] = val[e]; li[pos] = idx[e]; }
        eqbase += __popcll(meq); posbase += __popcll(msel);
    }
    LDS_WAIT(); asm volatile("" ::: "memory");
}
__device__ __forceinline__ float dpp_xor1(float x) { return __builtin_bit_cast(float, __builtin_amdgcn_update_dpp(0, __builtin_bit_cast(int, x), 0xB1, 0xF, 0xF, true)); }
__device__ __forceinline__ float dpp_xor2(float x) { return __builtin_bit_cast(float, __builtin_amdgcn_update_dpp(0, __builtin_bit_cast(int, x), 0x4E, 0xF, 0xF, true)); }
__device__ __forceinline__ float reduce8(const float (&v)[8], int lane) {
    const bool b0 = lane & 1, b1 = lane & 2, b2 = lane & 4;
    float w4[4], w2[2];
#pragma unroll
    for (int k = 0; k < 4; ++k) { const float keep = b0 ? v[4 + k] : v[k], send = b0 ? v[k] : v[4 + k]; w4[k] = keep + dpp_xor1(send); }
#pragma unroll
    for (int k = 0; k < 2; ++k) { const float keep = b1 ? w4[2 + k] : w4[k], send = b1 ? w4[k] : w4[2 + k]; w2[k] = keep + dpp_xor2(send); }
    const float keep = b2 ? w2[1] : w2[0], send = b2 ? w2[0] : w2[1];
    float r = keep + __shfl_xor(send, 4);
    r += __shfl_xor(r, 8); r += __shfl_xor(r, 16); r += __shfl_xor(r, 32);
    return r;
}
typedef float f32x2v __attribute__((ext_vector_type(2)));
__device__ __forceinline__ void peer_select_head(const f32x2 s0, const f32x2 s1, int lane, LAS float* wl, LAS int* fe, LAS float* fg, int cpk, int, bool cand_on) {
    int cpo = cpk; asm volatile("" : "+v"(cpo));
    const int ci_i = cpo >> 4, ci_j = cpo & 15;
    { const float v0[2] = {s0.x, s0.y}; const int i0[2] = {2 * lane, 2 * lane + 1}; top16_select<2>(v0, i0, wl, (LAS int*)(wl + 16)); }
    { const float v1[2] = {s1.x, s1.y}; const int i1[2] = {2 * lane, 2 * lane + 1}; top16_select<2>(v1, i1, wl + 32, (LAS int*)(wl + 48)); }
    if (lane < 32) { const int lst = lane >> 4, ii = lane & 15; const LAS float* lv = wl + lst * 32;
      const float v = lv[ii]; const int ix = ((const LAS int*)lv)[16 + ii]; int rank = 0;
#pragma unroll
      for (int jq = 0; jq < 4; ++jq) { const f32x4 q = *(const LAS f32x4*)(lv + jq * 4);
#pragma unroll
          for (int e = 0; e < 4; ++e) rank += (q[e] > v || (q[e] == v && (jq * 4 + e) < ii)) ? 1 : 0; }
      wl[64 + lst * 32 + rank] = v; ((LAS int*)wl)[64 + lst * 32 + 16 + rank] = ix; }
    LDS_WAIT(); asm volatile("" ::: "memory");
    { const float cvv = cand_on ? wl[64 + ci_i] + wl[96 + ci_j] : -INFINITY;
      const float cv[1] = {cvv}; const int ci[1] = {ci_i * 16 + ci_j};
      top16_select<1>(cv, ci, wl + 128, (LAS int*)(wl + 144)); }
    { const bool act = lane < 16; const float sc = act ? wl[128 + lane] : -3.0e38f; const int fi = act ? ((LAS int*)wl)[144 + lane] : 0;
      const int e = ((LAS int*)wl)[80 + (fi >> 4)] * 128 + ((LAS int*)wl)[112 + (fi & 15)];
      const float mx = wave_max(sc), ex = act ? __expf(sc - mx) : 0.f, sm = wave_sum(ex);
      if (act) { fe[lane] = e; fg[lane] = ex / sm; } }
    LDS_WAIT(); asm volatile("" ::: "memory");
}
__device__ __forceinline__ void peer_tile(const Ctx& C, const AP& a, int l, int tile, const float* x1, float* xout, bool write_hb) {
    unsigned char* ws = a.ws;
    const int tid = C.tid, lane = C.lane, w = C.wave, tb = tile * 32;
    LAS float* keys = (LAS float*)C.lds;
    LAS int* rt_idx = (LAS int*)(C.lds + 65536);
    LAS float* rt_gate = (LAS float*)(C.lds + 81920);
    LAS float* wl = (LAS float*)(C.lds + 98304) + w * 256;
    LAS float* ssp = (LAS float*)(C.lds + 98304 + 8 * 1024);
    const float* qry = (const float*)(ws + WS_PROJ);
    int ci_i, ci_j; const bool cand_on = lane < 50;
    if (lane < 16) { ci_i = 0; ci_j = lane; } else if (lane < 24) { ci_i = 1; ci_j = lane - 16; } else if (lane < 29) { ci_i = 2; ci_j = lane - 24; }
    else if (lane < 33) { ci_i = 3; ci_j = lane - 29; } else if (lane < 36) { ci_i = 4; ci_j = lane - 33; } else if (lane < 38) { ci_i = 5; ci_j = lane - 36; }
    else if (lane < 40) { ci_i = 6; ci_j = lane - 38; } else if (lane < 42) { ci_i = 7; ci_j = lane - 40; } else if (lane < 50) { ci_i = lane - 34; ci_j = 0; } else { ci_i = 0; ci_j = 0; }
    float* Ssc = (float*)(ws + WS_RW) + (size_t)tile * 65536;
    { const int fr = lane & 15, fq = lane >> 4;
      LAS bf16_t* qbuf = (LAS bf16_t*)C.lds;
      const int prow = tid >> 4, pcol = (tid & 15) * 8;
#define PEER_QSTAGE(h_) do { const float* qp_ = qry + (size_t)(tb + prow) * 1024 + (h_) * 128 + pcol; bf16x8_t qh_, ql_; split8(*(const f32x4*)qp_, *(const f32x4*)(qp_ + 4), qh_, ql_); \
          LAS bf16_t* d_ = qbuf + ((h_) & 1) * 8704 + prow * 136 + pcol; *(LAS bf16x8_t*)d_ = qh_; *(LAS bf16x8_t*)(d_ + 4352) = ql_; } while (0)
      PEER_QSTAGE(0);
      bf16x8_t kraw[2][2][2];
#define PEER_KLOAD(h_) _Pragma("unroll") for (int pp = 0; pp < 2; ++pp) _Pragma("unroll") for (int ks = 0; ks < 2; ++ks) { \
          const bf16_t* kp = (const bf16_t*)(ws + WS_KEYST) + ((size_t)(((l * 8 + (h_)) * 2 + pp) * 128 + 16 * w + fr)) * 64 + ks * 32 + fq * 8; kraw[pp][ks][0] = *(const bf16x8_t*)kp; kraw[pp][ks][1] = *(const bf16x8_t*)(kp + 262144); }
      PEER_KLOAD(0)
      __syncthreads();
#pragma unroll 1
      for (int h = 0; h < 8; ++h) {
        if (h + 1 < 8) PEER_QSTAGE(h + 1);
        const LAS bf16_t* qh = qbuf + (h & 1) * 8704; const LAS bf16_t* ql = qh + 4352;
        bf16x8_t bhh[2][2], bll[2][2];
#pragma unroll
        for (int pp = 0; pp < 2; ++pp)
#pragma unroll
            for (int ks = 0; ks < 2; ++ks) { bhh[pp][ks] = kraw[pp][ks][0]; bll[pp][ks] = kraw[pp][ks][1]; }
        if (h + 1 < 8) { PEER_KLOAD(h + 1) }
#pragma unroll
        for (int pp = 0; pp < 2; ++pp) {
            const int hp = h * 2 + pp;
            bf16x8_t bh[2], bl[2];
#pragma unroll
            for (int ks = 0; ks < 2; ++ks) { bh[ks] = bhh[pp][ks]; bl[ks] = bll[pp][ks]; }
#pragma unroll
            for (int mt = 0; mt < 2; ++mt) { f32x4 acc = {0.f, 0.f, 0.f, 0.f};
#pragma unroll
                for (int ks = 0; ks < 2; ++ks) { const int qo = (mt * 16 + fr) * 136 + pp * 64 + ks * 32 + fq * 8;
                    const bf16x8_t ah = *(const LAS bf16x8_t*)(qh + qo), al = *(const LAS bf16x8_t*)(ql + qo);
                    acc = __builtin_amdgcn_mfma_f32_16x16x32_bf16(al, bh[ks], acc, 0, 0, 0); acc = __builtin_amdgcn_mfma_f32_16x16x32_bf16(ah, bl[ks], acc, 0, 0, 0);
                    acc = __builtin_amdgcn_mfma_f32_16x16x32_bf16(ah, bh[ks], acc, 0, 0, 0); }
#pragma unroll
                for (int r = 0; r < 4; ++r) Ssc[(size_t)(hp * 32 + mt * 16 + fq * 4 + r) * 128 + 16 * w + fr] = acc[r]; }
        }
        __syncthreads();
      }
#undef PEER_QSTAGE
#undef PEER_KLOAD
    }
    __syncthreads();
    const unsigned char* U6 = ws + WS_UB + (size_t)l * ETAB; const unsigned char* V4 = ws + WS_UB + 64 * MiB + (size_t)l * 16 * MiB;
    const float* Us = (const float*)(ws + WS_VB) + (0 * 2 + l) * 16384; const float* Vs = (const float*)(ws + WS_VB) + (1 * 2 + l) * 16384;
    bf16_t* hb = (bf16_t*)(ws + WS_HB);
    u32x4 ua[8]; u32x4 va[8]; float sul, svl, gl; float xf[32], acc[32];
#define PEER_IDS(mye_, ei_) _Pragma("unroll") for (int e = 0; e < 8; ++e) ei_[e] = __builtin_amdgcn_readlane(mye_, ((e >> 2) & 1) | (((e >> 1) & 1) << 1) | ((e & 1) << 2));
#define PEER_ISSUE_U(ei_, ln_) _Pragma("unroll") for (int e = 0; e < 8; ++e) ua[e] = ((const u32x4*)(U6 + (size_t)ei_[e] * 1024))[ln_];
#define PEER_ISSUE_V(ei_, ln_) _Pragma("unroll") for (int e = 0; e < 8; ++e) va[e] = ((const u32x4*)(V4 + (size_t)ei_[e] * 1024))[ln_];
#define PEER_DOTS(dot_) _Pragma("unroll") for (int e = 0; e < 8; ++e) { f32x2v s2 = {0.f, 0.f}; \
        _Pragma("unroll") for (int d4 = 0; d4 < 4; ++d4) { const unsigned wd = ua[e][d4]; \
            s2 = __builtin_elementwise_fma((f32x2v){xf[8 * d4 + 0], xf[8 * d4 + 1]}, __builtin_amdgcn_cvt_scalef32_pk_f32_fp4(wd, 1.0f, 0), s2); \
            s2 = __builtin_elementwise_fma((f32x2v){xf[8 * d4 + 2], xf[8 * d4 + 3]}, __builtin_amdgcn_cvt_scalef32_pk_f32_fp4(wd, 1.0f, 1), s2); \
            s2 = __builtin_elementwise_fma((f32x2v){xf[8 * d4 + 4], xf[8 * d4 + 5]}, __builtin_amdgcn_cvt_scalef32_pk_f32_fp4(wd, 1.0f, 2), s2); \
            s2 = __builtin_elementwise_fma((f32x2v){xf[8 * d4 + 6], xf[8 * d4 + 7]}, __builtin_amdgcn_cvt_scalef32_pk_f32_fp4(wd, 1.0f, 3), s2); } \
        dot_[e] = s2.x + s2.y; }
#define PEER_ACCUM(cfl_) _Pragma("unroll") for (int e = 0; e < 8; ++e) { \
        const int src = ((e >> 2) & 1) | (((e >> 1) & 1) << 1) | ((e & 1) << 2); \
        const float cf = __builtin_bit_cast(float, __builtin_amdgcn_readlane(__builtin_bit_cast(int, cfl_), src)); \
        _Pragma("unroll") for (int d4 = 0; d4 < 4; ++d4) { const unsigned wd = va[e][d4]; \
            const f32x2v p0 = __builtin_amdgcn_cvt_scalef32_pk_f32_fp4(wd, 1.0f, 0), p1 = __builtin_amdgcn_cvt_scalef32_pk_f32_fp4(wd, 1.0f, 1); \
            const f32x2v p2 = __builtin_amdgcn_cvt_scalef32_pk_f32_fp4(wd, 1.0f, 2), p3 = __builtin_amdgcn_cvt_scalef32_pk_f32_fp4(wd, 1.0f, 3); \
            acc[8 * d4 + 0] += cf * p0.x; acc[8 * d4 + 1] += cf * p0.y; acc[8 * d4 + 2] += cf * p1.x; acc[8 * d4 + 3] += cf * p1.y; \
            acc[8 * d4 + 4] += cf * p2.x; acc[8 * d4 + 5] += cf * p2.y; acc[8 * d4 + 6] += cf * p3.x; acc[8 * d4 + 7] += cf * p3.y; } \
        if (e < 7) {   \
            asm volatile("" : "+v"(va[e + 1][0]), "+v"(va[e + 1][1]) : "v"(acc[0]), "v"(acc[1]), "v"(acc[2]), "v"(acc[3]), "v"(acc[4]), "v"(acc[5]), "v"(acc[6]), "v"(acc[7]), \
                         "v"(acc[8]), "v"(acc[9]), "v"(acc[10]), "v"(acc[11]), "v"(acc[12]), "v"(acc[13]), "v"(acc[14]), "v"(acc[15])); \
            asm volatile("" : "+v"(va[e + 1][2]), "+v"(va[e + 1][3]) : "v"(acc[16]), "v"(acc[17]), "v"(acc[18]), "v"(acc[19]), "v"(acc[20]), "v"(acc[21]), "v"(acc[22]), "v"(acc[23]), \
                         "v"(acc[24]), "v"(acc[25]), "v"(acc[26]), "v"(acc[27]), "v"(acc[28]), "v"(acc[29]), "v"(acc[30]), "v"(acc[31])); } }
    {
        const int tokl = w * 4;
        peer_select_head(*(const f32x2*)(Ssc + (size_t)(0 * 32 + tokl) * 128 + 2 * lane), *(const f32x2*)(Ssc + (size_t)(1 * 32 + tokl) * 128 + 2 * lane), lane, wl, (LAS int*)(wl + 160), wl + 176, ci_i * 16 + ci_j, 0, cand_on);
        int ln = lane; asm volatile("" : "+v"(ln)); const int el1 = ((ln >> 2) & 1) | (((ln >> 1) & 1) << 1) | ((ln & 1) << 2);
        const int mye = ((LAS int*)(wl + 160))[el1]; int ei[8]; PEER_IDS(mye, ei) PEER_ISSUE_U(ei, ln) PEER_ISSUE_V(ei, ln)
        sul = Us[mye]; svl = Vs[mye]; gl = (wl + 176)[el1];
    }
#pragma unroll 1
    for (int hh = 0; hh < 32; ++hh) {
        const int h = hh & 7, tokl = w * 4 + (hh >> 3), tok = tb + tokl;
        LAS int* fe = (LAS int*)(wl + 160 + (hh & 1) * 32); LAS float* fg = wl + 176 + (hh & 1) * 32;
        if (h == 0) {
            const u32x2* xp = (const u32x2*)(hb + (size_t)tok * DM) + lane;
#pragma unroll
            for (int j = 0; j < 8; ++j) { const u32x2 xw = xp[64 * j]; xf[j * 4 + 0] = bflo(xw.x); xf[j * 4 + 1] = bfhi(xw.x); xf[j * 4 + 2] = bflo(xw.y); xf[j * 4 + 3] = bfhi(xw.y); }
#pragma unroll
            for (int i = 0; i < 32; ++i) acc[i] = 0.f;
        }
        {
            float dot[8]; PEER_DOTS(dot)
            int ln = lane; asm volatile("" : "+v"(ln)); const int el1 = ((ln >> 2) & 1) | (((ln >> 1) & 1) << 1) | ((ln & 1) << 2);
            const int mye = fe[8 + el1]; int ei[8]; PEER_IDS(mye, ei) PEER_ISSUE_U(ei, ln)
            const float cfl = gl * gelu_erf(reduce8(dot, lane) * sul) * svl;
            PEER_ACCUM(cfl)
            f32x2 ns0 = {0.f, 0.f}, ns1 = {0.f, 0.f};
            if (hh < 31) { const int tk2 = w * 4 + ((hh + 1) >> 3), h2 = (hh + 1) & 7;
                ns0 = *(const f32x2*)(Ssc + (size_t)((h2 * 2 + 0) * 32 + tk2) * 128 + 2 * ln); ns1 = *(const f32x2*)(Ssc + (size_t)((h2 * 2 + 1) * 32 + tk2) * 128 + 2 * ln); }
            PEER_ISSUE_V(ei, ln)
            sul = Us[mye]; svl = Vs[mye]; gl = fg[8 + el1];
            if (hh < 31) peer_select_head(ns0, ns1, lane, wl, (LAS int*)(wl + 160 + ((hh + 1) & 1) * 32), wl + 176 + ((hh + 1) & 1) * 32, ci_i * 16 + ci_j, 0, cand_on);
        }
        {
            float dot[8]; PEER_DOTS(dot)
            int ln = lane; asm volatile("" : "+v"(ln)); const int el1 = ((ln >> 2) & 1) | (((ln >> 1) & 1) << 1) | ((ln & 1) << 2);
            const int nofs = hh < 31 ? ((hh + 1) & 1) * 32 : (hh & 1) * 32 + 8;
            const int mye = ((LAS int*)(wl + 160 + nofs))[el1]; int ei[8]; PEER_IDS(mye, ei) PEER_ISSUE_U(ei, ln)
            const float cfl = gl * gelu_erf(reduce8(dot, lane) * sul) * svl;
            PEER_ACCUM(cfl)
            PEER_ISSUE_V(ei, ln)
            sul = Us[mye]; svl = Vs[mye]; gl = (wl + 176 + nofs)[el1];
        }
        if (h == 7) {
        f32x4 o[8]; float ssq = 0.f;
#pragma unroll
        for (int j = 0; j < 8; ++j) { o[j] = *((const f32x4*)(x1 + (size_t)tok * DM) + 64 * j + lane) + (f32x4){acc[j * 4 + 0], acc[j * 4 + 1], acc[j * 4 + 2], acc[j * 4 + 3]};
            *((f32x4*)(xout + (size_t)tok * DM) + 64 * j + lane) = o[j]; ssq += o[j].x * o[j].x + o[j].y * o[j].y + o[j].z * o[j].z + o[j].w * o[j].w; }
        if (write_hb) {
            const float rs = rsqrtf(wave_sum(ssq) * (1.f / DM) + 1e-6f);
#pragma unroll
            for (int j = 0; j < 8; ++j) { u32x2 pw; pw.x = pk2(o[j].x * rs, o[j].y * rs); pw.y = pk2(o[j].z * rs, o[j].w * rs); *((u32x2*)(hb + (size_t)tok * DM) + 64 * j + lane) = pw; }
        }
        }
    }
#undef PEER_IDS
#undef PEER_ISSUE_U
#undef PEER_ISSUE_V
#undef PEER_DOTS
#undef PEER_ACCUM
    __syncthreads();
}

constexpr int N_PHASES = 19;
template <int PH>
__device__ __forceinline__ void run_phase(unsigned char* lds_raw, const int wave0) {
    if constexpr (PH == 0) { if (PON(9)) { const Ctx C = fresh_ctx_w(lds_raw, wave0); const AP a = fresh_args(); phase_prep(C, a); } }
    else {
            constexpr int l = (PH - 1) / 9, k = (PH - 1) % 9;
            switch (k) {
            case 0: if (PON(0)) {
                const Ctx C = fresh_ctx_w(lds_raw, wave0); const AP a = fresh_args(); unsigned char* ws = a.ws;
                pg8::Gemm g{(const bf16_t*)(ws + WS_HB), (const bf16_t*)(ws + WS_WINT) + (size_t)l * PROJ * DM, DM};
                pg8::Order S; S.init(32, 16, 1, 0, 0, 0, C.G, C.bx);
                pg8::EpiInProj E{(bf16_t*)(ws + WS_PA), (float*)(ws + WS_PROJ), (bf16_t*)(ws + WS_PRB)};
                pg8::gemm_phase(C.lds, g, S, E, C.tid);
            } break;
            case 1: if (PON(1)) {
                int bxo = blockIdx.x; asm volatile("" : "+s"(bxo));
                if (bxo < 128) { const Ctx C = fresh_ctx_w(lds_raw, wave0); const AP a = fresh_args();
                  for (int ti = C.bx; ti < MTOK / 32; ti += C.G) rwkv_prep_item(C, a, l, ti); }
                if (PON(11)) { const Ctx C = fresh_ctx_w(lds_raw, wave0); const AP a = fresh_args(); unsigned char* ws = a.ws;
                  pg8::Gemm g{(const bf16_t*)(ws + WS_WCST) + (size_t)l * 1024 * 512, (const bf16_t*)(ws + WS_PA), 512};
                  pg8::Order S; S.init(4, 32, 1, 0, 0, 0, C.G, C.bx);
                  pg8::EpiC1 E{(bf16_t*)(ws + WS_C1)};
                  pg8::gemm_phase(C.lds, g, S, E, C.tid); }
                __syncthreads();
                if (PON(12)) { const Ctx C = fresh_ctx_w(lds_raw, wave0); const AP a = fresh_args();
                  const int m0 = C.bx < 128 ? C.gw : 2048 + C.gw, m1 = C.bx < 128 ? 3072 : MTOK;
                  for (int m = m0; m < m1; m += 1024) qk_prep_token(a, l, m, C.lane); }
                if (PON(13)) { const Ctx C = fresh_ctx_w(lds_raw, wave0); const AP a = fresh_args();
                  const int i1 = C.bx < 128 ? 1024 : 4096;
                  for (int it = C.gw; it < i1; it += 1024) s5_ends_item(a, l, it, C.lane, (LAS float*)(C.lds + C.wave * 4096)); }
                if (bxo >= 128) { __syncthreads(); const Ctx C = fresh_ctx_w(lds_raw, wave0); const AP a = fresh_args();
                  for (int ti = C.bx; ti < MTOK / 32; ti += C.G) rwkv_prep_item(C, a, l, ti); }
            } break;
            case 2: if (PON(2)) {
                if (PON(17)) { const Ctx C = fresh_ctx_w(lds_raw, wave0); const AP a = fresh_args();
                  volatile LAS int* qs = (volatile LAS int*)(C.lds + LDS_BYTES - 128);
                  unsigned* q0 = (unsigned*)(a.ws + WS_CTL) + 64 + l * 64; unsigned* q1 = q0 + 2;
                  const int order = (C.bx >> 3) & 1; int stage = 0;
#pragma unroll 1
                  for (;;) {
                    __syncthreads();
                    if (C.tid == 0) {
                        int nb = -1;
                        while (stage < 2) {
                            const int q = stage ^ order;
                            const int t = (int)__hip_atomic_fetch_add(q ? q1 : q0, 8u, __ATOMIC_RELAXED, __HIP_MEMORY_SCOPE_AGENT);
                            const int b2 = q ? 4096 + t : t;
                            if (b2 < (q ? 14336 : 4096)) { nb = b2; break; }
                            ++stage;
                        }
                        *qs = nb;
                    }
                    __syncthreads();
                    const int base = *qs; if (base < 0) break;
                    const int it = base + C.wave;
                    if (it < 4096) s5_final_item_h(a, l, it, C.lane, C.lds + C.wave * 16384);
                    else if (it < 12288) rwkv_chunk_pre(a, it - 4096, C.lane, C.lds + C.wave * 16384);
                    else c1_fold_item(a, it - 12288, C.lane);
                  } }
            } break;
            case 3: if (PON(3)) {
                int bx0 = blockIdx.x; asm volatile("" : "+s"(bx0));
                if (bx0 < 64) { const Ctx C = fresh_ctx_w(lds_raw, wave0); const AP a = fresh_args(); rwkv_seq_chain(C, a, C.bx); }
                else if (bx0 < 192) {
                    if (PON(15)) { const Ctx C = fresh_ctx_w(lds_raw, wave0); const AP a = fresh_args(); unsigned char* ws = a.ws;
                      const int au = C.bx - 64;
                      { const int qblk = au & 7, hq = (au >> 3) & 3, b = au >> 5;
                        const bf16_t* Q = (const bf16_t*)(ws + WS_QB) + ((size_t)(b * SEQ + qblk * 256)) * 512 + hq * 128;
                        const bf16_t* Kp = (const bf16_t*)(ws + WS_QB) + (size_t)MTOK * 512 + ((size_t)b * SEQ) * 256 + (hq >> 1) * 128;
                        const bf16_t* Vp = Kp + (size_t)MTOK * 256;
                        float* O = (float*)(ws + WS_YA) + (size_t)2 * RWSZ + ((size_t)(b * SEQ + qblk * 256)) * 512 + hq * 128;
                        att::attn_dense_body<att::bf16>(Q, Kp, Vp, O, SEQ, (char*)C.lds, C.tid);
                      } }
                } else {
                    { const Ctx C = fresh_ctx_w(lds_raw, wave0); const AP a = fresh_args(); unsigned char* ws = a.ws;
                        pg8::Gemm g{(const bf16_t*)(ws + WS_YGELU), (const bf16_t*)(ws + WS_WGLUT) + (size_t)l * 512 * 512, 512};
                        pg8::Order S; S.init(32, 2, 1, 0, 0, 0, 64, C.bx - 192);
                        pg8::EpiGlu E{(const bf16_t*)(ws + WS_YGELU), (float*)(ws + WS_YA) + RWSZ};
                        pg8::gemm_phase(C.lds, g, S, E, C.tid);
                        __syncthreads(); }
                    if (PON(16)) { const Ctx C = fresh_ctx_w(lds_raw, wave0); const AP a = fresh_args(); unsigned char* ws = a.ws;
                      pg8::Gemm g{(const bf16_t*)(ws + WS_DFT), (const bf16_t*)(ws + WS_C1F), 2048};
                      pg8::Order S; S.init(8, 2, 4, 0, 2, 8, 64, C.bx - 192);
                      pg8::EpiF32 E{(float*)(ws + WS_YA), 512};
                      pg8::gemm_phase(C.lds, g, S, E, C.tid); }
                }
            } break;
            case 4: if (PON(4)) {
                const Ctx C = fresh_ctx_w(lds_raw, wave0); const AP a = fresh_args();
                for (int m = C.gw; m < MTOK; m += C.ngw) {
                    branch_norm_item(a, m * 4 + 0, C.lane); branch_norm_item(a, m * 4 + 1, C.lane); branch_norm_item(a, m * 4 + 2, C.lane); branch_d_item(a, l, m, C.lane); }
            } break;
            case 5: if (PON(5)) {
                const Ctx C = fresh_ctx_w(lds_raw, wave0); const AP a = fresh_args(); unsigned char* ws = a.ws;
                const float* xin = l == 0 ? a.in[0] : (const float*)(ws + WS_X2);
                pg8::Gemm g{(const bf16_t*)(ws + WS_HB), (const bf16_t*)(ws + WS_WOUTT) + (size_t)l * DM * DM, DM};
                pg8::Order S; S.init(32, 8, 1, 0, 0, 0, C.G, C.bx);
                pg8::EpiResid E{xin, (float*)(ws + WS_X1), DM};
                pg8::gemm_phase(C.lds, g, S, E, C.tid);
            } break;
            case 6: if (PON(6)) {
                const Ctx C = fresh_ctx_w(lds_raw, wave0); const AP a = fresh_args(); unsigned char* ws = a.ws;
                for (int m = C.gw; m < MTOK; m += C.ngw) rms_row_to_bf16((const float*)(ws + WS_X1) + (size_t)m * DM, (bf16_t*)(ws + WS_HB) + (size_t)m * DM, C.lane);
            } break;
            case 7: if (PON(7)) {
                int bx0 = blockIdx.x; asm volatile("" : "+s"(bx0));
                if (bx0 < 128) {
                    const Ctx C = fresh_ctx_w(lds_raw, wave0); const AP a = fresh_args(); unsigned char* ws = a.ws;
                    pg8::Gemm g{(const bf16_t*)(ws + WS_HB), (const bf16_t*)(ws + WS_WQT) + (size_t)l * 1024 * DM, DM};
                    pg8::Order S; S.init(32, 4, 1, 0, 0, 0, 128, C.bx);
                    pg8::EpiF32 E{(float*)(ws + WS_PROJ), 1024};
                    pg8::gemm_phase(C.lds, g, S, E, C.tid);
                } else {
                    const Ctx C = fresh_ctx_w(lds_raw, wave0); const AP a = fresh_args();
#pragma unroll 1
                    for (int it = (C.bx - 128) * 8 + C.wave; it < 16384; it += 1024) { const int r2 = it * 2; expert_row_item2(a, r2 >> 14, l, r2 & 16383, C.lane); }
                }
            } break;
            case 8: if (PON(8)) {
                const Ctx C = fresh_ctx_w(lds_raw, wave0); const AP a = fresh_args(); unsigned char* ws = a.ws;
                float* xo = l == 0 ? (float*)(ws + WS_X2) : a.out;
                for (int tile = C.bx; tile < MTOK / 32; tile += C.G) peer_tile(C, a, l, tile, (const float*)(ws + WS_X1), xo, l == 0);
            } break;
            default: break;
            }
    }
}
__global__ void __launch_bounds__(NTHR, 2) fwd_kernel(Args a0) {
    extern __shared__ __attribute__((aligned(16))) unsigned char lds_raw[];
    cg::grid_group grid = cg::this_grid();
    const int wave0 = __builtin_amdgcn_readfirstlane((int)threadIdx.x >> 6);
    volatile LAS unsigned* bst = (volatile LAS unsigned*)((LAS unsigned char*)lds_raw + LDS_BYTES - 64);
    if (threadIdx.x < 2) bst[threadIdx.x] = 0u;
    __syncthreads();
    const XcdBarrier xbar = xcd_barrier_post((unsigned*)(a0.ws + WS_CTL) + 4096, bst);
    const int lo = a0.ph_lo, hi = a0.ph_hi;
    if (lo < 0) grid.sync();
#define MK_STEP(PH) if (lo <= (PH) && (PH) < hi) { run_phase<PH>(lds_raw, wave0); \
        if ((((unsigned)PROBE_REP_MASK >> (PH)) & 1u) != 0u) { xcd_barrier(xbar); run_phase<PH>(lds_raw, wave0); } \
        if ((PH) + 1 < hi) xcd_barrier(xbar); }
    MK_STEP(0) MK_STEP(1) MK_STEP(2) MK_STEP(3) MK_STEP(4) MK_STEP(5) MK_STEP(6) MK_STEP(7) MK_STEP(8) MK_STEP(9)
    MK_STEP(10) MK_STEP(11) MK_STEP(12) MK_STEP(13) MK_STEP(14) MK_STEP(15) MK_STEP(16) MK_STEP(17) MK_STEP(18)
#undef MK_STEP
}

extern "C" void kernel_launch(void* const* d_in, const int* in_sizes, int n_in, void* d_out, int out_size, void* d_ws, size_t ws_size, hipStream_t stream) {
    static int grid = 0;
    if (grid == 0) {
        if (n_in != 36 || in_sizes[0] != MTOK * DM || out_size != MTOK * DM || ws_size < WS_END) {
            fprintf(stderr, "kernel_launch: shape mismatch: n_in %d in0 %d out %d ws %zu (need %zu)\n", n_in, n_in > 0 ? in_sizes[0] : -1, out_size, ws_size, (size_t)WS_END); grid = -1; return; }
        int dev = 0, cus = 0, per_cu = 0;
        if (hipGetDevice(&dev) != hipSuccess || hipDeviceGetAttribute(&cus, hipDeviceAttributeMultiprocessorCount, dev) != hipSuccess) { fprintf(stderr, "kernel_launch: device query failed\n"); grid = -1; return; }
        if (hipFuncSetAttribute((const void*)fwd_kernel, hipFuncAttributeMaxDynamicSharedMemorySize, LDS_BYTES) != hipSuccess) { fprintf(stderr, "kernel_launch: hipFuncSetAttribute failed\n"); grid = -1; return; }
        if (hipOccupancyMaxActiveBlocksPerMultiprocessor(&per_cu, (const void*)fwd_kernel, NTHR, LDS_BYTES) != hipSuccess || per_cu < 1) { fprintf(stderr, "kernel_launch: occupancy query gives %d\n", per_cu); grid = -1; return; }
        grid = cus * per_cu; if (grid > 256) grid = 256;
        if (grid < 128) { fprintf(stderr, "kernel_launch: grid %d too small\n", grid); grid = -1; return; }
    }
    if (grid < 0) return;
    if (hipMemsetAsync((char*)d_ws + WS_CTL, 0, 65536, stream) != hipSuccess) { fprintf(stderr, "kernel_launch: memset failed\n"); return; }
    Args a{};
    for (int i = 0; i < 36; ++i) a.in[i] = (const float*)d_in[i];
    a.out = (float*)d_out; a.ws = (unsigned char*)d_ws;
#if MK_ONE_LAUNCH
    a.ph_lo = 0; a.ph_hi = N_PHASES;
    void* args[] = {&a};
    hipError_t e = hipLaunchCooperativeKernel((const void*)fwd_kernel, dim3(grid), dim3(NTHR), args, LDS_BYTES, stream);
    if (e != hipSuccess) fprintf(stderr, "kernel_launch: cooperative launch failed: %s (grid %d)\n", hipGetErrorString(e), grid);
#else
    for (int ph = 0; ph < N_PHASES; ++ph) {
        a.ph_lo = ph; a.ph_hi = ph + 1;
        hipLaunchKernelGGL(fwd_kernel, dim3(grid), dim3(NTHR), LDS_BYTES, stream, a);
    }
    hipError_t e = hipPeekAtLastError();
    if (e != hipSuccess) fprintf(stderr, "kernel_launch: launch failed: %s\n", hipGetErrorString(e));
#endif
}
```
